# Optimizing an MI355X kernel written in HIP

```python
import math
import jax, jax.numpy as jnp
from jax import lax
import numpy as np

D_MODEL = 4096
BATCH = 4
SEQ = 4096
DEPTH = 2

N_META = 16
N_A_LAYERS = DEPTH // 2
N_B_LAYERS = DEPTH - N_A_LAYERS
EPS = 1e-6

M_HEADS = 8
M_QK_DIM = D_MODEL // 2 // M_HEADS
M_V_DIM = D_MODEL // M_HEADS
M_QK_TOT = M_HEADS * M_QK_DIM
M_V_TOT = M_HEADS * M_V_DIM
M_CHUNK = 64
GATE_CAP = 15.0
M_IN_WIDTH = 2 * M_QK_TOT + 2 * M_V_TOT + 2 * M_HEADS
M_SPLITS = (M_QK_TOT, 2 * M_QK_TOT, 2 * M_QK_TOT + M_V_TOT,
            2 * M_QK_TOT + 2 * M_V_TOT, 2 * M_QK_TOT + 2 * M_V_TOT + M_HEADS)

A_HEADS = D_MODEL // 64
Q_LORA = D_MODEL // 4
KV_LORA = 512
NOPE_DIM = 128
ROPE_DIM = 64
V_HEAD_DIM = 128
QK_HEAD_DIM = NOPE_DIM + ROPE_DIM
ROPE_THETA = 10000.0
Q_BLOCK = 128

D_FF = -(-8 * D_MODEL // (3 * 256)) * 256

kernel_name = "yoco_mlstm_mla_hybrid"


def rms_norm(x, g):
    xf = x.astype(jnp.float32)
    y = xf * lax.rsqrt(jnp.mean(xf * xf, axis=-1, keepdims=True) + EPS)
    return (y * g.astype(jnp.float32)).astype(x.dtype)


def soft_cap(z):
    return GATE_CAP * jnp.tanh(z / GATE_CAP)


def rope_tables(pos):
    inv = 1.0 / (ROPE_THETA ** (jnp.arange(0, ROPE_DIM, 2, dtype=jnp.float32) / ROPE_DIM))
    ang = pos.astype(jnp.float32)[..., None] * inv
    return jnp.cos(ang), jnp.sin(ang)


def apply_rope(t, cos, sin):
    half = ROPE_DIM // 2
    t1, t2 = t[..., :half], t[..., half:]
    c, s = cos[:, :, None, :], sin[:, :, None, :]
    return jnp.concatenate([t1 * c - t2 * s, t1 * s + t2 * c], axis=-1).astype(t.dtype)


def mlstm_chunk(state, inp):
    c, n, m = state
    q, k, v, logi, logf = inp
    t_len = q.shape[2]
    b = jnp.cumsum(logf, axis=-1)
    causal = jnp.tril(jnp.ones((t_len, t_len), dtype=bool))
    d = jnp.where(causal, b[..., :, None] - b[..., None, :] + logi[..., None, :], -jnp.inf)
    inter = b + m[..., None]
    m_t = jnp.maximum(inter, jnp.max(d, axis=-1))
    w = jnp.exp(d - m_t[..., None])
    a = jnp.exp(inter - m_t)
    s = jnp.einsum('bhtd,bhsd->bhts', q, k) * w
    num = a[..., None] * jnp.einsum('bhtd,bhde->bhte', q, c) + jnp.einsum('bhts,bhse->bhte', s, v)
    den = a * jnp.einsum('bhtd,bhd->bht', q, n) + jnp.sum(s, axis=-1)
    h = num / jnp.maximum(jnp.abs(den), jnp.exp(-m_t))[..., None]
    b_last = b[..., -1]
    g = b_last[..., None] - b + logi
    m_new = jnp.maximum(b_last + m, jnp.max(g, axis=-1))
    decay = jnp.exp(b_last + m - m_new)
    kw = k * jnp.exp(g - m_new[..., None])[..., None]
    c_new = decay[..., None, None] * c + jnp.einsum('bhsd,bhse->bhde', kw, v)
    n_new = decay[..., None] * n + jnp.sum(kw, axis=2)
    return (c_new, n_new, m_new), h


def to_chunks(t):
    b_, h_, s_ = t.shape[:3]
    t = t.reshape((b_, h_, s_ // M_CHUNK, M_CHUNK) + t.shape[3:])
    return jnp.moveaxis(t, 2, 0)


def mlstm_mixer(xn, w_in, b_i, b_f, g_out, w_out):
    bsz, length, _ = xn.shape
    proj = xn @ w_in
    q, k, v, o, gi, gf = jnp.split(proj, M_SPLITS, axis=-1)

    def heads(t, dim):
        return t.reshape(bsz, length, M_HEADS, dim).transpose(0, 2, 1, 3).astype(jnp.float32)

    q = heads(q, M_QK_DIM)
    k = heads(k, M_QK_DIM) * (M_QK_DIM ** -0.5)
    v = heads(v, M_V_DIM)
    logi = soft_cap(gi.astype(jnp.float32) + b_i.astype(jnp.float32)).transpose(0, 2, 1)
    logf = jax.nn.log_sigmoid(soft_cap(gf.astype(jnp.float32) + b_f.astype(jnp.float32))).transpose(0, 2, 1)
    state0 = (jnp.zeros((bsz, M_HEADS, M_QK_DIM, M_V_DIM), jnp.float32),
              jnp.zeros((bsz, M_HEADS, M_QK_DIM), jnp.float32),
              jnp.zeros((bsz, M_HEADS), jnp.float32))
    seqs = (q, k, v, logi, logf)
    state, h_meta = mlstm_chunk(state0, tuple(t[:, :, :N_META] for t in seqs))
    _, h_rest = lax.scan(mlstm_chunk, state, tuple(to_chunks(t[:, :, N_META:]) for t in seqs))
    h_rest = jnp.moveaxis(h_rest, 0, 2).reshape(bsz, M_HEADS, length - N_META, M_V_DIM)
    hh = jnp.concatenate([h_meta, h_rest], axis=2).transpose(0, 2, 1, 3)
    hh = rms_norm(hh, g_out.reshape(M_HEADS, M_V_DIM))
    out = (hh.reshape(bsz, length, M_V_TOT) * jax.nn.sigmoid(o.astype(jnp.float32))).astype(xn.dtype)
    return out @ w_out


def swiglu(xn, w_gate_up, w_down):
    g, u = jnp.split(xn @ w_gate_up, 2, axis=-1)
    return (jax.nn.silu(g) * u) @ w_down


def shared_mla_kv(h, g_in, w_down, g_latent, w_up, g_k, cos, sin):
    bsz, length, _ = h.shape
    a = rms_norm(h, g_in) @ w_down
    c_kv, k_rope = a[..., :KV_LORA], a[..., KV_LORA:]
    kv = (rms_norm(c_kv, g_latent) @ w_up).reshape(bsz, length, A_HEADS, NOPE_DIM + V_HEAD_DIM)
    k_nope, v = kv[..., :NOPE_DIM], kv[..., NOPE_DIM:]
    k_rope = jnp.broadcast_to(k_rope[:, :, None, :], (bsz, length, A_HEADS, ROPE_DIM))
    k = rms_norm(jnp.concatenate([k_nope, k_rope], axis=-1), g_k)
    k = jnp.concatenate([k[..., :NOPE_DIM], apply_rope(k[..., NOPE_DIM:], cos, sin)], axis=-1)
    return k.transpose(0, 2, 1, 3), v.transpose(0, 2, 1, 3)


def causal_block_attention(q, k, v):
    length = q.shape[2]
    bounds = [0] + list(range(N_META, length, Q_BLOCK)) + [length]
    scale = QK_HEAD_DIM ** -0.5
    outs = []
    for lo, hi in zip(bounds[:-1], bounds[1:]):
        s = jnp.einsum('bhqd,bhkd->bhqk', q[:, :, lo:hi], k[:, :, :hi],
                       preferred_element_type=jnp.float32) * scale
        mask = (lo + jnp.arange(hi - lo))[:, None] >= jnp.arange(hi)[None, :]
        p = jax.nn.softmax(jnp.where(mask, s, -jnp.inf), axis=-1)
        outs.append(jnp.einsum('bhqk,bhkd->bhqd', p.astype(v.dtype), v[:, :, :hi]))
    return jnp.concatenate(outs, axis=2)


def mla_mixer(xn, k, v, w_dq, g_q_latent, w_uq, g_q, w_o, cos, sin):
    bsz, length, _ = xn.shape
    c_q = rms_norm(xn @ w_dq, g_q_latent)
    q = rms_norm((c_q @ w_uq).reshape(bsz, length, A_HEADS, QK_HEAD_DIM), g_q)
    q = jnp.concatenate([q[..., :NOPE_DIM], apply_rope(q[..., NOPE_DIM:], cos, sin)], axis=-1)
    o = causal_block_attention(q.transpose(0, 2, 1, 3), k, v)
    return o.transpose(0, 2, 1, 3).reshape(bsz, length, A_HEADS * V_HEAD_DIM) @ w_o


def setup_inputs(seed: int = 0) -> dict:
    key = jax.random.key(seed)
    ks = jax.random.split(key, 32)
    f32 = jnp.float32

    def nrm(k, shape, fan_in):
        return jax.random.normal(k, shape, f32) * (fan_in ** -0.5)

    def gain(k, shape):
        return 1.0 + 0.02 * jax.random.normal(k, shape, f32)

    x = jax.random.normal(ks[0], (BATCH, SEQ, D_MODEL), f32)
    offsets = jax.random.randint(ks[1], (BATCH, 1), 0, 256, dtype=jnp.int32)
    positions = (offsets + jnp.arange(SEQ, dtype=jnp.int32)[None, :]).astype(jnp.int32)
    meta_tokens = jax.random.normal(ks[2], (N_META, D_MODEL), f32)
    a_b_f = (jnp.broadcast_to(jnp.linspace(3.0, 6.0, M_HEADS, dtype=f32), (N_A_LAYERS, M_HEADS))
             + 0.1 * jax.random.normal(ks[6], (N_A_LAYERS, M_HEADS), f32))
    return {
        "x": x,
        "positions": positions,
        "meta_tokens": meta_tokens,
        "a_norm_g": gain(ks[3], (N_A_LAYERS, D_MODEL)),
        "a_w_in": nrm(ks[4], (N_A_LAYERS, D_MODEL, M_IN_WIDTH), D_MODEL),
        "a_b_i": 0.1 * jax.random.normal(ks[5], (N_A_LAYERS, M_HEADS), f32),
        "a_b_f": a_b_f,
        "a_out_norm_g": gain(ks[7], (N_A_LAYERS, M_V_TOT)),
        "a_w_out": nrm(ks[8], (N_A_LAYERS, M_V_TOT, D_MODEL), M_V_TOT),
        "ffn_norm_g": gain(ks[9], (DEPTH, D_MODEL)),
        "ffn_w_gate_up": nrm(ks[10], (DEPTH, D_MODEL, 2 * D_FF), D_MODEL),
        "ffn_w_down": nrm(ks[11], (DEPTH, D_FF, D_MODEL), D_FF),
        "kv_norm_g": gain(ks[12], (D_MODEL,)),
        "kv_w_down": nrm(ks[13], (D_MODEL, KV_LORA + ROPE_DIM), D_MODEL),
        "kv_latent_norm_g": gain(ks[14], (KV_LORA,)),
        "kv_w_up": nrm(ks[15], (KV_LORA, A_HEADS * (NOPE_DIM + V_HEAD_DIM)), KV_LORA),
        "k_norm_g": gain(ks[16], (QK_HEAD_DIM,)),
        "b_norm_g": gain(ks[17], (N_B_LAYERS, D_MODEL)),
        "b_w_dq": nrm(ks[18], (N_B_LAYERS, D_MODEL, Q_LORA), D_MODEL),
        "b_q_latent_norm_g": gain(ks[19], (N_B_LAYERS, Q_LORA)),
        "b_w_uq": nrm(ks[20], (N_B_LAYERS, Q_LORA, A_HEADS * QK_HEAD_DIM), Q_LORA),
        "q_norm_g": gain(ks[21], (N_B_LAYERS, QK_HEAD_DIM)),
        "b_w_o": nrm(ks[22], (N_B_LAYERS, A_HEADS * V_HEAD_DIM, D_MODEL), A_HEADS * V_HEAD_DIM),
    }


def reference(x, positions, meta_tokens, a_norm_g, a_w_in, a_b_i, a_b_f, a_out_norm_g, a_w_out,
              ffn_norm_g, ffn_w_gate_up, ffn_w_down, kv_norm_g, kv_w_down, kv_latent_norm_g,
              kv_w_up, k_norm_g, b_norm_g, b_w_dq, b_q_latent_norm_g, b_w_uq, q_norm_g, b_w_o):
    bsz = x.shape[0]
    meta = jnp.broadcast_to(meta_tokens[None].astype(x.dtype), (bsz, N_META, D_MODEL))
    h = jnp.concatenate([meta, x], axis=1)
    meta_pos = jnp.broadcast_to(jnp.arange(N_META, dtype=jnp.int32)[None, :], (bsz, N_META))
    pos = jnp.concatenate([meta_pos, positions.astype(jnp.int32) + N_META], axis=1)
    cos, sin = rope_tables(pos)
    k_shared, v_shared = None, None
    for layer in range(DEPTH):
        if layer < N_A_LAYERS:
            i = layer
            h = h + mlstm_mixer(rms_norm(h, a_norm_g[i]), a_w_in[i], a_b_i[i], a_b_f[i],
                                a_out_norm_g[i], a_w_out[i])
        else:
            j = layer - N_A_LAYERS
            if j == 0:
                k_shared, v_shared = shared_mla_kv(h, kv_norm_g, kv_w_down, kv_latent_norm_g,
                                                   kv_w_up, k_norm_g, cos, sin)
            h = h + mla_mixer(rms_norm(h, b_norm_g[j]), k_shared, v_shared, b_w_dq[j],
                              b_q_latent_norm_g[j], b_w_uq[j], q_norm_g[j], b_w_o[j], cos, sin)
        h = h + swiglu(rms_norm(h, ffn_norm_g[layer]), ffn_w_gate_up[layer], ffn_w_down[layer])
    return h[:, N_META:]
```

```cpp
#include <hip/hip_runtime.h>
#include <cstdio>
#include <cstdint>
#ifndef MK_N_LAUNCHES
#define MK_N_LAUNCHES 0
#endif
#undef MK_N_LAUNCHES
#define MK_N_LAUNCHES 1
namespace pg8 {
#define PG8_LAS __attribute__((address_space(3)))
typedef unsigned short bf16_t;
typedef short bf16x8 __attribute__((ext_vector_type(8)));
typedef float f32x4 __attribute__((ext_vector_type(4)));
typedef unsigned u32x4 __attribute__((ext_vector_type(4)));
constexpr int BM = 256, BK = 64, HALF = 128, HTB = HALF * BK * 2  , STAGE_BYTES = 8 * HTB, NXCD = 8, WGM = 8;

__host__ __device__ __forceinline__ int lds_byte(int r, int c) { const int st = (r >> 4) * 2 + (c >> 5), rr = r & 15, cc = c & 31, ob = rr * 64 + cc * 2; return st * 1024 + (ob ^ (((ob >> 9) & 1) << 5)); }
__host__ __device__ __forceinline__ void stage_rc(int b, int& R, int& C) { const int st = b / 1024, sb = b % 1024, swz = sb ^ (((sb >> 9) & 1) << 5); R = (st >> 1) * 16 + swz / 64; C = (st & 1) * 32 + (swz % 64) / 2; }
__host__ __device__ __forceinline__ int perm32(int rho) { const int n = rho >> 4, i = rho & 15; return 8 * (i >> 2) + 4 * n + (i & 3); }

struct Unit { int pm, pn; };
struct Gemm { const bf16_t* A; const bf16_t* Bt; int M, N, K; int sB = 0x7F7F7F7F, sA = 0x7F7F7F7F; };
typedef int i32x8 __attribute__((ext_vector_type(8))); typedef int i32x4 __attribute__((ext_vector_type(4)));
__device__ __forceinline__ i32x8 cat8(bf16x8 a, bf16x8 b) { const i32x4 x = __builtin_bit_cast(i32x4, a), y = __builtin_bit_cast(i32x4, b); return __builtin_shufflevector(x, y, 0, 1, 2, 3, 4, 5, 6, 7); }

struct StaticOrder {
    int nM, nN, nwg, G, c;
    __host__ __device__ void init(int M, int N, int G_, int c_) { nM = M / BM; nN = N / BM; nwg = nM * nN; G = G_; c = c_; }
    __host__ __device__ bool next(int i, Unit& u) const {
        const long L = (long)i * G + c; if (L >= nwg) return false;
        int wgid = (int)L; { const int q = nwg / NXCD, r = nwg % NXCD, xcd = wgid % NXCD, off = wgid / NXCD; wgid = (xcd < r ? xcd * (q + 1) : r * (q + 1) + (xcd - r) * q) + off; }
        const int nig = WGM * nN, gid = wgid / nig, fm = gid * WGM, gsz = (nM - fm) < WGM ? (nM - fm) : WGM;
        u.pm = fm + ((wgid % nig) % gsz); u.pn = (wgid % nig) / gsz; return true;
    }
    __device__ __forceinline__ void a_ready(const Unit&) const {}
    __device__ __forceinline__ void done(const Unit&) const {}
};

typedef float f32x2_cv __attribute__((ext_vector_type(2))); typedef __bf16 bf16x2_cv __attribute__((ext_vector_type(2)));
__device__ __forceinline__ unsigned cvt_pk_bf16(float lo, float hi) { const f32x2_cv v = {lo, hi}; const bf16x2_cv b = __builtin_convertvector(v, bf16x2_cv); return __builtin_bit_cast(unsigned, b); }
__host__ __device__ __forceinline__ int v_img_off8(int k, int d) { return k * 128 + ((((d >> 5) ^ (((k >> 1) & 1) | (((k >> 3) & 1) << 1))) & 3) << 5) + (d & 31); }
__host__ __device__ __forceinline__ int v_st(int k, int c) { const int kk = (k & ~0xC) | ((k & 4) << 1) | ((k & 8) >> 1); return ((kk >> 3) * 4 + (c >> 5)) * 512 + ((kk & 7) * 32 + (c & 31)) * 2; }

struct EpiBf16 {
    static constexpr bool PERM = true, AFTER_DRAIN = false, INIT = false;
    bf16_t* O; int ldc;
    __device__ __forceinline__ void operator()(const f32x4 (&acc)[2][2][4][2], const Unit& u, int wr, int wc, int fr, int fq) const {
        const int row0 = u.pm * BM + wr * 64 + fr, col0 = u.pn * BM + wc * 32 + 8 * fq;
#pragma unroll
        for (int ai = 0; ai < 2; ++ai)
#pragma unroll
            for (int m = 0; m < 4; ++m) { bf16_t* rowp = O + (size_t)(row0 + ai * HALF + m * 16) * ldc + col0;
#pragma unroll
                for (int bj = 0; bj < 2; ++bj) { const f32x4 v0 = acc[ai][bj][m][0], v1 = acc[ai][bj][m][1];
                    u32x4 w; w.x = cvt_pk_bf16(v0[0], v0[1]); w.y = cvt_pk_bf16(v0[2], v0[3]); w.z = cvt_pk_bf16(v1[0], v1[1]); w.w = cvt_pk_bf16(v1[2], v1[3]);
                    *(u32x4*)(rowp + bj * HALF) = w; } }
    }
};
struct EpiF32 {
    static constexpr bool PERM = false, AFTER_DRAIN = false, INIT = false;
    float* C; int ldc;
    __device__ __forceinline__ void operator()(const f32x4 (&acc)[2][2][4][2], const Unit& u, int wr, int wc, int fr, int fq) const {
        const int row0 = u.pm * BM + wr * 64 + fr, col0 = u.pn * BM + wc * 32 + 4 * fq;
#pragma unroll
        for (int ai = 0; ai < 2; ++ai)
#pragma unroll
            for (int m = 0; m < 4; ++m) { float* rowp = C + (size_t)(row0 + ai * HALF + m * 16) * ldc + col0;
#pragma unroll
                for (int bj = 0; bj < 2; ++bj)
#pragma unroll
                    for (int n = 0; n < 2; ++n) *(f32x4*)(rowp + bj * HALF + n * 16) = acc[ai][bj][m][n]; }
    }
};
struct EpiResF32 {
    static constexpr bool PERM = false, AFTER_DRAIN = false, INIT = false;
    const float* base; float* out; int ldc;
    __device__ __forceinline__ void init(f32x4 (&acc)[2][2][4][2], const Unit& u, int wr, int wc, int fr, int fq) const {}
    __device__ __forceinline__ void operator()(const f32x4 (&acc)[2][2][4][2], const Unit& u, int wr, int wc, int fr, int fq) const {
        const int row0 = u.pm * BM + wr * 64 + fr, col0 = u.pn * BM + wc * 32 + 4 * fq;
#pragma unroll
        for (int ai = 0; ai < 2; ++ai)
#pragma unroll
            for (int m = 0; m < 4; ++m) { const size_t off = (size_t)(row0 + ai * HALF + m * 16) * ldc + col0;
#pragma unroll
                for (int bj = 0; bj < 2; ++bj)
#pragma unroll
                    for (int n = 0; n < 2; ++n) { const f32x4 b = *(const f32x4*)(base + off + bj * HALF + n * 16); *(f32x4*)(out + off + bj * HALF + n * 16) = b + acc[ai][bj][m][n]; } }
    }
};
typedef _Float16 f16_t; typedef _Float16 f16x2_cv __attribute__((ext_vector_type(2)));
__device__ __forceinline__ unsigned cvt_pk_f16(float lo, float hi) { const f32x2_cv v = {lo, hi}; const f16x2_cv b = __builtin_convertvector(v, f16x2_cv); return __builtin_bit_cast(unsigned, b); }
__device__ __forceinline__ float f16lo(unsigned w) { return (float)__builtin_bit_cast(f16x2_cv, w)[0]; }
__device__ __forceinline__ float f16hi(unsigned w) { return (float)__builtin_bit_cast(f16x2_cv, w)[1]; }
template <class TI, class TO> struct EpiRes {
    static constexpr bool PERM = true, AFTER_DRAIN = false, INIT = false;
    const TI* base; TO* out; int ldc;
    __device__ __forceinline__ void operator()(const f32x4 (&acc)[2][2][4][2], const Unit& u, int wr, int wc, int fr, int fq) const {
        const int row0 = u.pm * BM + wr * 64 + fr, col0 = u.pn * BM + wc * 32 + 8 * fq;
#pragma unroll
        for (int ai = 0; ai < 2; ++ai)
#pragma unroll
            for (int m = 0; m < 4; ++m) { const size_t off = (size_t)(row0 + ai * HALF + m * 16) * ldc + col0;
#pragma unroll
                for (int bj = 0; bj < 2; ++bj) { f32x4 v0 = acc[ai][bj][m][0], v1 = acc[ai][bj][m][1];
                    if constexpr (sizeof(TI) == 4) { v0 += *(const f32x4*)(base + off + bj * HALF); v1 += *(const f32x4*)(base + off + bj * HALF + 4); }
                    else { const u32x4 b = *(const u32x4*)(base + off + bj * HALF);
                        v0[0] += f16lo(b.x); v0[1] += f16hi(b.x); v0[2] += f16lo(b.y); v0[3] += f16hi(b.y); v1[0] += f16lo(b.z); v1[1] += f16hi(b.z); v1[2] += f16lo(b.w); v1[3] += f16hi(b.w); }
                    if constexpr (sizeof(TO) == 4) { *(f32x4*)(out + off + bj * HALF) = v0; *(f32x4*)(out + off + bj * HALF + 4) = v1; }
                    else { u32x4 w; w.x = cvt_pk_f16(v0[0], v0[1]); w.y = cvt_pk_f16(v0[2], v0[3]); w.z = cvt_pk_f16(v1[0], v1[1]); w.w = cvt_pk_f16(v1[2], v1[3]); *(u32x4*)(out + off + bj * HALF) = w; } } }
    }
};
__device__ __forceinline__ float silu_mul(float g, float u) { return g * __builtin_amdgcn_rcpf(1.0f + __expf(-g)) * u; }
struct EpiSwiglu {
    static constexpr bool PERM = true, AFTER_DRAIN = false, INIT = false;
    bf16_t* O; int ldc;
    __device__ __forceinline__ void operator()(const f32x4 (&acc)[2][2][4][2], const Unit& u, int wr, int wc, int fr, int fq) const {
        const int row0 = u.pm * BM + wr * 64 + fr, col0 = u.pn * HALF + wc * 32 + 8 * fq;
#pragma unroll
        for (int ai = 0; ai < 2; ++ai)
#pragma unroll
            for (int m = 0; m < 4; ++m) { bf16_t* rowp = O + (size_t)(row0 + ai * HALF + m * 16) * ldc + col0;
                const f32x4 g0 = acc[ai][0][m][0], g1 = acc[ai][0][m][1], u0 = acc[ai][1][m][0], u1 = acc[ai][1][m][1];
                u32x4 w; w.x = cvt_pk_bf16(silu_mul(g0[0], u0[0]), silu_mul(g0[1], u0[1])); w.y = cvt_pk_bf16(silu_mul(g0[2], u0[2]), silu_mul(g0[3], u0[3]));
                w.z = cvt_pk_bf16(silu_mul(g1[0], u1[0]), silu_mul(g1[1], u1[1])); w.w = cvt_pk_bf16(silu_mul(g1[2], u1[2]), silu_mul(g1[3], u1[3]));
                *(u32x4*)rowp = w; }
    }
};
struct EpiKvUp {
    static constexpr bool PERM = true, AFTER_DRAIN = false, INIT = false;
    bf16_t* KN; bf16_t* V;
    __device__ __forceinline__ void operator()(const f32x4 (&acc)[2][2][4][2], const Unit& u, int wr, int wc, int fr, int fq) const {
        const int row0 = u.pm * BM + wr * 64 + fr, colL = wc * 32 + 8 * fq;
#pragma unroll
        for (int ai = 0; ai < 2; ++ai)
#pragma unroll
            for (int m = 0; m < 4; ++m) { const int row = row0 + ai * HALF + m * 16, b = row >> 12, key = 16 + (row & 4095);
#pragma unroll
                for (int bj = 0; bj < 2; ++bj) { const f32x4 v0 = acc[ai][bj][m][0], v1 = acc[ai][bj][m][1];
                    u32x4 w; w.x = cvt_pk_bf16(v0[0], v0[1]); w.y = cvt_pk_bf16(v0[2], v0[3]); w.z = cvt_pk_bf16(v1[0], v1[1]); w.w = cvt_pk_bf16(v1[2], v1[3]);
                    if (bj == 0) *(u32x4*)(KN + (size_t)row * 8192 + u.pn * HALF + colL) = w;
                    else { typedef unsigned u32x2 __attribute__((ext_vector_type(2))); u32x2 w8;
                        int x = __builtin_amdgcn_cvt_pk_fp8_f32(v0[0] * 16.f, v0[1] * 16.f, 0, false); x = __builtin_amdgcn_cvt_pk_fp8_f32(v0[2] * 16.f, v0[3] * 16.f, x, true); w8.x = (unsigned)x;
                        x = __builtin_amdgcn_cvt_pk_fp8_f32(v1[0] * 16.f, v1[1] * 16.f, 0, false); x = __builtin_amdgcn_cvt_pk_fp8_f32(v1[2] * 16.f, v1[3] * 16.f, x, true); w8.y = (unsigned)x;
                        *(u32x2*)((char*)V + ((size_t)((b * 64 + u.pn) * 65 + (key >> 6))) * 8192 + v_img_off8(key & 63, colL)) = w8; } } }
    }
};
struct EpiF16 {
    static constexpr bool PERM = true, AFTER_DRAIN = false, INIT = false;
    f16_t* O; int ldc;
    __device__ __forceinline__ void operator()(const f32x4 (&acc)[2][2][4][2], const Unit& u, int wr, int wc, int fr, int fq) const {
        const int row0 = u.pm * BM + wr * 64 + fr, col0 = u.pn * BM + wc * 32 + 8 * fq;
#pragma unroll
        for (int ai = 0; ai < 2; ++ai)
#pragma unroll
            for (int m = 0; m < 4; ++m) { f16_t* rowp = O + (size_t)(row0 + ai * HALF + m * 16) * ldc + col0;
#pragma unroll
                for (int bj = 0; bj < 2; ++bj) { const f32x4 v0 = acc[ai][bj][m][0], v1 = acc[ai][bj][m][1];
                    u32x4 w; w.x = cvt_pk_f16(v0[0], v0[1]); w.y = cvt_pk_f16(v0[2], v0[3]); w.z = cvt_pk_f16(v1[0], v1[1]); w.w = cvt_pk_f16(v1[2], v1[3]);
                    *(u32x4*)(rowp + bj * HALF) = w; } }
    }
};
struct EpiF8 {
    static constexpr bool PERM = true, AFTER_DRAIN = false, INIT = false;
    unsigned char* O; int ldc;
    __device__ __forceinline__ void operator()(const f32x4 (&acc)[2][2][4][2], const Unit& u, int wr, int wc, int fr, int fq) const {
        typedef unsigned u32x2 __attribute__((ext_vector_type(2)));
        const int row0 = u.pm * BM + wr * 64 + fr, col0 = u.pn * BM + wc * 32 + 8 * fq;
#pragma unroll
        for (int ai = 0; ai < 2; ++ai)
#pragma unroll
            for (int m = 0; m < 4; ++m) { unsigned char* rowp = O + (size_t)(row0 + ai * HALF + m * 16) * ldc + col0;
#pragma unroll
                for (int bj = 0; bj < 2; ++bj) { const f32x4 v0 = acc[ai][bj][m][0], v1 = acc[ai][bj][m][1]; u32x2 w8;
                    int x = __builtin_amdgcn_cvt_pk_fp8_f32(v0[0] * 16.f, v0[1] * 16.f, 0, false); x = __builtin_amdgcn_cvt_pk_fp8_f32(v0[2] * 16.f, v0[3] * 16.f, x, true); w8.x = (unsigned)x;
                    x = __builtin_amdgcn_cvt_pk_fp8_f32(v1[0] * 16.f, v1[1] * 16.f, 0, false); x = __builtin_amdgcn_cvt_pk_fp8_f32(v1[2] * 16.f, v1[3] * 16.f, x, true); w8.y = (unsigned)x;
                    *(u32x2*)(rowp + bj * HALF) = w8; } }
    }
};
__host__ __device__ __forceinline__ int k_img_off8(int r, int d) { return r * 192 + ((((d >> 4) + (r >> 2)) % 12) << 4) + (d & 15); }
struct EpiKvUpK {
    static constexpr bool PERM = true, AFTER_DRAIN = false, INIT = false;
    unsigned char* Kimg; bf16_t* V; const float* PRE; const float* SSR; const float* gk; PG8_LAS float* red;
    __device__ __forceinline__ void operator()(const f32x4 (&acc)[2][2][4][2], const Unit& u, int wr, int wc, int fr, int fq) const {
        typedef unsigned u32x2 __attribute__((ext_vector_type(2)));
        asm volatile("" : "+v"(fr), "+v"(fq));
        const int rl0 = wr * 64 + fr, colL = wc * 32 + 8 * fq;
#pragma unroll
        for (int j = 0; j < 8; ++j) { const f32x4 v0 = acc[j >> 2][0][j & 3][0], v1 = acc[j >> 2][0][j & 3][1];
            float s = ((v0[0] * v0[0] + v0[1] * v0[1]) + (v0[2] * v0[2] + v0[3] * v0[3])) + ((v1[0] * v1[0] + v1[1] * v1[1]) + (v1[2] * v1[2] + v1[3] * v1[3]));
            s += __shfl_xor(s, 16); s += __shfl_xor(s, 32);
            if (fq == 0) red[(rl0 + (j >> 2) * HALF + (j & 3) * 16) * 4 + wc] = s; }
        asm volatile("s_waitcnt lgkmcnt(0)" ::: "memory"); __builtin_amdgcn_s_barrier(); asm volatile("" ::: "memory");
        int rowv = u.pm * BM + rl0; asm volatile("" : "+v"(rowv));
        const int rlA = rl0 + (fq >> 1) * HALF + (fq & 1) * 32, rowA = rowv + (fq >> 1) * HALF + (fq & 1) * 32;
        float rA, rB;
        { const float sA = SSR[(unsigned)rowA], sB = SSR[(unsigned)rowA + 16u]; const f32x4 tA = *(const PG8_LAS f32x4*)(red + rlA * 4), tB = *(const PG8_LAS f32x4*)(red + (rlA + 16) * 4);
          rA = 16.0f / sqrtf((((tA[0] + tA[1]) + (tA[2] + tA[3])) + sA) * (1.0f / 192.0f) + 1e-6f); rB = 16.0f / sqrtf((((tB[0] + tB[1]) + (tB[2] + tB[3])) + sB) * (1.0f / 192.0f) + 1e-6f); }
        __builtin_amdgcn_sched_barrier(0);
        const f32x4 ga = *(const f32x4*)(gk + colL), gb = *(const f32x4*)(gk + colL + 4);
#pragma unroll
        for (int j = 0; j < 8; ++j) { const int row = rowv + (j >> 2) * HALF + (j & 3) * 16, key = 16 + (row & 4095); const unsigned tile = (unsigned)(((row >> 12) * 64 + u.pn) * 65 + (key >> 6));
            const float rr = __shfl((j & 1) ? rB : rA, fr + 16 * (j >> 1));
            { const f32x4 v0 = acc[j >> 2][0][j & 3][0], v1 = acc[j >> 2][0][j & 3][1]; u32x2 w8;
                int x = __builtin_amdgcn_cvt_pk_fp8_f32(v0[0] * ga[0] * rr, v0[1] * ga[1] * rr, 0, false); x = __builtin_amdgcn_cvt_pk_fp8_f32(v0[2] * ga[2] * rr, v0[3] * ga[3] * rr, x, true); w8.x = (unsigned)x;
                x = __builtin_amdgcn_cvt_pk_fp8_f32(v1[0] * gb[0] * rr, v1[1] * gb[1] * rr, 0, false); x = __builtin_amdgcn_cvt_pk_fp8_f32(v1[2] * gb[2] * rr, v1[3] * gb[3] * rr, x, true); w8.y = (unsigned)x;
                *(u32x2*)(Kimg + (tile * 12288u + (unsigned)k_img_off8(key & 63, colL))) = w8; }
            { const f32x4 v0 = acc[j >> 2][1][j & 3][0], v1 = acc[j >> 2][1][j & 3][1]; u32x2 w8;
                int x = __builtin_amdgcn_cvt_pk_fp8_f32(v0[0] * 16.f, v0[1] * 16.f, 0, false); x = __builtin_amdgcn_cvt_pk_fp8_f32(v0[2] * 16.f, v0[3] * 16.f, x, true); w8.x = (unsigned)x;
                x = __builtin_amdgcn_cvt_pk_fp8_f32(v1[0] * 16.f, v1[1] * 16.f, 0, false); x = __builtin_amdgcn_cvt_pk_fp8_f32(v1[2] * 16.f, v1[3] * 16.f, x, true); w8.y = (unsigned)x;
                *(u32x2*)((unsigned char*)V + (tile * 8192u + (unsigned)v_img_off8(key & 63, colL))) = w8; }
            if (j & 1) __builtin_amdgcn_sched_barrier(0); }
#pragma unroll
        for (int x2 = 0; x2 < 2; ++x2) { const float rr = x2 ? rB : rA;
            const int row = rowA + 16 * x2, key = 16 + (row & 4095); const unsigned tile = (unsigned)(((row >> 12) * 64 + u.pn) * 65 + (key >> 6));
            const float* pp = (const float*)((const char*)PRE + (unsigned)(row * 256 + 64 * wc)); const f32x4 p0 = *(const f32x4*)pp, p1 = *(const f32x4*)(pp + 4), p2 = *(const f32x4*)(pp + 8), p3 = *(const f32x4*)(pp + 12);
            u32x4 w; int x = __builtin_amdgcn_cvt_pk_fp8_f32(p0[0] * rr, p0[1] * rr, 0, false); x = __builtin_amdgcn_cvt_pk_fp8_f32(p0[2] * rr, p0[3] * rr, x, true); w.x = (unsigned)x;
            x = __builtin_amdgcn_cvt_pk_fp8_f32(p1[0] * rr, p1[1] * rr, 0, false); x = __builtin_amdgcn_cvt_pk_fp8_f32(p1[2] * rr, p1[3] * rr, x, true); w.y = (unsigned)x;
            x = __builtin_amdgcn_cvt_pk_fp8_f32(p2[0] * rr, p2[1] * rr, 0, false); x = __builtin_amdgcn_cvt_pk_fp8_f32(p2[2] * rr, p2[3] * rr, x, true); w.z = (unsigned)x;
            x = __builtin_amdgcn_cvt_pk_fp8_f32(p3[0] * rr, p3[1] * rr, 0, false); x = __builtin_amdgcn_cvt_pk_fp8_f32(p3[2] * rr, p3[3] * rr, x, true); w.w = (unsigned)x;
            *(u32x4*)(Kimg + (tile * 12288u + (unsigned)k_img_off8(key & 63, 128 + 16 * wc))) = w;
            __builtin_amdgcn_sched_barrier(0); }
    }
};

template <class Epi, class Sched, bool ALIGN_EPI = false, bool SP2 = false, bool F8 = false>
__device__ __forceinline__ void gemm_phase(PG8_LAS unsigned char* lds, const Gemm g, const Sched& S, const Epi& E, int wave_id) {
    const int wid = wave_id, lane = (int)__builtin_amdgcn_mbcnt_hi(~0u, __builtin_amdgcn_mbcnt_lo(~0u, 0u)), tid = wid * 64 + lane, wr = wid >> 2, wc = wid & 3, fr = lane & 15, fq = lane >> 4;
    const int K = g.K, nt = K / BK;
    unsigned voffA[2], voffB[2];
#pragma unroll
    for (int i = 0; i < 2; ++i) { int R, C; stage_rc(tid * 16 + i * 8192, R, C); const int Rb = Epi::PERM ? ((R & ~31) + perm32(R & 31)) : R;
        voffA[i] = (unsigned)(R * K + C) * 2u; voffB[i] = (unsigned)(Rb * K + C) * 2u; }
    const size_t kstep = (size_t)(BK * 2);
    const size_t hstep = (size_t)HALF * K * 2;
    const size_t tstep = 2 * hstep;
    const unsigned ldsw = (unsigned)wid * 1024u;
    const int aoff = lds_byte(wr * 64 + fr, fq * 8), boff = lds_byte(wc * 32 + fr, fq * 8);
#define PG8_SA(b, h) (((b) * 2 + (h)) * HTB)
#define PG8_SB(b, h) ((4 + (b) * 2 + (h)) * HTB)
#define PG8_STAGE(bufoff, gbase, voff) do { _Pragma("unroll") for (int _i = 0; _i < 2; ++_i) \
        __builtin_amdgcn_global_load_lds((const unsigned*)((const char*)(gbase) + (voff)[_i]), (PG8_LAS unsigned*)(lds + (bufoff) + ldsw + _i * 8192), 16, 0, 0); } while (0)
#define PG8_LDA(dst, b, h) do { if constexpr (F8) { _Pragma("unroll") for (int m = 0; m < 4; ++m) dst##8[m] = cat8(*(const PG8_LAS bf16x8*)(lds + PG8_SA(b, h) + aoff + m * 2048), *(const PG8_LAS bf16x8*)(lds + PG8_SA(b, h) + aoff + m * 2048 + 1024)); } \
        else { _Pragma("unroll") for (int m = 0; m < 4; ++m) _Pragma("unroll") for (int k = 0; k < 2; ++k) dst[m][k] = *(const PG8_LAS bf16x8*)(lds + PG8_SA(b, h) + aoff + m * 2048 + k * 1024); } } while (0)
#define PG8_LDB(dst, b, h) do { if constexpr (F8) { _Pragma("unroll") for (int n = 0; n < 2; ++n) dst##8[n] = cat8(*(const PG8_LAS bf16x8*)(lds + PG8_SB(b, h) + boff + n * 2048), *(const PG8_LAS bf16x8*)(lds + PG8_SB(b, h) + boff + n * 2048 + 1024)); } \
        else { _Pragma("unroll") for (int n = 0; n < 2; ++n) _Pragma("unroll") for (int k = 0; k < 2; ++k) dst[n][k] = *(const PG8_LAS bf16x8*)(lds + PG8_SB(b, h) + boff + n * 2048 + k * 1024); } } while (0)
#define PG8_MMA(ai, bj, At, Bt) do { __builtin_amdgcn_s_setprio(1); \
        if constexpr (F8) { _Pragma("unroll") for (int m = 0; m < 4; ++m) _Pragma("unroll") for (int n = 0; n < 2; ++n) \
            asm volatile("v_mfma_scale_f32_16x16x128_f8f6f4 %0, %1, %2, %0, %3, %4 op_sel_hi:[0,0,0]" : "+v"(acc[ai][bj][m][n]) : "v"(Bt##8[n]), "v"(At##8[m]), "v"(f8sB), "v"(f8sA)); } \
        else { _Pragma("unroll") for (int m = 0; m < 4; ++m) _Pragma("unroll") for (int n = 0; n < 2; ++n) _Pragma("unroll") for (int k = 0; k < 2; ++k) \
            acc[ai][bj][m][n] = __builtin_amdgcn_mfma_f32_16x16x32_bf16(Bt[n][k], At[m][k], acc[ai][bj][m][n], 0, 0, 0); } \
        __builtin_amdgcn_s_setprio(0); } while (0)
#define PG8_WAIT_V(n) asm volatile("s_waitcnt vmcnt(" #n ")" ::: "memory")
#define PG8_WAIT_L(n) asm volatile("s_waitcnt lgkmcnt(" #n ")" ::: "memory")
#define PG8_BAR __builtin_amdgcn_s_barrier()
#define PG8_SCHED __builtin_amdgcn_sched_barrier(0)
    Unit cur, nxt; int ui = 0;
    if (!S.next(0, cur)) return;
    f32x4 acc[2][2][4][2];
    if constexpr (Epi::INIT) E.init(acc, cur, wr, wc, fr, fq);
    else {
#pragma unroll
    for (int a = 0; a < 2; ++a)
#pragma unroll
        for (int b = 0; b < 2; ++b)
#pragma unroll
            for (int m = 0; m < 4; ++m)
#pragma unroll
                for (int n = 0; n < 2; ++n) acc[a][b][m][n] = (f32x4){0.f, 0.f, 0.f, 0.f};
    }
    bf16x8 At[F8 ? 1 : 4][2], B0[F8 ? 1 : 2][2], B1[F8 ? 1 : 2][2];
    const int f8sB = g.sB, f8sA = g.sA;
    i32x8 At8[F8 ? 4 : 1], B08[F8 ? 2 : 1], B18[F8 ? 2 : 1];
    const char* cA = (const char*)g.A + (size_t)cur.pm * tstep; const char* cB = (const char*)g.Bt + (size_t)cur.pn * tstep;
    S.a_ready(cur);
    if constexpr (SP2) {
        PG8_STAGE(PG8_SB(0, 0), cB, voffB); PG8_STAGE(PG8_SB(0, 1), cB + hstep, voffB); PG8_STAGE(PG8_SA(0, 0), cA, voffA); PG8_STAGE(PG8_SA(0, 1), cA + hstep, voffA);
        if (wr == 1) PG8_BAR;
        PG8_WAIT_V(2); PG8_BAR;
        PG8_STAGE(PG8_SB(1, 0), cB + kstep, voffB); PG8_STAGE(PG8_SA(1, 0), cA + kstep, voffA); PG8_STAGE(PG8_SB(1, 1), cB + hstep + kstep, voffB);
        PG8_WAIT_V(6); PG8_BAR;
    } else {
        PG8_STAGE(PG8_SB(0, 0), cB, voffB); PG8_STAGE(PG8_SA(0, 0), cA, voffA); PG8_STAGE(PG8_SB(0, 1), cB + hstep, voffB); PG8_STAGE(PG8_SA(0, 1), cA + hstep, voffA);
        if (wr == 1) PG8_BAR;
        PG8_WAIT_V(4); PG8_BAR;
        PG8_STAGE(PG8_SB(1, 0), cB + kstep, voffB); PG8_STAGE(PG8_SA(1, 0), cA + kstep, voffA); PG8_STAGE(PG8_SB(1, 1), cB + hstep + kstep, voffB);
        PG8_WAIT_V(6); PG8_BAR;
    }
    for (;;) {
        const bool has_next = S.next(ui + 1, nxt);
        const char* nA = has_next ? (const char*)g.A + (size_t)nxt.pm * tstep : cA; const char* nB = has_next ? (const char*)g.Bt + (size_t)nxt.pn * tstep : cB;
        for (int t = 0; t < nt; t += 2) {
            const bool last = (t == nt - 2);
            const char* a1 = cA + (size_t)(t + 1) * kstep;
            const char* a2 = last ? nA : cA + (size_t)(t + 2) * kstep; const char* b2 = last ? nB : cB + (size_t)(t + 2) * kstep;
            const char* a3 = a2 + kstep; const char* b3 = b2 + kstep;
            if (last && has_next) S.a_ready(nxt);
            if constexpr (SP2) {
            PG8_LDB(B0, 0, 0); PG8_LDB(B1, 0, 1); PG8_SCHED; PG8_LDA(At, 0, 0); PG8_STAGE(PG8_SA(1, 1), a1 + hstep, voffA);
            PG8_WAIT_V(8); PG8_WAIT_L(0); PG8_BAR; PG8_MMA(0, 0, At, B0); PG8_MMA(0, 1, At, B1); PG8_BAR; PG8_SCHED;
            PG8_LDA(At, 0, 1); PG8_STAGE(PG8_SB(0, 0), b2, voffB); PG8_STAGE(PG8_SB(0, 1), b2 + hstep, voffB); PG8_STAGE(PG8_SA(0, 0), a2, voffA);
            PG8_WAIT_V(8); PG8_WAIT_L(0); PG8_BAR; PG8_MMA(1, 0, At, B0); PG8_MMA(1, 1, At, B1); PG8_BAR; PG8_SCHED;
            PG8_LDB(B0, 1, 0); PG8_LDB(B1, 1, 1); PG8_SCHED; PG8_LDA(At, 1, 0); PG8_STAGE(PG8_SA(0, 1), a2 + hstep, voffA);
            PG8_WAIT_V(8); PG8_WAIT_L(0); PG8_BAR; PG8_MMA(0, 0, At, B0); PG8_MMA(0, 1, At, B1); PG8_BAR; PG8_SCHED;
            PG8_LDA(At, 1, 1); PG8_STAGE(PG8_SB(1, 0), b3, voffB); PG8_STAGE(PG8_SB(1, 1), b3 + hstep, voffB); PG8_STAGE(PG8_SA(1, 0), a3, voffA);
            PG8_WAIT_V(8); PG8_WAIT_L(0); PG8_BAR; PG8_MMA(1, 0, At, B0); PG8_MMA(1, 1, At, B1); PG8_BAR; PG8_SCHED;
            } else {
            PG8_LDB(B0, 0, 0); PG8_SCHED; PG8_LDA(At, 0, 0); PG8_STAGE(PG8_SA(1, 1), a1 + hstep, voffA);
            PG8_WAIT_L(8); PG8_BAR; PG8_WAIT_L(0); PG8_MMA(0, 0, At, B0); PG8_BAR; PG8_SCHED;
            PG8_LDB(B1, 0, 1); PG8_STAGE(PG8_SB(0, 0), b2, voffB);
            PG8_BAR; PG8_WAIT_L(0); PG8_MMA(0, 1, At, B1); PG8_BAR;
            PG8_LDA(At, 0, 1); PG8_STAGE(PG8_SA(0, 0), a2, voffA);
            PG8_BAR; PG8_WAIT_L(0); PG8_MMA(1, 0, At, B0); PG8_BAR; PG8_SCHED;
            PG8_STAGE(PG8_SB(0, 1), b2 + hstep, voffB);
            PG8_WAIT_V(6); PG8_BAR; PG8_MMA(1, 1, At, B1); PG8_BAR;
            PG8_LDB(B0, 1, 0); PG8_SCHED; PG8_LDA(At, 1, 0); PG8_STAGE(PG8_SA(0, 1), a2 + hstep, voffA);
            PG8_WAIT_L(8); PG8_BAR; PG8_WAIT_L(0); PG8_MMA(0, 0, At, B0); PG8_BAR; PG8_SCHED;
            PG8_LDB(B1, 1, 1); PG8_STAGE(PG8_SB(1, 0), b3, voffB);
            PG8_BAR; PG8_WAIT_L(0); PG8_MMA(0, 1, At, B1); PG8_BAR;
            PG8_LDA(At, 1, 1); PG8_STAGE(PG8_SA(1, 0), a3, voffA);
            PG8_BAR; PG8_WAIT_L(0); PG8_MMA(1, 0, At, B0); PG8_BAR; PG8_SCHED;
            PG8_STAGE(PG8_SB(1, 1), b3 + hstep, voffB);
            PG8_WAIT_V(6); PG8_BAR; PG8_MMA(1, 1, At, B1); PG8_BAR;
            }
        }
        if constexpr (F8) asm volatile("s_nop 15\n\ts_nop 15" ::: "memory");
        if constexpr (ALIGN_EPI) { if (wr == 0) PG8_BAR; }
        if constexpr (!Epi::AFTER_DRAIN) { E(acc, cur, wr, wc, fr, fq); S.done(cur); }
        if (!has_next) break;
        if constexpr (Epi::INIT) E.init(acc, nxt, wr, wc, fr, fq);
        else {
#pragma unroll
        for (int a = 0; a < 2; ++a)
#pragma unroll
            for (int b = 0; b < 2; ++b)
#pragma unroll
                for (int m = 0; m < 4; ++m)
#pragma unroll
                    for (int n = 0; n < 2; ++n) acc[a][b][m][n] = (f32x4){0.f, 0.f, 0.f, 0.f};
        }
        cur = nxt; cA = nA; cB = nB; ++ui;
        if constexpr (ALIGN_EPI) { if (wr == 1) PG8_BAR; }
    }
    PG8_WAIT_V(0);
    if constexpr (!ALIGN_EPI) { if (wr == 0) PG8_BAR; }
    PG8_BAR;
    if constexpr (Epi::AFTER_DRAIN) { E.fused(acc, cur, wr, wc, fr, fq, lds, wid, lane); S.done(cur); }
#undef PG8_SA
#undef PG8_SB
#undef PG8_STAGE
#undef PG8_LDA
#undef PG8_LDB
#undef PG8_MMA
#undef PG8_WAIT_V
#undef PG8_WAIT_L
#undef PG8_BAR
#undef PG8_SCHED
}
}

constexpr int BATCH = 4, SEQ = 4096, DM = 4096, NMETA = 16, MR = BATCH * SEQ  , MT = MR + NMETA  ;
constexpr int MHEADS = 8, MDK = 256, MDV = 512, NPROJ = 12288  , NIN = 12304  ;
constexpr int AH = 64, QLORA = 1024, KVLORA = 512, NOPE = 128, ROPE = 64, QKD = 192, VHD = 128;
constexpr int DFF = 11008, NGU = 2 * DFF;
constexpr int NKT = 65;
constexpr int NKVQ = 1792;
constexpr float EPS = 1e-6f;
constexpr float W_O_SCALE = 256.0f, ATT_O_SCALE = 16.0f, F8_W_SCALE = 256.0f, F8_A_SCALE = 16.0f;
constexpr int NWAVES = 8, NTHR = 512;

constexpr size_t MiB = 1u << 20;
constexpr size_t WS_CTL = 0, CTL_ZERO_BYTES = 1 * MiB;
constexpr size_t WS_HMETA = 1 * MiB;
constexpr size_t WS_GATES = 2 * MiB;
constexpr size_t WS_ROPE = 3 * MiB + 512 * 1024;
constexpr size_t WS_W_IN = 8 * MiB, WS_W_OUT = 105 * MiB, WS_W_GU0 = 137 * MiB, WS_W_GU1 = 309 * MiB, WS_W_DN0 = 481 * MiB, WS_W_DN1 = 567 * MiB;
constexpr size_t WS_W_KVQ = 653 * MiB, WS_W_KVUP = 667 * MiB, WS_W_UQ = 683 * MiB, WS_W_O = 707 * MiB;
constexpr size_t WS_W_O8 = WS_W_O, WS_W_KVQ8 = WS_W_O + 32 * MiB, WS_W_INO8 = WS_W_O + 39 * MiB, WS_W_UQ8 = WS_W_UQ, WS_W_KVUP8 = WS_W_O + 55 * MiB;
constexpr size_t WS_XN = 771 * MiB;
constexpr size_t WS_BIG = 900 * MiB;
constexpr size_t WS_HH = 1285 * MiB;
constexpr size_t WS_LAT = WS_HH, WS_CKVN = WS_HH + 113 * MiB;
constexpr size_t WS_CQN = 1415 * MiB;
constexpr size_t WS_KNOPE = 1447 * MiB;
constexpr size_t WS_V = 1704 * MiB;
constexpr size_t WS_K = 1964 * MiB;
constexpr size_t WS_H16 = 2354 * MiB;
constexpr size_t WS_PRE = 2482 * MiB;
constexpr size_t WS_SSR = 2486 * MiB;
constexpr size_t WS_END = 2488 * MiB;
static_assert(WS_W_IN + (size_t)NIN * DM * 2 <= WS_W_OUT && WS_W_GU0 + (size_t)NGU * DM * 2 <= WS_W_GU1 && WS_W_DN0 + (size_t)DM * DFF * 2 <= WS_W_DN1 && WS_W_KVQ + (size_t)NKVQ * DM * 2 <= WS_W_KVUP, "ws map");
static_assert(WS_XN + (size_t)MT * DM * 2 <= WS_BIG && WS_BIG + (size_t)MT * NPROJ * 2 <= WS_HH && WS_LAT + (size_t)MT * NKVQ * 4 <= WS_CKVN && WS_CKVN + (size_t)MT * KVLORA * 2 <= WS_CQN, "ws map");
static_assert(WS_KNOPE + (size_t)MT * 8192 * 2 <= WS_V && WS_V + (size_t)256 * NKT * 8192 <= WS_K && WS_K + (size_t)256 * NKT * 12288 <= WS_END && WS_ROPE + (size_t)MT * 64 * 4 <= WS_W_IN && WS_GATES + (size_t)16 * MT * 4 <= WS_ROPE, "ws map");

constexpr int RING_BYTES = 131072;
constexpr int LDSCTL_OFF = 143360, MISC_OFF = LDSCTL_OFF + 320;
constexpr int EPI_RED_OFF = 147456;
constexpr int LDS_BYTES = 151552;

#define GAS __attribute__((address_space(1)))
#define LAS __attribute__((address_space(3)))
typedef unsigned short bf16;
typedef unsigned v4u __attribute__((ext_vector_type(4)));
typedef unsigned v2u __attribute__((ext_vector_type(2)));
typedef float f32x4 __attribute__((ext_vector_type(4)));
typedef float f32x16 __attribute__((ext_vector_type(16)));
typedef short bf16x8 __attribute__((ext_vector_type(8)));
typedef short s16x4 __attribute__((ext_vector_type(4)));
typedef GAS unsigned gu32;
#define RLX_AGENT __ATOMIC_RELAXED, __HIP_MEMORY_SCOPE_AGENT
#define LDS_WAIT() asm volatile("s_waitcnt lgkmcnt(0)" ::: "memory")
#define VM_WAIT() asm volatile("s_waitcnt vmcnt(0)" ::: "memory")
#define SBAR() __builtin_amdgcn_sched_barrier(0)
__device__ __forceinline__ unsigned pk2(float lo, float hi) { return pg8::cvt_pk_bf16(lo, hi); }
__device__ __forceinline__ unsigned pk2a(float lo, float hi) { unsigned r; asm volatile("v_cvt_pk_bf16_f32 %0, %1, %2" : "=v"(r) : "v"(lo), "v"(hi)); return r; }
__device__ __forceinline__ float bf2f(unsigned short b) { return __uint_as_float((unsigned)b << 16); }
__device__ __forceinline__ float bflo(unsigned w) { return __uint_as_float(w << 16); }
__device__ __forceinline__ float bfhi(unsigned w) { return __uint_as_float(w & 0xffff0000u); }
#define XB_TMO      128
#define XB_XCNT(j)  (256  + 64 * (j))
#define XB_XSUB(j)  (1280 + 64 * (j))
#define XB_XGEN(j)  (2304 + 64 * (j))
#define XB_TOP      3328
#define XB_TOPGEN   3392
#define XCD_BAR_WORDS 3456
#define XB_SPIN_CAP (1u << 18)

__device__ __forceinline__ unsigned xb_ld(unsigned* p)              { return __hip_atomic_load(p, __ATOMIC_RELAXED, __HIP_MEMORY_SCOPE_AGENT); }
__device__ __forceinline__ unsigned xb_add(unsigned* p, unsigned v) { return __hip_atomic_fetch_add(p, v, __ATOMIC_RELAXED, __HIP_MEMORY_SCOPE_AGENT); }
__device__ __forceinline__ unsigned xb_xcc_id() { return (unsigned)__builtin_amdgcn_s_getreg((3 << 11) | 20) & 0xFu; }
#define XB_SPIN(cond, bar) do { unsigned _sp = 0; while (cond) { __builtin_amdgcn_s_sleep(1); \
    if ((++_sp & 255u) == 0u) { if (xb_ld(&(bar)[XB_TMO])) break; if (_sp > XB_SPIN_CAP) { atomicAdd(&(bar)[XB_TMO], 1u); break; } } } } while (0)

struct XcdBarrier {
    unsigned* bar; unsigned x;
    int wave;
    volatile LAS unsigned* st;
};

__device__ __forceinline__ XcdBarrier xcd_barrier_post(unsigned* bar, volatile LAS unsigned* st) {
    XcdBarrier b; b.bar = bar; b.x = xb_xcc_id(); b.st = st;
    if (threadIdx.x == 0) (void)xb_add(&bar[XB_XCNT(b.x)], 1u);
    return b;
}
__device__ __forceinline__ void xcd_barrier_complete(unsigned* bar, unsigned x, unsigned& nloc, unsigned& nx) {
    const unsigned G = gridDim.x * gridDim.y * gridDim.z;
    unsigned sum, cnt, mine, sp = 0u;
    for (;;) {
        sum = 0u; cnt = 0u; mine = 0u;
#pragma unroll
        for (unsigned j = 0; j < 16; ++j) { const unsigned c = xb_ld(&bar[XB_XCNT(j)]); sum += c; cnt += (c > 0u) ? 1u : 0u; mine = (j == x) ? c : mine; }
        if (sum == G) break;
        __builtin_amdgcn_s_sleep(1);
        if ((++sp & 255u) == 0u) { if (xb_ld(&bar[XB_TMO])) break; if (sp > XB_SPIN_CAP) { atomicAdd(&bar[XB_TMO], 1u); break; } }
    }
    nloc = mine > 0u ? mine : 1u; nx = cnt > 0u ? cnt : 1u;
}

__device__ __forceinline__ void xcd_barrier(const XcdBarrier& b) {
    asm volatile("s_waitcnt vmcnt(0)" ::: "memory");
    __syncthreads();
    if (b.wave == 0 && __builtin_amdgcn_mbcnt_hi(~0u, __builtin_amdgcn_mbcnt_lo(~0u, 0u)) == 0u) {
        unsigned* bar = b.bar;
        __builtin_amdgcn_s_waitcnt(0);
        unsigned nloc = b.st[0], nx = b.st[1];
        if (nloc == 0u) { xcd_barrier_complete(bar, b.x, nloc, nx); b.st[0] = nloc; b.st[1] = nx; }
        const unsigned old = xb_add(&bar[XB_XSUB(b.x)], 1u);
        const unsigned gen = old / nloc;
        if (old + 1u == (gen + 1u) * nloc) {
            __builtin_amdgcn_fence(__ATOMIC_RELEASE, "agent");
            asm volatile("s_waitcnt vmcnt(0)" ::: "memory");
            const unsigned og = xb_add(&bar[XB_TOP], 1u);
            const unsigned tg = og / nx;
            if (og + 1u == (tg + 1u) * nx) xb_add(&bar[XB_TOPGEN], 1u);
            else XB_SPIN(xb_ld(&bar[XB_TOPGEN]) == tg, bar);
            __builtin_amdgcn_fence(__ATOMIC_ACQUIRE, "agent");
            xb_add(&bar[XB_XGEN(b.x)], 1u);
            asm volatile("s_waitcnt vmcnt(0)" ::: "memory");
        } else {
            XB_SPIN(xb_ld(&bar[XB_XGEN(b.x)]) == gen, bar);
            __builtin_amdgcn_fence(__ATOMIC_ACQUIRE, "agent");
            asm volatile("s_waitcnt vmcnt(0)" ::: "memory");
        }
    }
    __syncthreads();
}


struct Args { const void* in[23]; float* out; unsigned char* ws; int ph_lo, ph_hi, dry, pad; };
struct Frame { LAS unsigned char* lds; int tid, lane, wave, vcu, G, gw, ngw; };

__device__ __forceinline__ float wave_sum(float v) {
#pragma unroll
    for (int o = 1; o < 64; o <<= 1) v += __shfl_xor(v, o);
    return v;
}
__device__ __forceinline__ bf16x8 ld8g(const bf16* p) { return *(const bf16x8*)p; }

__device__ __forceinline__ void tr_item(const float* __restrict__ W, int ldw, int scol, int nvalid, const float* __restrict__ gain, bf16* WT, int K, int drow, int k0, LAS float* scr, int lane) {
    const int nn = (lane & 31) < nvalid ? (lane & 31) : (nvalid - 1);
    float v[32]; const float* wp = W + (size_t)(k0 + (lane >> 5)) * ldw + scol + nn;
#pragma unroll
    for (int i = 0; i < 32; ++i) v[i] = wp[(size_t)(2 * i) * ldw];
    if (gain) {
#pragma unroll
        for (int i = 0; i < 32; ++i) v[i] *= gain[k0 + 2 * i + (lane >> 5)]; }
#pragma unroll
    for (int i = 0; i < 32; ++i) scr[(2 * i + (lane >> 5)) * 33 + (lane & 31)] = v[i];
    LDS_WAIT(); asm volatile("" ::: "memory");
    const int c = lane & 7;
#pragma unroll
    for (int j = 0; j < 4; ++j) { const int n = (lane >> 3) + 8 * j; const LAS float* s = scr + (8 * c) * 33 + n;
        v4u o; o.x = pk2(s[0 * 33], s[1 * 33]); o.y = pk2(s[2 * 33], s[3 * 33]); o.z = pk2(s[4 * 33], s[5 * 33]); o.w = pk2(s[6 * 33], s[7 * 33]);
        if (n < nvalid) *(GAS v4u*)(WT + (size_t)(drow + n) * K + k0 + 8 * c) = o; }
    LDS_WAIT(); asm volatile("" ::: "memory");
}
__device__ __forceinline__ void tr_item_f8(const float* __restrict__ W, int ldw, int scol, const float* __restrict__ gain, float scale, unsigned char* WT8, int K, int drow, int k0, LAS float* scr, int lane) {
    float v[32]; const float* wp = W + (size_t)(k0 + (lane >> 5)) * ldw + scol + (lane & 31);
#pragma unroll
    for (int i = 0; i < 32; ++i) v[i] = wp[(size_t)(2 * i) * ldw];
    if (gain) {
#pragma unroll
        for (int i = 0; i < 32; ++i) v[i] *= gain[k0 + 2 * i + (lane >> 5)]; }
#pragma unroll
    for (int i = 0; i < 32; ++i) scr[(2 * i + (lane >> 5)) * 33 + (lane & 31)] = v[i] * scale;
    LDS_WAIT(); asm volatile("" ::: "memory");
    const int c = lane & 7;
#pragma unroll
    for (int j = 0; j < 4; ++j) { const int n = (lane >> 3) + 8 * j; const LAS float* s = scr + (8 * c) * 33 + n;
        v2u o; int w = __builtin_amdgcn_cvt_pk_fp8_f32(s[0 * 33], s[1 * 33], 0, false); w = __builtin_amdgcn_cvt_pk_fp8_f32(s[2 * 33], s[3 * 33], w, true); o.x = (unsigned)w;
        w = __builtin_amdgcn_cvt_pk_fp8_f32(s[4 * 33], s[5 * 33], 0, false); w = __builtin_amdgcn_cvt_pk_fp8_f32(s[6 * 33], s[7 * 33], w, true); o.y = (unsigned)w;
        *(GAS v2u*)(WT8 + (size_t)(drow + n) * K + k0 + 8 * c) = o; }
    LDS_WAIT(); asm volatile("" ::: "memory");
}
__device__ __forceinline__ void norm_row(const float* src, bf16* dst, unsigned char* dst8, int lane) {
    const GAS f32x4* xr = (const GAS f32x4*)src + lane;
    f32x4 v[16]; float s = 0.f;
#pragma unroll
    for (int j = 0; j < 16; ++j) { v[j] = xr[64 * j]; s += (v[j].x * v[j].x + v[j].y * v[j].y) + (v[j].z * v[j].z + v[j].w * v[j].w); }
    const float r = 1.0f / sqrtf(wave_sum(s) * (1.0f / DM) + EPS);
    if (dst) { GAS v2u* o8 = (GAS v2u*)dst + lane;
#pragma unroll
        for (int j = 0; j < 16; ++j) { v2u w; w.x = pk2(v[j].x * r, v[j].y * r); w.y = pk2(v[j].z * r, v[j].w * r); o8[64 * j] = w; } }
    if (dst8) { GAS unsigned* o4 = (GAS unsigned*)dst8 + lane; const float r8 = r * F8_A_SCALE;
#pragma unroll
        for (int j = 0; j < 16; ++j) { int w = __builtin_amdgcn_cvt_pk_fp8_f32(v[j].x * r8, v[j].y * r8, 0, false); w = __builtin_amdgcn_cvt_pk_fp8_f32(v[j].z * r8, v[j].w * r8, w, true); o4[64 * j] = (unsigned)w; } }
}
__device__ __forceinline__ void norm_row_h(const pg8::f16_t* src, bf16* dst, unsigned char* dst8, int lane) {
    const GAS v4u* xr = (const GAS v4u*)src + lane;
    v4u h[8]; float s = 0.f;
#pragma unroll
    for (int j = 0; j < 8; ++j) { h[j] = xr[64 * j];
        const float a0 = pg8::f16lo(h[j].x), a1 = pg8::f16hi(h[j].x), a2 = pg8::f16lo(h[j].y), a3 = pg8::f16hi(h[j].y), a4 = pg8::f16lo(h[j].z), a5 = pg8::f16hi(h[j].z), a6 = pg8::f16lo(h[j].w), a7 = pg8::f16hi(h[j].w);
        s += ((a0 * a0 + a1 * a1) + (a2 * a2 + a3 * a3)) + ((a4 * a4 + a5 * a5) + (a6 * a6 + a7 * a7)); }
    const float r = 1.0f / sqrtf(wave_sum(s) * (1.0f / DM) + EPS);
    if (dst) { GAS v4u* o = (GAS v4u*)dst + lane;
#pragma unroll
        for (int j = 0; j < 8; ++j) { v4u w; w.x = pk2(pg8::f16lo(h[j].x) * r, pg8::f16hi(h[j].x) * r); w.y = pk2(pg8::f16lo(h[j].y) * r, pg8::f16hi(h[j].y) * r);
            w.z = pk2(pg8::f16lo(h[j].z) * r, pg8::f16hi(h[j].z) * r); w.w = pk2(pg8::f16lo(h[j].w) * r, pg8::f16hi(h[j].w) * r); o[64 * j] = w; } }
    if (dst8) { GAS v2u* o = (GAS v2u*)dst8 + lane; const float r8 = r * F8_A_SCALE;
#pragma unroll
        for (int j = 0; j < 8; ++j) { v2u w; int x = __builtin_amdgcn_cvt_pk_fp8_f32(pg8::f16lo(h[j].x) * r8, pg8::f16hi(h[j].x) * r8, 0, false); x = __builtin_amdgcn_cvt_pk_fp8_f32(pg8::f16lo(h[j].y) * r8, pg8::f16hi(h[j].y) * r8, x, true); w.x = (unsigned)x;
            x = __builtin_amdgcn_cvt_pk_fp8_f32(pg8::f16lo(h[j].z) * r8, pg8::f16hi(h[j].z) * r8, 0, false); x = __builtin_amdgcn_cvt_pk_fp8_f32(pg8::f16lo(h[j].w) * r8, pg8::f16hi(h[j].w) * r8, x, true); w.y = (unsigned)x; o[64 * j] = w; } }
}
__device__ __forceinline__ void norm_phase(Frame& F, const float* real, const float* meta, bf16* XN, unsigned char* X8, int nrows, int mode) {
    for (int m = F.gw; m < nrows; m += F.ngw) { const bool isreal = m < MR;
        norm_row(isreal ? real + (size_t)m * DM : meta + (size_t)(m - MR) * DM, (isreal && mode == 2) ? nullptr : XN + (size_t)m * DM, (isreal && mode != 0) ? X8 + (size_t)m * DM : nullptr, F.lane); }
}
__device__ __forceinline__ void norm_phase_h(Frame& F, const pg8::f16_t* real, const float* meta, bf16* XN, unsigned char* X8, int nrows, int mode) {
    for (int m = F.gw; m < nrows; m += F.ngw) {
        if (m < MR) norm_row_h(real + (size_t)m * DM, mode == 2 ? nullptr : XN + (size_t)m * DM, mode != 0 ? X8 + (size_t)m * DM : nullptr, F.lane);
        else norm_row(meta + (size_t)(m - MR) * DM, XN + (size_t)m * DM, nullptr, F.lane); }
}

struct P0Item { const float* wp; const float* gp; unsigned char* dp; int ldw, rowstep, kind, nvalid; float scale; };
constexpr int P0_I_IN = 64 * 385, P0_I_OUT = 64 * 128, P0_I_GU = 64 * 688, P0_I_DN = 172 * 128, P0_I_KVQ = 64 * 56, P0_I_KVU = 8 * 512, P0_I_UQ = 16 * 384, P0_I_O = 128 * 128, P0_I_INO = 64 * 128;
constexpr int P0_NITEMS = P0_I_IN + P0_I_OUT + 2 * P0_I_GU + 2 * P0_I_DN + P0_I_KVQ + P0_I_KVU + P0_I_UQ + P0_I_KVQ + P0_I_KVU + P0_I_INO + P0_I_O;
constexpr int P0_DEFER_A = 16384, P0_DEFER_B = 16384;
static_assert(P0_DEFER_B <= P0_I_DN && P0_DEFER_A + P0_DEFER_B <= P0_I_DN + P0_I_GU, "deferred items must be layer-1 FFN weights, the P16 share down-projection only");
__device__ __forceinline__ P0Item p0_decode(const Args& a, int it, int lane) {
    unsigned char* ws = a.ws;
    const float* w_in = (const float*)a.in[4]; const float* w_out = (const float*)a.in[8]; const float* w_gu = (const float*)a.in[10]; const float* w_dn = (const float*)a.in[11];
    const float* w_kvd = (const float*)a.in[13]; const float* w_kvu = (const float*)a.in[15]; const float* w_dq = (const float*)a.in[18]; const float* w_uq = (const float*)a.in[20]; const float* w_o = (const float*)a.in[22];
    const float* g_a = (const float*)a.in[3]; const float* g_ffn = (const float*)a.in[9]; const float* g_kv = (const float*)a.in[12]; const float* g_kvl = (const float*)a.in[14];
    const float* g_b = (const float*)a.in[17]; const float* g_ql = (const float*)a.in[19];
    const float* W = nullptr; const float* gain = nullptr; unsigned char* dst = nullptr; int ldw = 0, scol = 0, nvalid = 32, kind = 0, K = 0, drow = 0, k0 = 0; float scale = 1.f;
    int r = it;
    if (r < P0_I_IN) { const int kb = r / 385, nb = r % 385; W = w_in; ldw = NIN; scol = 32 * nb; nvalid = nb == 384 ? 16 : 32; gain = g_a; dst = ws + WS_W_IN; K = DM; drow = 32 * nb; k0 = 64 * kb; }
    else if ((r -= P0_I_IN) < P0_I_OUT) { const int kb = r / 128, nb = r % 128; W = w_out; ldw = DM; scol = 32 * nb; dst = ws + WS_W_OUT; K = DM; drow = 32 * nb; k0 = 64 * kb; }
    else if ((r -= P0_I_OUT) < P0_I_GU) { const int kb = r / 688, nb = r % 688, n0 = 32 * nb, j = n0 >> 8, i0 = n0 & 255;
        W = w_gu; ldw = NGU; scol = i0 < 128 ? 128 * j + i0 : DFF + 128 * j + (i0 - 128); gain = g_ffn; dst = ws + WS_W_GU0; K = DM; drow = n0; k0 = 64 * kb; }
    else if ((r -= P0_I_GU) < P0_I_DN) { const int kb = r / 128, nb = r % 128; W = w_dn; ldw = DM; scol = 32 * nb; dst = ws + WS_W_DN0; K = DFF; drow = 32 * nb; k0 = 64 * kb; }
    else if ((r -= P0_I_DN) < P0_I_KVQ) { const int kb = r / 56, nb = r % 56; dst = ws + WS_W_KVQ; K = DM; drow = 32 * nb; k0 = 64 * kb;
        if (nb < 18) { W = w_kvd; ldw = KVLORA + ROPE; scol = 32 * nb; gain = g_kv; } else if (nb >= 24) { W = w_dq; ldw = QLORA; scol = 32 * (nb - 24); gain = g_b; } else kind = 2; }
    else if ((r -= P0_I_KVQ) < P0_I_KVU) { const int kb = r / 512, nb = r % 512; W = w_kvu; ldw = 16384; scol = 32 * nb; gain = g_kvl; dst = ws + WS_W_KVUP; K = KVLORA; drow = 32 * nb; k0 = 64 * kb; }
    else if ((r -= P0_I_KVU) < P0_I_UQ) { const int kb = r / 384, nb = r % 384; W = w_uq; ldw = AH * QKD; scol = 32 * nb; gain = g_ql; kind = 1; scale = F8_W_SCALE; dst = ws + WS_W_UQ8; K = QLORA; drow = 32 * nb; k0 = 64 * kb; }
    else if ((r -= P0_I_UQ) < P0_I_KVQ) { const int kb = r / 56, nb = r % 56; kind = 1; scale = F8_W_SCALE; dst = ws + WS_W_KVQ8; K = DM; drow = 32 * nb; k0 = 64 * kb;
        if (nb < 18) { W = w_kvd; ldw = KVLORA + ROPE; scol = 32 * nb; gain = g_kv; } else if (nb >= 24) { W = w_dq; ldw = QLORA; scol = 32 * (nb - 24); gain = g_b; } else kind = 3; }
    else if ((r -= P0_I_KVQ) < P0_I_KVU) { const int kb = r / 512, nb = r % 512; W = w_kvu; ldw = 16384; scol = 32 * nb; gain = g_kvl; kind = 1; scale = F8_W_SCALE; dst = ws + WS_W_KVUP8; K = KVLORA; drow = 32 * nb; k0 = 64 * kb; }
    else if ((r -= P0_I_KVU) < P0_I_INO) { const int kb = r / 128, nb = r % 128; W = w_in; ldw = NIN; scol = 8192 + 32 * nb; gain = g_a; kind = 1; scale = F8_W_SCALE; dst = ws + WS_W_INO8; K = DM; drow = 32 * nb; k0 = 64 * kb; }
    else if ((r -= P0_I_INO) < P0_I_O) { const int kb = r / 128, nb = r % 128; W = w_o; ldw = DM; scol = 32 * nb; kind = 1; scale = W_O_SCALE; dst = ws + WS_W_O8; K = AH * VHD; drow = 32 * nb; k0 = 64 * kb; }
    else if ((r -= P0_I_O) < P0_I_GU) { const int kb = r / 688, nb = r % 688, n0 = 32 * nb, j = n0 >> 8, i0 = n0 & 255;
        W = w_gu + (size_t)DM * NGU; ldw = NGU; scol = i0 < 128 ? 128 * j + i0 : DFF + 128 * j + (i0 - 128); gain = g_ffn + DM; dst = ws + WS_W_GU1; K = DM; drow = n0; k0 = 64 * kb; }
    else { r -= P0_I_GU; const int kb = r / 128, nb = r % 128; W = w_dn + (size_t)DFF * DM; ldw = DM; scol = 32 * nb; dst = ws + WS_W_DN1; K = DFF; drow = 32 * nb; k0 = 64 * kb; }
    P0Item d; const int nn = (lane & 31) < nvalid ? (lane & 31) : (nvalid - 1); const int esz = (kind & 1) ? 1 : 2;
    d.wp = W + (size_t)(k0 + (lane >> 5)) * ldw + scol + nn; d.gp = gain ? gain + k0 + 8 * (lane & 7) : nullptr;
    d.dp = dst + ((size_t)(drow + (lane >> 3)) * K + k0 + 8 * (lane & 7)) * esz; d.ldw = ldw; d.rowstep = 8 * K * esz; d.kind = kind; d.nvalid = nvalid; d.scale = scale;
    return d;
}
__device__ __forceinline__ void p0_load(const P0Item& d, float (&v)[32], f32x4& g0, f32x4& g1) {
    g0 = (f32x4){1.f, 1.f, 1.f, 1.f}; g1 = g0;
    if (d.kind < 2) {
#pragma unroll
        for (int i = 0; i < 32; ++i) v[i] = d.wp[(size_t)(2 * i) * d.ldw];
        if (d.gp) { g0 = *(const GAS f32x4*)d.gp; g1 = *(const GAS f32x4*)(d.gp + 4); } }
}
__device__ __forceinline__ void p0_process(const P0Item& d, const float (&v)[32], f32x4 g0, f32x4 g1, LAS float* scr, int lane) {
    if (d.kind < 2) {
#pragma unroll
        for (int i = 0; i < 32; ++i) scr[(2 * i + (lane >> 5)) * 33 + (lane & 31)] = v[i];
        LDS_WAIT(); asm volatile("" ::: "memory");
        const int c = lane & 7;
#pragma unroll
        for (int j = 0; j < 4; ++j) { const int n = (lane >> 3) + 8 * j; const LAS float* s = scr + (8 * c) * 33 + n;
            const float f0 = s[0 * 33] * g0.x, f1 = s[1 * 33] * g0.y, f2 = s[2 * 33] * g0.z, f3 = s[3 * 33] * g0.w, f4 = s[4 * 33] * g1.x, f5 = s[5 * 33] * g1.y, f6 = s[6 * 33] * g1.z, f7 = s[7 * 33] * g1.w;
            if (d.kind == 0) { v4u o; o.x = pk2(f0, f1); o.y = pk2(f2, f3); o.z = pk2(f4, f5); o.w = pk2(f6, f7);
                if (n < d.nvalid) *(GAS v4u*)(d.dp + (size_t)j * d.rowstep) = o; }
            else { const float sc = d.scale; v2u o; int w = __builtin_amdgcn_cvt_pk_fp8_f32(f0 * sc, f1 * sc, 0, false); w = __builtin_amdgcn_cvt_pk_fp8_f32(f2 * sc, f3 * sc, w, true); o.x = (unsigned)w;
                w = __builtin_amdgcn_cvt_pk_fp8_f32(f4 * sc, f5 * sc, 0, false); w = __builtin_amdgcn_cvt_pk_fp8_f32(f6 * sc, f7 * sc, w, true); o.y = (unsigned)w;
                *(GAS v2u*)(d.dp + (size_t)j * d.rowstep) = o; } }
        LDS_WAIT(); asm volatile("" ::: "memory");
    } else {
#pragma unroll
        for (int j = 0; j < 4; ++j) { if (d.kind == 2) *(GAS v4u*)(d.dp + (size_t)j * d.rowstep) = (v4u){0u, 0u, 0u, 0u}; else *(GAS v2u*)(d.dp + (size_t)j * d.rowstep) = (v2u){0u, 0u}; } }
}
__device__ __forceinline__ void p0_items(Frame& F, const Args& a, int first, int last, int w, int stride, LAS float* scr) {
    int it = first + w; if (it >= last) return;
    P0Item d = p0_decode(a, it, F.lane); float v[32]; f32x4 g0, g1; p0_load(d, v, g0, g1);
    for (;;) { const int itn = it + stride; const bool more = itn < last;
        P0Item dn = d; float vn[32]; f32x4 gn0 = g0, gn1 = g1;
#pragma unroll
        for (int i = 0; i < 32; ++i) vn[i] = 0.f;
        if (more) { dn = p0_decode(a, itn, F.lane); p0_load(dn, vn, gn0, gn1); }
        asm volatile("" ::: "memory");
        p0_process(d, v, g0, g1, scr, F.lane);
        if (!more) break;
        d = dn; g0 = gn0; g1 = gn1; it = itn;
#pragma unroll
        for (int i = 0; i < 32; ++i) v[i] = vn[i]; }
}
__device__ __forceinline__ void p0_deferred(Frame& F, const Args& a, int nunits, int first, int count) {
    const int c = (int)blockIdx.x, G = F.G, rem = nunits % G;
    if (rem == 0) { p0_items(F, a, first, first + count, F.gw, F.ngw, (LAS float*)(F.lds + F.wave * 16384)); return; }
    if (c >= rem) p0_items(F, a, first, first + count, (c - rem) * NWAVES + F.wave, (G - rem) * NWAVES, (LAS float*)(F.lds + F.wave * 16384));
}

__device__ __forceinline__ void p0_prologue(Frame& F, const Args& a) {
    unsigned char* ws = a.ws;
    LAS float* scr = (LAS float*)(F.lds + F.wave * 16384);
    const float* w_in = (const float*)a.in[4]; const float* w_out = (const float*)a.in[8]; const float* w_gu = (const float*)a.in[10]; const float* w_dn = (const float*)a.in[11];
    const float* w_kvd = (const float*)a.in[13]; const float* w_kvu = (const float*)a.in[15]; const float* w_dq = (const float*)a.in[18]; const float* w_uq = (const float*)a.in[20]; const float* w_o = (const float*)a.in[22];
    const float* g_a = (const float*)a.in[3]; const float* g_ffn = (const float*)a.in[9]; const float* g_kv = (const float*)a.in[12]; const float* g_kvl = (const float*)a.in[14];
    const float* g_b = (const float*)a.in[17]; const float* g_ql = (const float*)a.in[19];
    p0_items(F, a, 0, P0_NITEMS - P0_DEFER_A - P0_DEFER_B, F.gw, F.ngw, scr);
    { const int* positions = (const int*)a.in[1]; float* rope = (float*)(ws + WS_ROPE);
        for (int e = F.vcu * NTHR + F.tid; e < MT * 32; e += F.G * NTHR) { const int row = e >> 5, i = e & 31;
            const int pos = row < MR ? positions[row] + NMETA : row - MR;
            const float inv = 1.0f / powf(10000.0f, (float)(2 * i) * (1.0f / 64.0f));
            const float ang = (float)pos * inv;
            rope[(size_t)row * 64 + i] = cosf(ang); rope[(size_t)row * 64 + 32 + i] = sinf(ang); } }
    { for (int e = F.vcu * NTHR + F.tid; e < 256 * 1280; e += F.G * NTHR) { const int bh = e / 1280, c = e % 1280;
            if (c < 768) *(GAS v4u*)(ws + WS_K + ((size_t)(bh * NKT + 64)) * 12288 + (size_t)c * 16) = (v4u){0u, 0u, 0u, 0u};
            else *(GAS v4u*)(ws + WS_V + ((size_t)(bh * NKT + 64)) * 8192 + (size_t)(c - 768) * 16) = (v4u){0u, 0u, 0u, 0u}; } }
    norm_phase(F, (const float*)a.in[0], (const float*)a.in[2], (bf16*)(ws + WS_XN), ws + WS_HH, MT, 1);
}

template <int NT>
__device__ __forceinline__ void skinny_wg(Frame& F, const bf16* __restrict__ A16, const bf16* __restrict__ Brows0, const bf16* __restrict__ Brows1, int K, f32x4 (&res)[NT]) {
    const int lane = F.lane, kw = K >> 3, k_lo = F.wave * kw;
    const bf16* pb = A16 + (size_t)(lane & 15) * K + 8 * (lane >> 4) + k_lo;
    const bf16* pa0 = Brows0 + (size_t)(lane & 15) * K + 8 * (lane >> 4) + k_lo;
    const bf16* pa1 = Brows1 + (size_t)(lane & 15) * K + 8 * (lane >> 4) + k_lo;
    f32x4 acc[NT];
#pragma unroll
    for (int i = 0; i < NT; ++i) acc[i] = (f32x4){0.f, 0.f, 0.f, 0.f};
#pragma unroll 8
    for (int k0 = 0; k0 < kw; k0 += 32) { const bf16x8 y = ld8g(pb + k0); const bf16x8 x0 = ld8g(pa0 + k0); acc[0] = __builtin_amdgcn_mfma_f32_16x16x32_bf16(x0, y, acc[0], 0, 0, 0);
        if (NT == 2) { const bf16x8 x1 = ld8g(pa1 + k0); acc[NT - 1] = __builtin_amdgcn_mfma_f32_16x16x32_bf16(x1, y, acc[NT - 1], 0, 0, 0); } }
    LAS f32x4* red = (LAS f32x4*)F.lds;
#pragma unroll
    for (int i = 0; i < NT; ++i) red[(i * NWAVES + F.wave) * 64 + lane] = acc[i];
    LDS_WAIT(); __syncthreads();
    if (F.wave == 0) {
#pragma unroll
        for (int i = 0; i < NT; ++i) { f32x4 sacc = red[(i * NWAVES) * 64 + lane];
#pragma unroll
            for (int w = 1; w < NWAVES; ++w) sacc = sacc + red[(i * NWAVES + w) * 64 + lane];
            res[i] = sacc; } }
    LDS_WAIT(); __syncthreads();
}

__device__ __forceinline__ void gate_norm_phase(Frame& F, const Args& a) {
    const bf16* HH = (const bf16*)(a.ws + WS_HH); const bf16* PROJ = (const bf16*)(a.ws + WS_BIG); bf16* A2 = (bf16*)(a.ws + WS_XN); const float* g_out = (const float*)a.in[7];
    for (int m = F.gw; m < MT; m += F.ngw) {
#pragma unroll
        for (int j = 0; j < 8; ++j) { const int e = j * 512 + F.lane * 8;
            const v4u hw = *(const GAS v4u*)(HH + (size_t)m * DM + e), ow = *(const GAS v4u*)(PROJ + (size_t)m * NPROJ + 8192 + e);
            const f32x4 g0 = *(const GAS f32x4*)(g_out + e), g1 = *(const GAS f32x4*)(g_out + e + 4);
            float hv[8] = {bflo(hw.x), bfhi(hw.x), bflo(hw.y), bfhi(hw.y), bflo(hw.z), bfhi(hw.z), bflo(hw.w), bfhi(hw.w)};
            const float ov[8] = {bflo(ow.x), bfhi(ow.x), bflo(ow.y), bfhi(ow.y), bflo(ow.z), bfhi(ow.z), bflo(ow.w), bfhi(ow.w)};
            const float gv[8] = {g0.x, g0.y, g0.z, g0.w, g1.x, g1.y, g1.z, g1.w};
            float s = 0.f;
#pragma unroll
            for (int i = 0; i < 8; ++i) s += hv[i] * hv[i];
            const float r = 1.0f / sqrtf(wave_sum(s) * (1.0f / MDV) + EPS);
#pragma unroll
            for (int i = 0; i < 8; ++i) hv[i] = hv[i] * r * gv[i] * (1.0f / (1.0f + __expf(-ov[i])));
            v4u o; o.x = pk2(hv[0], hv[1]); o.y = pk2(hv[2], hv[3]); o.z = pk2(hv[4], hv[5]); o.w = pk2(hv[6], hv[7]);
            *(GAS v4u*)(A2 + (size_t)m * DM + e) = o; }
    }
}

__device__ __forceinline__ void latent_norm_phase(Frame& F, const Args& a) {
    const float* LAT = (const float*)(a.ws + WS_LAT); const pg8::f16_t* LAT16 = (const pg8::f16_t*)(a.ws + WS_LAT); bf16* CKVN = (bf16*)(a.ws + WS_CKVN); bf16* CQN = (bf16*)(a.ws + WS_CQN);
    for (int m = F.gw; m < MT; m += F.ngw) {
        if (m < MR) { const pg8::f16_t* row = LAT16 + (size_t)m * NKVQ;
            { const v4u xw = *(const GAS v4u*)(row + 8 * F.lane);
                const float x0 = pg8::f16lo(xw.x), x1 = pg8::f16hi(xw.x), x2 = pg8::f16lo(xw.y), x3 = pg8::f16hi(xw.y), x4 = pg8::f16lo(xw.z), x5 = pg8::f16hi(xw.z), x6 = pg8::f16lo(xw.w), x7 = pg8::f16hi(xw.w);
                const float s = ((x0 * x0 + x1 * x1) + (x2 * x2 + x3 * x3)) + ((x4 * x4 + x5 * x5) + (x6 * x6 + x7 * x7));
                const float r8 = F8_A_SCALE / sqrtf(wave_sum(s) * (1.0f / KVLORA) + EPS); v2u o;
                int w = __builtin_amdgcn_cvt_pk_fp8_f32(x0 * r8, x1 * r8, 0, false); w = __builtin_amdgcn_cvt_pk_fp8_f32(x2 * r8, x3 * r8, w, true); o.x = (unsigned)w;
                w = __builtin_amdgcn_cvt_pk_fp8_f32(x4 * r8, x5 * r8, 0, false); w = __builtin_amdgcn_cvt_pk_fp8_f32(x6 * r8, x7 * r8, w, true); o.y = (unsigned)w;
                *(GAS v2u*)((unsigned char*)CKVN + (size_t)m * KVLORA + 8 * F.lane) = o; }
            {
                const pg8::f16_t* lrow = row + KVLORA; const float* rt = (const float*)(a.ws + WS_ROPE) + (size_t)m * 64; const float* g_k = (const float*)a.in[16]; const int i = F.lane & 31;
                const float t1 = (float)lrow[i] * g_k[128 + i], t2 = (float)lrow[32 + i] * g_k[160 + i], cs = rt[i], sn = rt[32 + i]; const float krl = (float)lrow[F.lane]; const float ssr = wave_sum(krl * krl);
                ((float*)(a.ws + WS_PRE))[(size_t)m * 64 + F.lane] = (F.lane & 32) ? (t1 * sn + t2 * cs) : (t1 * cs - t2 * sn);
                if (F.lane == 0) ((float*)(a.ws + WS_SSR))[m] = ssr; }
            { v2u v[4]; float s = 0.f;
#pragma unroll
                for (int j = 0; j < 4; ++j) { v[j] = *(const GAS v2u*)(row + 768 + (j * 64 + F.lane) * 4);
                    const float q0 = pg8::f16lo(v[j].x), q1 = pg8::f16hi(v[j].x), q2 = pg8::f16lo(v[j].y), q3 = pg8::f16hi(v[j].y); s += (q0 * q0 + q1 * q1) + (q2 * q2 + q3 * q3); }
                const float r8 = F8_A_SCALE / sqrtf(wave_sum(s) * (1.0f / QLORA) + EPS);
#pragma unroll
                for (int j = 0; j < 4; ++j) { int w = __builtin_amdgcn_cvt_pk_fp8_f32(pg8::f16lo(v[j].x) * r8, pg8::f16hi(v[j].x) * r8, 0, false); w = __builtin_amdgcn_cvt_pk_fp8_f32(pg8::f16lo(v[j].y) * r8, pg8::f16hi(v[j].y) * r8, w, true);
                    *(GAS unsigned*)((unsigned char*)CQN + (size_t)m * QLORA + (j * 64 + F.lane) * 4) = (unsigned)w; } }
        } else { const float* row = LAT + (size_t)m * NKVQ;
            const f32x4 x0 = *(const GAS f32x4*)(row + 8 * F.lane), x1 = *(const GAS f32x4*)(row + 8 * F.lane + 4);
            const float s = (x0.x * x0.x + x0.y * x0.y) + (x0.z * x0.z + x0.w * x0.w) + (x1.x * x1.x + x1.y * x1.y) + (x1.z * x1.z + x1.w * x1.w);
            const float r = 1.0f / sqrtf(wave_sum(s) * (1.0f / KVLORA) + EPS);
            v4u o; o.x = pk2(x0.x * r, x0.y * r); o.y = pk2(x0.z * r, x0.w * r); o.z = pk2(x1.x * r, x1.y * r); o.w = pk2(x1.z * r, x1.w * r);
            *(GAS v4u*)(CKVN + (size_t)m * KVLORA + 8 * F.lane) = o; }
    }
}

using pg8::k_img_off8;
__device__ __forceinline__ v2u f8x8(const float (&x)[8], float sc) { v2u o; int w = __builtin_amdgcn_cvt_pk_fp8_f32(x[0] * sc, x[1] * sc, 0, false); w = __builtin_amdgcn_cvt_pk_fp8_f32(x[2] * sc, x[3] * sc, w, true); o.x = (unsigned)w;
    w = __builtin_amdgcn_cvt_pk_fp8_f32(x[4] * sc, x[5] * sc, 0, false); w = __builtin_amdgcn_cvt_pk_fp8_f32(x[6] * sc, x[7] * sc, w, true); o.y = (unsigned)w; return o; }
__device__ __forceinline__ void k_final_phase(Frame& F, const Args& a) {
    const float* LAT = (const float*)(a.ws + WS_LAT); const bf16* KN = (const bf16*)(a.ws + WS_KNOPE); const float* ROPEt = (const float*)(a.ws + WS_ROPE); const float* g_k = (const float*)a.in[16];
    unsigned char* Kimg = a.ws + WS_K; const int lane = F.lane, c = lane & 15, hq = lane >> 4;
    float gn[8];
#pragma unroll
    for (int i = 0; i < 8; ++i) gn[i] = g_k[8 * c + i];
    for (int m = MR + F.gw; m < MT; m += F.ngw) {
        const float* lrow = LAT + (size_t)m * NKVQ + KVLORA;
        const float krl = lrow[lane]; const float ss_rope = wave_sum(krl * krl);
        float pre[8];
        { const int i0 = 8 * (c & 3); const float* rt = ROPEt + (size_t)m * 64;
#pragma unroll
            for (int i = 0; i < 8; ++i) { const float t1 = lrow[i0 + i] * g_k[128 + i0 + i], t2 = lrow[32 + i0 + i] * g_k[160 + i0 + i], cs = rt[i0 + i], sn = rt[32 + i0 + i];
                pre[i] = (c & 4) ? (t1 * sn + t2 * cs) : (t1 * cs - t2 * sn); } }
        const int nb = m < MR ? 1 : BATCH; const int key = m < MR ? NMETA + (m & (SEQ - 1)) : m - MR; const int b0 = m < MR ? (m >> 12) : 0;
        const int kt = key >> 6, kr = key & 63;
#pragma unroll 4
        for (int j = 0; j < 16; ++j) { const int h = 4 * j + hq;
            const v4u kw = *(const GAS v4u*)(KN + (size_t)m * 8192 + h * 128 + 8 * c);
            float kv[8] = {bflo(kw.x), bfhi(kw.x), bflo(kw.y), bfhi(kw.y), bflo(kw.z), bfhi(kw.z), bflo(kw.w), bfhi(kw.w)};
            float s = 0.f;
#pragma unroll
            for (int i = 0; i < 8; ++i) s += kv[i] * kv[i];
            s += __shfl_xor(s, 1); s += __shfl_xor(s, 2); s += __shfl_xor(s, 4); s += __shfl_xor(s, 8);
            const float r = 1.0f / sqrtf((s + ss_rope) * (1.0f / QKD) + EPS);
#pragma unroll
            for (int i = 0; i < 8; ++i) kv[i] *= gn[i];
            const v2u o = f8x8(kv, r * F8_A_SCALE), p = f8x8(pre, r * F8_A_SCALE);
            for (int bb = 0; bb < nb; ++bb) { unsigned char* img = Kimg + ((size_t)(((b0 + bb) * AH + h) * NKT + kt)) * 12288;
                *(GAS v2u*)(img + k_img_off8(kr, 8 * c)) = o;
                if (c < 8) *(GAS v2u*)(img + k_img_off8(kr, 128 + 8 * c)) = p; } }
    }
}

constexpr int ML_KP = 528, ML_VP = 144, ML_KR0 = 0, ML_KRSZ = 64 * ML_KP, ML_VR0 = 2 * ML_KRSZ, ML_VRSZ = 64 * ML_VP, ML_CT = ML_VR0 + 2 * ML_VRSZ, ML_WS = ML_CT + 80 * ML_KP, ML_END = ML_WS + NWAVES * 512;
static_assert(ML_END <= LDSCTL_OFF, "mLSTM LDS");
__device__ __forceinline__ s16x4 lds_tr(LAS const unsigned char* p) { typedef short v4i16_t __attribute__((ext_vector_type(4))); return __builtin_bit_cast(s16x4, __builtin_amdgcn_ds_read_tr16_b64_v4i16((LAS v4i16_t*)p)); }
__device__ __forceinline__ bf16x8 cat4(s16x4 lo, s16x4 hi) { return (bf16x8){lo[0], lo[1], lo[2], lo[3], hi[0], hi[1], hi[2], hi[3]}; }
__device__ __forceinline__ float prefix_sum64(float v, int lane) {
#pragma unroll
    for (int d = 1; d < 64; d <<= 1) { const float t = __shfl_up(v, d); if (lane >= d) v += t; }
    return v;
}
__device__ __forceinline__ float prefix_max64(float v, int lane) {
#pragma unroll
    for (int d = 1; d < 64; d <<= 1) { const float t = __shfl_up(v, d); if (lane >= d) v = fmaxf(v, t); }
    return v;
}
__device__ __forceinline__ float log_sigmoid(float x) { return fminf(x, 0.f) - log1pf(expf(-fabsf(x))); }

__device__ __forceinline__ void mlstm_unit(Frame& F, const Args& a, int unit) {
    const int bh = unit >> 3, sl = unit & 7, b = bh >> 3, h = bh & 7;
    const int tid = F.tid, lane = F.lane, wave = F.wave, tb = wave >> 1, eh = wave & 1, c15 = lane & 15, q4 = lane >> 4;
    LAS unsigned char* lds = F.lds;
    const bf16* PROJ = (const bf16*)(a.ws + WS_BIG); const float* GATES = (const float*)(a.ws + WS_GATES); bf16* HH = (bf16*)(a.ws + WS_HH);
    const float b_i = ((const float*)a.in[5])[h], b_f = ((const float*)a.in[6])[h];
    f32x4 Cacc[2][5];
#pragma unroll
    for (int i = 0; i < 2; ++i)
#pragma unroll
        for (int e = 0; e < 5; ++e) Cacc[i][e] = (f32x4){0.f, 0.f, 0.f, 0.f};
    float m_state = 0.f;
    for (int i = tid; i < (80 * ML_KP) / 16; i += NTHR) *(LAS v4u*)(lds + ML_CT + 16 * i) = (v4u){0u, 0u, 0u, 0u};
#define ML_ROW(c, i) ((c) == 0 ? MR + ((i) & 15) : b * SEQ + 64 * ((c) - 1) + (i))
#define ML_VALID(c, i) ((c) > 0 || (i) < NMETA)
    v4u kst[4], vst; bf16x8 qf[8], qn[8]; float bc_c, u_c, pm_c, bc_n, u_n, pm_n;
    const GAS unsigned char* Pb = (const GAS unsigned char*)PROJ;
    const unsigned kofs = (unsigned)(((tid >> 5) * NPROJ + 2048 + h * MDK + (tid & 31) * 8) * 2);
    const unsigned vofs = (unsigned)(((tid >> 3) * NPROJ + 4096 + h * MDV + sl * 64 + (tid & 7) * 8) * 2);
    const unsigned qofs = (unsigned)(((16 * tb + c15) * NPROJ + h * MDK + 8 * q4) * 2);
    constexpr unsigned ROWB = NPROJ * 2;
    {
#pragma unroll
        for (int j = 0; j < 4; ++j) { const int id = tid + NTHR * j, i = id >> 5, ch = id & 31; const v4u x = *(const GAS v4u*)(Pb + (size_t)(MR + (i & 15)) * ROWB + (2048 + h * MDK + ch * 8) * 2);
            *(LAS v4u*)(lds + ML_KR0 + i * ML_KP + ch * 16) = ML_VALID(0, i) ? x : (v4u){0u, 0u, 0u, 0u}; }
        { const int i = tid >> 3, ch = tid & 7; const v4u x = *(const GAS v4u*)(Pb + (size_t)(MR + (i & 15)) * ROWB + (4096 + h * MDV + sl * 64 + ch * 8) * 2);
            *(LAS v4u*)(lds + ML_VR0 + i * ML_VP + ch * 16) = ML_VALID(0, i) ? x : (v4u){0u, 0u, 0u, 0u}; }
        { const int i = 16 * tb + c15;
#pragma unroll
            for (int ks = 0; ks < 8; ++ks) { const bf16x8 x = *(const GAS bf16x8*)(Pb + (size_t)(MR + (i & 15)) * ROWB + (h * MDK + 32 * ks + 8 * q4) * 2); qf[ks] = ML_VALID(0, i) ? x : (bf16x8){0, 0, 0, 0, 0, 0, 0, 0}; } }
    }
    float* GSC = (float*)(a.ws + WS_KNOPE) + (size_t)unit * (65 * 192);
    for (int c = wave; c <= 64; c += NWAVES) {
        const bool tokv = ML_VALID(c, lane);
        const float gi = GATES[(size_t)h * MT + ML_ROW(c, lane)], gf = GATES[(size_t)(8 + h) * MT + ML_ROW(c, lane)];
        const float logi = tokv ? 15.0f * tanhf((gi + b_i) * (1.0f / 15.0f)) : -__builtin_inff();
        const float logf = tokv ? log_sigmoid(15.0f * tanhf((gf + b_f) * (1.0f / 15.0f))) : 0.f;
        const float bcum = prefix_sum64(logf, lane);
        const float u = logi - bcum;
        const float pm = prefix_max64(u, lane);
        GSC[c * 192 + lane] = bcum; GSC[c * 192 + 64 + lane] = u; GSC[c * 192 + 128 + lane] = pm;
    }
    VM_WAIT(); __syncthreads();
#define ML_GLOAD(c, B, U, P) do { B = __hip_atomic_load(GSC + (c) * 192 + lane, __ATOMIC_RELAXED, __HIP_MEMORY_SCOPE_AGENT); U = __hip_atomic_load(GSC + (c) * 192 + 64 + lane, __ATOMIC_RELAXED, __HIP_MEMORY_SCOPE_AGENT); \
        P = __hip_atomic_load(GSC + (c) * 192 + 128 + lane, __ATOMIC_RELAXED, __HIP_MEMORY_SCOPE_AGENT); } while (0)
    ML_GLOAD(0, bc_c, u_c, pm_c);
    LDS_WAIT(); __syncthreads();
    for (int c = 0; c <= 64; ++c) {
        const int cur = c & 1, nx = cur ^ 1, cn = c < 64 ? c + 1 : 64;
        LAS const unsigned char* KRc = lds + ML_KR0 + cur * ML_KRSZ; LAS const unsigned char* VRc = lds + ML_VR0 + cur * ML_VRSZ;
        const GAS unsigned char* Pn = Pb + (size_t)(b * SEQ + 64 * (cn - 1)) * ROWB;
#pragma unroll
        for (int j = 0; j < 4; ++j) kst[j] = *(const GAS v4u*)(Pn + (kofs + (unsigned)j * (16u * ROWB)));
        vst = *(const GAS v4u*)(Pn + vofs);
        ML_GLOAD(cn, bc_n, u_n, pm_n);
        f32x4 Sacc[4];
#pragma unroll
        for (int sb = 0; sb < 4; ++sb) Sacc[sb] = (f32x4){0.f, 0.f, 0.f, 0.f};
        f32x4 a1[3], a2[3];
#pragma unroll
        for (int x = 0; x < 3; ++x) { a1[x] = (f32x4){0.f, 0.f, 0.f, 0.f}; a2[x] = (f32x4){0.f, 0.f, 0.f, 0.f}; }
#define ML_SGROUP(kp) do { _Pragma("unroll") for (int ks = 2 * (kp); ks < 2 * (kp) + 2; ++ks) { _Pragma("unroll") for (int sb = 0; sb < 4; ++sb) if (sb <= tb) { \
            const bf16x8 kf = *(LAS const bf16x8*)(KRc + (16 * sb + c15) * ML_KP + (32 * ks + 8 * q4) * 2); Sacc[sb] = __builtin_amdgcn_mfma_f32_16x16x32_bf16(kf, qf[ks], Sacc[sb], 0, 0, 0); } } SBAR(); } while (0)
        ML_SGROUP(0);
        const float bcum = bc_c, u = u_c;
        const float Mv = fmaxf(m_state, pm_c);
        const float av = __expf(m_state - Mv);
        const float mt = bcum + Mv;
        const float M63 = __shfl(Mv, 63), b63 = __shfl(bcum, 63);
        const float wl = __expf(u - M63) * 0.0625f;
        const float decay = __shfl(av, 63);
        LAS float* uS = (LAS float*)(lds + ML_WS + wave * 512); LAS float* wS = uS + 64;
        uS[lane] = u; wS[lane] = wl; LDS_WAIT();
        ML_SGROUP(1); ML_SGROUP(2); ML_SGROUP(3);
#undef ML_SGROUP
        const float Mt = __shfl(Mv, 16 * tb + c15), at = __shfl(av, 16 * tb + c15), mtt = __shfl(mt, 16 * tb + c15);
        bf16x8 pf[2];
        {   float sp[4][4];
#pragma unroll
            for (int kp = 0; kp < 4; ++kp) {
#pragma unroll
                for (int ks = 2 * kp; ks < 2 * kp + 2; ++ks) {
#pragma unroll
                    for (int x = 0; x < 3; ++x) { const int eb = x < 2 ? 2 * eh + x : 4; const bf16x8 cf = *(LAS const bf16x8*)(lds + ML_CT + (16 * eb + c15) * ML_KP + (32 * ks + 8 * q4) * 2);
                        a1[x] = __builtin_amdgcn_mfma_f32_16x16x32_bf16(cf, qf[ks], a1[x], 0, 0, 0); } }
                { const int sb = kp; const f32x4 u4 = *(LAS const f32x4*)(uS + 16 * sb + 4 * q4);
#pragma unroll
                    for (int j = 0; j < 4; ++j) { const int s_abs = 16 * sb + 4 * q4 + j; const float us = u4[j];
                        const float w = (s_abs <= 16 * tb + c15) ? __expf(us - Mt) : 0.f; sp[sb][j] = (sb <= tb) ? Sacc[sb][j] * 0.0625f * w : 0.f; } }
                SBAR(); }
#pragma unroll
            for (int k2 = 0; k2 < 2; ++k2) { v4u w; w.x = pk2(sp[2 * k2][0], sp[2 * k2][1]); w.y = pk2(sp[2 * k2][2], sp[2 * k2][3]); w.z = pk2(sp[2 * k2 + 1][0], sp[2 * k2 + 1][1]); w.w = pk2(sp[2 * k2 + 1][2], sp[2 * k2 + 1][3]);
                pf[k2] = __builtin_bit_cast(bf16x8, w); } }
        const bf16x8 onesf = (c15 == 0) ? (bf16x8){0x3F80, 0x3F80, 0x3F80, 0x3F80, 0x3F80, 0x3F80, 0x3F80, 0x3F80} : (bf16x8){0, 0, 0, 0, 0, 0, 0, 0};
#pragma unroll
        for (int k2 = 0; k2 < 2; ++k2) {
#pragma unroll
            for (int x = 0; x < 2; ++x) { const int eb = 2 * eh + x; LAS const unsigned char* p = VRc + (32 * k2 + 4 * q4 + (c15 >> 2)) * ML_VP + (16 * eb + 4 * (c15 & 3)) * 2;
                const s16x4 lo = lds_tr(p), hi = lds_tr(p + 16 * ML_VP);
                a2[x] = __builtin_amdgcn_mfma_f32_16x16x32_bf16(cat4(lo, hi), pf[k2], a2[x], 0, 0, 0); }
            a2[2] = __builtin_amdgcn_mfma_f32_16x16x32_bf16(onesf, pf[k2], a2[2], 0, 0, 0); }
        {   const float den0 = at * a1[2][0] + a2[2][0];
            const float den = __shfl(den0, c15);
            const float inv = 1.0f / fmaxf(fabsf(den), __expf(-mtt));
            const int tl = 16 * tb + c15;
            if (ML_VALID(c, tl)) { const unsigned ho = (unsigned)((ML_ROW(c, tl) * DM + h * MDV + sl * 64 + 4 * q4 + 32 * eh) * 2);
#pragma unroll
                for (int x = 0; x < 2; ++x) { v2u w; w.x = pk2((at * a1[x][0] + a2[x][0]) * inv, (at * a1[x][1] + a2[x][1]) * inv); w.y = pk2((at * a1[x][2] + a2[x][2]) * inv, (at * a1[x][3] + a2[x][3]) * inv);
                    *(GAS v2u*)((GAS unsigned char*)HH + (ho + 32u * x)) = w; } } }
#pragma unroll
        for (int ks = 0; ks < 8; ++ks) qn[ks] = *(const GAS bf16x8*)(Pn + (qofs + 64u * ks));
#pragma unroll
        for (int i = 0; i < 2; ++i)
#pragma unroll
            for (int e = 0; e < 5; ++e) Cacc[i][e] = Cacc[i][e] * decay;
#pragma unroll
        for (int k2 = 0; k2 < 2; ++k2) {
            const f32x4 wv0 = *(LAS const f32x4*)(wS + 32 * k2 + 8 * q4), wv1 = *(LAS const f32x4*)(wS + 32 * k2 + 8 * q4 + 4);
            const float wlv[8] = {wv0.x, wv0.y, wv0.z, wv0.w, wv1.x, wv1.y, wv1.z, wv1.w};
            bf16x8 bfr[5];
#pragma unroll
            for (int eb = 0; eb < 4; ++eb) { LAS const unsigned char* p = VRc + (32 * k2 + 8 * q4 + (c15 >> 2)) * ML_VP + (16 * eb + 4 * (c15 & 3)) * 2;
                const s16x4 lo = lds_tr(p), hi = lds_tr(p + 4 * ML_VP);
                v4u w; w.x = pk2(bf2f((unsigned short)lo[0]) * wlv[0], bf2f((unsigned short)lo[1]) * wlv[1]); w.y = pk2(bf2f((unsigned short)lo[2]) * wlv[2], bf2f((unsigned short)lo[3]) * wlv[3]);
                w.z = pk2(bf2f((unsigned short)hi[0]) * wlv[4], bf2f((unsigned short)hi[1]) * wlv[5]); w.w = pk2(bf2f((unsigned short)hi[2]) * wlv[6], bf2f((unsigned short)hi[3]) * wlv[7]);
                bfr[eb] = __builtin_bit_cast(bf16x8, w); }
            { v4u w; w.x = pk2(wlv[0], wlv[1]); w.y = pk2(wlv[2], wlv[3]); w.z = pk2(wlv[4], wlv[5]); w.w = pk2(wlv[6], wlv[7]); if (c15 != 0) w = (v4u){0u, 0u, 0u, 0u}; bfr[4] = __builtin_bit_cast(bf16x8, w); }
#pragma unroll
            for (int i = 0; i < 2; ++i) { const int rb = 2 * wave + i; LAS const unsigned char* p = KRc + (32 * k2 + 8 * q4 + (c15 >> 2)) * ML_KP + (16 * rb + 4 * (c15 & 3)) * 2;
                const s16x4 lo = lds_tr(p), hi = lds_tr(p + 4 * ML_KP); const bf16x8 af = cat4(lo, hi);
#pragma unroll
                for (int eb = 0; eb < 5; ++eb) Cacc[i][eb] = __builtin_amdgcn_mfma_f32_16x16x32_bf16(af, bfr[eb], Cacc[i][eb], 0, 0, 0); }
        }
        LDS_WAIT(); __syncthreads();
#pragma unroll
        for (int i = 0; i < 2; ++i)
#pragma unroll
            for (int eb = 0; eb < 5; ++eb) { v2u w; w.x = pk2(Cacc[i][eb][0], Cacc[i][eb][1]); w.y = pk2(Cacc[i][eb][2], Cacc[i][eb][3]);
                *(LAS v2u*)(lds + ML_CT + (16 * eb + c15) * ML_KP + (16 * (2 * wave + i) + 4 * q4) * 2) = w; }
#pragma unroll
        for (int j = 0; j < 4; ++j) { const int id = tid + NTHR * j, i = id >> 5, ch = id & 31; *(LAS v4u*)(lds + ML_KR0 + nx * ML_KRSZ + i * ML_KP + ch * 16) = kst[j]; }
        { const int i = tid >> 3, ch = tid & 7; *(LAS v4u*)(lds + ML_VR0 + nx * ML_VRSZ + i * ML_VP + ch * 16) = vst; }
#pragma unroll
        for (int ks = 0; ks < 8; ++ks) qf[ks] = qn[ks];
        bc_c = bc_n; u_c = u_n; pm_c = pm_n;
        m_state = b63 + M63;
        LDS_WAIT(); __syncthreads();
    }
#undef ML_ROW
#undef ML_VALID
#undef ML_GLOAD
}

constexpr int AT_KSZ = 12288, AT_VSZ = 8192, AT_K0 = 0, AT_V0 = 2 * AT_KSZ, AT_WS = AT_V0 + 2 * AT_VSZ, AT_GQ = AT_WS + NWAVES * 256, AT_OST = AT_GQ + 768, AT_END = AT_OST + NWAVES * 4096;
static_assert(AT_END <= RING_BYTES, "attention LDS");
constexpr float AT_SCALE = 0.07216878364870322f / 256.0f;
constexpr float AT_THR = 2.5f;
__device__ __forceinline__ int crow(int r, int hi) { return (r & 3) + 8 * (r >> 2) + 4 * hi; }
__device__ __forceinline__ int v_rd_base(int lane) { return ((lane & 3) << 3) | (((lane >> 2) & 3) << 6) | (((lane >> 4) & 1) << 5) | (((lane >> 5) & 1) << 8); }
constexpr int v_rd_off(int d0, int ks, int half) { return d0 * 512 + ks * 4096 + half * 2048; }
__device__ __forceinline__ void at_mask(f32x16& p0, f32x16& p1, int dq) {
    const float NEG = -__builtin_inff();
#pragma unroll
    for (int r = 0; r < 16; ++r) { const int c = (r & 3) + 8 * (r >> 2); if (dq - c < 0) p0[r] = NEG; if (dq - c - 32 < 0) p1[r] = NEG; }
}
__device__ __forceinline__ void at_partialSM(f32x16& p0, f32x16& p1, float& m_reg, float& mn, float& alpha) {
    float pmax = p0[0];
#pragma unroll
    for (int r = 1; r < 16; ++r) pmax = fmaxf(pmax, p0[r]);
#pragma unroll
    for (int r = 0; r < 16; ++r) pmax = fmaxf(pmax, p1[r]);
    { auto rr = __builtin_amdgcn_permlane32_swap(__float_as_uint(pmax), __float_as_uint(pmax), false, false); pmax = fmaxf(__uint_as_float(rr[0]), __uint_as_float(rr[1])); }
    constexpr float C2 = 1.4426950408889634f * AT_SCALE;
    if (__builtin_expect(__all((pmax - m_reg) * AT_SCALE <= AT_THR), 1)) { mn = m_reg; alpha = 1.f; }
    else { mn = fmaxf(m_reg, pmax); alpha = __builtin_amdgcn_exp2f((m_reg - mn) * C2); m_reg = mn; }
    const float mnL = 5.0f - mn * C2;
#pragma unroll
    for (int r = 0; r < 16; ++r) p0[r] = __builtin_amdgcn_exp2f(fmaf(p0[r], C2, mnL));
#pragma unroll
    for (int r = 0; r < 16; ++r) p1[r] = __builtin_amdgcn_exp2f(fmaf(p1[r], C2, mnL));
}
__device__ __forceinline__ void at_finishSM(const f32x16& p0, const f32x16& p1, float alpha, float& l_reg, bf16x8& pa0, bf16x8& pa1, bf16x8& pa2, bf16x8& pa3) {
    float ps = 0.f;
#pragma unroll
    for (int r = 0; r < 16; ++r) ps += p0[r];
#pragma unroll
    for (int r = 0; r < 16; ++r) ps += p1[r];
    { auto rr = __builtin_amdgcn_permlane32_swap(__float_as_uint(ps), __float_as_uint(ps), false, false); ps = __uint_as_float(rr[0]) + __uint_as_float(rr[1]); }
    l_reg = l_reg * alpha + ps;
#define AT_PK4(P, B_, OUT) do { unsigned a0 = pk2a(P[B_+0], P[B_+1]), a1 = pk2a(P[B_+2], P[B_+3]); unsigned b0 = pk2a(P[B_+4], P[B_+5]), b1 = pk2a(P[B_+6], P[B_+7]); \
        auto r0 = __builtin_amdgcn_permlane32_swap(a0, b0, false, false); auto r1 = __builtin_amdgcn_permlane32_swap(a1, b1, false, false); \
        v4u w = {r0[0], r1[0], r0[1], r1[1]}; OUT = __builtin_bit_cast(bf16x8, w); } while (0)
    AT_PK4(p0, 0, pa0); AT_PK4(p0, 8, pa1); AT_PK4(p1, 0, pa2); AT_PK4(p1, 8, pa3);
#undef AT_PK4
}
__device__ __forceinline__ void at_qkt(f32x16& p0, f32x16& p1, LAS const unsigned char* Kb, int r32, int hi, const bf16x8* qr) {
    p0 = (f32x16){0.f, 0.f, 0.f, 0.f, 0.f, 0.f, 0.f, 0.f, 0.f, 0.f, 0.f, 0.f, 0.f, 0.f, 0.f, 0.f}; p1 = p0;
    LAS const unsigned char* kb[4];
#pragma unroll
    for (int dd = 0; dd < 4; ++dd) kb[dd] = Kb + r32 * 384 + (((2 * dd + hi) ^ ((r32 >> 1) & 7)) << 4);
    bf16x8 c0[2], c1[2], n0[2], n1[2];
#pragma unroll
    for (int dd = 0; dd < 2; ++dd) { LAS const unsigned char* p = kb[dd]; c0[dd] = *(LAS const bf16x8*)p; c1[dd] = *(LAS const bf16x8*)(p + 32 * 384); }
#pragma unroll
    for (int g = 0; g < 6; ++g) {
        if (g < 5) {
#pragma unroll
            for (int dd = 0; dd < 2; ++dd) { LAS const unsigned char* p = kb[2 * ((g + 1) & 1) + dd] + ((g + 1) >> 1) * 128; n0[dd] = *(LAS const bf16x8*)p; n1[dd] = *(LAS const bf16x8*)(p + 32 * 384); } }
        SBAR();
#pragma unroll
        for (int dd = 0; dd < 2; ++dd) { p0 = __builtin_amdgcn_mfma_f32_32x32x16_bf16(c0[dd], qr[2 * g + dd], p0, 0, 0, 0); p1 = __builtin_amdgcn_mfma_f32_32x32x16_bf16(c1[dd], qr[2 * g + dd], p1, 0, 0, 0); }
        SBAR();
#pragma unroll
        for (int dd = 0; dd < 2; ++dd) { c0[dd] = n0[dd]; c1[dd] = n1[dd]; } }
}
__device__ __forceinline__ void at_qkt8(f32x16& p0, f32x16& p1, LAS const unsigned char* Kb, const int (&ko)[6], int kmask, const pg8::i32x8* q8) {
#define AT_KO2(x) (ko[x] + 6080 + 192 * ((kmask >> (x)) & 1))
    p0 = (f32x16){0.f, 0.f, 0.f, 0.f, 0.f, 0.f, 0.f, 0.f, 0.f, 0.f, 0.f, 0.f, 0.f, 0.f, 0.f, 0.f}; p1 = p0;
    pg8::i32x8 a0 = pg8::cat8(*(LAS const bf16x8*)(Kb + ko[0]), *(LAS const bf16x8*)(Kb + ko[1])), a1 = pg8::cat8(*(LAS const bf16x8*)(Kb + AT_KO2(0)), *(LAS const bf16x8*)(Kb + AT_KO2(1)));
#pragma unroll
    for (int j = 0; j < 3; ++j) { pg8::i32x8 n0 = a0, n1 = a1;
        if (j < 2) { n0 = pg8::cat8(*(LAS const bf16x8*)(Kb + ko[2 * j + 2]), *(LAS const bf16x8*)(Kb + ko[2 * j + 3])); n1 = pg8::cat8(*(LAS const bf16x8*)(Kb + AT_KO2(2 * j + 2)), *(LAS const bf16x8*)(Kb + AT_KO2(2 * j + 3))); }
        SBAR();
        p0 = __builtin_amdgcn_mfma_scale_f32_32x32x64_f8f6f4(a0, q8[j], p0, 0, 0, 0, 0, 0, 0);
        p1 = __builtin_amdgcn_mfma_scale_f32_32x32x64_f8f6f4(a1, q8[j], p1, 0, 0, 0, 0, 0, 0);
        SBAR(); a0 = n0; a1 = n1; }
#undef AT_KO2
}
__device__ __forceinline__ void at_pv(f32x16* o, unsigned vb0, bf16x8 pa0, bf16x8 pa1, bf16x8 pa2, bf16x8 pa3) {
#define AT_TRRD(dst, off) asm volatile("ds_read_b64_tr_b16 %0, %1 offset:%2" : "=&v"(dst) : "v"(vb0), "i"(off) : "memory")
#define AT_LOADV(L, H, d0) do { constexpr int b_ = v_rd_off(d0, 0, 0); AT_TRRD(L[0], b_); AT_TRRD(H[0], b_ + 2048); AT_TRRD(L[1], b_ + 4096); AT_TRRD(H[1], b_ + 6144); \
        AT_TRRD(L[2], b_ + 8192); AT_TRRD(H[2], b_ + 10240); AT_TRRD(L[3], b_ + 12288); AT_TRRD(H[3], b_ + 14336); } while (0)
#define AT_MMAV(L, H, d0) do { o[d0] = __builtin_amdgcn_mfma_f32_32x32x16_bf16(pa0, cat4(L[0], H[0]), o[d0], 0, 0, 0); o[d0] = __builtin_amdgcn_mfma_f32_32x32x16_bf16(pa1, cat4(L[1], H[1]), o[d0], 0, 0, 0); \
        o[d0] = __builtin_amdgcn_mfma_f32_32x32x16_bf16(pa2, cat4(L[2], H[2]), o[d0], 0, 0, 0); o[d0] = __builtin_amdgcn_mfma_f32_32x32x16_bf16(pa3, cat4(L[3], H[3]), o[d0], 0, 0, 0); } while (0)
    s16x4 la[4], ha[4], lb[4], hb[4];
    AT_LOADV(la, ha, 0); AT_LOADV(lb, hb, 1);
    asm volatile("s_waitcnt lgkmcnt(8)" ::: "memory"); SBAR(); AT_MMAV(la, ha, 0); SBAR();
    AT_LOADV(la, ha, 2);
    asm volatile("s_waitcnt lgkmcnt(8)" ::: "memory"); SBAR(); AT_MMAV(lb, hb, 1); SBAR();
    AT_LOADV(lb, hb, 3);
    asm volatile("s_waitcnt lgkmcnt(8)" ::: "memory"); SBAR(); AT_MMAV(la, ha, 2); SBAR();
    asm volatile("s_waitcnt lgkmcnt(0)" ::: "memory"); SBAR(); AT_MMAV(lb, hb, 3); SBAR();
#undef AT_MMAV
#undef AT_LOADV
#undef AT_TRRD
}
__device__ __forceinline__ pg8::i32x8 at_finishSM8(const f32x16& p0, const f32x16& p1, float alpha, float& l_reg) {
    float ps = 0.f;
#pragma unroll
    for (int r = 0; r < 16; ++r) ps += p0[r];
#pragma unroll
    for (int r = 0; r < 16; ++r) ps += p1[r];
    { auto rr = __builtin_amdgcn_permlane32_swap(__float_as_uint(ps), __float_as_uint(ps), false, false); ps = __uint_as_float(rr[0]) + __uint_as_float(rr[1]); }
    l_reg = l_reg * alpha + ps;
    int w[8];
#pragma unroll
    for (int k = 0; k < 4; ++k) { int x = __builtin_amdgcn_cvt_pk_fp8_f32(p0[4 * k], p0[4 * k + 1], 0, false); x = __builtin_amdgcn_cvt_pk_fp8_f32(p0[4 * k + 2], p0[4 * k + 3], x, true); w[k] = x;
        x = __builtin_amdgcn_cvt_pk_fp8_f32(p1[4 * k], p1[4 * k + 1], 0, false); x = __builtin_amdgcn_cvt_pk_fp8_f32(p1[4 * k + 2], p1[4 * k + 3], x, true); w[4 + k] = x; }
    return (pg8::i32x8){w[0], w[1], w[2], w[3], w[4], w[5], w[6], w[7]};
}
__device__ __forceinline__ s16x4 lds_tr8(LAS const unsigned char* p) { typedef int v2i_t __attribute__((ext_vector_type(2))); return __builtin_bit_cast(s16x4, __builtin_amdgcn_ds_read_tr8_b64_v2i32((LAS v2i_t*)p)); }
__device__ __forceinline__ void at_pv8(f32x16* o, LAS const unsigned char* const (&va)[4], pg8::i32x8 P8) {
#pragma unroll
    for (int d0 = 0; d0 < 4; ++d0) { const s16x4 t0 = lds_tr8(va[d0]), t1 = lds_tr8(va[d0] + 2048), t2 = lds_tr8(va[d0] + 4096), t3 = lds_tr8(va[d0] + 6144);
        const pg8::i32x8 B = pg8::cat8(cat4(t0, t1), cat4(t2, t3));
        asm volatile("v_mfma_f32_32x32x64_f8f6f4 %0, %1, %2, %0" : "+v"(o[d0]) : "v"(P8), "v"(B)); }
    asm volatile("s_nop 15\n\ts_nop 15" ::: "memory");
}
__device__ __forceinline__ void at_dma_tile(LAS unsigned char* lds, const unsigned char* Kt, const unsigned char* Vt, int buf, int wave, int lane) {
    unsigned lo = (unsigned)lane * 16u; asm volatile("" : "+v"(lo));
#pragma unroll
    for (int i = 0; i < 2; ++i) { const int pc = wave + 8 * i; if (pc < 12) __builtin_amdgcn_global_load_lds((const unsigned*)((Kt + pc * 1024) + lo), (LAS unsigned*)(lds + AT_K0 + buf * AT_KSZ + pc * 1024), 16, 0, 0); }
    __builtin_amdgcn_global_load_lds((const unsigned*)((Vt + wave * 1024) + lo), (LAS unsigned*)(lds + AT_V0 + buf * AT_VSZ + wave * 1024), 16, 0, 0);
}
__device__ __forceinline__ void attn_block(Frame& F, const Args& a, int bh, int qb) {
    const int lane = F.lane, wave = F.wave, r32 = lane & 31, hi = lane >> 5, b = bh >> 6, h = bh & 63;
    LAS unsigned char* lds = F.lds;
    const bf16* QRAW = (const bf16*)(a.ws + WS_BIG); const float* ROPEt = (const float*)(a.ws + WS_ROPE);
    const unsigned char* Kimg = a.ws + WS_K + (size_t)bh * NKT * AT_KSZ; const unsigned char* Vimg = a.ws + WS_V + (size_t)bh * NKT * AT_VSZ;
    bf16* ATO = (bf16*)(a.ws + WS_KNOPE);
    const int NT = 4 * qb + 5;
    at_dma_tile(lds, Kimg, Vimg, 0, wave, lane);
    const int m = b * SEQ + 256 * qb + 32 * wave + r32;
    pg8::i32x8 q8[3];
#define Q8F(word, b) __builtin_amdgcn_cvt_f32_fp8((int)(word), b)
    {   v2u qraw[12]; float ss = 0.f;
        const unsigned qo = (unsigned)(m * (AH * QKD) + h * QKD);
#pragma unroll
        for (int j = 0; j < 3; ++j)
#pragma unroll
            for (int i = 0; i < 4; ++i) { const int d = j < 2 ? 64 * j + 32 * hi + 8 * i : (i < 2 ? 128 + 16 * hi + 8 * i : 160 + 16 * hi + 8 * (i - 2));
                qraw[4 * j + i] = *(const GAS v2u*)((const GAS unsigned char*)QRAW + (qo + (unsigned)d)); }
#pragma unroll
        for (int d0 = 0; d0 < 12; ++d0) { const v2u w = qraw[d0];
            ss += (Q8F(w.x, 0) * Q8F(w.x, 0) + Q8F(w.x, 1) * Q8F(w.x, 1)) + (Q8F(w.x, 2) * Q8F(w.x, 2) + Q8F(w.x, 3) * Q8F(w.x, 3)) + (Q8F(w.y, 0) * Q8F(w.y, 0) + Q8F(w.y, 1) * Q8F(w.y, 1)) + (Q8F(w.y, 2) * Q8F(w.y, 2) + Q8F(w.y, 3) * Q8F(w.y, 3)); }
        ss += __shfl_xor(ss, 32);
        const float r = (F8_A_SCALE / 16.0f) / sqrtf(ss * (1.0f / (256.0f * QKD)) + EPS);
        LAS const float* gq = (LAS const float*)(lds + AT_GQ);
#pragma unroll
        for (int j = 0; j < 2; ++j) { int wds[8];
#pragma unroll
            for (int i = 0; i < 4; ++i) { const v2u w = qraw[4 * j + i]; const int d = 64 * j + 32 * hi + 8 * i; const f32x4 g0 = *(LAS const f32x4*)(gq + d), g1 = *(LAS const f32x4*)(gq + d + 4);
                int x = __builtin_amdgcn_cvt_pk_fp8_f32(Q8F(w.x, 0) * r * g0.x, Q8F(w.x, 1) * r * g0.y, 0, false); x = __builtin_amdgcn_cvt_pk_fp8_f32(Q8F(w.x, 2) * r * g0.z, Q8F(w.x, 3) * r * g0.w, x, true); wds[2 * i] = x;
                x = __builtin_amdgcn_cvt_pk_fp8_f32(Q8F(w.y, 0) * r * g1.x, Q8F(w.y, 1) * r * g1.y, 0, false); x = __builtin_amdgcn_cvt_pk_fp8_f32(Q8F(w.y, 2) * r * g1.z, Q8F(w.y, 3) * r * g1.w, x, true); wds[2 * i + 1] = x; }
            q8[j] = (pg8::i32x8){wds[0], wds[1], wds[2], wds[3], wds[4], wds[5], wds[6], wds[7]}; }
        {
            const float* rt = ROPEt + (size_t)m * 64; float o1[16], o2[16];
#pragma unroll
            for (int i = 0; i < 2; ++i) { const v2u w1 = qraw[8 + i], w2 = qraw[10 + i]; const int i0 = 16 * hi + 8 * i;
                const f32x4 ga = *(LAS const f32x4*)(gq + 128 + i0), gb = *(LAS const f32x4*)(gq + 128 + i0 + 4), gc = *(LAS const f32x4*)(gq + 160 + i0), gd = *(LAS const f32x4*)(gq + 160 + i0 + 4);
                const f32x4 c0 = *(const GAS f32x4*)(rt + i0), c1 = *(const GAS f32x4*)(rt + i0 + 4), s0 = *(const GAS f32x4*)(rt + 32 + i0), s1 = *(const GAS f32x4*)(rt + 32 + i0 + 4);
                const float t1[8] = {Q8F(w1.x, 0) * r * ga.x, Q8F(w1.x, 1) * r * ga.y, Q8F(w1.x, 2) * r * ga.z, Q8F(w1.x, 3) * r * ga.w, Q8F(w1.y, 0) * r * gb.x, Q8F(w1.y, 1) * r * gb.y, Q8F(w1.y, 2) * r * gb.z, Q8F(w1.y, 3) * r * gb.w};
                const float t2[8] = {Q8F(w2.x, 0) * r * gc.x, Q8F(w2.x, 1) * r * gc.y, Q8F(w2.x, 2) * r * gc.z, Q8F(w2.x, 3) * r * gc.w, Q8F(w2.y, 0) * r * gd.x, Q8F(w2.y, 1) * r * gd.y, Q8F(w2.y, 2) * r * gd.z, Q8F(w2.y, 3) * r * gd.w};
                const float cs[8] = {c0.x, c0.y, c0.z, c0.w, c1.x, c1.y, c1.z, c1.w}, sn[8] = {s0.x, s0.y, s0.z, s0.w, s1.x, s1.y, s1.z, s1.w};
#pragma unroll
                for (int e = 0; e < 8; ++e) { o1[8 * i + e] = t1[e] * cs[e] - t2[e] * sn[e]; o2[8 * i + e] = t1[e] * sn[e] + t2[e] * cs[e]; } }
            int wds[8];
#pragma unroll
            for (int k = 0; k < 4; ++k) { int x = __builtin_amdgcn_cvt_pk_fp8_f32(o1[4 * k], o1[4 * k + 1], 0, false); x = __builtin_amdgcn_cvt_pk_fp8_f32(o1[4 * k + 2], o1[4 * k + 3], x, true); wds[k] = x;
                x = __builtin_amdgcn_cvt_pk_fp8_f32(o2[4 * k], o2[4 * k + 1], 0, false); x = __builtin_amdgcn_cvt_pk_fp8_f32(o2[4 * k + 2], o2[4 * k + 3], x, true); wds[4 + k] = x; }
            q8[2] = (pg8::i32x8){wds[0], wds[1], wds[2], wds[3], wds[4], wds[5], wds[6], wds[7]}; }
    }
#undef Q8F
    int ko[6], kmask = 0;
    { int rq = r32; asm volatile("" : "+v"(rq));
#pragma unroll
      for (int j = 0; j < 3; ++j)
#pragma unroll
        for (int w = 0; w < 2; ++w) { const int c = j < 2 ? 4 * j + 2 * hi + w : 8 + hi + 2 * w; const int cp = (c + (rq >> 2)) % 12;
            ko[2 * j + w] = rq * 192 + (cp << 4); kmask |= (cp < 4 ? 1 : 0) << (2 * j + w); } }
    LAS float* wsf = (LAS float*)(lds + AT_WS + wave * 256); LAS float* li_l = wsf; LAS float* al_l = wsf + 32;
    float m_reg = -1e30f, l_reg = 0.f; f32x16 o[4];
#pragma unroll
    for (int d = 0; d < 4; ++d) o[d] = (f32x16){0.f, 0.f, 0.f, 0.f, 0.f, 0.f, 0.f, 0.f, 0.f, 0.f, 0.f, 0.f, 0.f, 0.f, 0.f, 0.f};
    const int qlo = NMETA + 256 * qb + 32 * wave;
    const int qm = qlo + r32 - 4 * hi;
    int vrow0, vsk;
    { const int q = (lane & 15) >> 1; vrow0 = ((q & 3) + 8 * (q >> 2) + 4 * hi) * 128 + 16 * ((lane >> 4) & 1) + 8 * (lane & 1); vsk = ((q >> 1) & 1) | (((q >> 2) & 1) << 1); }
    VM_WAIT(); __syncthreads();
    for (int t = 0; t < NT; ++t) {
        const int buf = t & 1;
        if (t + 1 < NT) at_dma_tile(lds, Kimg + (size_t)(t + 1) * AT_KSZ, Vimg + (size_t)(t + 1) * AT_VSZ, buf ^ 1, wave, lane);
        const int kb = 64 * t;
        if (kb <= qlo + 31) {
            f32x16 p0, p1; float mn, alpha;
            at_qkt8(p0, p1, lds + AT_K0 + buf * AT_KSZ, ko, kmask, q8);
            if (kb + 63 > qlo) at_mask(p0, p1, qm - kb);
            at_partialSM(p0, p1, m_reg, mn, alpha);
            if (__any(alpha < 1.f)) { if (hi == 0) al_l[r32] = alpha; LDS_WAIT();
#pragma unroll
                for (int d = 0; d < 4; ++d)
#pragma unroll
                    for (int r = 0; r < 16; ++r) o[d][r] *= al_l[crow(r, hi)]; }
            const pg8::i32x8 P8 = at_finishSM8(p0, p1, alpha, l_reg);
            LAS const unsigned char* vt = lds + AT_V0 + buf * AT_VSZ + vrow0;
            LAS const unsigned char* const va[4] = {vt + ((0 ^ vsk) << 5), vt + ((1 ^ vsk) << 5), vt + ((2 ^ vsk) << 5), vt + ((3 ^ vsk) << 5)};
            at_pv8(o, va, P8);
        }
        VM_WAIT(); LDS_WAIT(); __syncthreads();
    }
    if (hi == 0) li_l[r32] = l_reg;
    LDS_WAIT();
    {   LAS unsigned char* ost = lds + AT_OST + wave * 4096 + 4 * hi * 128 + r32;
#pragma unroll
        for (int r = 0; r < 16; ++r) { const float rl = (ATT_O_SCALE / F8_A_SCALE) * __builtin_amdgcn_rcpf(li_l[crow(r, hi)]);
#pragma unroll
            for (int d0 = 0; d0 < 4; d0 += 2) { const int w = __builtin_amdgcn_cvt_pk_fp8_f32(o[d0][r] * rl, o[d0 + 1][r] * rl, 0, false);
                ost[((r & 3) + 8 * (r >> 2)) * 128 + d0 * 32] = (unsigned char)w; ost[((r & 3) + 8 * (r >> 2)) * 128 + d0 * 32 + 32] = (unsigned char)(w >> 8); } }
        LDS_WAIT();
        unsigned ob = (unsigned)((b * SEQ + 256 * qb + 32 * wave + (lane >> 3)) * (AH * VHD) + h * VHD + 16 * (lane & 7));
        asm volatile("" : "+v"(ob));
#pragma unroll
        for (int j = 0; j < 4; ++j) { const v4u x = *(LAS const v4u*)(lds + AT_OST + wave * 4096 + ((lane >> 3) + 8 * j) * 128 + 16 * (lane & 7));
            *(GAS v4u*)((GAS unsigned char*)ATO + (ob + (unsigned)(8 * j * (AH * VHD)))) = x; } }
    LDS_WAIT(); __syncthreads();
}
__device__ __forceinline__ void attn_phase(Frame& F, const Args& a) {
    if (F.tid < QKD) ((LAS float*)(F.lds + AT_GQ))[F.tid] = ((const float*)a.in[21])[F.tid];
    LDS_WAIT(); __syncthreads();
    for (int n = F.vcu; n < 2048; n += F.G) { const int st = n >> 8, cu = n & 255, xcd = cu >> 5, j = cu & 31; const int bh = 32 * xcd + 4 * st + (j >> 3), p = j & 7;
        attn_block(F, a, bh, 15 - p); attn_block(F, a, bh, p); }
}

__device__ __forceinline__ void meta_in_phase(Frame& F, const Args& a) {
    const bf16* XN = (const bf16*)(a.ws + WS_XN); const bf16* WT = (const bf16*)(a.ws + WS_W_IN); bf16* PROJ = (bf16*)(a.ws + WS_BIG); float* GATES = (float*)(a.ws + WS_GATES);
    const int lane = F.lane, r = lane & 15, q4 = lane >> 4;
    for (int t = F.vcu; t < 769 + 1024; t += F.G) { f32x4 acc[1];
        if (t < 769) { skinny_wg<1>(F, XN + (size_t)MR * DM, WT + (size_t)(16 * t) * DM, WT, DM, acc);
            if (F.wave == 0) {
                if (t < 768) { v2u w; w.x = pk2(acc[0][0], acc[0][1]); w.y = pk2(acc[0][2], acc[0][3]); *(GAS v2u*)(PROJ + (size_t)(MR + r) * NPROJ + 16 * t + 4 * q4) = w; }
                else {
#pragma unroll
                    for (int j = 0; j < 4; ++j) GATES[(size_t)(4 * q4 + j) * MT + MR + r] = acc[0][j]; } } }
        else { const int tt = t - 769;
            skinny_wg<1>(F, WT + (size_t)NPROJ * DM, XN + (size_t)(16 * tt) * DM, XN, DM, acc);
            if (F.wave == 0) *(GAS f32x4*)(GATES + (size_t)r * MT + 16 * tt + 4 * q4) = acc[0]; }
    }
}
__device__ __forceinline__ void meta_out_phase(Frame& F, const Args& a) {
    const bf16* A2 = (const bf16*)(a.ws + WS_XN); const bf16* WT = (const bf16*)(a.ws + WS_W_OUT); float* HM = (float*)(a.ws + WS_HMETA); const float* mt = (const float*)a.in[2];
    const int lane = F.lane, r = lane & 15, q4 = lane >> 4;
    for (int t = F.vcu; t < 256; t += F.G) { f32x4 acc[1]; skinny_wg<1>(F, A2 + (size_t)MR * DM, WT + (size_t)(16 * t) * DM, WT, DM, acc);
        if (F.wave == 0) { const size_t o = (size_t)r * DM + 16 * t + 4 * q4; *(GAS f32x4*)(HM + o) = *(const GAS f32x4*)(mt + o) + acc[0]; } }
}
__device__ __forceinline__ void meta_gu_phase(Frame& F, const Args& a) {
    const bf16* XN = (const bf16*)(a.ws + WS_XN); const bf16* WT = (const bf16*)(a.ws + WS_W_GU0); bf16* ACT = (bf16*)(a.ws + WS_BIG);
    const int lane = F.lane, r = lane & 15, q4 = lane >> 4;
    for (int t = F.vcu; t < DFF / 16; t += F.G) { const int c0 = 16 * t, j = c0 >> 7, i = c0 & 127; f32x4 gu[2];
        skinny_wg<2>(F, XN + (size_t)MR * DM, WT + (size_t)(256 * j + i) * DM, WT + (size_t)(256 * j + 128 + i) * DM, DM, gu);
        if (F.wave == 0) { v2u w; w.x = pk2(pg8::silu_mul(gu[0][0], gu[1][0]), pg8::silu_mul(gu[0][1], gu[1][1])); w.y = pk2(pg8::silu_mul(gu[0][2], gu[1][2]), pg8::silu_mul(gu[0][3], gu[1][3]));
            *(GAS v2u*)(ACT + (size_t)(MR + r) * DFF + c0 + 4 * q4) = w; } }
}
__device__ __forceinline__ void meta_down_phase(Frame& F, const Args& a) {
    const bf16* ACT = (const bf16*)(a.ws + WS_BIG); const bf16* WT = (const bf16*)(a.ws + WS_W_DN0); float* HM = (float*)(a.ws + WS_HMETA);
    const int lane = F.lane, r = lane & 15, q4 = lane >> 4;
    for (int t = F.vcu; t < 256; t += F.G) { f32x4 acc[1]; skinny_wg<1>(F, ACT + (size_t)MR * DFF, WT + (size_t)(16 * t) * DFF, WT, DFF, acc);
        if (F.wave == 0) { const size_t o = (size_t)r * DM + 16 * t + 4 * q4; *(GAS f32x4*)(HM + o) = *(const GAS f32x4*)(HM + o) + acc[0]; } }
}
__device__ __forceinline__ void meta_kvq_phase(Frame& F, const Args& a) {
    const bf16* XN = (const bf16*)(a.ws + WS_XN); const bf16* WT = (const bf16*)(a.ws + WS_W_KVQ); float* LAT = (float*)(a.ws + WS_LAT);
    const int lane = F.lane, r = lane & 15, q4 = lane >> 4;
    for (int t = F.vcu; t < 36; t += F.G) { f32x4 acc[1]; skinny_wg<1>(F, XN + (size_t)MR * DM, WT + (size_t)(16 * t) * DM, WT, DM, acc);
        if (F.wave == 0) *(GAS f32x4*)(LAT + (size_t)(MR + r) * NKVQ + 16 * t + 4 * q4) = acc[0]; }
}
__device__ __forceinline__ void meta_kvup_phase(Frame& F, const Args& a) {
    const bf16* CK = (const bf16*)(a.ws + WS_CKVN); const bf16* WT = (const bf16*)(a.ws + WS_W_KVUP); bf16* KN = (bf16*)(a.ws + WS_KNOPE); unsigned char* Vimg = a.ws + WS_V;
    const int lane = F.lane, r = lane & 15, q4 = lane >> 4;
    for (int t = F.vcu; t < 1024; t += F.G) { f32x4 acc[1]; skinny_wg<1>(F, CK + (size_t)MR * KVLORA, WT + (size_t)(16 * t) * KVLORA, WT, KVLORA, acc);
        if (F.wave == 0) { const int n = 16 * t + 4 * q4, hd = n >> 8, wi = n & 255; v2u w; w.x = pk2(acc[0][0], acc[0][1]); w.y = pk2(acc[0][2], acc[0][3]);
            if (wi < 128) *(GAS v2u*)(KN + (size_t)(MR + r) * 8192 + hd * 128 + wi) = w;
            else { const int c0 = wi - 128; int x = __builtin_amdgcn_cvt_pk_fp8_f32(acc[0][0] * 16.f, acc[0][1] * 16.f, 0, false); x = __builtin_amdgcn_cvt_pk_fp8_f32(acc[0][2] * 16.f, acc[0][3] * 16.f, x, true);
                for (int bb = 0; bb < BATCH; ++bb) *(GAS unsigned*)(Vimg + ((size_t)((bb * AH + hd) * NKT)) * 8192 + pg8::v_img_off8(r, c0)) = (unsigned)x; } } }
}

constexpr int NPH = 18;
__global__ void __launch_bounds__(NTHR, 2) mk_fwd(Args args) {
    extern __shared__ __attribute__((aligned(16))) unsigned char lds_raw[];
    Frame F;
    F.lds = (LAS unsigned char*)lds_raw;
    F.tid = threadIdx.x; F.lane = F.tid & 63; F.wave = __builtin_amdgcn_readfirstlane(F.tid >> 6);
    F.G = gridDim.x; { const int bx = blockIdx.x; F.vcu = (F.G % 8 == 0) ? (bx % 8) * (F.G / 8) + bx / 8 : bx; }
    F.gw = F.vcu * NWAVES + F.wave; F.ngw = F.G * NWAVES;
    volatile LAS unsigned* MISC = (volatile LAS unsigned*)(F.lds + MISC_OFF);
    for (int u = F.tid; u < (LDS_BYTES - LDSCTL_OFF) / 4; u += NTHR) ((LAS unsigned*)(F.lds + LDSCTL_OFF))[u] = 0u;
    __syncthreads();
    unsigned char* ws = args.ws;
    const int lo = args.ph_lo, hi = args.ph_hi;
    const bool one_launch = (hi - lo) > 1;
    XcdBarrier bar; bar.bar = (unsigned*)(ws + WS_CTL); bar.x = 0; bar.st = nullptr;
    if (one_launch) bar = xcd_barrier_post((unsigned*)(ws + WS_CTL), MISC + 8);
    bar.wave = F.wave;
#ifndef MK_PHASES
#define MK_PHASES 0x3ffff
#endif
#define IN(k) ((((MK_PHASES) >> (k)) & 1) && lo <= (k) && (k) < hi)
#define SEAM(k) do { if (IN((k) + 1)) xcd_barrier(bar); } while (0)
    pg8::f16_t* H = (pg8::f16_t*)(ws + WS_H16);
#define REFRESH() do { F.lane = (int)__builtin_amdgcn_mbcnt_hi(~0u, __builtin_amdgcn_mbcnt_lo(~0u, 0u)); F.tid = F.wave * 64 + F.lane; } while (0)
    pg8::f16_t* Hw = args.dry ? (pg8::f16_t*)(ws + WS_END) : H;

    if (IN(0)) { REFRESH(); p0_prologue(F, args); SEAM(0); }
    if (IN(1)) { REFRESH();
        { pg8::Gemm g{(const bf16*)(ws + WS_XN), (const bf16*)(ws + WS_W_IN), MR, 8192, DM}; pg8::StaticOrder S; S.init(MR, 8192, F.G, (int)blockIdx.x);
          pg8::EpiBf16 E{(bf16*)(ws + WS_BIG), NPROJ};
          pg8::gemm_phase<pg8::EpiBf16, pg8::StaticOrder, true, true>(F.lds, g, S, E, F.wave); }
        { pg8::Gemm g{(const bf16*)(ws + WS_HH), (const bf16*)(ws + WS_W_INO8), MR, DM, DM / 2, 0x77777777, 0x7B7B7B7B}; pg8::StaticOrder S; S.init(MR, DM, F.G, (int)blockIdx.x);
          pg8::EpiBf16 E{(bf16*)(ws + WS_BIG) + 8192, NPROJ};
          pg8::gemm_phase<pg8::EpiBf16, pg8::StaticOrder, true, true, true>(F.lds, g, S, E, F.wave); }
        meta_in_phase(F, args); SEAM(1); }
    if (IN(2)) { REFRESH(); for (int u = F.vcu; u < 256; u += F.G) mlstm_unit(F, args, u); SEAM(2); }
    if (IN(3)) { REFRESH(); gate_norm_phase(F, args); SEAM(3); }
    if (IN(4)) { REFRESH();
        pg8::Gemm g{(const bf16*)(ws + WS_XN), (const bf16*)(ws + WS_W_OUT), MR, DM, DM}; pg8::StaticOrder S; S.init(MR, DM, F.G, (int)blockIdx.x);
        pg8::EpiRes<float, pg8::f16_t> E{(const float*)args.in[0], H, DM};
        pg8::gemm_phase<pg8::EpiRes<float, pg8::f16_t>, pg8::StaticOrder, true, true>(F.lds, g, S, E, F.wave);
        meta_out_phase(F, args); SEAM(4); }
    if (IN(5)) { REFRESH(); norm_phase_h(F, H, (const float*)(ws + WS_HMETA), (bf16*)(ws + WS_XN), nullptr, MT, 0); SEAM(5); }
    if (IN(6)) { REFRESH();
        pg8::Gemm g{(const bf16*)(ws + WS_XN), (const bf16*)(ws + WS_W_GU0), MR, NGU, DM}; pg8::StaticOrder S; S.init(MR, NGU, F.G, (int)blockIdx.x);
        pg8::EpiSwiglu E{(bf16*)(ws + WS_BIG), DFF};
        pg8::gemm_phase<pg8::EpiSwiglu, pg8::StaticOrder, true, true>(F.lds, g, S, E, F.wave);
        p0_deferred(F, args, (MR / 256) * (NGU / 256), P0_NITEMS - P0_DEFER_A - P0_DEFER_B, P0_DEFER_A); __syncthreads();
        meta_gu_phase(F, args); SEAM(6); }
    if (IN(7)) { REFRESH();
        pg8::Gemm g{(const bf16*)(ws + WS_BIG), (const bf16*)(ws + WS_W_DN0), MR, DM, DFF}; pg8::StaticOrder S; S.init(MR, DM, F.G, (int)blockIdx.x);
        pg8::EpiRes<pg8::f16_t, pg8::f16_t> E{H, Hw, DM};
        pg8::gemm_phase<pg8::EpiRes<pg8::f16_t, pg8::f16_t>, pg8::StaticOrder, true, true>(F.lds, g, S, E, F.wave);
        meta_down_phase(F, args); SEAM(7); }
    if (IN(8)) { REFRESH(); norm_phase_h(F, H, (const float*)(ws + WS_HMETA), (bf16*)(ws + WS_XN), ws + WS_XN, MT, 2); SEAM(8); }
    if (IN(9)) { REFRESH();
        pg8::Gemm g{(const bf16*)(ws + WS_XN), (const bf16*)(ws + WS_W_KVQ8), MR, NKVQ, DM / 2, 0x77777777, 0x7B7B7B7B}; pg8::StaticOrder S; S.init(MR, NKVQ, F.G, (int)blockIdx.x);
        pg8::EpiF16 E{(pg8::f16_t*)(ws + WS_LAT), NKVQ};
        pg8::gemm_phase<pg8::EpiF16, pg8::StaticOrder, true, true, true>(F.lds, g, S, E, F.wave);
        meta_kvq_phase(F, args); SEAM(9); }
    if (IN(10)) { REFRESH(); latent_norm_phase(F, args); SEAM(10); }
    if (IN(11)) { REFRESH();
        { pg8::Gemm g{(const bf16*)(ws + WS_CKVN), (const bf16*)(ws + WS_W_KVUP8), MR, AH * 256, KVLORA / 2, 0x77777777, 0x7B7B7B7B}; pg8::StaticOrder S; S.init(MR, AH * 256, F.G, (int)blockIdx.x);
          pg8::EpiKvUpK E{ws + WS_K, (bf16*)(ws + WS_V), (const float*)(ws + WS_PRE), (const float*)(ws + WS_SSR), (const float*)args.in[16], (LAS float*)(F.lds + EPI_RED_OFF)};
          pg8::gemm_phase<pg8::EpiKvUpK, pg8::StaticOrder, true, true, true>(F.lds, g, S, E, F.wave); }
        { pg8::Gemm g{(const bf16*)(ws + WS_CQN), (const bf16*)(ws + WS_W_UQ8), MR, AH * QKD, QLORA / 2, 0x77777777, 0x7B7B7B7B}; pg8::StaticOrder S; S.init(MR, AH * QKD, F.G, (int)blockIdx.x);
          pg8::EpiF8 E{ws + WS_BIG, AH * QKD};
          pg8::gemm_phase<pg8::EpiF8, pg8::StaticOrder, true, true, true>(F.lds, g, S, E, F.wave); }
        meta_kvup_phase(F, args); SEAM(11); }
    if (IN(12)) { REFRESH(); k_final_phase(F, args); SEAM(12); }
    if (IN(13)) { REFRESH(); attn_phase(F, args); SEAM(13); }
    if (IN(14)) { REFRESH();
        pg8::Gemm g{(const bf16*)(ws + WS_KNOPE), (const bf16*)(ws + WS_W_O), MR, DM, AH * VHD / 2, 0x77777777, 0x7B7B7B7B}; pg8::StaticOrder S; S.init(MR, DM, F.G, (int)blockIdx.x);
        pg8::EpiRes<pg8::f16_t, pg8::f16_t> E{H, Hw, DM};
        pg8::gemm_phase<pg8::EpiRes<pg8::f16_t, pg8::f16_t>, pg8::StaticOrder, true, true, true>(F.lds, g, S, E, F.wave); SEAM(14); }
    if (IN(15)) { REFRESH(); norm_phase_h(F, H, (const float*)(ws + WS_HMETA), (bf16*)(ws + WS_XN), nullptr, MR, 0); SEAM(15); }
    if (IN(16)) { REFRESH();
        pg8::Gemm g{(const bf16*)(ws + WS_XN), (const bf16*)(ws + WS_W_GU1), MR, NGU, DM}; pg8::StaticOrder S; S.init(MR, NGU, F.G, (int)blockIdx.x);
        pg8::EpiSwiglu E{(bf16*)(ws + WS_BIG), DFF};
        pg8::gemm_phase<pg8::EpiSwiglu, pg8::StaticOrder, true, true>(F.lds, g, S, E, F.wave);
        p0_deferred(F, args, (MR / 256) * (NGU / 256), P0_NITEMS - P0_DEFER_B, P0_DEFER_B); SEAM(16); }
    if (IN(17)) { REFRESH();
        pg8::Gemm g{(const bf16*)(ws + WS_BIG), (const bf16*)(ws + WS_W_DN1), MR, DM, DFF}; pg8::StaticOrder S; S.init(MR, DM, F.G, (int)blockIdx.x);
        pg8::EpiRes<pg8::f16_t, float> E{H, args.dry ? (float*)(ws + WS_END) : args.out, DM};
        pg8::gemm_phase<pg8::EpiRes<pg8::f16_t, float>, pg8::StaticOrder, true, true>(F.lds, g, S, E, F.wave); }
#undef REFRESH
#undef IN
#undef SEAM
}

__global__ void mk_dump(const unsigned char* src, int is_bf16, size_t n_src, float* out, size_t n_out) {
    for (size_t i = (size_t)blockIdx.x * blockDim.x + threadIdx.x; i < n_out; i += (size_t)gridDim.x * blockDim.x) { const size_t j = i % n_src;
        out[i] = is_bf16 ? bf2f(((const unsigned short*)src)[j]) : ((const float*)src)[j]; }
}
extern "C" void kernel_launch(void* const* d_in, const int* in_sizes, int n_in, void* d_out, int out_size, void* d_ws, size_t ws_size, hipStream_t stream) {
    static int grid = 0;
    if (grid == 0) {
        if (n_in != 23 || out_size != MR * DM || ws_size < WS_END) { fprintf(stderr, "kernel_launch: unexpected shapes (n_in %d, out %d, ws %zu < %zu)\n", n_in, out_size, ws_size, (size_t)WS_END); grid = -1; return; }
        int dev = 0, cus = 0, per_cu = 0;
        if (hipGetDevice(&dev) != hipSuccess || hipDeviceGetAttribute(&cus, hipDeviceAttributeMultiprocessorCount, dev) != hipSuccess) { grid = -1; return; }
        if (hipFuncSetAttribute((const void*)mk_fwd, hipFuncAttributeMaxDynamicSharedMemorySize, LDS_BYTES) != hipSuccess) { fprintf(stderr, "kernel_launch: hipFuncSetAttribute failed\n"); grid = -1; return; }
        if (hipOccupancyMaxActiveBlocksPerMultiprocessor(&per_cu, (const void*)mk_fwd, NTHR, LDS_BYTES) != hipSuccess || per_cu < 1) fprintf(stderr, "kernel_launch: occupancy query reports %d\n", per_cu);
        (void)hipGetLastError();
        grid = cus;
    }
    if (grid < 0) return;
    (void)hipMemsetAsync((char*)d_ws + WS_CTL, 0, CTL_ZERO_BYTES, stream);
    Args a{};
    for (int i = 0; i < 23; ++i) a.in[i] = d_in[i];
    a.out = (float*)d_out; a.ws = (unsigned char*)d_ws;
#if defined(MK_STOP_AFTER)
    for (int p = 0; p <= MK_STOP_AFTER; ++p) { a.ph_lo = p; a.ph_hi = p + 1; hipLaunchKernelGGL(mk_fwd, dim3(grid), dim3(NTHR), LDS_BYTES, stream, a); }
#if defined(MK_DUMP_OFF)
    hipLaunchKernelGGL(mk_dump, dim3(2048), dim3(256), 0, stream, (const unsigned char*)d_ws + (size_t)(MK_DUMP_OFF) * MiB, (int)(MK_DUMP_BF16), (size_t)(MK_DUMP_N), (float*)d_out, (size_t)out_size);
#endif
#elif MK_N_LAUNCHES == 1
    a.ph_lo = 0; a.ph_hi = NPH;
    hipLaunchKernelGGL(mk_fwd, dim3(grid), dim3(NTHR), LDS_BYTES, stream, a);
#else
    for (int p = 0; p < NPH; ++p) { a.ph_lo = p; a.ph_hi = p + 1;
#if defined(MK_REPEAT_PHASE)
        if (((MK_REPEAT_PHASE) >> p) & 1) { a.dry = 1; for (int rr = 0; rr < (MK_REPEAT_N); ++rr) hipLaunchKernelGGL(mk_fwd, dim3(grid), dim3(NTHR), LDS_BYTES, stream, a); a.dry = 0; }
#endif
        hipLaunchKernelGGL(mk_fwd, dim3(grid), dim3(NTHR), LDS_BYTES, stream, a);
#if defined(MK_REPEAT_PHASE)
#endif
    }
#endif
}
```

```cpp
#include <hip/hip_runtime.h>
#include <cstdio>
#include <cstdint>
#ifndef MK_N_LAUNCHES
#define MK_N_LAUNCHES 0
#endif
#undef MK_N_LAUNCHES
#define MK_N_LAUNCHES 1
namespace pg8 {
#define PG8_LAS __attribute__((address_space(3)))
typedef unsigned short bf16_t;
typedef short bf16x8 __attribute__((ext_vector_type(8)));
typedef float f32x4 __attribute__((ext_vector_type(4)));
typedef unsigned u32x4 __attribute__((ext_vector_type(4)));
constexpr int BM = 256, BK = 64, HALF = 128, HTB = HALF * BK * 2  , STAGE_BYTES = 8 * HTB, NXCD = 8, WGM = 8;

__host__ __device__ __forceinline__ int lds_byte(int r, int c) { const int st = (r >> 4) * 2 + (c >> 5), rr = r & 15, cc = c & 31, ob = rr * 64 + cc * 2; return st * 1024 + (ob ^ (((ob >> 9) & 1) << 5)); }
__host__ __device__ __forceinline__ void stage_rc(int b, int& R, int& C) { const int st = b / 1024, sb = b % 1024, swz = sb ^ (((sb >> 9) & 1) << 5); R = (st >> 1) * 16 + swz / 64; C = (st & 1) * 32 + (swz % 64) / 2; }
__host__ __device__ __forceinline__ int perm32(int rho) { const int n = rho >> 4, i = rho & 15; return 8 * (i >> 2) + 4 * n + (i & 3); }

struct Unit { int pm, pn; };
struct Gemm { const bf16_t* A; const bf16_t* Bt; int M, N, K; int sB = 0x7F7F7F7F, sA = 0x7F7F7F7F; };
typedef int i32x8 __attribute__((ext_vector_type(8))); typedef int i32x4 __attribute__((ext_vector_type(4)));
__device__ __forceinline__ i32x8 cat8(bf16x8 a, bf16x8 b) { const i32x4 x = __builtin_bit_cast(i32x4, a), y = __builtin_bit_cast(i32x4, b); return __builtin_shufflevector(x, y, 0, 1, 2, 3, 4, 5, 6, 7); }

struct StaticOrder {
    int nM, nN, nwg, G, c;
    __host__ __device__ void init(int M, int N, int G_, int c_) { nM = M / BM; nN = N / BM; nwg = nM * nN; G = G_; c = c_; }
    __host__ __device__ bool next(int i, Unit& u) const {
        const long L = (long)i * G + c; if (L >= nwg) return false;
        int wgid = (int)L; { const int q = nwg / NXCD, r = nwg % NXCD, xcd = wgid % NXCD, off = wgid / NXCD; wgid = (xcd < r ? xcd * (q + 1) : r * (q + 1) + (xcd - r) * q) + off; }
        const int nig = WGM * nN, gid = wgid / nig, fm = gid * WGM, gsz = (nM - fm) < WGM ? (nM - fm) : WGM;
        u.pm = fm + ((wgid % nig) % gsz); u.pn = (wgid % nig) / gsz; return true;
    }
    __device__ __forceinline__ void a_ready(const Unit&) const {}
    __device__ __forceinline__ void done(const Unit&) const {}
};

typedef float f32x2_cv __attribute__((ext_vector_type(2))); typedef __bf16 bf16x2_cv __attribute__((ext_vector_type(2)));
__device__ __forceinline__ unsigned cvt_pk_bf16(float lo, float hi) { const f32x2_cv v = {lo, hi}; const bf16x2_cv b = __builtin_convertvector(v, bf16x2_cv); return __builtin_bit_cast(unsigned, b); }
__host__ __device__ __forceinline__ int v_img_off8(int k, int d) { return k * 128 + ((((d >> 5) ^ (((k >> 1) & 1) | (((k >> 3) & 1) << 1))) & 3) << 5) + (d & 31); }
__host__ __device__ __forceinline__ int v_st(int k, int c) { const int kk = (k & ~0xC) | ((k & 4) << 1) | ((k & 8) >> 1); return ((kk >> 3) * 4 + (c >> 5)) * 512 + ((kk & 7) * 32 + (c & 31)) * 2; }

struct EpiBf16 {
    static constexpr bool PERM = true, AFTER_DRAIN = false, INIT = false;
    bf16_t* O; int ldc;
    __device__ __forceinline__ void operator()(const f32x4 (&acc)[2][2][4][2], const Unit& u, int wr, int wc, int fr, int fq) const {
        const int row0 = u.pm * BM + wr * 64 + fr, col0 = u.pn * BM + wc * 32 + 8 * fq;
#pragma unroll
        for (int ai = 0; ai < 2; ++ai)
#pragma unroll
            for (int m = 0; m < 4; ++m) { bf16_t* rowp = O + (size_t)(row0 + ai * HALF + m * 16) * ldc + col0;
#pragma unroll
                for (int bj = 0; bj < 2; ++bj) { const f32x4 v0 = acc[ai][bj][m][0], v1 = acc[ai][bj][m][1];
                    u32x4 w; w.x = cvt_pk_bf16(v0[0], v0[1]); w.y = cvt_pk_bf16(v0[2], v0[3]); w.z = cvt_pk_bf16(v1[0], v1[1]); w.w = cvt_pk_bf16(v1[2], v1[3]);
                    *(u32x4*)(rowp + bj * HALF) = w; } }
    }
};
struct EpiF32 {
    static constexpr bool PERM = false, AFTER_DRAIN = false, INIT = false;
    float* C; int ldc;
    __device__ __forceinline__ void operator()(const f32x4 (&acc)[2][2][4][2], const Unit& u, int wr, int wc, int fr, int fq) const {
        const int row0 = u.pm * BM + wr * 64 + fr, col0 = u.pn * BM + wc * 32 + 4 * fq;
#pragma unroll
        for (int ai = 0; ai < 2; ++ai)
#pragma unroll
            for (int m = 0; m < 4; ++m) { float* rowp = C + (size_t)(row0 + ai * HALF + m * 16) * ldc + col0;
#pragma unroll
                for (int bj = 0; bj < 2; ++bj)
#pragma unroll
                    for (int n = 0; n < 2; ++n) *(f32x4*)(rowp + bj * HALF + n * 16) = acc[ai][bj][m][n]; }
    }
};
struct EpiResF32 {
    static constexpr bool PERM = false, AFTER_DRAIN = false, INIT = false;
    const float* base; float* out; int ldc;
    __device__ __forceinline__ void init(f32x4 (&acc)[2][2][4][2], const Unit& u, int wr, int wc, int fr, int fq) const {}
    __device__ __forceinline__ void operator()(const f32x4 (&acc)[2][2][4][2], const Unit& u, int wr, int wc, int fr, int fq) const {
        const int row0 = u.pm * BM + wr * 64 + fr, col0 = u.pn * BM + wc * 32 + 4 * fq;
#pragma unroll
        for (int ai = 0; ai < 2; ++ai)
#pragma unroll
            for (int m = 0; m < 4; ++m) { const size_t off = (size_t)(row0 + ai * HALF + m * 16) * ldc + col0;
#pragma unroll
                for (int bj = 0; bj < 2; ++bj)
#pragma unroll
                    for (int n = 0; n < 2; ++n) { const f32x4 b = *(const f32x4*)(base + off + bj * HALF + n * 16); *(f32x4*)(out + off + bj * HALF + n * 16) = b + acc[ai][bj][m][n]; } }
    }
};
typedef _Float16 f16_t; typedef _Float16 f16x2_cv __attribute__((ext_vector_type(2)));
__device__ __forceinline__ unsigned cvt_pk_f16(float lo, float hi) { const f32x2_cv v = {lo, hi}; const f16x2_cv b = __builtin_convertvector(v, f16x2_cv); return __builtin_bit_cast(unsigned, b); }
__device__ __forceinline__ float f16lo(unsigned w) { return (float)__builtin_bit_cast(f16x2_cv, w)[0]; }
__device__ __forceinline__ float f16hi(unsigned w) { return (float)__builtin_bit_cast(f16x2_cv, w)[1]; }
template <class TI, class TO> struct EpiRes {
    static constexpr bool PERM = true, AFTER_DRAIN = false, INIT = false;
    const TI* base; TO* out; int ldc;
    __device__ __forceinline__ void operator()(const f32x4 (&acc)[2][2][4][2], const Unit& u, int wr, int wc, int fr, int fq) const {
        const int row0 = u.pm * BM + wr * 64 + fr, col0 = u.pn * BM + wc * 32 + 8 * fq;
#pragma unroll
        for (int ai = 0; ai < 2; ++ai)
#pragma unroll
            for (int m = 0; m < 4; ++m) { const size_t off = (size_t)(row0 + ai * HALF + m * 16) * ldc + col0;
#pragma unroll
                for (int bj = 0; bj < 2; ++bj) { f32x4 v0 = acc[ai][bj][m][0], v1 = acc[ai][bj][m][1];
                    if constexpr (sizeof(TI) == 4) { v0 += *(const f32x4*)(base + off + bj * HALF); v1 += *(const f32x4*)(base + off + bj * HALF + 4); }
                    else { const u32x4 b = *(const u32x4*)(base + off + bj * HALF);
                        v0[0] += f16lo(b.x); v0[1] += f16hi(b.x); v0[2] += f16lo(b.y); v0[3] += f16hi(b.y); v1[0] += f16lo(b.z); v1[1] += f16hi(b.z); v1[2] += f16lo(b.w); v1[3] += f16hi(b.w); }
                    if constexpr (sizeof(TO) == 4) { *(f32x4*)(out + off + bj * HALF) = v0; *(f32x4*)(out + off + bj * HALF + 4) = v1; }
                    else { u32x4 w; w.x = cvt_pk_f16(v0[0], v0[1]); w.y = cvt_pk_f16(v0[2], v0[3]); w.z = cvt_pk_f16(v1[0], v1[1]); w.w = cvt_pk_f16(v1[2], v1[3]); *(u32x4*)(out + off + bj * HALF) = w; } } }
    }
};
__device__ __forceinline__ float silu_mul(float g, float u) { return g * __builtin_amdgcn_rcpf(1.0f + __expf(-g)) * u; }
struct EpiSwiglu {
    static constexpr bool PERM = true, AFTER_DRAIN = false, INIT = false;
    bf16_t* O; int ldc;
    __device__ __forceinline__ void operator()(const f32x4 (&acc)[2][2][4][2], const Unit& u, int wr, int wc, int fr, int fq) const {
        const int row0 = u.pm * BM + wr * 64 + fr, col0 = u.pn * HALF + wc * 32 + 8 * fq;
#pragma unroll
        for (int ai = 0; ai < 2; ++ai)
#pragma unroll
            for (int m = 0; m < 4; ++m) { bf16_t* rowp = O + (size_t)(row0 + ai * HALF + m * 16) * ldc + col0;
                const f32x4 g0 = acc[ai][0][m][0], g1 = acc[ai][0][m][1], u0 = acc[ai][1][m][0], u1 = acc[ai][1][m][1];
                u32x4 w; w.x = cvt_pk_bf16(silu_mul(g0[0], u0[0]), silu_mul(g0[1], u0[1])); w.y = cvt_pk_bf16(silu_mul(g0[2], u0[2]), silu_mul(g0[3], u0[3]));
                w.z = cvt_pk_bf16(silu_mul(g1[0], u1[0]), silu_mul(g1[1], u1[1])); w.w = cvt_pk_bf16(silu_mul(g1[2], u1[2]), silu_mul(g1[3], u1[3]));
                *(u32x4*)rowp = w; }
    }
};
struct EpiKvUp {
    static constexpr bool PERM = true, AFTER_DRAIN = false, INIT = false;
    bf16_t* KN; bf16_t* V;
    __device__ __forceinline__ void operator()(const f32x4 (&acc)[2][2][4][2], const Unit& u, int wr, int wc, int fr, int fq) const {
        const int row0 = u.pm * BM + wr * 64 + fr, colL = wc * 32 + 8 * fq;
#pragma unroll
        for (int ai = 0; ai < 2; ++ai)
#pragma unroll
            for (int m = 0; m < 4; ++m) { const int row = row0 + ai * HALF + m * 16, b = row >> 12, key = 16 + (row & 4095);
#pragma unroll
                for (int bj = 0; bj < 2; ++bj) { const f32x4 v0 = acc[ai][bj][m][0], v1 = acc[ai][bj][m][1];
                    u32x4 w; w.x = cvt_pk_bf16(v0[0], v0[1]); w.y = cvt_pk_bf16(v0[2], v0[3]); w.z = cvt_pk_bf16(v1[0], v1[1]); w.w = cvt_pk_bf16(v1[2], v1[3]);
                    if (bj == 0) *(u32x4*)(KN + (size_t)row * 8192 + u.pn * HALF + colL) = w;
                    else { typedef unsigned u32x2 __attribute__((ext_vector_type(2))); u32x2 w8;
                        int x = __builtin_amdgcn_cvt_pk_fp8_f32(v0[0] * 16.f, v0[1] * 16.f, 0, false); x = __builtin_amdgcn_cvt_pk_fp8_f32(v0[2] * 16.f, v0[3] * 16.f, x, true); w8.x = (unsigned)x;
                        x = __builtin_amdgcn_cvt_pk_fp8_f32(v1[0] * 16.f, v1[1] * 16.f, 0, false); x = __builtin_amdgcn_cvt_pk_fp8_f32(v1[2] * 16.f, v1[3] * 16.f, x, true); w8.y = (unsigned)x;
                        *(u32x2*)((char*)V + ((size_t)((b * 64 + u.pn) * 65 + (key >> 6))) * 8192 + v_img_off8(key & 63, colL)) = w8; } } }
    }
};
struct EpiF16 {
    static constexpr bool PERM = true, AFTER_DRAIN = false, INIT = false;
    f16_t* O; int ldc;
    __device__ __forceinline__ void operator()(const f32x4 (&acc)[2][2][4][2], const Unit& u, int wr, int wc, int fr, int fq) const {
        const int row0 = u.pm * BM + wr * 64 + fr, col0 = u.pn * BM + wc * 32 + 8 * fq;
#pragma unroll
        for (int ai = 0; ai < 2; ++ai)
#pragma unroll
            for (int m = 0; m < 4; ++m) { f16_t* rowp = O + (size_t)(row0 + ai * HALF + m * 16) * ldc + col0;
#pragma unroll
                for (int bj = 0; bj < 2; ++bj) { const f32x4 v0 = acc[ai][bj][m][0], v1 = acc[ai][bj][m][1];
                    u32x4 w; w.x = cvt_pk_f16(v0[0], v0[1]); w.y = cvt_pk_f16(v0[2], v0[3]); w.z = cvt_pk_f16(v1[0], v1[1]); w.w = cvt_pk_f16(v1[2], v1[3]);
                    *(u32x4*)(rowp + bj * HALF) = w; } }
    }
};
struct EpiF8 {
    static constexpr bool PERM = true, AFTER_DRAIN = false, INIT = false;
    unsigned char* O; int ldc;
    __device__ __forceinline__ void operator()(const f32x4 (&acc)[2][2][4][2], const Unit& u, int wr, int wc, int fr, int fq) const {
        typedef unsigned u32x2 __attribute__((ext_vector_type(2)));
        const int row0 = u.pm * BM + wr * 64 + fr, col0 = u.pn * BM + wc * 32 + 8 * fq;
#pragma unroll
        for (int ai = 0; ai < 2; ++ai)
#pragma unroll
            for (int m = 0; m < 4; ++m) { unsigned char* rowp = O + (size_t)(row0 + ai * HALF + m * 16) * ldc + col0;
#pragma unroll
                for (int bj = 0; bj < 2; ++bj) { const f32x4 v0 = acc[ai][bj][m][0], v1 = acc[ai][bj][m][1]; u32x2 w8;
                    int x = __builtin_amdgcn_cvt_pk_fp8_f32(v0[0] * 16.f, v0[1] * 16.f, 0, false); x = __builtin_amdgcn_cvt_pk_fp8_f32(v0[2] * 16.f, v0[3] * 16.f, x, true); w8.x = (unsigned)x;
                    x = __builtin_amdgcn_cvt_pk_fp8_f32(v1[0] * 16.f, v1[1] * 16.f, 0, false); x = __builtin_amdgcn_cvt_pk_fp8_f32(v1[2] * 16.f, v1[3] * 16.f, x, true); w8.y = (unsigned)x;
                    *(u32x2*)(rowp + bj * HALF) = w8; } }
    }
};
__host__ __device__ __forceinline__ int k_img_off8(int r, int d) { return r * 192 + ((((d >> 4) + (r >> 2)) % 12) << 4) + (d & 15); }
struct EpiKvUpK {
    static constexpr bool PERM = true, AFTER_DRAIN = false, INIT = false;
    unsigned char* Kimg; bf16_t* V; const float* PRE; const float* SSR; const float* gk; PG8_LAS float* red;
    __device__ __forceinline__ void operator()(const f32x4 (&acc)[2][2][4][2], const Unit& u, int wr, int wc, int fr, int fq) const {
        typedef unsigned u32x2 __attribute__((ext_vector_type(2)));
        asm volatile("" : "+v"(fr), "+v"(fq));
        const int rl0 = wr * 64 + fr, colL = wc * 32 + 8 * fq;
#pragma unroll
        for (int j = 0; j < 8; ++j) { const f32x4 v0 = acc[j >> 2][0][j & 3][0], v1 = acc[j >> 2][0][j & 3][1];
            float s = ((v0[0] * v0[0] + v0[1] * v0[1]) + (v0[2] * v0[2] + v0[3] * v0[3])) + ((v1[0] * v1[0] + v1[1] * v1[1]) + (v1[2] * v1[2] + v1[3] * v1[3]));
            s += __shfl_xor(s, 16); s += __shfl_xor(s, 32);
            if (fq == 0) red[(rl0 + (j >> 2) * HALF + (j & 3) * 16) * 4 + wc] = s; }
        asm volatile("s_waitcnt lgkmcnt(0)" ::: "memory"); __builtin_amdgcn_s_barrier(); asm volatile("" ::: "memory");
        int rowv = u.pm * BM + rl0; asm volatile("" : "+v"(rowv));
        const int rlA = rl0 + (fq >> 1) * HALF + (fq & 1) * 32, rowA = rowv + (fq >> 1) * HALF + (fq & 1) * 32;
        float rA, rB;
        { const float sA = SSR[(unsigned)rowA], sB = SSR[(unsigned)rowA + 16u]; const f32x4 tA = *(const PG8_LAS f32x4*)(red + rlA * 4), tB = *(const PG8_LAS f32x4*)(red + (rlA + 16) * 4);
          rA = 16.0f / sqrtf((((tA[0] + tA[1]) + (tA[2] + tA[3])) + sA) * (1.0f / 192.0f) + 1e-6f); rB = 16.0f / sqrtf((((tB[0] + tB[1]) + (tB[2] + tB[3])) + sB) * (1.0f / 192.0f) + 1e-6f); }
        __builtin_amdgcn_sched_barrier(0);
        const f32x4 ga = *(const f32x4*)(gk + colL), gb = *(const f32x4*)(gk + colL + 4);
#pragma unroll
        for (int j = 0; j < 8; ++j) { const int row = rowv + (j >> 2) * HALF + (j & 3) * 16, key = 16 + (row & 4095); const unsigned tile = (unsigned)(((row >> 12) * 64 + u.pn) * 65 + (key >> 6));
            const float rr = __shfl((j & 1) ? rB : rA, fr + 16 * (j >> 1));
            { const f32x4 v0 = acc[j >> 2][0][j & 3][0], v1 = acc[j >> 2][0][j & 3][1]; u32x2 w8;
                int x = __builtin_amdgcn_cvt_pk_fp8_f32(v0[0] * ga[0] * rr, v0[1] * ga[1] * rr, 0, false); x = __builtin_amdgcn_cvt_pk_fp8_f32(v0[2] * ga[2] * rr, v0[3] * ga[3] * rr, x, true); w8.x = (unsigned)x;
                x = __builtin_amdgcn_cvt_pk_fp8_f32(v1[0] * gb[0] * rr, v1[1] * gb[1] * rr, 0, false); x = __builtin_amdgcn_cvt_pk_fp8_f32(v1[2] * gb[2] * rr, v1[3] * gb[3] * rr, x, true); w8.y = (unsigned)x;
                *(u32x2*)(Kimg + (tile * 12288u + (unsigned)k_img_off8(key & 63, colL))) = w8; }
            { const f32x4 v0 = acc[j >> 2][1][j & 3][0], v1 = acc[j >> 2][1][j & 3][1]; u32x2 w8;
                int x = __builtin_amdgcn_cvt_pk_fp8_f32(v0[0] * 16.f, v0[1] * 16.f, 0, false); x = __builtin_amdgcn_cvt_pk_fp8_f32(v0[2] * 16.f, v0[3] * 16.f, x, true); w8.x = (unsigned)x;
                x = __builtin_amdgcn_cvt_pk_fp8_f32(v1[0] * 16.f, v1[1] * 16.f, 0, false); x = __builtin_amdgcn_cvt_pk_fp8_f32(v1[2] * 16.f, v1[3] * 16.f, x, true); w8.y = (unsigned)x;
                *(u32x2*)((unsigned char*)V + (tile * 8192u + (unsigned)v_img_off8(key & 63, colL))) = w8; }
            if (j & 1) __builtin_amdgcn_sched_barrier(0); }
#pragma unroll
        for (int x2 = 0; x2 < 2; ++x2) { const float rr = x2 ? rB : rA;
            const int row = rowA + 16 * x2, key = 16 + (row & 4095); const unsigned tile = (unsigned)(((row >> 12) * 64 + u.pn) * 65 + (key >> 6));
            const float* pp = (const float*)((const char*)PRE + (unsigned)(row * 256 + 64 * wc)); const f32x4 p0 = *(const f32x4*)pp, p1 = *(const f32x4*)(pp + 4), p2 = *(const f32x4*)(pp + 8), p3 = *(const f32x4*)(pp + 12);
            u32x4 w; int x = __builtin_amdgcn_cvt_pk_fp8_f32(p0[0] * rr, p0[1] * rr, 0, false); x = __builtin_amdgcn_cvt_pk_fp8_f32(p0[2] * rr, p0[3] * rr, x, true); w.x = (unsigned)x;
            x = __builtin_amdgcn_cvt_pk_fp8_f32(p1[0] * rr, p1[1] * rr, 0, false); x = __builtin_amdgcn_cvt_pk_fp8_f32(p1[2] * rr, p1[3] * rr, x, true); w.y = (unsigned)x;
            x = __builtin_amdgcn_cvt_pk_fp8_f32(p2[0] * rr, p2[1] * rr, 0, false); x = __builtin_amdgcn_cvt_pk_fp8_f32(p2[2] * rr, p2[3] * rr, x, true); w.z = (unsigned)x;
            x = __builtin_amdgcn_cvt_pk_fp8_f32(p3[0] * rr, p3[1] * rr, 0, false); x = __builtin_amdgcn_cvt_pk_fp8_f32(p3[2] * rr, p3[3] * rr, x, true); w.w = (unsigned)x;
            *(u32x4*)(Kimg + (tile * 12288u + (unsigned)k_img_off8(key & 63, 128 + 16 * wc))) = w;
            __builtin_amdgcn_sched_barrier(0); }
    }
};

template <class Epi, class Sched, bool ALIGN_EPI = false, bool SP2 = false, bool F8 = false>
__device__ __forceinline__ void gemm_phase(PG8_LAS unsigned char* lds, const Gemm g, const Sched& S, const Epi& E, int wave_id) {
    const int wid = wave_id, lane = (int)__builtin_amdgcn_mbcnt_hi(~0u, __builtin_amdgcn_mbcnt_lo(~0u, 0u)), tid = wid * 64 + lane, wr = wid >> 2, wc = wid & 3, fr = lane & 15, fq = lane >> 4;
    const int K = g.K, nt = K / BK;
    unsigned voffA[2], voffB[2];
#pragma unroll
    for (int i = 0; i < 2; ++i) { int R, C; stage_rc(tid * 16 + i * 8192, R, C); const int Rb = Epi::PERM ? ((R & ~31) + perm32(R & 31)) : R;
        voffA[i] = (unsigned)(R * K + C) * 2u; voffB[i] = (unsigned)(Rb * K + C) * 2u; }
    const size_t kstep = (size_t)(BK * 2);
    const size_t hstep = (size_t)HALF * K * 2;
    const size_t tstep = 2 * hstep;
    const unsigned ldsw = (unsigned)wid * 1024u;
    const int aoff = lds_byte(wr * 64 + fr, fq * 8), boff = lds_byte(wc * 32 + fr, fq * 8);
#define PG8_SA(b, h) (((b) * 2 + (h)) * HTB)
#define PG8_SB(b, h) ((4 + (b) * 2 + (h)) * HTB)
#define PG8_STAGE(bufoff, gbase, voff) do { _Pragma("unroll") for (int _i = 0; _i < 2; ++_i) \
        __builtin_amdgcn_global_load_lds((const unsigned*)((const char*)(gbase) + (voff)[_i]), (PG8_LAS unsigned*)(lds + (bufoff) + ldsw + _i * 8192), 16, 0, 0); } while (0)
#define PG8_LDA(dst, b, h) do { if constexpr (F8) { _Pragma("unroll") for (int m = 0; m < 4; ++m) dst##8[m] = cat8(*(const PG8_LAS bf16x8*)(lds + PG8_SA(b, h) + aoff + m * 2048), *(const PG8_LAS bf16x8*)(lds + PG8_SA(b, h) + aoff + m * 2048 + 1024)); } \
        else { _Pragma("unroll") for (int m = 0; m < 4; ++m) _Pragma("unroll") for (int k = 0; k < 2; ++k) dst[m][k] = *(const PG8_LAS bf16x8*)(lds + PG8_SA(b, h) + aoff + m * 2048 + k * 1024); } } while (0)
#define PG8_LDB(dst, b, h) do { if constexpr (F8) { _Pragma("unroll") for (int n = 0; n < 2; ++n) dst##8[n] = cat8(*(const PG8_LAS bf16x8*)(lds + PG8_SB(b, h) + boff + n * 2048), *(const PG8_LAS bf16x8*)(lds + PG8_SB(b, h) + boff + n * 2048 + 1024)); } \
        else { _Pragma("unroll") for (int n = 0; n < 2; ++n) _Pragma("unroll") for (int k = 0; k < 2; ++k) dst[n][k] = *(const PG8_LAS bf16x8*)(lds + PG8_SB(b, h) + boff + n * 2048 + k * 1024); } } while (0)
#define PG8_MMA(ai, bj, At, Bt) do { __builtin_amdgcn_s_setprio(1); \
        if constexpr (F8) { _Pragma("unroll") for (int m = 0; m < 4; ++m) _Pragma("unroll") for (int n = 0; n < 2; ++n) \
            asm volatile("v_mfma_scale_f32_16x16x128_f8f6f4 %0, %1, %2, %0, %3, %4 op_sel_hi:[0,0,0]" : "+v"(acc[ai][bj][m][n]) : "v"(Bt##8[n]), "v"(At##8[m]), "v"(f8sB), "v"(f8sA)); } \
        else { _Pragma("unroll") for (int m = 0; m < 4; ++m) _Pragma("unroll") for (int n = 0; n < 2; ++n) _Pragma("unroll") for (int k = 0; k < 2; ++k) \
            acc[ai][bj][m][n] = __builtin_amdgcn_mfma_f32_16x16x32_bf16(Bt[n][k], At[m][k], acc[ai][bj][m][n], 0, 0, 0); } \
        __builtin_amdgcn_s_setprio(0); } while (0)
#define PG8_WAIT_V(n) asm volatile("s_waitcnt vmcnt(" #n ")" ::: "memory")
#define PG8_WAIT_L(n) asm volatile("s_waitcnt lgkmcnt(" #n ")" ::: "memory")
#define PG8_BAR __builtin_amdgcn_s_barrier()
#define PG8_SCHED __builtin_amdgcn_sched_barrier(0)
    Unit cur, nxt; int ui = 0;
    if (!S.next(0, cur)) return;
    f32x4 acc[2][2][4][2];
    if constexpr (Epi::INIT) E.init(acc, cur, wr, wc, fr, fq);
    else {
#pragma unroll
    for (int a = 0; a < 2; ++a)
#pragma unroll
        for (int b = 0; b < 2; ++b)
#pragma unroll
            for (int m = 0; m < 4; ++m)
#pragma unroll
                for (int n = 0; n < 2; ++n) acc[a][b][m][n] = (f32x4){0.f, 0.f, 0.f, 0.f};
    }
    bf16x8 At[F8 ? 1 : 4][2], B0[F8 ? 1 : 2][2], B1[F8 ? 1 : 2][2];
    const int f8sB = g.sB, f8sA = g.sA;
    i32x8 At8[F8 ? 4 : 1], B08[F8 ? 2 : 1], B18[F8 ? 2 : 1];
    const char* cA = (const char*)g.A + (size_t)cur.pm * tstep; const char* cB = (const char*)g.Bt + (size_t)cur.pn * tstep;
    S.a_ready(cur);
    if constexpr (SP2) {
        PG8_STAGE(PG8_SB(0, 0), cB, voffB); PG8_STAGE(PG8_SB(0, 1), cB + hstep, voffB); PG8_STAGE(PG8_SA(0, 0), cA, voffA); PG8_STAGE(PG8_SA(0, 1), cA + hstep, voffA);
        if (wr == 1) PG8_BAR;
        PG8_WAIT_V(2); PG8_BAR;
        PG8_STAGE(PG8_SB(1, 0), cB + kstep, voffB); PG8_STAGE(PG8_SA(1, 0), cA + kstep, voffA); PG8_STAGE(PG8_SB(1, 1), cB + hstep + kstep, voffB);
        PG8_WAIT_V(6); PG8_BAR;
    } else {
        PG8_STAGE(PG8_SB(0, 0), cB, voffB); PG8_STAGE(PG8_SA(0, 0), cA, voffA); PG8_STAGE(PG8_SB(0, 1), cB + hstep, voffB); PG8_STAGE(PG8_SA(0, 1), cA + hstep, voffA);
        if (wr == 1) PG8_BAR;
        PG8_WAIT_V(4); PG8_BAR;
        PG8_STAGE(PG8_SB(1, 0), cB + kstep, voffB); PG8_STAGE(PG8_SA(1, 0), cA + kstep, voffA); PG8_STAGE(PG8_SB(1, 1), cB + hstep + kstep, voffB);
        PG8_WAIT_V(6); PG8_BAR;
    }
    for (;;) {
        const bool has_next = S.next(ui + 1, nxt);
        const char* nA = has_next ? (const char*)g.A + (size_t)nxt.pm * tstep : cA; const char* nB = has_next ? (const char*)g.Bt + (size_t)nxt.pn * tstep : cB;
        for (int t = 0; t < nt; t += 2) {
            const bool last = (t == nt - 2);
            const char* a1 = cA + (size_t)(t + 1) * kstep;
            const char* a2 = last ? nA : cA + (size_t)(t + 2) * kstep; const char* b2 = last ? nB : cB + (size_t)(t + 2) * kstep;
            const char* a3 = a2 + kstep; const char* b3 = b2 + kstep;
            if (last && has_next) S.a_ready(nxt);
            if constexpr (SP2) {
            PG8_LDB(B0, 0, 0); PG8_LDB(B1, 0, 1); PG8_SCHED; PG8_LDA(At, 0, 0); PG8_STAGE(PG8_SA(1, 1), a1 + hstep, voffA);
            PG8_WAIT_V(8); PG8_WAIT_L(0); PG8_BAR; PG8_MMA(0, 0, At, B0); PG8_MMA(0, 1, At, B1); PG8_BAR; PG8_SCHED;
            PG8_LDA(At, 0, 1); PG8_STAGE(PG8_SB(0, 0), b2, voffB); PG8_STAGE(PG8_SB(0, 1), b2 + hstep, voffB); PG8_STAGE(PG8_SA(0, 0), a2, voffA);
            PG8_WAIT_V(8); PG8_WAIT_L(0); PG8_BAR; PG8_MMA(1, 0, At, B0); PG8_MMA(1, 1, At, B1); PG8_BAR; PG8_SCHED;
            PG8_LDB(B0, 1, 0); PG8_LDB(B1, 1, 1); PG8_SCHED; PG8_LDA(At, 1, 0); PG8_STAGE(PG8_SA(0, 1), a2 + hstep, voffA);
            PG8_WAIT_V(8); PG8_WAIT_L(0); PG8_BAR; PG8_MMA(0, 0, At, B0); PG8_MMA(0, 1, At, B1); PG8_BAR; PG8_SCHED;
            PG8_LDA(At, 1, 1); PG8_STAGE(PG8_SB(1, 0), b3, voffB); PG8_STAGE(PG8_SB(1, 1), b3 + hstep, voffB); PG8_STAGE(PG8_SA(1, 0), a3, voffA);
            PG8_WAIT_V(8); PG8_WAIT_L(0); PG8_BAR; PG8_MMA(1, 0, At, B0); PG8_MMA(1, 1, At, B1); PG8_BAR; PG8_SCHED;
            } else {
            PG8_LDB(B0, 0, 0); PG8_SCHED; PG8_LDA(At, 0, 0); PG8_STAGE(PG8_SA(1, 1), a1 + hstep, voffA);
            PG8_WAIT_L(8); PG8_BAR; PG8_WAIT_L(0); PG8_MMA(0, 0, At, B0); PG8_BAR; PG8_SCHED;
            PG8_LDB(B1, 0, 1); PG8_STAGE(PG8_SB(0, 0), b2, voffB);
            PG8_BAR; PG8_WAIT_L(0); PG8_MMA(0, 1, At, B1); PG8_BAR;
            PG8_LDA(At, 0, 1); PG8_STAGE(PG8_SA(0, 0), a2, voffA);
            PG8_BAR; PG8_WAIT_L(0); PG8_MMA(1, 0, At, B0); PG8_BAR; PG8_SCHED;
            PG8_STAGE(PG8_SB(0, 1), b2 + hstep, voffB);
            PG8_WAIT_V(6); PG8_BAR; PG8_MMA(1, 1, At, B1); PG8_BAR;
            PG8_LDB(B0, 1, 0); PG8_SCHED; PG8_LDA(At, 1, 0); PG8_STAGE(PG8_SA(0, 1), a2 + hstep, voffA);
            PG8_WAIT_L(8); PG8_BAR; PG8_WAIT_L(0); PG8_MMA(0, 0, At, B0); PG8_BAR; PG8_SCHED;
            PG8_LDB(B1, 1, 1); PG8_STAGE(PG8_SB(1, 0), b3, voffB);
            PG8_BAR; PG8_WAIT_L(0); PG8_MMA(0, 1, At, B1); PG8_BAR;
            PG8_LDA(At, 1, 1); PG8_STAGE(PG8_SA(1, 0), a3, voffA);
            PG8_BAR; PG8_WAIT_L(0); PG8_MMA(1, 0, At, B0); PG8_BAR; PG8_SCHED;
            PG8_STAGE(PG8_SB(1, 1), b3 + hstep, voffB);
            PG8_WAIT_V(6); PG8_BAR; PG8_MMA(1, 1, At, B1); PG8_BAR;
            }
        }
        if constexpr (F8) asm volatile("s_nop 15\n\ts_nop 15" ::: "memory");
        if constexpr (ALIGN_EPI) { if (wr == 0) PG8_BAR; }
        if constexpr (!Epi::AFTER_DRAIN) { E(acc, cur, wr, wc, fr, fq); S.done(cur); }
        if (!has_next) break;
        if constexpr (Epi::INIT) E.init(acc, nxt, wr, wc, fr, fq);
        else {
#pragma unroll
        for (int a = 0; a < 2; ++a)
#pragma unroll
            for (int b = 0; b < 2; ++b)
#pragma unroll
                for (int m = 0; m < 4; ++m)
#pragma unroll
                    for (int n = 0; n < 2; ++n) acc[a][b][m][n] = (f32x4){0.f, 0.f, 0.f, 0.f};
        }
        cur = nxt; cA = nA; cB = nB; ++ui;
        if constexpr (ALIGN_EPI) { if (wr == 1) PG8_BAR; }
    }
    PG8_WAIT_V(0);
    if constexpr (!ALIGN_EPI) { if (wr == 0) PG8_BAR; }
    PG8_BAR;
    if constexpr (Epi::AFTER_DRAIN) { E.fused(acc, cur, wr, wc, fr, fq, lds, wid, lane); S.done(cur); }
#undef PG8_SA
#undef PG8_SB
#undef PG8_STAGE
#undef PG8_LDA
#undef PG8_LDB
#undef PG8_MMA
#undef PG8_WAIT_V
#undef PG8_WAIT_L
#undef PG8_BAR
#undef PG8_SCHED
}
}

constexpr int BATCH = 4, SEQ = 4096, DM = 4096, NMETA = 16, MR = BATCH * SEQ  , MT = MR + NMETA  ;
constexpr int MHEADS = 8, MDK = 256, MDV = 512, NPROJ = 12288  , NIN = 12304  ;
constexpr int AH = 64, QLORA = 1024, KVLORA = 512, NOPE = 128, ROPE = 64, QKD = 192, VHD = 128;
constexpr int DFF = 11008, NGU = 2 * DFF;
constexpr int NKT = 65;
constexpr int NKVQ = 1792;
constexpr float EPS = 1e-6f;
constexpr float W_O_SCALE = 256.0f, ATT_O_SCALE = 16.0f, F8_W_SCALE = 256.0f, F8_A_SCALE = 16.0f;
constexpr int NWAVES = 8, NTHR = 512;

constexpr size_t MiB = 1u << 20;
constexpr size_t WS_CTL = 0, CTL_ZERO_BYTES = 1 * MiB;
constexpr size_t WS_HMETA = 1 * MiB;
constexpr size_t WS_GATES = 2 * MiB;
constexpr size_t WS_ROPE = 3 * MiB + 512 * 1024;
constexpr size_t WS_W_IN = 8 * MiB, WS_W_OUT = 105 * MiB, WS_W_GU0 = 137 * MiB, WS_W_GU1 = 309 * MiB, WS_W_DN0 = 481 * MiB, WS_W_DN1 = 567 * MiB;
constexpr size_t WS_W_KVQ = 653 * MiB, WS_W_KVUP = 667 * MiB, WS_W_UQ = 683 * MiB, WS_W_O = 707 * MiB;
constexpr size_t WS_W_O8 = WS_W_O, WS_W_KVQ8 = WS_W_O + 32 * MiB, WS_W_INO8 = WS_W_O + 39 * MiB, WS_W_UQ8 = WS_W_UQ, WS_W_KVUP8 = WS_W_O + 55 * MiB;
constexpr size_t WS_XN = 771 * MiB;
constexpr size_t WS_BIG = 900 * MiB;
constexpr size_t WS_HH = 1285 * MiB;
constexpr size_t WS_LAT = WS_HH, WS_CKVN = WS_HH + 113 * MiB;
constexpr size_t WS_CQN = 1415 * MiB;
constexpr size_t WS_KNOPE = 1447 * MiB;
constexpr size_t WS_V = 1704 * MiB;
constexpr size_t WS_K = 1964 * MiB;
constexpr size_t WS_H16 = 2354 * MiB;
constexpr size_t WS_PRE = 2482 * MiB;
constexpr size_t WS_SSR = 2486 * MiB;
constexpr size_t WS_END = 2488 * MiB;
static_assert(WS_W_IN + (size_t)NIN * DM * 2 <= WS_W_OUT && WS_W_GU0 + (size_t)NGU * DM * 2 <= WS_W_GU1 && WS_W_DN0 + (size_t)DM * DFF * 2 <= WS_W_DN1 && WS_W_KVQ + (size_t)NKVQ * DM * 2 <= WS_W_KVUP, "ws map");
static_assert(WS_XN + (size_t)MT * DM * 2 <= WS_BIG && WS_BIG + (size_t)MT * NPROJ * 2 <= WS_HH && WS_LAT + (size_t)MT * NKVQ * 4 <= WS_CKVN && WS_CKVN + (size_t)MT * KVLORA * 2 <= WS_CQN, "ws map");
static_assert(WS_KNOPE + (size_t)MT * 8192 * 2 <= WS_V && WS_V + (size_t)256 * NKT * 8192 <= WS_K && WS_K + (size_t)256 * NKT * 12288 <= WS_END && WS_ROPE + (size_t)MT * 64 * 4 <= WS_W_IN && WS_GATES + (size_t)16 * MT * 4 <= WS_ROPE, "ws map");

constexpr int RING_BYTES = 131072;
constexpr int LDSCTL_OFF = 143360, MISC_OFF = LDSCTL_OFF + 320;
constexpr int EPI_RED_OFF = 147456;
constexpr int LDS_BYTES = 151552;

#define GAS __attribute__((address_space(1)))
#define LAS __attribute__((address_space(3)))
typedef unsigned short bf16;
typedef unsigned v4u __attribute__((ext_vector_type(4)));
typedef unsigned v2u __attribute__((ext_vector_type(2)));
typedef float f32x4 __attribute__((ext_vector_type(4)));
typedef float f32x16 __attribute__((ext_vector_type(16)));
typedef short bf16x8 __attribute__((ext_vector_type(8)));
typedef short s16x4 __attribute__((ext_vector_type(4)));
typedef GAS unsigned gu32;
#define RLX_AGENT __ATOMIC_RELAXED, __HIP_MEMORY_SCOPE_AGENT
#define LDS_WAIT() asm volatile("s_waitcnt lgkmcnt(0)" ::: "memory")
#define VM_WAIT() asm volatile("s_waitcnt vmcnt(0)" ::: "memory")
#define SBAR() __builtin_amdgcn_sched_barrier(0)
__device__ __forceinline__ unsigned pk2(float lo, float hi) { return pg8::cvt_pk_bf16(lo, hi); }
__device__ __forceinline__ unsigned pk2a(float lo, float hi) { unsigned r; asm volatile("v_cvt_pk_bf16_f32 %0, %1, %2" : "=v"(r) : "v"(lo), "v"(hi)); return r; }
__device__ __forceinline__ float bf2f(unsigned short b) { return __uint_as_float((unsigned)b << 16); }
__device__ __forceinline__ float bflo(unsigned w) { return __uint_as_float(w << 16); }
__device__ __forceinline__ float bfhi(unsigned w) { return __uint_as_float(w & 0xffff0000u); }
#define XB_TMO      128
#define XB_XCNT(j)  (256  + 64 * (j))
#define XB_XSUB(j)  (1280 + 64 * (j))
#define XB_XGEN(j)  (2304 + 64 * (j))
#define XB_TOP      3328
#define XB_TOPGEN   3392
#define XCD_BAR_WORDS 3456
#define XB_SPIN_CAP (1u << 18)

__device__ __forceinline__ unsigned xb_ld(unsigned* p)              { return __hip_atomic_load(p, __ATOMIC_RELAXED, __HIP_MEMORY_SCOPE_AGENT); }
__device__ __forceinline__ unsigned xb_add(unsigned* p, unsigned v) { return __hip_atomic_fetch_add(p, v, __ATOMIC_RELAXED, __HIP_MEMORY_SCOPE_AGENT); }
__device__ __forceinline__ unsigned xb_xcc_id() { return (unsigned)__builtin_amdgcn_s_getreg((3 << 11) | 20) & 0xFu; }
#define XB_SPIN(cond, bar) do { unsigned _sp = 0; while (cond) { __builtin_amdgcn_s_sleep(1); \
    if ((++_sp & 255u) == 0u) { if (xb_ld(&(bar)[XB_TMO])) break; if (_sp > XB_SPIN_CAP) { atomicAdd(&(bar)[XB_TMO], 1u); break; } } } } while (0)

struct XcdBarrier {
    unsigned* bar; unsigned x;
    int wave;
    volatile LAS unsigned* st;
};

__device__ __forceinline__ XcdBarrier xcd_barrier_post(unsigned* bar, volatile LAS unsigned* st) {
    XcdBarrier b; b.bar = bar; b.x = xb_xcc_id(); b.st = st;
    if (threadIdx.x == 0) (void)xb_add(&bar[XB_XCNT(b.x)], 1u);
    return b;
}
__device__ __forceinline__ void xcd_barrier_complete(unsigned* bar, unsigned x, unsigned& nloc, unsigned& nx) {
    const unsigned G = gridDim.x * gridDim.y * gridDim.z;
    unsigned sum, cnt, mine, sp = 0u;
    for (;;) {
        sum = 0u; cnt = 0u; mine = 0u;
#pragma unroll
        for (unsigned j = 0; j < 16; ++j) { const unsigned c = xb_ld(&bar[XB_XCNT(j)]); sum += c; cnt += (c > 0u) ? 1u : 0u; mine = (j == x) ? c : mine; }
        if (sum == G) break;
        __builtin_amdgcn_s_sleep(1);
        if ((++sp & 255u) == 0u) { if (xb_ld(&bar[XB_TMO])) break; if (sp > XB_SPIN_CAP) { atomicAdd(&bar[XB_TMO], 1u); break; } }
    }
    nloc = mine > 0u ? mine : 1u; nx = cnt > 0u ? cnt : 1u;
}

__device__ __forceinline__ void xcd_barrier(const XcdBarrier& b) {
    asm volatile("s_waitcnt vmcnt(0)" ::: "memory");
    __syncthreads();
    if (b.wave == 0 && __builtin_amdgcn_mbcnt_hi(~0u, __builtin_amdgcn_mbcnt_lo(~0u, 0u)) == 0u) {
        unsigned* bar = b.bar;
        __builtin_amdgcn_s_waitcnt(0);
        unsigned nloc = b.st[0], nx = b.st[1];
        if (nloc == 0u) { xcd_barrier_complete(bar, b.x, nloc, nx); b.st[0] = nloc; b.st[1] = nx; }
        const unsigned old = xb_add(&bar[XB_XSUB(b.x)], 1u);
        const unsigned gen = old / nloc;
        if (old + 1u == (gen + 1u) * nloc) {
            __builtin_amdgcn_fence(__ATOMIC_RELEASE, "agent");
            asm volatile("s_waitcnt vmcnt(0)" ::: "memory");
            const unsigned og = xb_add(&bar[XB_TOP], 1u);
            const unsigned tg = og / nx;
            if (og + 1u == (tg + 1u) * nx) xb_add(&bar[XB_TOPGEN], 1u);
            else XB_SPIN(xb_ld(&bar[XB_TOPGEN]) == tg, bar);
            __builtin_amdgcn_fence(__ATOMIC_ACQUIRE, "agent");
            xb_add(&bar[XB_XGEN(b.x)], 1u);
            asm volatile("s_waitcnt vmcnt(0)" ::: "memory");
        } else {
            XB_SPIN(xb_ld(&bar[XB_XGEN(b.x)]) == gen, bar);
            __builtin_amdgcn_fence(__ATOMIC_ACQUIRE, "agent");
            asm volatile("s_waitcnt vmcnt(0)" ::: "memory");
        }
    }
    __syncthreads();
}


struct Args { const void* in[23]; float* out; unsigned char* ws; int ph_lo, ph_hi, dry, pad; };
struct Frame { LAS unsigned char* lds; int tid, lane, wave, vcu, G, gw, ngw; };

__device__ __forceinline__ float wave_sum(float v) {
#pragma unroll
    for (int o = 1; o < 64; o <<= 1) v += __shfl_xor(v, o);
    return v;
}
__device__ __forceinline__ bf16x8 ld8g(const bf16* p) { return *(const bf16x8*)p; }

__device__ __forceinline__ void tr_item(const float* __restrict__ W, int ldw, int scol, int nvalid, const float* __restrict__ gain, bf16* WT, int K, int drow, int k0, LAS float* scr, int lane) {
    const int nn = (lane & 31) < nvalid ? (lane & 31) : (nvalid - 1);
    float v[32]; const float* wp = W + (size_t)(k0 + (lane >> 5)) * ldw + scol + nn;
#pragma unroll
    for (int i = 0; i < 32; ++i) v[i] = wp[(size_t)(2 * i) * ldw];
    if (gain) {
#pragma unroll
        for (int i = 0; i < 32; ++i) v[i] *= gain[k0 + 2 * i + (lane >> 5)]; }
#pragma unroll
    for (int i = 0; i < 32; ++i) scr[(2 * i + (lane >> 5)) * 33 + (lane & 31)] = v[i];
    LDS_WAIT(); asm volatile("" ::: "memory");
    const int c = lane & 7;
#pragma unroll
    for (int j = 0; j < 4; ++j) { const int n = (lane >> 3) + 8 * j; const LAS float* s = scr + (8 * c) * 33 + n;
        v4u o; o.x = pk2(s[0 * 33], s[1 * 33]); o.y = pk2(s[2 * 33], s[3 * 33]); o.z = pk2(s[4 * 33], s[5 * 33]); o.w = pk2(s[6 * 33], s[7 * 33]);
        if (n < nvalid) *(GAS v4u*)(WT + (size_t)(drow + n) * K + k0 + 8 * c) = o; }
    LDS_WAIT(); asm volatile("" ::: "memory");
}
__device__ __forceinline__ void tr_item_f8(const float* __restrict__ W, int ldw, int scol, const float* __restrict__ gain, float scale, unsigned char* WT8, int K, int drow, int k0, LAS float* scr, int lane) {
    float v[32]; const float* wp = W + (size_t)(k0 + (lane >> 5)) * ldw + scol + (lane & 31);
#pragma unroll
    for (int i = 0; i < 32; ++i) v[i] = wp[(size_t)(2 * i) * ldw];
    if (gain) {
#pragma unroll
        for (int i = 0; i < 32; ++i) v[i] *= gain[k0 + 2 * i + (lane >> 5)]; }
#pragma unroll
    for (int i = 0; i < 32; ++i) scr[(2 * i + (lane >> 5)) * 33 + (lane & 31)] = v[i] * scale;
    LDS_WAIT(); asm volatile("" ::: "memory");
    const int c = lane & 7;
#pragma unroll
    for (int j = 0; j < 4; ++j) { const int n = (lane >> 3) + 8 * j; const LAS float* s = scr + (8 * c) * 33 + n;
        v2u o; int w = __builtin_amdgcn_cvt_pk_fp8_f32(s[0 * 33], s[1 * 33], 0, false); w = __builtin_amdgcn_cvt_pk_fp8_f32(s[2 * 33], s[3 * 33], w, true); o.x = (unsigned)w;
        w = __builtin_amdgcn_cvt_pk_fp8_f32(s[4 * 33], s[5 * 33], 0, false); w = __builtin_amdgcn_cvt_pk_fp8_f32(s[6 * 33], s[7 * 33], w, true); o.y = (unsigned)w;
        *(GAS v2u*)(WT8 + (size_t)(drow + n) * K + k0 + 8 * c) = o; }
    LDS_WAIT(); asm volatile("" ::: "memory");
}
__device__ __forceinline__ void norm_row(const float* src, bf16* dst, unsigned char* dst8, int lane) {
    const GAS f32x4* xr = (const GAS f32x4*)src + lane;
    f32x4 v[16]; float s = 0.f;
#pragma unroll
    for (int j = 0; j < 16; ++j) { v[j] = xr[64 * j]; s += (v[j].x * v[j].x + v[j].y * v[j].y) + (v[j].z * v[j].z + v[j].w * v[j].w); }
    const float r = 1.0f / sqrtf(wave_sum(s) * (1.0f / DM) + EPS);
    if (dst) { GAS v2u* o8 = (GAS v2u*)dst + lane;
#pragma unroll
        for (int j = 0; j < 16; ++j) { v2u w; w.x = pk2(v[j].x * r, v[j].y * r); w.y = pk2(v[j].z * r, v[j].w * r); o8[64 * j] = w; } }
    if (dst8) { GAS unsigned* o4 = (GAS unsigned*)dst8 + lane; const float r8 = r * F8_A_SCALE;
#pragma unroll
        for (int j = 0; j < 16; ++j) { int w = __builtin_amdgcn_cvt_pk_fp8_f32(v[j].x * r8, v[j].y * r8, 0, false); w = __builtin_amdgcn_cvt_pk_fp8_f32(v[j].z * r8, v[j].w * r8, w, true); o4[64 * j] = (unsigned)w; } }
}
__device__ __forceinline__ void norm_row_h(const pg8::f16_t* src, bf16* dst, unsigned char* dst8, int lane) {
    const GAS v4u* xr = (const GAS v4u*)src + lane;
    v4u h[8]; float s = 0.f;
#pragma unroll
    for (int j = 0; j < 8; ++j) { h[j] = xr[64 * j];
        const float a0 = pg8::f16lo(h[j].x), a1 = pg8::f16hi(h[j].x), a2 = pg8::f16lo(h[j].y), a3 = pg8::f16hi(h[j].y), a4 = pg8::f16lo(h[j].z), a5 = pg8::f16hi(h[j].z), a6 = pg8::f16lo(h[j].w), a7 = pg8::f16hi(h[j].w);
        s += ((a0 * a0 + a1 * a1) + (a2 * a2 + a3 * a3)) + ((a4 * a4 + a5 * a5) + (a6 * a6 + a7 * a7)); }
    const float r = 1.0f / sqrtf(wave_sum(s) * (1.0f / DM) + EPS);
    if (dst) { GAS v4u* o = (GAS v4u*)dst + lane;
#pragma unroll
        for (int j = 0; j < 8; ++j) { v4u w; w.x = pk2(pg8::f16lo(h[j].x) * r, pg8::f16hi(h[j].x) * r); w.y = pk2(pg8::f16lo(h[j].y) * r, pg8::f16hi(h[j].y) * r);
            w.z = pk2(pg8::f16lo(h[j].z) * r, pg8::f16hi(h[j].z) * r); w.w = pk2(pg8::f16lo(h[j].w) * r, pg8::f16hi(h[j].w) * r); o[64 * j] = w; } }
    if (dst8) { GAS v2u* o = (GAS v2u*)dst8 + lane; const float r8 = r * F8_A_SCALE;
#pragma unroll
        for (int j = 0; j < 8; ++j) { v2u w; int x = __builtin_amdgcn_cvt_pk_fp8_f32(pg8::f16lo(h[j].x) * r8, pg8::f16hi(h[j].x) * r8, 0, false); x = __builtin_amdgcn_cvt_pk_fp8_f32(pg8::f16lo(h[j].y) * r8, pg8::f16hi(h[j].y) * r8, x, true); w.x = (unsigned)x;
            x = __builtin_amdgcn_cvt_pk_fp8_f32(pg8::f16lo(h[j].z) * r8, pg8::f16hi(h[j].z) * r8, 0, false); x = __builtin_amdgcn_cvt_pk_fp8_f32(pg8::f16lo(h[j].w) * r8, pg8::f16hi(h[j].w) * r8, x, true); w.y = (unsigned)x; o[64 * j] = w; } }
}
__device__ __forceinline__ void norm_phase(Frame& F, const float* real, const float* meta, bf16* XN, unsigned char* X8, int nrows, int mode) {
    for (int m = F.gw; m < nrows; m += F.ngw) { const bool isreal = m < MR;
        norm_row(isreal ? real + (size_t)m * DM : meta + (size_t)(m - MR) * DM, (isreal && mode == 2) ? nullptr : XN + (size_t)m * DM, (isreal && mode != 0) ? X8 + (size_t)m * DM : nullptr, F.lane); }
}
__device__ __forceinline__ void norm_phase_h(Frame& F, const pg8::f16_t* real, const float* meta, bf16* XN, unsigned char* X8, int nrows, int mode) {
    for (int m = F.gw; m < nrows; m += F.ngw) {
        if (m < MR) norm_row_h(real + (size_t)m * DM, mode == 2 ? nullptr : XN + (size_t)m * DM, mode != 0 ? X8 + (size_t)m * DM : nullptr, F.lane);
        else norm_row(meta + (size_t)(m - MR) * DM, XN + (size_t)m * DM, nullptr, F.lane); }
}

struct P0Item { const float* wp; const float* gp; unsigned char* dp; int ldw, rowstep, kind, nvalid; float scale; };
constexpr int P0_I_IN = 64 * 385, P0_I_OUT = 64 * 128, P0_I_GU = 64 * 688, P0_I_DN = 172 * 128, P0_I_KVQ = 64 * 56, P0_I_KVU = 8 * 512, P0_I_UQ = 16 * 384, P0_I_O = 128 * 128, P0_I_INO = 64 * 128;
constexpr int P0_NITEMS = P0_I_IN + P0_I_OUT + 2 * P0_I_GU + 2 * P0_I_DN + P0_I_KVQ + P0_I_KVU + P0_I_UQ + P0_I_KVQ + P0_I_KVU + P0_I_INO + P0_I_O;
constexpr int P0_DEFER_A = 16384, P0_DEFER_B = 16384;
static_assert(P0_DEFER_B <= P0_I_DN && P0_DEFER_A + P0_DEFER_B <= P0_I_DN + P0_I_GU, "deferred items must be layer-1 FFN weights, the P16 share down-projection only");
__device__ __forceinline__ P0Item p0_decode(const Args& a, int it, int lane) {
    unsigned char* ws = a.ws;
    const float* w_in = (const float*)a.in[4]; const float* w_out = (const float*)a.in[8]; const float* w_gu = (const float*)a.in[10]; const float* w_dn = (const float*)a.in[11];
    const float* w_kvd = (const float*)a.in[13]; const float* w_kvu = (const float*)a.in[15]; const float* w_dq = (const float*)a.in[18]; const float* w_uq = (const float*)a.in[20]; const float* w_o = (const float*)a.in[22];
    const float* g_a = (const float*)a.in[3]; const float* g_ffn = (const float*)a.in[9]; const float* g_kv = (const float*)a.in[12]; const float* g_kvl = (const float*)a.in[14];
    const float* g_b = (const float*)a.in[17]; const float* g_ql = (const float*)a.in[19];
    const float* W = nullptr; const float* gain = nullptr; unsigned char* dst = nullptr; int ldw = 0, scol = 0, nvalid = 32, kind = 0, K = 0, drow = 0, k0 = 0; float scale = 1.f;
    int r = it;
    if (r < P0_I_IN) { const int kb = r / 385, nb = r % 385; W = w_in; ldw = NIN; scol = 32 * nb; nvalid = nb == 384 ? 16 : 32; gain = g_a; dst = ws + WS_W_IN; K = DM; drow = 32 * nb; k0 = 64 * kb; }
    else if ((r -= P0_I_IN) < P0_I_OUT) { const int kb = r / 128, nb = r % 128; W = w_out; ldw = DM; scol = 32 * nb; dst = ws + WS_W_OUT; K = DM; drow = 32 * nb; k0 = 64 * kb; }
    else if ((r -= P0_I_OUT) < P0_I_GU) { const int kb = r / 688, nb = r % 688, n0 = 32 * nb, j = n0 >> 8, i0 = n0 & 255;
        W = w_gu; ldw = NGU; scol = i0 < 128 ? 128 * j + i0 : DFF + 128 * j + (i0 - 128); gain = g_ffn; dst = ws + WS_W_GU0; K = DM; drow = n0; k0 = 64 * kb; }
    else if ((r -= P0_I_GU) < P0_I_DN) { const int kb = r / 128, nb = r % 128; W = w_dn; ldw = DM; scol = 32 * nb; dst = ws + WS_W_DN0; K = DFF; drow = 32 * nb; k0 = 64 * kb; }
    else if ((r -= P0_I_DN) < P0_I_KVQ) { const int kb = r / 56, nb = r % 56; dst = ws + WS_W_KVQ; K = DM; drow = 32 * nb; k0 = 64 * kb;
        if (nb < 18) { W = w_kvd; ldw = KVLORA + ROPE; scol = 32 * nb; gain = g_kv; } else if (nb >= 24) { W = w_dq; ldw = QLORA; scol = 32 * (nb - 24); gain = g_b; } else kind = 2; }
    else if ((r -= P0_I_KVQ) < P0_I_KVU) { const int kb = r / 512, nb = r % 512; W = w_kvu; ldw = 16384; scol = 32 * nb; gain = g_kvl; dst = ws + WS_W_KVUP; K = KVLORA; drow = 32 * nb; k0 = 64 * kb; }
    else if ((r -= P0_I_KVU) < P0_I_UQ) { const int kb = r / 384, nb = r % 384; W = w_uq; ldw = AH * QKD; scol = 32 * nb; gain = g_ql; kind = 1; scale = F8_W_SCALE; dst = ws + WS_W_UQ8; K = QLORA; drow = 32 * nb; k0 = 64 * kb; }
    else if ((r -= P0_I_UQ) < P0_I_KVQ) { const int kb = r / 56, nb = r % 56; kind = 1; scale = F8_W_SCALE; dst = ws + WS_W_KVQ8; K = DM; drow = 32 * nb; k0 = 64 * kb;
        if (nb < 18) { W = w_kvd; ldw = KVLORA + ROPE; scol = 32 * nb; gain = g_kv; } else if (nb >= 24) { W = w_dq; ldw = QLORA; scol = 32 * (nb - 24); gain = g_b; } else kind = 3; }
    else if ((r -= P0_I_KVQ) < P0_I_KVU) { const int kb = r / 512, nb = r % 512; W = w_kvu; ldw = 16384; scol = 32 * nb; gain = g_kvl; kind = 1; scale = F8_W_SCALE; dst = ws + WS_W_KVUP8; K = KVLORA; drow = 32 * nb; k0 = 64 * kb; }
    else if ((r -= P0_I_KVU) < P0_I_INO) { const int kb = r / 128, nb = r % 128; W = w_in; ldw = NIN; scol = 8192 + 32 * nb; gain = g_a; kind = 1; scale = F8_W_SCALE; dst = ws + WS_W_INO8; K = DM; drow = 32 * nb; k0 = 64 * kb; }
    else if ((r -= P0_I_INO) < P0_I_O) { const int kb = r / 128, nb = r % 128; W = w_o; ldw = DM; scol = 32 * nb; kind = 1; scale = W_O_SCALE; dst = ws + WS_W_O8; K = AH * VHD; drow = 32 * nb; k0 = 64 * kb; }
    else if ((r -= P0_I_O) < P0_I_GU) { const int kb = r / 688, nb = r % 688, n0 = 32 * nb, j = n0 >> 8, i0 = n0 & 255;
        W = w_gu + (size_t)DM * NGU; ldw = NGU; scol = i0 < 128 ? 128 * j + i0 : DFF + 128 * j + (i0 - 128); gain = g_ffn + DM; dst = ws + WS_W_GU1; K = DM; drow = n0; k0 = 64 * kb; }
    else { r -= P0_I_GU; const int kb = r / 128, nb = r % 128; W = w_dn + (size_t)DFF * DM; ldw = DM; scol = 32 * nb; dst = ws + WS_W_DN1; K = DFF; drow = 32 * nb; k0 = 64 * kb; }
    P0Item d; const int nn = (lane & 31) < nvalid ? (lane & 31) : (nvalid - 1); const int esz = (kind & 1) ? 1 : 2;
    d.wp = W + (size_t)(k0 + (lane >> 5)) * ldw + scol + nn; d.gp = gain ? gain + k0 + 8 * (lane & 7) : nullptr;
    d.dp = dst + ((size_t)(drow + (lane >> 3)) * K + k0 + 8 * (lane & 7)) * esz; d.ldw = ldw; d.rowstep = 8 * K * esz; d.kind = kind; d.nvalid = nvalid; d.scale = scale;
    return d;
}
__device__ __forceinline__ void p0_load(const P0Item& d, float (&v)[32], f32x4& g0, f32x4& g1) {
    g0 = (f32x4){1.f, 1.f, 1.f, 1.f}; g1 = g0;
    if (d.kind < 2) {
#pragma unroll
        for (int i = 0; i < 32; ++i) v[i] = d.wp[(size_t)(2 * i) * d.ldw];
        if (d.gp) { g0 = *(const GAS f32x4*)d.gp; g1 = *(const GAS f32x4*)(d.gp + 4); } }
}
__device__ __forceinline__ void p0_process(const P0Item& d, const float (&v)[32], f32x4 g0, f32x4 g1, LAS float* scr, int lane) {
    if (d.kind < 2) {
#pragma unroll
        for (int i = 0; i < 32; ++i) scr[(2 * i + (lane >> 5)) * 33 + (lane & 31)] = v[i];
        LDS_WAIT(); asm volatile("" ::: "memory");
        const int c = lane & 7;
#pragma unroll
        for (int j = 0; j < 4; ++j) { const int n = (lane >> 3) + 8 * j; const LAS float* s = scr + (8 * c) * 33 + n;
            const float f0 = s[0 * 33] * g0.x, f1 = s[1 * 33] * g0.y, f2 = s[2 * 33] * g0.z, f3 = s[3 * 33] * g0.w, f4 = s[4 * 33] * g1.x, f5 = s[5 * 33] * g1.y, f6 = s[6 * 33] * g1.z, f7 = s[7 * 33] * g1.w;
            if (d.kind == 0) { v4u o; o.x = pk2(f0, f1); o.y = pk2(f2, f3); o.z = pk2(f4, f5); o.w = pk2(f6, f7);
                if (n < d.nvalid) *(GAS v4u*)(d.dp + (size_t)j * d.rowstep) = o; }
            else { const float sc = d.scale; v2u o; int w = __builtin_amdgcn_cvt_pk_fp8_f32(f0 * sc, f1 * sc, 0, false); w = __builtin_amdgcn_cvt_pk_fp8_f32(f2 * sc, f3 * sc, w, true); o.x = (unsigned)w;
                w = __builtin_amdgcn_cvt_pk_fp8_f32(f4 * sc, f5 * sc, 0, false); w = __builtin_amdgcn_cvt_pk_fp8_f32(f6 * sc, f7 * sc, w, true); o.y = (unsigned)w;
                *(GAS v2u*)(d.dp + (size_t)j * d.rowstep) = o; } }
        LDS_WAIT(); asm volatile("" ::: "memory");
    } else {
#pragma unroll
        for (int j = 0; j < 4; ++j) { if (d.kind == 2) *(GAS v4u*)(d.dp + (size_t)j * d.rowstep) = (v4u){0u, 0u, 0u, 0u}; else *(GAS v2u*)(d.dp + (size_t)j * d.rowstep) = (v2u){0u, 0u}; } }
}
__device__ __forceinline__ void p0_items(Frame& F, const Args& a, int first, int last, int w, int stride, LAS float* scr) {
    int it = first + w; if (it >= last) return;
    P0Item d = p0_decode(a, it, F.lane); float v[32]; f32x4 g0, g1; p0_load(d, v, g0, g1);
    for (;;) { const int itn = it + stride; const bool more = itn < last;
        P0Item dn = d; float vn[32]; f32x4 gn0 = g0, gn1 = g1;
#pragma unroll
        for (int i = 0; i < 32; ++i) vn[i] = 0.f;
        if (more) { dn = p0_decode(a, itn, F.lane); p0_load(dn, vn, gn0, gn1); }
        asm volatile("" ::: "memory");
        p0_process(d, v, g0, g1, scr, F.lane);
        if (!more) break;
        d = dn; g0 = gn0; g1 = gn1; it = itn;
#pragma unroll
        for (int i = 0; i < 32; ++i) v[i] = vn[i]; }
}
__device__ __forceinline__ void p0_deferred(Frame& F, const Args& a, int nunits, int first, int count) {
    const int c = (int)blockIdx.x, G = F.G, rem = nunits % G;
    if (rem == 0) { p0_items(F, a, first, first + count, F.gw, F.ngw, (LAS float*)(F.lds + F.wave * 16384)); return; }
    if (c >= rem) p0_items(F, a, first, first + count, (c - rem) * NWAVES + F.wave, (G - rem) * NWAVES, (LAS float*)(F.lds + F.wave * 16384));
}

__device__ __forceinline__ void p0_prologue(Frame& F, const Args& a) {
    unsigned char* ws = a.ws;
    LAS float* scr = (LAS float*)(F.lds + F.wave * 16384);
    const float* w_in = (const float*)a.in[4]; const float* w_out = (const float*)a.in[8]; const float* w_gu = (const float*)a.in[10]; const float* w_dn = (const float*)a.in[11];
    const float* w_kvd = (const float*)a.in[13]; const float* w_kvu = (const float*)a.in[15]; const float* w_dq = (const float*)a.in[18]; const float* w_uq = (const float*)a.in[20]; const float* w_o = (const float*)a.in[22];
    const float* g_a = (const float*)a.in[3]; const float* g_ffn = (const float*)a.in[9]; const float* g_kv = (const float*)a.in[12]; const float* g_kvl = (const float*)a.in[14];
    const float* g_b = (const float*)a.in[17]; const float* g_ql = (const float*)a.in[19];
    p0_items(F, a, 0, P0_NITEMS - P0_DEFER_A - P0_DEFER_B, F.gw, F.ngw, scr);
    { const int* positions = (const int*)a.in[1]; float* rope = (float*)(ws + WS_ROPE);
        for (int e = F.vcu * NTHR + F.tid; e < MT * 32; e += F.G * NTHR) { const int row = e >> 5, i = e & 31;
            const int pos = row < MR ? positions[row] + NMETA : row - MR;
            const float inv = 1.0f / powf(10000.0f, (float)(2 * i) * (1.0f / 64.0f));
            const float ang = (float)pos * inv;
            rope[(size_t)row * 64 + i] = cosf(ang); rope[(size_t)row * 64 + 32 + i] = sinf(ang); } }
    { for (int e = F.vcu * NTHR + F.tid; e < 256 * 1280; e += F.G * NTHR) { const int bh = e / 1280, c = e % 1280;
            if (c < 768) *(GAS v4u*)(ws + WS_K + ((size_t)(bh * NKT + 64)) * 12288 + (size_t)c * 16) = (v4u){0u, 0u, 0u, 0u};
            else *(GAS v4u*)(ws + WS_V + ((size_t)(bh * NKT + 64)) * 8192 + (size_t)(c - 768) * 16) = (v4u){0u, 0u, 0u, 0u}; } }
    norm_phase(F, (const float*)a.in[0], (const float*)a.in[2], (bf16*)(ws + WS_XN), ws + WS_HH, MT, 1);
}

template <int NT>
__device__ __forceinline__ void skinny_wg(Frame& F, const bf16* __restrict__ A16, const bf16* __restrict__ Brows0, const bf16* __restrict__ Brows1, int K, f32x4 (&res)[NT]) {
    const int lane = F.lane, kw = K >> 3, k_lo = F.wave * kw;
    const bf16* pb = A16 + (size_t)(lane & 15) * K + 8 * (lane >> 4) + k_lo;
    const bf16* pa0 = Brows0 + (size_t)(lane & 15) * K + 8 * (lane >> 4) + k_lo;
    const bf16* pa1 = Brows1 + (size_t)(lane & 15) * K + 8 * (lane >> 4) + k_lo;
    f32x4 acc[NT];
#pragma unroll
    for (int i = 0; i < NT; ++i) acc[i] = (f32x4){0.f, 0.f, 0.f, 0.f};
#pragma unroll 8
    for (int k0 = 0; k0 < kw; k0 += 32) { const bf16x8 y = ld8g(pb + k0); const bf16x8 x0 = ld8g(pa0 + k0); acc[0] = __builtin_amdgcn_mfma_f32_16x16x32_bf16(x0, y, acc[0], 0, 0, 0);
        if (NT == 2) { const bf16x8 x1 = ld8g(pa1 + k0); acc[NT - 1] = __builtin_amdgcn_mfma_f32_16x16x32_bf16(x1, y, acc[NT - 1], 0, 0, 0); } }
    LAS f32x4* red = (LAS f32x4*)F.lds;
#pragma unroll
    for (int i = 0; i < NT; ++i) red[(i * NWAVES + F.wave) * 64 + lane] = acc[i];
    LDS_WAIT(); __syncthreads();
    if (F.wave == 0) {
#pragma unroll
        for (int i = 0; i < NT; ++i) { f32x4 sacc = red[(i * NWAVES) * 64 + lane];
#pragma unroll
            for (int w = 1; w < NWAVES; ++w) sacc = sacc + red[(i * NWAVES + w) * 64 + lane];
            res[i] = sacc; } }
    LDS_WAIT(); __syncthreads();
}

__device__ __forceinline__ void gate_norm_phase(Frame& F, const Args& a) {
    const bf16* HH = (const bf16*)(a.ws + WS_HH); const bf16* PROJ = (const bf16*)(a.ws + WS_BIG); bf16* A2 = (bf16*)(a.ws + WS_XN); const float* g_out = (const float*)a.in[7];
    for (int m = F.gw; m < MT; m += F.ngw) {
#pragma unroll
        for (int j = 0; j < 8; ++j) { const int e = j * 512 + F.lane * 8;
            const v4u hw = *(const GAS v4u*)(HH + (size_t)m * DM + e), ow = *(const GAS v4u*)(PROJ + (size_t)m * NPROJ + 8192 + e);
            const f32x4 g0 = *(const GAS f32x4*)(g_out + e), g1 = *(const GAS f32x4*)(g_out + e + 4);
            float hv[8] = {bflo(hw.x), bfhi(hw.x), bflo(hw.y), bfhi(hw.y), bflo(hw.z), bfhi(hw.z), bflo(hw.w), bfhi(hw.w)};
            const float ov[8] = {bflo(ow.x), bfhi(ow.x), bflo(ow.y), bfhi(ow.y), bflo(ow.z), bfhi(ow.z), bflo(ow.w), bfhi(ow.w)};
            const float gv[8] = {g0.x, g0.y, g0.z, g0.w, g1.x, g1.y, g1.z, g1.w};
            float s = 0.f;
#pragma unroll
            for (int i = 0; i < 8; ++i) s += hv[i] * hv[i];
            const float r = 1.0f / sqrtf(wave_sum(s) * (1.0f / MDV) + EPS);
#pragma unroll
            for (int i = 0; i < 8; ++i) hv[i] = hv[i] * r * gv[i] * (1.0f / (1.0f + __expf(-ov[i])));
            v4u o; o.x = pk2(hv[0], hv[1]); o.y = pk2(hv[2], hv[3]); o.z = pk2(hv[4], hv[5]); o.w = pk2(hv[6], hv[7]);
            *(GAS v4u*)(A2 + (size_t)m * DM + e) = o; }
    }
}

__device__ __forceinline__ void latent_norm_phase(Frame& F, const Args& a) {
    const float* LAT = (const float*)(a.ws + WS_LAT); const pg8::f16_t* LAT16 = (const pg8::f16_t*)(a.ws + WS_LAT); bf16* CKVN = (bf16*)(a.ws + WS_CKVN); bf16* CQN = (bf16*)(a.ws + WS_CQN);
    for (int m = F.gw; m < MT; m += F.ngw) {
        if (m < MR) { const pg8::f16_t* row = LAT16 + (size_t)m * NKVQ;
            { const v4u xw = *(const GAS v4u*)(row + 8 * F.lane);
                const float x0 = pg8::f16lo(xw.x), x1 = pg8::f16hi(xw.x), x2 = pg8::f16lo(xw.y), x3 = pg8::f16hi(xw.y), x4 = pg8::f16lo(xw.z), x5 = pg8::f16hi(xw.z), x6 = pg8::f16lo(xw.w), x7 = pg8::f16hi(xw.w);
                const float s = ((x0 * x0 + x1 * x1) + (x2 * x2 + x3 * x3)) + ((x4 * x4 + x5 * x5) + (x6 * x6 + x7 * x7));
                const float r8 = F8_A_SCALE / sqrtf(wave_sum(s) * (1.0f / KVLORA) + EPS); v2u o;
                int w = __builtin_amdgcn_cvt_pk_fp8_f32(x0 * r8, x1 * r8, 0, false); w = __builtin_amdgcn_cvt_pk_fp8_f32(x2 * r8, x3 * r8, w, true); o.x = (unsigned)w;
                w = __builtin_amdgcn_cvt_pk_fp8_f32(x4 * r8, x5 * r8, 0, false); w = __builtin_amdgcn_cvt_pk_fp8_f32(x6 * r8, x7 * r8, w, true); o.y = (unsigned)w;
                *(GAS v2u*)((unsigned char*)CKVN + (size_t)m * KVLORA + 8 * F.lane) = o; }
            {
                const pg8::f16_t* lrow = row + KVLORA; const float* rt = (const float*)(a.ws + WS_ROPE) + (size_t)m * 64; const float* g_k = (const float*)a.in[16]; const int i = F.lane & 31;
                const float t1 = (float)lrow[i] * g_k[128 + i], t2 = (float)lrow[32 + i] * g_k[160 + i], cs = rt[i], sn = rt[32 + i]; const float krl = (float)lrow[F.lane]; const float ssr = wave_sum(krl * krl);
                ((float*)(a.ws + WS_PRE))[(size_t)m * 64 + F.lane] = (F.lane & 32) ? (t1 * sn + t2 * cs) : (t1 * cs - t2 * sn);
                if (F.lane == 0) ((float*)(a.ws + WS_SSR))[m] = ssr; }
            { v2u v[4]; float s = 0.f;
#pragma unroll
                for (int j = 0; j < 4; ++j) { v[j] = *(const GAS v2u*)(row + 768 + (j * 64 + F.lane) * 4);
                    const float q0 = pg8::f16lo(v[j].x), q1 = pg8::f16hi(v[j].x), q2 = pg8::f16lo(v[j].y), q3 = pg8::f16hi(v[j].y); s += (q0 * q0 + q1 * q1) + (q2 * q2 + q3 * q3); }
                const float r8 = F8_A_SCALE / sqrtf(wave_sum(s) * (1.0f / QLORA) + EPS);
#pragma unroll
                for (int j = 0; j < 4; ++j) { int w = __builtin_amdgcn_cvt_pk_fp8_f32(pg8::f16lo(v[j].x) * r8, pg8::f16hi(v[j].x) * r8, 0, false); w = __builtin_amdgcn_cvt_pk_fp8_f32(pg8::f16lo(v[j].y) * r8, pg8::f16hi(v[j].y) * r8, w, true);
                    *(GAS unsigned*)((unsigned char*)CQN + (size_t)m * QLORA + (j * 64 + F.lane) * 4) = (unsigned)w; } }
        } else { const float* row = LAT + (size_t)m * NKVQ;
            const f32x4 x0 = *(const GAS f32x4*)(row + 8 * F.lane), x1 = *(const GAS f32x4*)(row + 8 * F.lane + 4);
            const float s = (x0.x * x0.x + x0.y * x0.y) + (x0.z * x0.z + x0.w * x0.w) + (x1.x * x1.x + x1.y * x1.y) + (x1.z * x1.z + x1.w * x1.w);
            const float r = 1.0f / sqrtf(wave_sum(s) * (1.0f / KVLORA) + EPS);
            v4u o; o.x = pk2(x0.x * r, x0.y * r); o.y = pk2(x0.z * r, x0.w * r); o.z = pk2(x1.x * r, x1.y * r); o.w = pk2(x1.z * r, x1.w * r);
            *(GAS v4u*)(CKVN + (size_t)m * KVLORA + 8 * F.lane) = o; }
    }
}

using pg8::k_img_off8;
__device__ __forceinline__ v2u f8x8(const float (&x)[8], float sc) { v2u o; int w = __builtin_amdgcn_cvt_pk_fp8_f32(x[0] * sc, x[1] * sc, 0, false); w = __builtin_amdgcn_cvt_pk_fp8_f32(x[2] * sc, x[3] * sc, w, true); o.x = (unsigned)w;
    w = __builtin_amdgcn_cvt_pk_fp8_f32(x[4] * sc, x[5] * sc, 0, false); w = __builtin_amdgcn_cvt_pk_fp8_f32(x[6] * sc, x[7] * sc, w, true); o.y = (unsigned)w; return o; }
__device__ __forceinline__ void k_final_phase(Frame& F, const Args& a) {
    const float* LAT = (const float*)(a.ws + WS_LAT); const bf16* KN = (const bf16*)(a.ws + WS_KNOPE); const float* ROPEt = (const float*)(a.ws + WS_ROPE); const float* g_k = (const float*)a.in[16];
    unsigned char* Kimg = a.ws + WS_K; const int lane = F.lane, c = lane & 15, hq = lane >> 4;
    float gn[8];
#pragma unroll
    for (int i = 0; i < 8; ++i) gn[i] = g_k[8 * c + i];
    for (int m = MR + F.gw; m < MT; m += F.ngw) {
        const float* lrow = LAT + (size_t)m * NKVQ + KVLORA;
        const float krl = lrow[lane]; const float ss_rope = wave_sum(krl * krl);
        float pre[8];
        { const int i0 = 8 * (c & 3); const float* rt = ROPEt + (size_t)m * 64;
#pragma unroll
            for (int i = 0; i < 8; ++i) { const float t1 = lrow[i0 + i] * g_k[128 + i0 + i], t2 = lrow[32 + i0 + i] * g_k[160 + i0 + i], cs = rt[i0 + i], sn = rt[32 + i0 + i];
                pre[i] = (c & 4) ? (t1 * sn + t2 * cs) : (t1 * cs - t2 * sn); } }
        const int nb = m < MR ? 1 : BATCH; const int key = m < MR ? NMETA + (m & (SEQ - 1)) : m - MR; const int b0 = m < MR ? (m >> 12) : 0;
        const int kt = key >> 6, kr = key & 63;
#pragma unroll 4
        for (int j = 0; j < 16; ++j) { const int h = 4 * j + hq;
            const v4u kw = *(const GAS v4u*)(KN + (size_t)m * 8192 + h * 128 + 8 * c);
            float kv[8] = {bflo(kw.x), bfhi(kw.x), bflo(kw.y), bfhi(kw.y), bflo(kw.z), bfhi(kw.z), bflo(kw.w), bfhi(kw.w)};
            float s = 0.f;
#pragma unroll
            for (int i = 0; i < 8; ++i) s += kv[i] * kv[i];
            s += __shfl_xor(s, 1); s += __shfl_xor(s, 2); s += __shfl_xor(s, 4); s += __shfl_xor(s, 8);
            const float r = 1.0f / sqrtf((s + ss_rope) * (1.0f / QKD) + EPS);
#pragma unroll
            for (int i = 0; i < 8; ++i) kv[i] *= gn[i];
            const v2u o = f8x8(kv, r * F8_A_SCALE), p = f8x8(pre, r * F8_A_SCALE);
            for (int bb = 0; bb < nb; ++bb) { unsigned char* img = Kimg + ((size_t)(((b0 + bb) * AH + h) * NKT + kt)) * 12288;
                *(GAS v2u*)(img + k_img_off8(kr, 8 * c)) = o;
                if (c < 8) *(GAS v2u*)(img + k_img_off8(kr, 128 + 8 * c)) = p; } }
    }
}

constexpr int ML_KP = 528, ML_VP = 144, ML_KR0 = 0, ML_KRSZ = 64 * ML_KP, ML_VR0 = 2 * ML_KRSZ, ML_VRSZ = 64 * ML_VP, ML_CT = ML_VR0 + 2 * ML_VRSZ, ML_WS = ML_CT + 80 * ML_KP, ML_END = ML_WS + NWAVES * 512;
static_assert(ML_END <= LDSCTL_OFF, "mLSTM LDS");
__device__ __forceinline__ s16x4 lds_tr(LAS const unsigned char* p) { typedef short v4i16_t __attribute__((ext_vector_type(4))); return __builtin_bit_cast(s16x4, __builtin_amdgcn_ds_read_tr16_b64_v4i16((LAS v4i16_t*)p)); }
__device__ __forceinline__ bf16x8 cat4(s16x4 lo, s16x4 hi) { return (bf16x8){lo[0], lo[1], lo[2], lo[3], hi[0], hi[1], hi[2], hi[3]}; }
__device__ __forceinline__ float prefix_sum64(float v, int lane) {
#pragma unroll
    for (int d = 1; d < 64; d <<= 1) { const float t = __shfl_up(v, d); if (lane >= d) v += t; }
    return v;
}
__device__ __forceinline__ float prefix_max64(float v, int lane) {
#pragma unroll
    for (int d = 1; d < 64; d <<= 1) { const float t = __shfl_up(v, d); if (lane >= d) v = fmaxf(v, t); }
    return v;
}
__device__ __forceinline__ float log_sigmoid(float x) { return fminf(x, 0.f) - log1pf(expf(-fabsf(x))); }

template <int TBV>
__device__ __forceinline__ void mlstm_unit_tb(Frame& F, const Args& a, int unit) {
    const int bh = unit >> 3, sl = unit & 7, b = bh >> 3, h = bh & 7;
    const int tid = F.tid, lane = F.lane, wave = F.wave, eh = wave & 1, c15 = lane & 15, q4 = lane >> 4; constexpr int tb = TBV;
    LAS unsigned char* lds = F.lds;
    const bf16* PROJ = (const bf16*)(a.ws + WS_BIG); const float* GATES = (const float*)(a.ws + WS_GATES); bf16* HH = (bf16*)(a.ws + WS_HH);
    const float b_i = ((const float*)a.in[5])[h], b_f = ((const float*)a.in[6])[h];
    f32x4 Cacc[2][5];
#pragma unroll
    for (int i = 0; i < 2; ++i)
#pragma unroll
        for (int e = 0; e < 5; ++e) Cacc[i][e] = (f32x4){0.f, 0.f, 0.f, 0.f};
    float m_state = 0.f;
    for (int i = tid; i < (80 * ML_KP) / 16; i += NTHR) *(LAS v4u*)(lds + ML_CT + 16 * i) = (v4u){0u, 0u, 0u, 0u};
#define ML_ROW(c, i) ((c) == 0 ? MR + ((i) & 15) : b * SEQ + 64 * ((c) - 1) + (i))
#define ML_VALID(c, i) ((c) > 0 || (i) < NMETA)
    v4u kst[4], vst; bf16x8 qf[8], qn[8]; float bc_c, u_c, pm_c, bc_n, u_n, pm_n;
    const GAS unsigned char* Pb = (const GAS unsigned char*)PROJ;
    const unsigned kofs = (unsigned)(((tid >> 5) * NPROJ + 2048 + h * MDK + (tid & 31) * 8) * 2);
    const unsigned vofs = (unsigned)(((tid >> 3) * NPROJ + 4096 + h * MDV + sl * 64 + (tid & 7) * 8) * 2);
    const unsigned qofs = (unsigned)(((16 * tb + c15) * NPROJ + h * MDK + 8 * q4) * 2);
    constexpr unsigned ROWB = NPROJ * 2;
    {
#pragma unroll
        for (int j = 0; j < 4; ++j) { const int id = tid + NTHR * j, i = id >> 5, ch = id & 31; const v4u x = *(const GAS v4u*)(Pb + (size_t)(MR + (i & 15)) * ROWB + (2048 + h * MDK + ch * 8) * 2);
            *(LAS v4u*)(lds + ML_KR0 + i * ML_KP + ch * 16) = ML_VALID(0, i) ? x : (v4u){0u, 0u, 0u, 0u}; }
        { const int i = tid >> 3, ch = tid & 7; const v4u x = *(const GAS v4u*)(Pb + (size_t)(MR + (i & 15)) * ROWB + (4096 + h * MDV + sl * 64 + ch * 8) * 2);
            *(LAS v4u*)(lds + ML_VR0 + i * ML_VP + ch * 16) = ML_VALID(0, i) ? x : (v4u){0u, 0u, 0u, 0u}; }
        { const int i = 16 * tb + c15;
#pragma unroll
            for (int ks = 0; ks < 8; ++ks) { const bf16x8 x = *(const GAS bf16x8*)(Pb + (size_t)(MR + (i & 15)) * ROWB + (h * MDK + 32 * ks + 8 * q4) * 2); qf[ks] = ML_VALID(0, i) ? x : (bf16x8){0, 0, 0, 0, 0, 0, 0, 0}; } }
    }
    float* GSC = (float*)(a.ws + WS_KNOPE) + (size_t)unit * (65 * 192);
    for (int c = wave; c <= 64; c += NWAVES) {
        const bool tokv = ML_VALID(c, lane);
        const float gi = GATES[(size_t)h * MT + ML_ROW(c, lane)], gf = GATES[(size_t)(8 + h) * MT + ML_ROW(c, lane)];
        const float logi = tokv ? 15.0f * tanhf((gi + b_i) * (1.0f / 15.0f)) : -__builtin_inff();
        const float logf = tokv ? log_sigmoid(15.0f * tanhf((gf + b_f) * (1.0f / 15.0f))) : 0.f;
        const float bcum = prefix_sum64(logf, lane);
        const float u = logi - bcum;
        const float pm = prefix_max64(u, lane);
        GSC[c * 192 + lane] = bcum; GSC[c * 192 + 64 + lane] = u; GSC[c * 192 + 128 + lane] = pm;
    }
    VM_WAIT(); __syncthreads();
#define ML_GLOAD(c, B, U, P) do { B = __hip_atomic_load(GSC + (c) * 192 + lane, __ATOMIC_RELAXED, __HIP_MEMORY_SCOPE_AGENT); U = __hip_atomic_load(GSC + (c) * 192 + 64 + lane, __ATOMIC_RELAXED, __HIP_MEMORY_SCOPE_AGENT); \
        P = __hip_atomic_load(GSC + (c) * 192 + 128 + lane, __ATOMIC_RELAXED, __HIP_MEMORY_SCOPE_AGENT); } while (0)
    ML_GLOAD(0, bc_c, u_c, pm_c);
    LDS_WAIT(); __syncthreads();
    for (int c = 0; c <= 64; ++c) {
        const int cur = c & 1, nx = cur ^ 1, cn = c < 64 ? c + 1 : 64;
        LAS const unsigned char* KRc = lds + ML_KR0 + cur * ML_KRSZ; LAS const unsigned char* VRc = lds + ML_VR0 + cur * ML_VRSZ;
        const GAS unsigned char* Pn = Pb + (size_t)(b * SEQ + 64 * (cn - 1)) * ROWB;
#pragma unroll
        for (int j = 0; j < 4; ++j) kst[j] = *(const GAS v4u*)(Pn + (kofs + (unsigned)j * (16u * ROWB)));
        vst = *(const GAS v4u*)(Pn + vofs);
        ML_GLOAD(cn, bc_n, u_n, pm_n);
        const float bcum = bc_c, u = u_c;
        const float Mv = fmaxf(m_state, pm_c);
        const float av = __expf(m_state - Mv);
        const float mt = bcum + Mv;
        const float M63 = __shfl(Mv, 63), b63 = __shfl(bcum, 63);
        const float wl = __expf(u - M63) * 0.0625f;
        const float decay = __shfl(av, 63);
        LAS float* uS = (LAS float*)(lds + ML_WS + wave * 512); LAS float* wS = uS + 64;
        uS[lane] = u; wS[lane] = wl; LDS_WAIT();
        f32x4 Sacc[4];
#pragma unroll
        for (int sb = 0; sb < 4; ++sb) Sacc[sb] = (f32x4){0.f, 0.f, 0.f, 0.f};
        f32x4 a1[3], a2[3];
#pragma unroll
        for (int x = 0; x < 3; ++x) { a1[x] = (f32x4){0.f, 0.f, 0.f, 0.f}; a2[x] = (f32x4){0.f, 0.f, 0.f, 0.f}; }
#pragma unroll
        for (int kp = 0; kp < 1; ++kp) {
#pragma unroll
            for (int ks = 8 * kp; ks < 8 * kp + 8; ++ks) {
#pragma unroll
                for (int sb = 0; sb < 4; ++sb) if (sb <= tb) { const bf16x8 kf = *(LAS const bf16x8*)(KRc + (16 * sb + c15) * ML_KP + (32 * ks + 8 * q4) * 2); Sacc[sb] = __builtin_amdgcn_mfma_f32_16x16x32_bf16(kf, qf[ks], Sacc[sb], 0, 0, 0); }
#pragma unroll
                for (int x = 0; x < 3; ++x) { const int eb = x < 2 ? 2 * eh + x : 4; const bf16x8 cf = *(LAS const bf16x8*)(lds + ML_CT + (16 * eb + c15) * ML_KP + (32 * ks + 8 * q4) * 2);
                    a1[x] = __builtin_amdgcn_mfma_f32_16x16x32_bf16(cf, qf[ks], a1[x], 0, 0, 0); } }
            SBAR(); }
        const float Mt = __shfl(Mv, 16 * tb + c15), at = __shfl(av, 16 * tb + c15), mtt = __shfl(mt, 16 * tb + c15);
        bf16x8 pf[2];
        {   float sp[4][4];
#pragma unroll
            for (int sb = 0; sb < 4; ++sb) { const f32x4 u4 = *(LAS const f32x4*)(uS + 16 * sb + 4 * q4);
#pragma unroll
                for (int j = 0; j < 4; ++j) { const int s_abs = 16 * sb + 4 * q4 + j; const float us = u4[j];
                    const float w = (s_abs <= 16 * tb + c15) ? __expf(us - Mt) : 0.f; sp[sb][j] = (sb <= tb) ? Sacc[sb][j] * 0.0625f * w : 0.f; } }
#pragma unroll
            for (int k2 = 0; k2 < 2; ++k2) { v4u w; w.x = pk2(sp[2 * k2][0], sp[2 * k2][1]); w.y = pk2(sp[2 * k2][2], sp[2 * k2][3]); w.z = pk2(sp[2 * k2 + 1][0], sp[2 * k2 + 1][1]); w.w = pk2(sp[2 * k2 + 1][2], sp[2 * k2 + 1][3]);
                pf[k2] = __builtin_bit_cast(bf16x8, w); } }
        const bf16x8 onesf = (c15 == 0) ? (bf16x8){0x3F80, 0x3F80, 0x3F80, 0x3F80, 0x3F80, 0x3F80, 0x3F80, 0x3F80} : (bf16x8){0, 0, 0, 0, 0, 0, 0, 0};
#pragma unroll
        for (int k2 = 0; k2 < 2; ++k2) {
#pragma unroll
            for (int x = 0; x < 2; ++x) { const int eb = 2 * eh + x; LAS const unsigned char* p = VRc + (32 * k2 + 4 * q4 + (c15 >> 2)) * ML_VP + (16 * eb + 4 * (c15 & 3)) * 2;
                const s16x4 lo = lds_tr(p), hi = lds_tr(p + 16 * ML_VP);
                a2[x] = __builtin_amdgcn_mfma_f32_16x16x32_bf16(cat4(lo, hi), pf[k2], a2[x], 0, 0, 0); }
            a2[2] = __builtin_amdgcn_mfma_f32_16x16x32_bf16(onesf, pf[k2], a2[2], 0, 0, 0); }
        {   const float den0 = at * a1[2][0] + a2[2][0];
            const float den = __shfl(den0, c15);
            const float inv = 1.0f / fmaxf(fabsf(den), __expf(-mtt));
            const int tl = 16 * tb + c15;
            if (ML_VALID(c, tl)) { const unsigned ho = (unsigned)((ML_ROW(c, tl) * DM + h * MDV + sl * 64 + 4 * q4 + 32 * eh) * 2);
#pragma unroll
                for (int x = 0; x < 2; ++x) { v2u w; w.x = pk2((at * a1[x][0] + a2[x][0]) * inv, (at * a1[x][1] + a2[x][1]) * inv); w.y = pk2((at * a1[x][2] + a2[x][2]) * inv, (at * a1[x][3] + a2[x][3]) * inv);
                    *(GAS v2u*)((GAS unsigned char*)HH + (ho + 32u * x)) = w; } } }
#pragma unroll
        for (int ks = 0; ks < 8; ++ks) qn[ks] = *(const GAS bf16x8*)(Pn + (qofs + 64u * ks));
#pragma unroll
        for (int i = 0; i < 2; ++i)
#pragma unroll
            for (int e = 0; e < 5; ++e) Cacc[i][e] = Cacc[i][e] * decay;
#pragma unroll
        for (int k2 = 0; k2 < 2; ++k2) {
            const f32x4 wv0 = *(LAS const f32x4*)(wS + 32 * k2 + 8 * q4), wv1 = *(LAS const f32x4*)(wS + 32 * k2 + 8 * q4 + 4);
            const float wlv[8] = {wv0.x, wv0.y, wv0.z, wv0.w, wv1.x, wv1.y, wv1.z, wv1.w};
            bf16x8 bfr[5];
#pragma unroll
            for (int eb = 0; eb < 4; ++eb) { LAS const unsigned char* p = VRc + (32 * k2 + 8 * q4 + (c15 >> 2)) * ML_VP + (16 * eb + 4 * (c15 & 3)) * 2;
                const s16x4 lo = lds_tr(p), hi = lds_tr(p + 4 * ML_VP);
                v4u w; w.x = pk2(bf2f((unsigned short)lo[0]) * wlv[0], bf2f((unsigned short)lo[1]) * wlv[1]); w.y = pk2(bf2f((unsigned short)lo[2]) * wlv[2], bf2f((unsigned short)lo[3]) * wlv[3]);
                w.z = pk2(bf2f((unsigned short)hi[0]) * wlv[4], bf2f((unsigned short)hi[1]) * wlv[5]); w.w = pk2(bf2f((unsigned short)hi[2]) * wlv[6], bf2f((unsigned short)hi[3]) * wlv[7]);
                bfr[eb] = __builtin_bit_cast(bf16x8, w); }
            { v4u w; w.x = pk2(wlv[0], wlv[1]); w.y = pk2(wlv[2], wlv[3]); w.z = pk2(wlv[4], wlv[5]); w.w = pk2(wlv[6], wlv[7]); if (c15 != 0) w = (v4u){0u, 0u, 0u, 0u}; bfr[4] = __builtin_bit_cast(bf16x8, w); }
#pragma unroll
            for (int i = 0; i < 2; ++i) { const int rb = 2 * wave + i; LAS const unsigned char* p = KRc + (32 * k2 + 8 * q4 + (c15 >> 2)) * ML_KP + (16 * rb + 4 * (c15 & 3)) * 2;
                const s16x4 lo = lds_tr(p), hi = lds_tr(p + 4 * ML_KP); const bf16x8 af = cat4(lo, hi);
#pragma unroll
                for (int eb = 0; eb < 5; ++eb) Cacc[i][eb] = __builtin_amdgcn_mfma_f32_16x16x32_bf16(af, bfr[eb], Cacc[i][eb], 0, 0, 0); }
        }
        LDS_WAIT(); __syncthreads();
#pragma unroll
        for (int i = 0; i < 2; ++i)
#pragma unroll
            for (int eb = 0; eb < 5; ++eb) { v2u w; w.x = pk2(Cacc[i][eb][0], Cacc[i][eb][1]); w.y = pk2(Cacc[i][eb][2], Cacc[i][eb][3]);
                *(LAS v2u*)(lds + ML_CT + (16 * eb + c15) * ML_KP + (16 * (2 * wave + i) + 4 * q4) * 2) = w; }
#pragma unroll
        for (int j = 0; j < 4; ++j) { const int id = tid + NTHR * j, i = id >> 5, ch = id & 31; *(LAS v4u*)(lds + ML_KR0 + nx * ML_KRSZ + i * ML_KP + ch * 16) = kst[j]; }
        { const int i = tid >> 3, ch = tid & 7; *(LAS v4u*)(lds + ML_VR0 + nx * ML_VRSZ + i * ML_VP + ch * 16) = vst; }
#pragma unroll
        for (int ks = 0; ks < 8; ++ks) qf[ks] = qn[ks];
        bc_c = bc_n; u_c = u_n; pm_c = pm_n;
        m_state = b63 + M63;
        LDS_WAIT(); __syncthreads();
    }
#undef ML_ROW
#undef ML_VALID
#undef ML_GLOAD
}
__device__ __forceinline__ void mlstm_unit(Frame& F, const Args& a, int unit) {
    switch (F.wave >> 1) { case 0: mlstm_unit_tb<0>(F, a, unit); break; case 1: mlstm_unit_tb<1>(F, a, unit); break; case 2: mlstm_unit_tb<2>(F, a, unit); break; default: mlstm_unit_tb<3>(F, a, unit); break; }
}

constexpr int AT_KSZ = 12288, AT_VSZ = 8192, AT_K0 = 0, AT_V0 = 2 * AT_KSZ, AT_WS = AT_V0 + 2 * AT_VSZ, AT_GQ = AT_WS + NWAVES * 256, AT_OST = AT_GQ + 768, AT_END = AT_OST + NWAVES * 4096;
static_assert(AT_END <= RING_BYTES, "attention LDS");
constexpr float AT_SCALE = 0.07216878364870322f / 256.0f;
constexpr float AT_THR = 2.5f;
__device__ __forceinline__ int crow(int r, int hi) { return (r & 3) + 8 * (r >> 2) + 4 * hi; }
__device__ __forceinline__ int v_rd_base(int lane) { return ((lane & 3) << 3) | (((lane >> 2) & 3) << 6) | (((lane >> 4) & 1) << 5) | (((lane >> 5) & 1) << 8); }
constexpr int v_rd_off(int d0, int ks, int half) { return d0 * 512 + ks * 4096 + half * 2048; }
__device__ __forceinline__ void at_mask(f32x16& p0, f32x16& p1, int dq) {
    const float NEG = -__builtin_inff();
#pragma unroll
    for (int r = 0; r < 16; ++r) { const int c = (r & 3) + 8 * (r >> 2); if (dq - c < 0) p0[r] = NEG; if (dq - c - 32 < 0) p1[r] = NEG; }
}
__device__ __forceinline__ void at_partialSM(f32x16& p0, f32x16& p1, float& m_reg, float& mn, float& alpha) {
    float pmax = p0[0];
#pragma unroll
    for (int r = 1; r < 16; ++r) pmax = fmaxf(pmax, p0[r]);
#pragma unroll
    for (int r = 0; r < 16; ++r) pmax = fmaxf(pmax, p1[r]);
    { auto rr = __builtin_amdgcn_permlane32_swap(__float_as_uint(pmax), __float_as_uint(pmax), false, false); pmax = fmaxf(__uint_as_float(rr[0]), __uint_as_float(rr[1])); }
    constexpr float C2 = 1.4426950408889634f * AT_SCALE;
    if (__builtin_expect(__all((pmax - m_reg) * AT_SCALE <= AT_THR), 1)) { mn = m_reg; alpha = 1.f; }
    else { mn = fmaxf(m_reg, pmax); alpha = __builtin_amdgcn_exp2f((m_reg - mn) * C2); m_reg = mn; }
    const float mnL = 5.0f - mn * C2;
#pragma unroll
    for (int r = 0; r < 16; ++r) p0[r] = __builtin_amdgcn_exp2f(fmaf(p0[r], C2, mnL));
#pragma unroll
    for (int r = 0; r < 16; ++r) p1[r] = __builtin_amdgcn_exp2f(fmaf(p1[r], C2, mnL));
}
__device__ __forceinline__ void at_finishSM(const f32x16& p0, const f32x16& p1, float alpha, float& l_reg, bf16x8& pa0, bf16x8& pa1, bf16x8& pa2, bf16x8& pa3) {
    float ps = 0.f;
#pragma unroll
    for (int r = 0; r < 16; ++r) ps += p0[r];
#pragma unroll
    for (int r = 0; r < 16; ++r) ps += p1[r];
    { auto rr = __builtin_amdgcn_permlane32_swap(__float_as_uint(ps), __float_as_uint(ps), false, false); ps = __uint_as_float(rr[0]) + __uint_as_float(rr[1]); }
    l_reg = l_reg * alpha + ps;
#define AT_PK4(P, B_, OUT) do { unsigned a0 = pk2a(P[B_+0], P[B_+1]), a1 = pk2a(P[B_+2], P[B_+3]); unsigned b0 = pk2a(P[B_+4], P[B_+5]), b1 = pk2a(P[B_+6], P[B_+7]); \
        auto r0 = __builtin_amdgcn_permlane32_swap(a0, b0, false, false); auto r1 = __builtin_amdgcn_permlane32_swap(a1, b1, false, false); \
        v4u w = {r0[0], r1[0], r0[1], r1[1]}; OUT = __builtin_bit_cast(bf16x8, w); } while (0)
    AT_PK4(p0, 0, pa0); AT_PK4(p0, 8, pa1); AT_PK4(p1, 0, pa2); AT_PK4(p1, 8, pa3);
#undef AT_PK4
}
__device__ __forceinline__ void at_qkt(f32x16& p0, f32x16& p1, LAS const unsigned char* Kb, int r32, int hi, const bf16x8* qr) {
    p0 = (f32x16){0.f, 0.f, 0.f, 0.f, 0.f, 0.f, 0.f, 0.f, 0.f, 0.f, 0.f, 0.f, 0.f, 0.f, 0.f, 0.f}; p1 = p0;
    LAS const unsigned char* kb[4];
#pragma unroll
    for (int dd = 0; dd < 4; ++dd) kb[dd] = Kb + r32 * 384 + (((2 * dd + hi) ^ ((r32 >> 1) & 7)) << 4);
    bf16x8 c0[2], c1[2], n0[2], n1[2];
#pragma unroll
    for (int dd = 0; dd < 2; ++dd) { LAS const unsigned char* p = kb[dd]; c0[dd] = *(LAS const bf16x8*)p; c1[dd] = *(LAS const bf16x8*)(p + 32 * 384); }
#pragma unroll
    for (int g = 0; g < 6; ++g) {
        if (g < 5) {
#pragma unroll
            for (int dd = 0; dd < 2; ++dd) { LAS const unsigned char* p = kb[2 * ((g + 1) & 1) + dd] + ((g + 1) >> 1) * 128; n0[dd] = *(LAS const bf16x8*)p; n1[dd] = *(LAS const bf16x8*)(p + 32 * 384); } }
        SBAR();
#pragma unroll
        for (int dd = 0; dd < 2; ++dd) { p0 = __builtin_amdgcn_mfma_f32_32x32x16_bf16(c0[dd], qr[2 * g + dd], p0, 0, 0, 0); p1 = __builtin_amdgcn_mfma_f32_32x32x16_bf16(c1[dd], qr[2 * g + dd], p1, 0, 0, 0); }
        SBAR();
#pragma unroll
        for (int dd = 0; dd < 2; ++dd) { c0[dd] = n0[dd]; c1[dd] = n1[dd]; } }
}
__device__ __forceinline__ void at_qkt8(f32x16& p0, f32x16& p1, LAS const unsigned char* Kb, const int (&ko)[6], int kmask, const pg8::i32x8* q8) {
#define AT_KO2(x) (ko[x] + 6080 + 192 * ((kmask >> (x)) & 1))
    p0 = (f32x16){0.f, 0.f, 0.f, 0.f, 0.f, 0.f, 0.f, 0.f, 0.f, 0.f, 0.f, 0.f, 0.f, 0.f, 0.f, 0.f}; p1 = p0;
    pg8::i32x8 a0 = pg8::cat8(*(LAS const bf16x8*)(Kb + ko[0]), *(LAS const bf16x8*)(Kb + ko[1])), a1 = pg8::cat8(*(LAS const bf16x8*)(Kb + AT_KO2(0)), *(LAS const bf16x8*)(Kb + AT_KO2(1)));
#pragma unroll
    for (int j = 0; j < 3; ++j) { pg8::i32x8 n0 = a0, n1 = a1;
        if (j < 2) { n0 = pg8::cat8(*(LAS const bf16x8*)(Kb + ko[2 * j + 2]), *(LAS const bf16x8*)(Kb + ko[2 * j + 3])); n1 = pg8::cat8(*(LAS const bf16x8*)(Kb + AT_KO2(2 * j + 2)), *(LAS const bf16x8*)(Kb + AT_KO2(2 * j + 3))); }
        SBAR();
        p0 = __builtin_amdgcn_mfma_scale_f32_32x32x64_f8f6f4(a0, q8[j], p0, 0, 0, 0, 0, 0, 0);
        p1 = __builtin_amdgcn_mfma_scale_f32_32x32x64_f8f6f4(a1, q8[j], p1, 0, 0, 0, 0, 0, 0);
        SBAR(); a0 = n0; a1 = n1; }
#undef AT_KO2
}
__device__ __forceinline__ void at_pv(f32x16* o, unsigned vb0, bf16x8 pa0, bf16x8 pa1, bf16x8 pa2, bf16x8 pa3) {
#define AT_TRRD(dst, off) asm volatile("ds_read_b64_tr_b16 %0, %1 offset:%2" : "=&v"(dst) : "v"(vb0), "i"(off) : "memory")
#define AT_LOADV(L, H, d0) do { constexpr int b_ = v_rd_off(d0, 0, 0); AT_TRRD(L[0], b_); AT_TRRD(H[0], b_ + 2048); AT_TRRD(L[1], b_ + 4096); AT_TRRD(H[1], b_ + 6144); \
        AT_TRRD(L[2], b_ + 8192); AT_TRRD(H[2], b_ + 10240); AT_TRRD(L[3], b_ + 12288); AT_TRRD(H[3], b_ + 14336); } while (0)
#define AT_MMAV(L, H, d0) do { o[d0] = __builtin_amdgcn_mfma_f32_32x32x16_bf16(pa0, cat4(L[0], H[0]), o[d0], 0, 0, 0); o[d0] = __builtin_amdgcn_mfma_f32_32x32x16_bf16(pa1, cat4(L[1], H[1]), o[d0], 0, 0, 0); \
        o[d0] = __builtin_amdgcn_mfma_f32_32x32x16_bf16(pa2, cat4(L[2], H[2]), o[d0], 0, 0, 0); o[d0] = __builtin_amdgcn_mfma_f32_32x32x16_bf16(pa3, cat4(L[3], H[3]), o[d0], 0, 0, 0); } while (0)
    s16x4 la[4], ha[4], lb[4], hb[4];
    AT_LOADV(la, ha, 0); AT_LOADV(lb, hb, 1);
    asm volatile("s_waitcnt lgkmcnt(8)" ::: "memory"); SBAR(); AT_MMAV(la, ha, 0); SBAR();
    AT_LOADV(la, ha, 2);
    asm volatile("s_waitcnt lgkmcnt(8)" ::: "memory"); SBAR(); AT_MMAV(lb, hb, 1); SBAR();
    AT_LOADV(lb, hb, 3);
    asm volatile("s_waitcnt lgkmcnt(8)" ::: "memory"); SBAR(); AT_MMAV(la, ha, 2); SBAR();
    asm volatile("s_waitcnt lgkmcnt(0)" ::: "memory"); SBAR(); AT_MMAV(lb, hb, 3); SBAR();
#undef AT_MMAV
#undef AT_LOADV
#undef AT_TRRD
}
__device__ __forceinline__ pg8::i32x8 at_finishSM8(const f32x16& p0, const f32x16& p1, float alpha, float& l_reg) {
    float ps = 0.f;
#pragma unroll
    for (int r = 0; r < 16; ++r) ps += p0[r];
#pragma unroll
    for (int r = 0; r < 16; ++r) ps += p1[r];
    { auto rr = __builtin_amdgcn_permlane32_swap(__float_as_uint(ps), __float_as_uint(ps), false, false); ps = __uint_as_float(rr[0]) + __uint_as_float(rr[1]); }
    l_reg = l_reg * alpha + ps;
    int w[8];
#pragma unroll
    for (int k = 0; k < 4; ++k) { int x = __builtin_amdgcn_cvt_pk_fp8_f32(p0[4 * k], p0[4 * k + 1], 0, false); x = __builtin_amdgcn_cvt_pk_fp8_f32(p0[4 * k + 2], p0[4 * k + 3], x, true); w[k] = x;
        x = __builtin_amdgcn_cvt_pk_fp8_f32(p1[4 * k], p1[4 * k + 1], 0, false); x = __builtin_amdgcn_cvt_pk_fp8_f32(p1[4 * k + 2], p1[4 * k + 3], x, true); w[4 + k] = x; }
    return (pg8::i32x8){w[0], w[1], w[2], w[3], w[4], w[5], w[6], w[7]};
}
__device__ __forceinline__ s16x4 lds_tr8(LAS const unsigned char* p) { typedef int v2i_t __attribute__((ext_vector_type(2))); return __builtin_bit_cast(s16x4, __builtin_amdgcn_ds_read_tr8_b64_v2i32((LAS v2i_t*)p)); }
__device__ __forceinline__ void at_pv8(f32x16* o, LAS const unsigned char* const (&va)[4], pg8::i32x8 P8) {
#pragma unroll
    for (int d0 = 0; d0 < 4; ++d0) { const s16x4 t0 = lds_tr8(va[d0]), t1 = lds_tr8(va[d0] + 2048), t2 = lds_tr8(va[d0] + 4096), t3 = lds_tr8(va[d0] + 6144);
        const pg8::i32x8 B = pg8::cat8(cat4(t0, t1), cat4(t2, t3));
        asm volatile("v_mfma_f32_32x32x64_f8f6f4 %0, %1, %2, %0" : "+v"(o[d0]) : "v"(P8), "v"(B)); }
    asm volatile("s_nop 15\n\ts_nop 15" ::: "memory");
}
__device__ __forceinline__ void at_dma_tile(LAS unsigned char* lds, const unsigned char* Kt, const unsigned char* Vt, int buf, int wave, int lane) {
    unsigned lo = (unsigned)lane * 16u; asm volatile("" : "+v"(lo));
#pragma unroll
    for (int i = 0; i < 2; ++i) { const int pc = wave + 8 * i; if (pc < 12) __builtin_amdgcn_global_load_lds((const unsigned*)((Kt + pc * 1024) + lo), (LAS unsigned*)(lds + AT_K0 + buf * AT_KSZ + pc * 1024), 16, 0, 0); }
    __builtin_amdgcn_global_load_lds((const unsigned*)((Vt + wave * 1024) + lo), (LAS unsigned*)(lds + AT_V0 + buf * AT_VSZ + wave * 1024), 16, 0, 0);
}
__device__ __forceinline__ void attn_block(Frame& F, const Args& a, int bh, int qb) {
    const int lane = F.lane, wave = F.wave, r32 = lane & 31, hi = lane >> 5, b = bh >> 6, h = bh & 63;
    LAS unsigned char* lds = F.lds;
    const bf16* QRAW = (const bf16*)(a.ws + WS_BIG); const float* ROPEt = (const float*)(a.ws + WS_ROPE);
    const unsigned char* Kimg = a.ws + WS_K + (size_t)bh * NKT * AT_KSZ; const unsigned char* Vimg = a.ws + WS_V + (size_t)bh * NKT * AT_VSZ;
    bf16* ATO = (bf16*)(a.ws + WS_KNOPE);
    const int NT = 4 * qb + 5;
    at_dma_tile(lds, Kimg, Vimg, 0, wave, lane);
    const int m = b * SEQ + 256 * qb + 32 * wave + r32;
    pg8::i32x8 q8[3];
#define Q8F(word, b) __builtin_amdgcn_cvt_f32_fp8((int)(word), b)
    {   v2u qraw[12]; float ss = 0.f;
        const unsigned qo = (unsigned)(m * (AH * QKD) + h * QKD);
#pragma unroll
        for (int j = 0; j < 3; ++j)
#pragma unroll
            for (int i = 0; i < 4; ++i) { const int d = j < 2 ? 64 * j + 32 * hi + 8 * i : (i < 2 ? 128 + 16 * hi + 8 * i : 160 + 16 * hi + 8 * (i - 2));
                qraw[4 * j + i] = *(const GAS v2u*)((const GAS unsigned char*)QRAW + (qo + (unsigned)d)); }
#pragma unroll
        for (int d0 = 0; d0 < 12; ++d0) { const v2u w = qraw[d0];
            ss += (Q8F(w.x, 0) * Q8F(w.x, 0) + Q8F(w.x, 1) * Q8F(w.x, 1)) + (Q8F(w.x, 2) * Q8F(w.x, 2) + Q8F(w.x, 3) * Q8F(w.x, 3)) + (Q8F(w.y, 0) * Q8F(w.y, 0) + Q8F(w.y, 1) * Q8F(w.y, 1)) + (Q8F(w.y, 2) * Q8F(w.y, 2) + Q8F(w.y, 3) * Q8F(w.y, 3)); }
        ss += __shfl_xor(ss, 32);
        const float r = (F8_A_SCALE / 16.0f) / sqrtf(ss * (1.0f / (256.0f * QKD)) + EPS);
        LAS const float* gq = (LAS const float*)(lds + AT_GQ);
#pragma unroll
        for (int j = 0; j < 2; ++j) { int wds[8];
#pragma unroll
            for (int i = 0; i < 4; ++i) { const v2u w = qraw[4 * j + i]; const int d = 64 * j + 32 * hi + 8 * i; const f32x4 g0 = *(LAS const f32x4*)(gq + d), g1 = *(LAS const f32x4*)(gq + d + 4);
                int x = __builtin_amdgcn_cvt_pk_fp8_f32(Q8F(w.x, 0) * r * g0.x, Q8F(w.x, 1) * r * g0.y, 0, false); x = __builtin_amdgcn_cvt_pk_fp8_f32(Q8F(w.x, 2) * r * g0.z, Q8F(w.x, 3) * r * g0.w, x, true); wds[2 * i] = x;
                x = __builtin_amdgcn_cvt_pk_fp8_f32(Q8F(w.y, 0) * r * g1.x, Q8F(w.y, 1) * r * g1.y, 0, false); x = __builtin_amdgcn_cvt_pk_fp8_f32(Q8F(w.y, 2) * r * g1.z, Q8F(w.y, 3) * r * g1.w, x, true); wds[2 * i + 1] = x; }
            q8[j] = (pg8::i32x8){wds[0], wds[1], wds[2], wds[3], wds[4], wds[5], wds[6], wds[7]}; }
        {
            const float* rt = ROPEt + (size_t)m * 64; float o1[16], o2[16];
#pragma unroll
            for (int i = 0; i < 2; ++i) { const v2u w1 = qraw[8 + i], w2 = qraw[10 + i]; const int i0 = 16 * hi + 8 * i;
                const f32x4 ga = *(LAS const f32x4*)(gq + 128 + i0), gb = *(LAS const f32x4*)(gq + 128 + i0 + 4), gc = *(LAS const f32x4*)(gq + 160 + i0), gd = *(LAS const f32x4*)(gq + 160 + i0 + 4);
                const f32x4 c0 = *(const GAS f32x4*)(rt + i0), c1 = *(const GAS f32x4*)(rt + i0 + 4), s0 = *(const GAS f32x4*)(rt + 32 + i0), s1 = *(const GAS f32x4*)(rt + 32 + i0 + 4);
                const float t1[8] = {Q8F(w1.x, 0) * r * ga.x, Q8F(w1.x, 1) * r * ga.y, Q8F(w1.x, 2) * r * ga.z, Q8F(w1.x, 3) * r * ga.w, Q8F(w1.y, 0) * r * gb.x, Q8F(w1.y, 1) * r * gb.y, Q8F(w1.y, 2) * r * gb.z, Q8F(w1.y, 3) * r * gb.w};
                const float t2[8] = {Q8F(w2.x, 0) * r * gc.x, Q8F(w2.x, 1) * r * gc.y, Q8F(w2.x, 2) * r * gc.z, Q8F(w2.x, 3) * r * gc.w, Q8F(w2.y, 0) * r * gd.x, Q8F(w2.y, 1) * r * gd.y, Q8F(w2.y, 2) * r * gd.z, Q8F(w2.y, 3) * r * gd.w};
                const float cs[8] = {c0.x, c0.y, c0.z, c0.w, c1.x, c1.y, c1.z, c1.w}, sn[8] = {s0.x, s0.y, s0.z, s0.w, s1.x, s1.y, s1.z, s1.w};
#pragma unroll
                for (int e = 0; e < 8; ++e) { o1[8 * i + e] = t1[e] * cs[e] - t2[e] * sn[e]; o2[8 * i + e] = t1[e] * sn[e] + t2[e] * cs[e]; } }
            int wds[8];
#pragma unroll
            for (int k = 0; k < 4; ++k) { int x = __builtin_amdgcn_cvt_pk_fp8_f32(o1[4 * k], o1[4 * k + 1], 0, false); x = __builtin_amdgcn_cvt_pk_fp8_f32(o1[4 * k + 2], o1[4 * k + 3], x, true); wds[k] = x;
                x = __builtin_amdgcn_cvt_pk_fp8_f32(o2[4 * k], o2[4 * k + 1], 0, false); x = __builtin_amdgcn_cvt_pk_fp8_f32(o2[4 * k + 2], o2[4 * k + 3], x, true); wds[4 + k] = x; }
            q8[2] = (pg8::i32x8){wds[0], wds[1], wds[2], wds[3], wds[4], wds[5], wds[6], wds[7]}; }
    }
#undef Q8F
    int ko[6], kmask = 0;
    { int rq = r32; asm volatile("" : "+v"(rq));
#pragma unroll
      for (int j = 0; j < 3; ++j)
#pragma unroll
        for (int w = 0; w < 2; ++w) { const int c = j < 2 ? 4 * j + 2 * hi + w : 8 + hi + 2 * w; const int cp = (c + (rq >> 2)) % 12;
            ko[2 * j + w] = rq * 192 + (cp << 4); kmask |= (cp < 4 ? 1 : 0) << (2 * j + w); } }
    LAS float* wsf = (LAS float*)(lds + AT_WS + wave * 256); LAS float* li_l = wsf; LAS float* al_l = wsf + 32;
    float m_reg = -1e30f, l_reg = 0.f; f32x16 o[4];
#pragma unroll
    for (int d = 0; d < 4; ++d) o[d] = (f32x16){0.f, 0.f, 0.f, 0.f, 0.f, 0.f, 0.f, 0.f, 0.f, 0.f, 0.f, 0.f, 0.f, 0.f, 0.f, 0.f};
    const int qlo = NMETA + 256 * qb + 32 * wave;
    const int qm = qlo + r32 - 4 * hi;
    int vrow0, vsk;
    { const int q = (lane & 15) >> 1; vrow0 = ((q & 3) + 8 * (q >> 2) + 4 * hi) * 128 + 16 * ((lane >> 4) & 1) + 8 * (lane & 1); vsk = ((q >> 1) & 1) | (((q >> 2) & 1) << 1); }
    VM_WAIT(); __syncthreads();
    for (int t = 0; t < NT; ++t) {
        const int buf = t & 1;
        if (t + 1 < NT) at_dma_tile(lds, Kimg + (size_t)(t + 1) * AT_KSZ, Vimg + (size_t)(t + 1) * AT_VSZ, buf ^ 1, wave, lane);
        const int kb = 64 * t;
        if (kb <= qlo + 31) {
            f32x16 p0, p1; float mn, alpha;
            at_qkt8(p0, p1, lds + AT_K0 + buf * AT_KSZ, ko, kmask, q8);
            if (kb + 63 > qlo) at_mask(p0, p1, qm - kb);
            at_partialSM(p0, p1, m_reg, mn, alpha);
            if (__any(alpha < 1.f)) { if (hi == 0) al_l[r32] = alpha; LDS_WAIT();
#pragma unroll
                for (int d = 0; d < 4; ++d)
#pragma unroll
                    for (int r = 0; r < 16; ++r) o[d][r] *= al_l[crow(r, hi)]; }
            const pg8::i32x8 P8 = at_finishSM8(p0, p1, alpha, l_reg);
            LAS const unsigned char* vt = lds + AT_V0 + buf * AT_VSZ + vrow0;
            LAS const unsigned char* const va[4] = {vt + ((0 ^ vsk) << 5), vt + ((1 ^ vsk) << 5), vt + ((2 ^ vsk) << 5), vt + ((3 ^ vsk) << 5)};
            at_pv8(o, va, P8);
        }
        VM_WAIT(); LDS_WAIT(); __syncthreads();
    }
    if (hi == 0) li_l[r32] = l_reg;
    LDS_WAIT();
    {   LAS unsigned char* ost = lds + AT_OST + wave * 4096 + 4 * hi * 128 + r32;
#pragma unroll
        for (int r = 0; r < 16; ++r) { const float rl = (ATT_O_SCALE / F8_A_SCALE) * __builtin_amdgcn_rcpf(li_l[crow(r, hi)]);
#pragma unroll
            for (int d0 = 0; d0 < 4; d0 += 2) { const int w = __builtin_amdgcn_cvt_pk_fp8_f32(o[d0][r] * rl, o[d0 + 1][r] * rl, 0, false);
                ost[((r & 3) + 8 * (r >> 2)) * 128 + d0 * 32] = (unsigned char)w; ost[((r & 3) + 8 * (r >> 2)) * 128 + d0 * 32 + 32] = (unsigned char)(w >> 8); } }
        LDS_WAIT();
        unsigned ob = (unsigned)((b * SEQ + 256 * qb + 32 * wave + (lane >> 3)) * (AH * VHD) + h * VHD + 16 * (lane & 7));
        asm volatile("" : "+v"(ob));
#pragma unroll
        for (int j = 0; j < 4; ++j) { const v4u x = *(LAS const v4u*)(lds + AT_OST + wave * 4096 + ((lane >> 3) + 8 * j) * 128 + 16 * (lane & 7));
            *(GAS v4u*)((GAS unsigned char*)ATO + (ob + (unsigned)(8 * j * (AH * VHD)))) = x; } }
    LDS_WAIT(); __syncthreads();
}
__device__ __forceinline__ void attn_phase(Frame& F, const Args& a) {
    if (F.tid < QKD) ((LAS float*)(F.lds + AT_GQ))[F.tid] = ((const float*)a.in[21])[F.tid];
    LDS_WAIT(); __syncthreads();
    for (int n = F.vcu; n < 2048; n += F.G) { const int st = n >> 8, cu = n & 255, xcd = cu >> 5, j = cu & 31; const int bh = 32 * xcd + 4 * st + (j >> 3), p = j & 7;
        attn_block(F, a, bh, 15 - p); attn_block(F, a, bh, p); }
}

__device__ __forceinline__ void meta_in_phase(Frame& F, const Args& a) {
    const bf16* XN = (const bf16*)(a.ws + WS_XN); const bf16* WT = (const bf16*)(a.ws + WS_W_IN); bf16* PROJ = (bf16*)(a.ws + WS_BIG); float* GATES = (float*)(a.ws + WS_GATES);
    const int lane = F.lane, r = lane & 15, q4 = lane >> 4;
    for (int t = F.vcu; t < 769 + 1024; t += F.G) { f32x4 acc[1];
        if (t < 769) { skinny_wg<1>(F, XN + (size_t)MR * DM, WT + (size_t)(16 * t) * DM, WT, DM, acc);
            if (F.wave == 0) {
                if (t < 768) { v2u w; w.x = pk2(acc[0][0], acc[0][1]); w.y = pk2(acc[0][2], acc[0][3]); *(GAS v2u*)(PROJ + (size_t)(MR + r) * NPROJ + 16 * t + 4 * q4) = w; }
                else {
#pragma unroll
                    for (int j = 0; j < 4; ++j) GATES[(size_t)(4 * q4 + j) * MT + MR + r] = acc[0][j]; } } }
        else { const int tt = t - 769;
            skinny_wg<1>(F, WT + (size_t)NPROJ * DM, XN + (size_t)(16 * tt) * DM, XN, DM, acc);
            if (F.wave == 0) *(GAS f32x4*)(GATES + (size_t)r * MT + 16 * tt + 4 * q4) = acc[0]; }
    }
}
__device__ __forceinline__ void meta_out_phase(Frame& F, const Args& a) {
    const bf16* A2 = (const bf16*)(a.ws + WS_XN); const bf16* WT = (const bf16*)(a.ws + WS_W_OUT); float* HM = (float*)(a.ws + WS_HMETA); const float* mt = (const float*)a.in[2];
    const int lane = F.lane, r = lane & 15, q4 = lane >> 4;
    for (int t = F.vcu; t < 256; t += F.G) { f32x4 acc[1]; skinny_wg<1>(F, A2 + (size_t)MR * DM, WT + (size_t)(16 * t) * DM, WT, DM, acc);
        if (F.wave == 0) { const size_t o = (size_t)r * DM + 16 * t + 4 * q4; *(GAS f32x4*)(HM + o) = *(const GAS f32x4*)(mt + o) + acc[0]; } }
}
__device__ __forceinline__ void meta_gu_phase(Frame& F, const Args& a) {
    const bf16* XN = (const bf16*)(a.ws + WS_XN); const bf16* WT = (const bf16*)(a.ws + WS_W_GU0); bf16* ACT = (bf16*)(a.ws + WS_BIG);
    const int lane = F.lane, r = lane & 15, q4 = lane >> 4;
    for (int t = F.vcu; t < DFF / 16; t += F.G) { const int c0 = 16 * t, j = c0 >> 7, i = c0 & 127; f32x4 gu[2];
        skinny_wg<2>(F, XN + (size_t)MR * DM, WT + (size_t)(256 * j + i) * DM, WT + (size_t)(256 * j + 128 + i) * DM, DM, gu);
        if (F.wave == 0) { v2u w; w.x = pk2(pg8::silu_mul(gu[0][0], gu[1][0]), pg8::silu_mul(gu[0][1], gu[1][1])); w.y = pk2(pg8::silu_mul(gu[0][2], gu[1][2]), pg8::silu_mul(gu[0][3], gu[1][3]));
            *(GAS v2u*)(ACT + (size_t)(MR + r) * DFF + c0 + 4 * q4) = w; } }
}
__device__ __forceinline__ void meta_down_phase(Frame& F, const Args& a) {
    const bf16* ACT = (const bf16*)(a.ws + WS_BIG); const bf16* WT = (const bf16*)(a.ws + WS_W_DN0); float* HM = (float*)(a.ws + WS_HMETA);
    const int lane = F.lane, r = lane & 15, q4 = lane >> 4;
    for (int t = F.vcu; t < 256; t += F.G) { f32x4 acc[1]; skinny_wg<1>(F, ACT + (size_t)MR * DFF, WT + (size_t)(16 * t) * DFF, WT, DFF, acc);
        if (F.wave == 0) { const size_t o = (size_t)r * DM + 16 * t + 4 * q4; *(GAS f32x4*)(HM + o) = *(const GAS f32x4*)(HM + o) + acc[0]; } }
}
__device__ __forceinline__ void meta_kvq_phase(Frame& F, const Args& a) {
    const bf16* XN = (const bf16*)(a.ws + WS_XN); const bf16* WT = (const bf16*)(a.ws + WS_W_KVQ); float* LAT = (float*)(a.ws + WS_LAT);
    const int lane = F.lane, r = lane & 15, q4 = lane >> 4;
    for (int t = F.vcu; t < 36; t += F.G) { f32x4 acc[1]; skinny_wg<1>(F, XN + (size_t)MR * DM, WT + (size_t)(16 * t) * DM, WT, DM, acc);
        if (F.wave == 0) *(GAS f32x4*)(LAT + (size_t)(MR + r) * NKVQ + 16 * t + 4 * q4) = acc[0]; }
}
__device__ __forceinline__ void meta_kvup_phase(Frame& F, const Args& a) {
    const bf16* CK = (const bf16*)(a.ws + WS_CKVN); const bf16* WT = (const bf16*)(a.ws + WS_W_KVUP); bf16* KN = (bf16*)(a.ws + WS_KNOPE); unsigned char* Vimg = a.ws + WS_V;
    const int lane = F.lane, r = lane & 15, q4 = lane >> 4;
    for (int t = F.vcu; t < 1024; t += F.G) { f32x4 acc[1]; skinny_wg<1>(F, CK + (size_t)MR * KVLORA, WT + (size_t)(16 * t) * KVLORA, WT, KVLORA, acc);
        if (F.wave == 0) { const int n = 16 * t + 4 * q4, hd = n >> 8, wi = n & 255; v2u w; w.x = pk2(acc[0][0], acc[0][1]); w.y = pk2(acc[0][2], acc[0][3]);
            if (wi < 128) *(GAS v2u*)(KN + (size_t)(MR + r) * 8192 + hd * 128 + wi) = w;
            else { const int c0 = wi - 128; int x = __builtin_amdgcn_cvt_pk_fp8_f32(acc[0][0] * 16.f, acc[0][1] * 16.f, 0, false); x = __builtin_amdgcn_cvt_pk_fp8_f32(acc[0][2] * 16.f, acc[0][3] * 16.f, x, true);
                for (int bb = 0; bb < BATCH; ++bb) *(GAS unsigned*)(Vimg + ((size_t)((bb * AH + hd) * NKT)) * 8192 + pg8::v_img_off8(r, c0)) = (unsigned)x; } } }
}

constexpr int NPH = 18;
__global__ void __launch_bounds__(NTHR, 2) mk_fwd(Args args) {
    extern __shared__ __attribute__((aligned(16))) unsigned char lds_raw[];
    Frame F;
    F.lds = (LAS unsigned char*)lds_raw;
    F.tid = threadIdx.x; F.lane = F.tid & 63; F.wave = __builtin_amdgcn_readfirstlane(F.tid >> 6);
    F.G = gridDim.x; { const int bx = blockIdx.x; F.vcu = (F.G % 8 == 0) ? (bx % 8) * (F.G / 8) + bx / 8 : bx; }
    F.gw = F.vcu * NWAVES + F.wave; F.ngw = F.G * NWAVES;
    volatile LAS unsigned* MISC = (volatile LAS unsigned*)(F.lds + MISC_OFF);
    for (int u = F.tid; u < (LDS_BYTES - LDSCTL_OFF) / 4; u += NTHR) ((LAS unsigned*)(F.lds + LDSCTL_OFF))[u] = 0u;
    __syncthreads();
    unsigned char* ws = args.ws;
    const int lo = args.ph_lo, hi = args.ph_hi;
    const bool one_launch = (hi - lo) > 1;
    XcdBarrier bar; bar.bar = (unsigned*)(ws + WS_CTL); bar.x = 0; bar.st = nullptr;
    if (one_launch) bar = xcd_barrier_post((unsigned*)(ws + WS_CTL), MISC + 8);
    bar.wave = F.wave;
#ifndef MK_PHASES
#define MK_PHASES 0x3ffff
#endif
#define IN(k) ((((MK_PHASES) >> (k)) & 1) && lo <= (k) && (k) < hi)
#define SEAM(k) do { if (IN((k) + 1)) xcd_barrier(bar); } while (0)
    pg8::f16_t* H = (pg8::f16_t*)(ws + WS_H16);
#define REFRESH() do { F.lane = (int)__builtin_amdgcn_mbcnt_hi(~0u, __builtin_amdgcn_mbcnt_lo(~0u, 0u)); F.tid = F.wave * 64 + F.lane; } while (0)
    pg8::f16_t* Hw = args.dry ? (pg8::f16_t*)(ws + WS_END) : H;

    if (IN(0)) { REFRESH(); p0_prologue(F, args); SEAM(0); }
    if (IN(1)) { REFRESH();
        { pg8::Gemm g{(const bf16*)(ws + WS_XN), (const bf16*)(ws + WS_W_IN), MR, 8192, DM}; pg8::StaticOrder S; S.init(MR, 8192, F.G, (int)blockIdx.x);
          pg8::EpiBf16 E{(bf16*)(ws + WS_BIG), NPROJ};
          pg8::gemm_phase<pg8::EpiBf16, pg8::StaticOrder, true, true>(F.lds, g, S, E, F.wave); }
        { pg8::Gemm g{(const bf16*)(ws + WS_HH), (const bf16*)(ws + WS_W_INO8), MR, DM, DM / 2, 0x77777777, 0x7B7B7B7B}; pg8::StaticOrder S; S.init(MR, DM, F.G, (int)blockIdx.x);
          pg8::EpiBf16 E{(bf16*)(ws + WS_BIG) + 8192, NPROJ};
          pg8::gemm_phase<pg8::EpiBf16, pg8::StaticOrder, true, true, true>(F.lds, g, S, E, F.wave); }
        meta_in_phase(F, args); SEAM(1); }
    if (IN(2)) { REFRESH(); for (int u = F.vcu; u < 256; u += F.G) mlstm_unit(F, args, u); SEAM(2); }
    if (IN(3)) { REFRESH(); gate_norm_phase(F, args); SEAM(3); }
    if (IN(4)) { REFRESH();
        pg8::Gemm g{(const bf16*)(ws + WS_XN), (const bf16*)(ws + WS_W_OUT), MR, DM, DM}; pg8::StaticOrder S; S.init(MR, DM, F.G, (int)blockIdx.x);
        pg8::EpiRes<float, pg8::f16_t> E{(const float*)args.in[0], H, DM};
        pg8::gemm_phase<pg8::EpiRes<float, pg8::f16_t>, pg8::StaticOrder, true, true>(F.lds, g, S, E, F.wave);
        meta_out_phase(F, args); SEAM(4); }
    if (IN(5)) { REFRESH(); norm_phase_h(F, H, (const float*)(ws + WS_HMETA), (bf16*)(ws + WS_XN), nullptr, MT, 0); SEAM(5); }
    if (IN(6)) { REFRESH();
        pg8::Gemm g{(const bf16*)(ws + WS_XN), (const bf16*)(ws + WS_W_GU0), MR, NGU, DM}; pg8::StaticOrder S; S.init(MR, NGU, F.G, (int)blockIdx.x);
        pg8::EpiSwiglu E{(bf16*)(ws + WS_BIG), DFF};
        pg8::gemm_phase<pg8::EpiSwiglu, pg8::StaticOrder, true, true>(F.lds, g, S, E, F.wave);
        p0_deferred(F, args, (MR / 256) * (NGU / 256), P0_NITEMS - P0_DEFER_A - P0_DEFER_B, P0_DEFER_A); __syncthreads();
        meta_gu_phase(F, args); SEAM(6); }
    if (IN(7)) { REFRESH();
        pg8::Gemm g{(const bf16*)(ws + WS_BIG), (const bf16*)(ws + WS_W_DN0), MR, DM, DFF}; pg8::StaticOrder S; S.init(MR, DM, F.G, (int)blockIdx.x);
        pg8::EpiRes<pg8::f16_t, pg8::f16_t> E{H, Hw, DM};
        pg8::gemm_phase<pg8::EpiRes<pg8::f16_t, pg8::f16_t>, pg8::StaticOrder, true, true>(F.lds, g, S, E, F.wave);
        meta_down_phase(F, args); SEAM(7); }
    if (IN(8)) { REFRESH(); norm_phase_h(F, H, (const float*)(ws + WS_HMETA), (bf16*)(ws + WS_XN), ws + WS_XN, MT, 2); SEAM(8); }
    if (IN(9)) { REFRESH();
        pg8::Gemm g{(const bf16*)(ws + WS_XN), (const bf16*)(ws + WS_W_KVQ8), MR, NKVQ, DM / 2, 0x77777777, 0x7B7B7B7B}; pg8::StaticOrder S; S.init(MR, NKVQ, F.G, (int)blockIdx.x);
        pg8::EpiF16 E{(pg8::f16_t*)(ws + WS_LAT), NKVQ};
        pg8::gemm_phase<pg8::EpiF16, pg8::StaticOrder, true, true, true>(F.lds, g, S, E, F.wave);
        meta_kvq_phase(F, args); SEAM(9); }
    if (IN(10)) { REFRESH(); latent_norm_phase(F, args); SEAM(10); }
    if (IN(11)) { REFRESH();
        { pg8::Gemm g{(const bf16*)(ws + WS_CKVN), (const bf16*)(ws + WS_W_KVUP8), MR, AH * 256, KVLORA / 2, 0x77777777, 0x7B7B7B7B}; pg8::StaticOrder S; S.init(MR, AH * 256, F.G, (int)blockIdx.x);
          pg8::EpiKvUpK E{ws + WS_K, (bf16*)(ws + WS_V), (const float*)(ws + WS_PRE), (const float*)(ws + WS_SSR), (const float*)args.in[16], (LAS float*)(F.lds + EPI_RED_OFF)};
          pg8::gemm_phase<pg8::EpiKvUpK, pg8::StaticOrder, true, true, true>(F.lds, g, S, E, F.wave); }
        { pg8::Gemm g{(const bf16*)(ws + WS_CQN), (const bf16*)(ws + WS_W_UQ8), MR, AH * QKD, QLORA / 2, 0x77777777, 0x7B7B7B7B}; pg8::StaticOrder S; S.init(MR, AH * QKD, F.G, (int)blockIdx.x);
          pg8::EpiF8 E{ws + WS_BIG, AH * QKD};
          pg8::gemm_phase<pg8::EpiF8, pg8::StaticOrder, true, true, true>(F.lds, g, S, E, F.wave); }
        meta_kvup_phase(F, args); SEAM(11); }
    if (IN(12)) { REFRESH(); k_final_phase(F, args); SEAM(12); }
    if (IN(13)) { REFRESH(); attn_phase(F, args); SEAM(13); }
    if (IN(14)) { REFRESH();
        pg8::Gemm g{(const bf16*)(ws + WS_KNOPE), (const bf16*)(ws + WS_W_O), MR, DM, AH * VHD / 2, 0x77777777, 0x7B7B7B7B}; pg8::StaticOrder S; S.init(MR, DM, F.G, (int)blockIdx.x);
        pg8::EpiRes<pg8::f16_t, pg8::f16_t> E{H, Hw, DM};
        pg8::gemm_phase<pg8::EpiRes<pg8::f16_t, pg8::f16_t>, pg8::StaticOrder, true, true, true>(F.lds, g, S, E, F.wave); SEAM(14); }
    if (IN(15)) { REFRESH(); norm_phase_h(F, H, (const float*)(ws + WS_HMETA), (bf16*)(ws + WS_XN), nullptr, MR, 0); SEAM(15); }
    if (IN(16)) { REFRESH();
        pg8::Gemm g{(const bf16*)(ws + WS_XN), (const bf16*)(ws + WS_W_GU1), MR, NGU, DM}; pg8::StaticOrder S; S.init(MR, NGU, F.G, (int)blockIdx.x);
        pg8::EpiSwiglu E{(bf16*)(ws + WS_BIG), DFF};
        pg8::gemm_phase<pg8::EpiSwiglu, pg8::StaticOrder, true, true>(F.lds, g, S, E, F.wave);
        p0_deferred(F, args, (MR / 256) * (NGU / 256), P0_NITEMS - P0_DEFER_B, P0_DEFER_B); SEAM(16); }
    if (IN(17)) { REFRESH();
        pg8::Gemm g{(const bf16*)(ws + WS_BIG), (const bf16*)(ws + WS_W_DN1), MR, DM, DFF}; pg8::StaticOrder S; S.init(MR, DM, F.G, (int)blockIdx.x);
        pg8::EpiRes<pg8::f16_t, float> E{H, args.dry ? (float*)(ws + WS_END) : args.out, DM};
        pg8::gemm_phase<pg8::EpiRes<pg8::f16_t, float>, pg8::StaticOrder, true, true>(F.lds, g, S, E, F.wave); }
#undef REFRESH
#undef IN
#undef SEAM
}

__global__ void mk_dump(const unsigned char* src, int is_bf16, size_t n_src, float* out, size_t n_out) {
    for (size_t i = (size_t)blockIdx.x * blockDim.x + threadIdx.x; i < n_out; i += (size_t)gridDim.x * blockDim.x) { const size_t j = i % n_src;
        out[i] = is_bf16 ? bf2f(((const unsigned short*)src)[j]) : ((const float*)src)[j]; }
}
extern "C" void kernel_launch(void* const* d_in, const int* in_sizes, int n_in, void* d_out, int out_size, void* d_ws, size_t ws_size, hipStream_t stream) {
    static int grid = 0;
    if (grid == 0) {
        if (n_in != 23 || out_size != MR * DM || ws_size < WS_END) { fprintf(stderr, "kernel_launch: unexpected shapes (n_in %d, out %d, ws %zu < %zu)\n", n_in, out_size, ws_size, (size_t)WS_END); grid = -1; return; }
        int dev = 0, cus = 0, per_cu = 0;
        if (hipGetDevice(&dev) != hipSuccess || hipDeviceGetAttribute(&cus, hipDeviceAttributeMultiprocessorCount, dev) != hipSuccess) { grid = -1; return; }
        if (hipFuncSetAttribute((const void*)mk_fwd, hipFuncAttributeMaxDynamicSharedMemorySize, LDS_BYTES) != hipSuccess) { fprintf(stderr, "kernel_launch: hipFuncSetAttribute failed\n"); grid = -1; return; }
        if (hipOccupancyMaxActiveBlocksPerMultiprocessor(&per_cu, (const void*)mk_fwd, NTHR, LDS_BYTES) != hipSuccess || per_cu < 1) fprintf(stderr, "kernel_launch: occupancy query reports %d\n", per_cu);
        (void)hipGetLastError();
        grid = cus;
    }
    if (grid < 0) return;
    (void)hipMemsetAsync((char*)d_ws + WS_CTL, 0, CTL_ZERO_BYTES, stream);
    Args a{};
    for (int i = 0; i < 23; ++i) a.in[i] = d_in[i];
    a.out = (float*)d_out; a.ws = (unsigned char*)d_ws;
#if defined(MK_STOP_AFTER)
    for (int p = 0; p <= MK_STOP_AFTER; ++p) { a.ph_lo = p; a.ph_hi = p + 1; hipLaunchKernelGGL(mk_fwd, dim3(grid), dim3(NTHR), LDS_BYTES, stream, a); }
#if defined(MK_DUMP_OFF)
    hipLaunchKernelGGL(mk_dump, dim3(2048), dim3(256), 0, stream, (const unsigned char*)d_ws + (size_t)(MK_DUMP_OFF) * MiB, (int)(MK_DUMP_BF16), (size_t)(MK_DUMP_N), (float*)d_out, (size_t)out_size);
#endif
#elif MK_N_LAUNCHES == 1
    a.ph_lo = 0; a.ph_hi = NPH;
    hipLaunchKernelGGL(mk_fwd, dim3(grid), dim3(NTHR), LDS_BYTES, stream, a);
#else
    for (int p = 0; p < NPH; ++p) { a.ph_lo = p; a.ph_hi = p + 1;
#if defined(MK_REPEAT_PHASE)
        if (((MK_REPEAT_PHASE) >> p) & 1) { a.dry = 1; for (int rr = 0; rr < (MK_REPEAT_N); ++rr) hipLaunchKernelGGL(mk_fwd, dim3(grid), dim3(NTHR), LDS_BYTES, stream, a); a.dry = 0; }
#endif
        hipLaunchKernelGGL(mk_fwd, dim3(grid), dim3(NTHR), LDS_BYTES, stream, a);
#if defined(MK_REPEAT_PHASE)
#endif
    }
#endif
}
```

```cpp
#include <hip/hip_runtime.h>
#include <cstdio>
#include <cstdint>
#ifndef MK_N_LAUNCHES
#define MK_N_LAUNCHES 0
#endif
#undef MK_N_LAUNCHES
#define MK_N_LAUNCHES 1
namespace pg8 {
#define PG8_LAS __attribute__((address_space(3)))
typedef unsigned short bf16_t;
typedef short bf16x8 __attribute__((ext_vector_type(8)));
typedef float f32x4 __attribute__((ext_vector_type(4)));
typedef unsigned u32x4 __attribute__((ext_vector_type(4)));
constexpr int BM = 256, BK = 64, HALF = 128, HTB = HALF * BK * 2  , STAGE_BYTES = 8 * HTB, NXCD = 8, WGM = 8;

__host__ __device__ __forceinline__ int lds_byte(int r, int c) { const int st = (r >> 4) * 2 + (c >> 5), rr = r & 15, cc = c & 31, ob = rr * 64 + cc * 2; return st * 1024 + (ob ^ (((ob >> 9) & 1) << 5)); }
__host__ __device__ __forceinline__ void stage_rc(int b, int& R, int& C) { const int st = b / 1024, sb = b % 1024, swz = sb ^ (((sb >> 9) & 1) << 5); R = (st >> 1) * 16 + swz / 64; C = (st & 1) * 32 + (swz % 64) / 2; }
__host__ __device__ __forceinline__ int perm32(int rho) { const int n = rho >> 4, i = rho & 15; return 8 * (i >> 2) + 4 * n + (i & 3); }

struct Unit { int pm, pn; };
struct Gemm { const bf16_t* A; const bf16_t* Bt; int M, N, K; int sB = 0x7F7F7F7F, sA = 0x7F7F7F7F; };
typedef int i32x8 __attribute__((ext_vector_type(8))); typedef int i32x4 __attribute__((ext_vector_type(4)));
__device__ __forceinline__ i32x8 cat8(bf16x8 a, bf16x8 b) { const i32x4 x = __builtin_bit_cast(i32x4, a), y = __builtin_bit_cast(i32x4, b); return __builtin_shufflevector(x, y, 0, 1, 2, 3, 4, 5, 6, 7); }

struct StaticOrder {
    int nM, nN, nwg, G, c;
    __host__ __device__ void init(int M, int N, int G_, int c_) { nM = M / BM; nN = N / BM; nwg = nM * nN; G = G_; c = c_; }
    __host__ __device__ bool next(int i, Unit& u) const {
        const long L = (long)i * G + c; if (L >= nwg) return false;
        int wgid = (int)L; { const int q = nwg / NXCD, r = nwg % NXCD, xcd = wgid % NXCD, off = wgid / NXCD; wgid = (xcd < r ? xcd * (q + 1) : r * (q + 1) + (xcd - r) * q) + off; }
        const int nig = WGM * nN, gid = wgid / nig, fm = gid * WGM, gsz = (nM - fm) < WGM ? (nM - fm) : WGM;
        u.pm = fm + ((wgid % nig) % gsz); u.pn = (wgid % nig) / gsz; return true;
    }
    __device__ __forceinline__ void a_ready(const Unit&) const {}
    __device__ __forceinline__ void done(const Unit&) const {}
};

typedef float f32x2_cv __attribute__((ext_vector_type(2))); typedef __bf16 bf16x2_cv __attribute__((ext_vector_type(2)));
__device__ __forceinline__ unsigned cvt_pk_bf16(float lo, float hi) { const f32x2_cv v = {lo, hi}; const bf16x2_cv b = __builtin_convertvector(v, bf16x2_cv); return __builtin_bit_cast(unsigned, b); }
__host__ __device__ __forceinline__ int v_img_off8(int k, int d) { return k * 128 + ((((d >> 5) ^ (((k >> 1) & 1) | (((k >> 3) & 1) << 1))) & 3) << 5) + (d & 31); }
__host__ __device__ __forceinline__ int v_st(int k, int c) { const int kk = (k & ~0xC) | ((k & 4) << 1) | ((k & 8) >> 1); return ((kk >> 3) * 4 + (c >> 5)) * 512 + ((kk & 7) * 32 + (c & 31)) * 2; }

struct EpiBf16 {
    static constexpr bool PERM = true, AFTER_DRAIN = false, INIT = false;
    bf16_t* O; int ldc;
    __device__ __forceinline__ void operator()(const f32x4 (&acc)[2][2][4][2], const Unit& u, int wr, int wc, int fr, int fq) const {
        const int row0 = u.pm * BM + wr * 64 + fr, col0 = u.pn * BM + wc * 32 + 8 * fq;
#pragma unroll
        for (int ai = 0; ai < 2; ++ai)
#pragma unroll
            for (int m = 0; m < 4; ++m) { bf16_t* rowp = O + (size_t)(row0 + ai * HALF + m * 16) * ldc + col0;
#pragma unroll
                for (int bj = 0; bj < 2; ++bj) { const f32x4 v0 = acc[ai][bj][m][0], v1 = acc[ai][bj][m][1];
                    u32x4 w; w.x = cvt_pk_bf16(v0[0], v0[1]); w.y = cvt_pk_bf16(v0[2], v0[3]); w.z = cvt_pk_bf16(v1[0], v1[1]); w.w = cvt_pk_bf16(v1[2], v1[3]);
                    *(u32x4*)(rowp + bj * HALF) = w; } }
    }
};
struct EpiF32 {
    static constexpr bool PERM = false, AFTER_DRAIN = false, INIT = false;
    float* C; int ldc;
    __device__ __forceinline__ void operator()(const f32x4 (&acc)[2][2][4][2], const Unit& u, int wr, int wc, int fr, int fq) const {
        const int row0 = u.pm * BM + wr * 64 + fr, col0 = u.pn * BM + wc * 32 + 4 * fq;
#pragma unroll
        for (int ai = 0; ai < 2; ++ai)
#pragma unroll
            for (int m = 0; m < 4; ++m) { float* rowp = C + (size_t)(row0 + ai * HALF + m * 16) * ldc + col0;
#pragma unroll
                for (int bj = 0; bj < 2; ++bj)
#pragma unroll
                    for (int n = 0; n < 2; ++n) *(f32x4*)(rowp + bj * HALF + n * 16) = acc[ai][bj][m][n]; }
    }
};
struct EpiResF32 {
    static constexpr bool PERM = false, AFTER_DRAIN = false, INIT = false;
    const float* base; float* out; int ldc;
    __device__ __forceinline__ void init(f32x4 (&acc)[2][2][4][2], const Unit& u, int wr, int wc, int fr, int fq) const {}
    __device__ __forceinline__ void operator()(const f32x4 (&acc)[2][2][4][2], const Unit& u, int wr, int wc, int fr, int fq) const {
        const int row0 = u.pm * BM + wr * 64 + fr, col0 = u.pn * BM + wc * 32 + 4 * fq;
#pragma unroll
        for (int ai = 0; ai < 2; ++ai)
#pragma unroll
            for (int m = 0; m < 4; ++m) { const size_t off = (size_t)(row0 + ai * HALF + m * 16) * ldc + col0;
#pragma unroll
                for (int bj = 0; bj < 2; ++bj)
#pragma unroll
                    for (int n = 0; n < 2; ++n) { const f32x4 b = *(const f32x4*)(base + off + bj * HALF + n * 16); *(f32x4*)(out + off + bj * HALF + n * 16) = b + acc[ai][bj][m][n]; } }
    }
};
typedef _Float16 f16_t; typedef _Float16 f16x2_cv __attribute__((ext_vector_type(2)));
__device__ __forceinline__ unsigned cvt_pk_f16(float lo, float hi) { const f32x2_cv v = {lo, hi}; const f16x2_cv b = __builtin_convertvector(v, f16x2_cv); return __builtin_bit_cast(unsigned, b); }
__device__ __forceinline__ float f16lo(unsigned w) { return (float)__builtin_bit_cast(f16x2_cv, w)[0]; }
__device__ __forceinline__ float f16hi(unsigned w) { return (float)__builtin_bit_cast(f16x2_cv, w)[1]; }
template <class TI, class TO> struct EpiRes {
    static constexpr bool PERM = true, AFTER_DRAIN = false, INIT = false;
    const TI* base; TO* out; int ldc;
    __device__ __forceinline__ void operator()(const f32x4 (&acc)[2][2][4][2], const Unit& u, int wr, int wc, int fr, int fq) const {
        const int row0 = u.pm * BM + wr * 64 + fr, col0 = u.pn * BM + wc * 32 + 8 * fq;
#pragma unroll
        for (int ai = 0; ai < 2; ++ai)
#pragma unroll
            for (int m = 0; m < 4; ++m) { const size_t off = (size_t)(row0 + ai * HALF + m * 16) * ldc + col0;
#pragma unroll
                for (int bj = 0; bj < 2; ++bj) { f32x4 v0 = acc[ai][bj][m][0], v1 = acc[ai][bj][m][1];
                    if constexpr (sizeof(TI) == 4) { v0 += *(const f32x4*)(base + off + bj * HALF); v1 += *(const f32x4*)(base + off + bj * HALF + 4); }
                    else { const u32x4 b = *(const u32x4*)(base + off + bj * HALF);
                        v0[0] += f16lo(b.x); v0[1] += f16hi(b.x); v0[2] += f16lo(b.y); v0[3] += f16hi(b.y); v1[0] += f16lo(b.z); v1[1] += f16hi(b.z); v1[2] += f16lo(b.w); v1[3] += f16hi(b.w); }
                    if constexpr (sizeof(TO) == 4) { *(f32x4*)(out + off + bj * HALF) = v0; *(f32x4*)(out + off + bj * HALF + 4) = v1; }
                    else { u32x4 w; w.x = cvt_pk_f16(v0[0], v0[1]); w.y = cvt_pk_f16(v0[2], v0[3]); w.z = cvt_pk_f16(v1[0], v1[1]); w.w = cvt_pk_f16(v1[2], v1[3]); *(u32x4*)(out + off + bj * HALF) = w; } } }
    }
};
__device__ __forceinline__ float silu_mul(float g, float u) { return g * __builtin_amdgcn_rcpf(1.0f + __expf(-g)) * u; }
struct EpiSwiglu {
    static constexpr bool PERM = true, AFTER_DRAIN = false, INIT = false;
    bf16_t* O; int ldc;
    __device__ __forceinline__ void operator()(const f32x4 (&acc)[2][2][4][2], const Unit& u, int wr, int wc, int fr, int fq) const {
        const int row0 = u.pm * BM + wr * 64 + fr, col0 = u.pn * HALF + wc * 32 + 8 * fq;
#pragma unroll
        for (int ai = 0; ai < 2; ++ai)
#pragma unroll
            for (int m = 0; m < 4; ++m) { bf16_t* rowp = O + (size_t)(row0 + ai * HALF + m * 16) * ldc + col0;
                const f32x4 g0 = acc[ai][0][m][0], g1 = acc[ai][0][m][1], u0 = acc[ai][1][m][0], u1 = acc[ai][1][m][1];
                u32x4 w; w.x = cvt_pk_bf16(silu_mul(g0[0], u0[0]), silu_mul(g0[1], u0[1])); w.y = cvt_pk_bf16(silu_mul(g0[2], u0[2]), silu_mul(g0[3], u0[3]));
                w.z = cvt_pk_bf16(silu_mul(g1[0], u1[0]), silu_mul(g1[1], u1[1])); w.w = cvt_pk_bf16(silu_mul(g1[2], u1[2]), silu_mul(g1[3], u1[3]));
                *(u32x4*)rowp = w; }
    }
};
struct EpiKvUp {
    static constexpr bool PERM = true, AFTER_DRAIN = false, INIT = false;
    bf16_t* KN; bf16_t* V;
    __device__ __forceinline__ void operator()(const f32x4 (&acc)[2][2][4][2], const Unit& u, int wr, int wc, int fr, int fq) const {
        const int row0 = u.pm * BM + wr * 64 + fr, colL = wc * 32 + 8 * fq;
#pragma unroll
        for (int ai = 0; ai < 2; ++ai)
#pragma unroll
            for (int m = 0; m < 4; ++m) { const int row = row0 + ai * HALF + m * 16, b = row >> 12, key = 16 + (row & 4095);
#pragma unroll
                for (int bj = 0; bj < 2; ++bj) { const f32x4 v0 = acc[ai][bj][m][0], v1 = acc[ai][bj][m][1];
                    u32x4 w; w.x = cvt_pk_bf16(v0[0], v0[1]); w.y = cvt_pk_bf16(v0[2], v0[3]); w.z = cvt_pk_bf16(v1[0], v1[1]); w.w = cvt_pk_bf16(v1[2], v1[3]);
                    if (bj == 0) *(u32x4*)(KN + (size_t)row * 8192 + u.pn * HALF + colL) = w;
                    else { typedef unsigned u32x2 __attribute__((ext_vector_type(2))); u32x2 w8;
                        int x = __builtin_amdgcn_cvt_pk_fp8_f32(v0[0] * 16.f, v0[1] * 16.f, 0, false); x = __builtin_amdgcn_cvt_pk_fp8_f32(v0[2] * 16.f, v0[3] * 16.f, x, true); w8.x = (unsigned)x;
                        x = __builtin_amdgcn_cvt_pk_fp8_f32(v1[0] * 16.f, v1[1] * 16.f, 0, false); x = __builtin_amdgcn_cvt_pk_fp8_f32(v1[2] * 16.f, v1[3] * 16.f, x, true); w8.y = (unsigned)x;
                        *(u32x2*)((char*)V + ((size_t)((b * 64 + u.pn) * 65 + (key >> 6))) * 8192 + v_img_off8(key & 63, colL)) = w8; } } }
    }
};
struct EpiF16 {
    static constexpr bool PERM = true, AFTER_DRAIN = false, INIT = false;
    f16_t* O; int ldc;
    __device__ __forceinline__ void operator()(const f32x4 (&acc)[2][2][4][2], const Unit& u, int wr, int wc, int fr, int fq) const {
        const int row0 = u.pm * BM + wr * 64 + fr, col0 = u.pn * BM + wc * 32 + 8 * fq;
#pragma unroll
        for (int ai = 0; ai < 2; ++ai)
#pragma unroll
            for (int m = 0; m < 4; ++m) { f16_t* rowp = O + (size_t)(row0 + ai * HALF + m * 16) * ldc + col0;
#pragma unroll
                for (int bj = 0; bj < 2; ++bj) { const f32x4 v0 = acc[ai][bj][m][0], v1 = acc[ai][bj][m][1];
                    u32x4 w; w.x = cvt_pk_f16(v0[0], v0[1]); w.y = cvt_pk_f16(v0[2], v0[3]); w.z = cvt_pk_f16(v1[0], v1[1]); w.w = cvt_pk_f16(v1[2], v1[3]);
                    *(u32x4*)(rowp + bj * HALF) = w; } }
    }
};
struct EpiF8 {
    static constexpr bool PERM = true, AFTER_DRAIN = false, INIT = false;
    unsigned char* O; int ldc;
    __device__ __forceinline__ void operator()(const f32x4 (&acc)[2][2][4][2], const Unit& u, int wr, int wc, int fr, int fq) const {
        typedef unsigned u32x2 __attribute__((ext_vector_type(2)));
        const int row0 = u.pm * BM + wr * 64 + fr, col0 = u.pn * BM + wc * 32 + 8 * fq;
#pragma unroll
        for (int ai = 0; ai < 2; ++ai)
#pragma unroll
            for (int m = 0; m < 4; ++m) { unsigned char* rowp = O + (size_t)(row0 + ai * HALF + m * 16) * ldc + col0;
#pragma unroll
                for (int bj = 0; bj < 2; ++bj) { const f32x4 v0 = acc[ai][bj][m][0], v1 = acc[ai][bj][m][1]; u32x2 w8;
                    int x = __builtin_amdgcn_cvt_pk_fp8_f32(v0[0] * 16.f, v0[1] * 16.f, 0, false); x = __builtin_amdgcn_cvt_pk_fp8_f32(v0[2] * 16.f, v0[3] * 16.f, x, true); w8.x = (unsigned)x;
                    x = __builtin_amdgcn_cvt_pk_fp8_f32(v1[0] * 16.f, v1[1] * 16.f, 0, false); x = __builtin_amdgcn_cvt_pk_fp8_f32(v1[2] * 16.f, v1[3] * 16.f, x, true); w8.y = (unsigned)x;
                    *(u32x2*)(rowp + bj * HALF) = w8; } }
    }
};
__host__ __device__ __forceinline__ int k_img_off8(int r, int d) { return r * 192 + ((((d >> 4) + (r >> 2)) % 12) << 4) + (d & 15); }
struct EpiKvUpK {
    static constexpr bool PERM = true, AFTER_DRAIN = false, INIT = false;
    unsigned char* Kimg; bf16_t* V; const float* PRE; const float* SSR; const float* gk; PG8_LAS float* red;
    __device__ __forceinline__ void operator()(const f32x4 (&acc)[2][2][4][2], const Unit& u, int wr, int wc, int fr, int fq) const {
        typedef unsigned u32x2 __attribute__((ext_vector_type(2)));
        asm volatile("" : "+v"(fr), "+v"(fq));
        const int rl0 = wr * 64 + fr, colL = wc * 32 + 8 * fq;
#pragma unroll
        for (int j = 0; j < 8; ++j) { const f32x4 v0 = acc[j >> 2][0][j & 3][0], v1 = acc[j >> 2][0][j & 3][1];
            float s = ((v0[0] * v0[0] + v0[1] * v0[1]) + (v0[2] * v0[2] + v0[3] * v0[3])) + ((v1[0] * v1[0] + v1[1] * v1[1]) + (v1[2] * v1[2] + v1[3] * v1[3]));
            s += __shfl_xor(s, 16); s += __shfl_xor(s, 32);
            if (fq == 0) red[(rl0 + (j >> 2) * HALF + (j & 3) * 16) * 4 + wc] = s; }
        asm volatile("s_waitcnt lgkmcnt(0)" ::: "memory"); __builtin_amdgcn_s_barrier(); asm volatile("" ::: "memory");
        int rowv = u.pm * BM + rl0; asm volatile("" : "+v"(rowv));
        const int rlA = rl0 + (fq >> 1) * HALF + (fq & 1) * 32, rowA = rowv + (fq >> 1) * HALF + (fq & 1) * 32;
        float rA, rB;
        { const float sA = SSR[(unsigned)rowA], sB = SSR[(unsigned)rowA + 16u]; const f32x4 tA = *(const PG8_LAS f32x4*)(red + rlA * 4), tB = *(const PG8_LAS f32x4*)(red + (rlA + 16) * 4);
          rA = 16.0f / sqrtf((((tA[0] + tA[1]) + (tA[2] + tA[3])) + sA) * (1.0f / 192.0f) + 1e-6f); rB = 16.0f / sqrtf((((tB[0] + tB[1]) + (tB[2] + tB[3])) + sB) * (1.0f / 192.0f) + 1e-6f); }
        __builtin_amdgcn_sched_barrier(0);
        const f32x4 ga = *(const f32x4*)(gk + colL), gb = *(const f32x4*)(gk + colL + 4);
#pragma unroll
        for (int j = 0; j < 8; ++j) { const int row = rowv + (j >> 2) * HALF + (j & 3) * 16, key = 16 + (row & 4095); const unsigned tile = (unsigned)(((row >> 12) * 64 + u.pn) * 65 + (key >> 6));
            const float rr = __shfl((j & 1) ? rB : rA, fr + 16 * (j >> 1));
            { const f32x4 v0 = acc[j >> 2][0][j & 3][0], v1 = acc[j >> 2][0][j & 3][1]; u32x2 w8;
                int x = __builtin_amdgcn_cvt_pk_fp8_f32(v0[0] * ga[0] * rr, v0[1] * ga[1] * rr, 0, false); x = __builtin_amdgcn_cvt_pk_fp8_f32(v0[2] * ga[2] * rr, v0[3] * ga[3] * rr, x, true); w8.x = (unsigned)x;
                x = __builtin_amdgcn_cvt_pk_fp8_f32(v1[0] * gb[0] * rr, v1[1] * gb[1] * rr, 0, false); x = __builtin_amdgcn_cvt_pk_fp8_f32(v1[2] * gb[2] * rr, v1[3] * gb[3] * rr, x, true); w8.y = (unsigned)x;
                *(u32x2*)(Kimg + (tile * 12288u + (unsigned)k_img_off8(key & 63, colL))) = w8; }
            { const f32x4 v0 = acc[j >> 2][1][j & 3][0], v1 = acc[j >> 2][1][j & 3][1]; u32x2 w8;
                int x = __builtin_amdgcn_cvt_pk_fp8_f32(v0[0] * 16.f, v0[1] * 16.f, 0, false); x = __builtin_amdgcn_cvt_pk_fp8_f32(v0[2] * 16.f, v0[3] * 16.f, x, true); w8.x = (unsigned)x;
                x = __builtin_amdgcn_cvt_pk_fp8_f32(v1[0] * 16.f, v1[1] * 16.f, 0, false); x = __builtin_amdgcn_cvt_pk_fp8_f32(v1[2] * 16.f, v1[3] * 16.f, x, true); w8.y = (unsigned)x;
                *(u32x2*)((unsigned char*)V + (tile * 8192u + (unsigned)v_img_off8(key & 63, colL))) = w8; }
            if (j & 1) __builtin_amdgcn_sched_barrier(0); }
#pragma unroll
        for (int x2 = 0; x2 < 2; ++x2) { const float rr = x2 ? rB : rA;
            const int row = rowA + 16 * x2, key = 16 + (row & 4095); const unsigned tile = (unsigned)(((row >> 12) * 64 + u.pn) * 65 + (key >> 6));
            const float* pp = (const float*)((const char*)PRE + (unsigned)(row * 256 + 64 * wc)); const f32x4 p0 = *(const f32x4*)pp, p1 = *(const f32x4*)(pp + 4), p2 = *(const f32x4*)(pp + 8), p3 = *(const f32x4*)(pp + 12);
            u32x4 w; int x = __builtin_amdgcn_cvt_pk_fp8_f32(p0[0] * rr, p0[1] * rr, 0, false); x = __builtin_amdgcn_cvt_pk_fp8_f32(p0[2] * rr, p0[3] * rr, x, true); w.x = (unsigned)x;
            x = __builtin_amdgcn_cvt_pk_fp8_f32(p1[0] * rr, p1[1] * rr, 0, false); x = __builtin_amdgcn_cvt_pk_fp8_f32(p1[2] * rr, p1[3] * rr, x, true); w.y = (unsigned)x;
            x = __builtin_amdgcn_cvt_pk_fp8_f32(p2[0] * rr, p2[1] * rr, 0, false); x = __builtin_amdgcn_cvt_pk_fp8_f32(p2[2] * rr, p2[3] * rr, x, true); w.z = (unsigned)x;
            x = __builtin_amdgcn_cvt_pk_fp8_f32(p3[0] * rr, p3[1] * rr, 0, false); x = __builtin_amdgcn_cvt_pk_fp8_f32(p3[2] * rr, p3[3] * rr, x, true); w.w = (unsigned)x;
            *(u32x4*)(Kimg + (tile * 12288u + (unsigned)k_img_off8(key & 63, 128 + 16 * wc))) = w;
            __builtin_amdgcn_sched_barrier(0); }
    }
};

template <class Epi, class Sched, bool ALIGN_EPI = false, bool SP2 = false, bool F8 = false>
__device__ __forceinline__ void gemm_phase(PG8_LAS unsigned char* lds, const Gemm g, const Sched& S, const Epi& E, int wave_id) {
    const int wid = wave_id, lane = (int)__builtin_amdgcn_mbcnt_hi(~0u, __builtin_amdgcn_mbcnt_lo(~0u, 0u)), tid = wid * 64 + lane, wr = wid >> 2, wc = wid & 3, fr = lane & 15, fq = lane >> 4;
    const int K = g.K, nt = K / BK;
    unsigned voffA[2], voffB[2];
#pragma unroll
    for (int i = 0; i < 2; ++i) { int R, C; stage_rc(tid * 16 + i * 8192, R, C); const int Rb = Epi::PERM ? ((R & ~31) + perm32(R & 31)) : R;
        voffA[i] = (unsigned)(R * K + C) * 2u; voffB[i] = (unsigned)(Rb * K + C) * 2u; }
    const size_t kstep = (size_t)(BK * 2);
    const size_t hstep = (size_t)HALF * K * 2;
    const size_t tstep = 2 * hstep;
    const unsigned ldsw = (unsigned)wid * 1024u;
    const int aoff = lds_byte(wr * 64 + fr, fq * 8), boff = lds_byte(wc * 32 + fr, fq * 8);
#define PG8_SA(b, h) (((b) * 2 + (h)) * HTB)
#define PG8_SB(b, h) ((4 + (b) * 2 + (h)) * HTB)
#define PG8_STAGE(bufoff, gbase, voff) do { _Pragma("unroll") for (int _i = 0; _i < 2; ++_i) \
        __builtin_amdgcn_global_load_lds((const unsigned*)((const char*)(gbase) + (voff)[_i]), (PG8_LAS unsigned*)(lds + (bufoff) + ldsw + _i * 8192), 16, 0, 0); } while (0)
#define PG8_LDA(dst, b, h) do { if constexpr (F8) { _Pragma("unroll") for (int m = 0; m < 4; ++m) dst##8[m] = cat8(*(const PG8_LAS bf16x8*)(lds + PG8_SA(b, h) + aoff + m * 2048), *(const PG8_LAS bf16x8*)(lds + PG8_SA(b, h) + aoff + m * 2048 + 1024)); } \
        else { _Pragma("unroll") for (int m = 0; m < 4; ++m) _Pragma("unroll") for (int k = 0; k < 2; ++k) dst[m][k] = *(const PG8_LAS bf16x8*)(lds + PG8_SA(b, h) + aoff + m * 2048 + k * 1024); } } while (0)
#define PG8_LDB(dst, b, h) do { if constexpr (F8) { _Pragma("unroll") for (int n = 0; n < 2; ++n) dst##8[n] = cat8(*(const PG8_LAS bf16x8*)(lds + PG8_SB(b, h) + boff + n * 2048), *(const PG8_LAS bf16x8*)(lds + PG8_SB(b, h) + boff + n * 2048 + 1024)); } \
        else { _Pragma("unroll") for (int n = 0; n < 2; ++n) _Pragma("unroll") for (int k = 0; k < 2; ++k) dst[n][k] = *(const PG8_LAS bf16x8*)(lds + PG8_SB(b, h) + boff + n * 2048 + k * 1024); } } while (0)
#define PG8_MMA(ai, bj, At, Bt) do { __builtin_amdgcn_s_setprio(1); \
        if constexpr (F8) { _Pragma("unroll") for (int m = 0; m < 4; ++m) _Pragma("unroll") for (int n = 0; n < 2; ++n) \
            asm volatile("v_mfma_scale_f32_16x16x128_f8f6f4 %0, %1, %2, %0, %3, %4 op_sel_hi:[0,0,0]" : "+v"(acc[ai][bj][m][n]) : "v"(Bt##8[n]), "v"(At##8[m]), "v"(f8sB), "v"(f8sA)); } \
        else { _Pragma("unroll") for (int m = 0; m < 4; ++m) _Pragma("unroll") for (int n = 0; n < 2; ++n) _Pragma("unroll") for (int k = 0; k < 2; ++k) \
            acc[ai][bj][m][n] = __builtin_amdgcn_mfma_f32_16x16x32_bf16(Bt[n][k], At[m][k], acc[ai][bj][m][n], 0, 0, 0); } \
        __builtin_amdgcn_s_setprio(0); } while (0)
#define PG8_WAIT_V(n) asm volatile("s_waitcnt vmcnt(" #n ")" ::: "memory")
#define PG8_WAIT_L(n) asm volatile("s_waitcnt lgkmcnt(" #n ")" ::: "memory")
#define PG8_BAR __builtin_amdgcn_s_barrier()
#define PG8_SCHED __builtin_amdgcn_sched_barrier(0)
    Unit cur, nxt; int ui = 0;
    if (!S.next(0, cur)) return;
    f32x4 acc[2][2][4][2];
    if constexpr (Epi::INIT) E.init(acc, cur, wr, wc, fr, fq);
    else {
#pragma unroll
    for (int a = 0; a < 2; ++a)
#pragma unroll
        for (int b = 0; b < 2; ++b)
#pragma unroll
            for (int m = 0; m < 4; ++m)
#pragma unroll
                for (int n = 0; n < 2; ++n) acc[a][b][m][n] = (f32x4){0.f, 0.f, 0.f, 0.f};
    }
    bf16x8 At[F8 ? 1 : 4][2], B0[F8 ? 1 : 2][2], B1[F8 ? 1 : 2][2];
    const int f8sB = g.sB, f8sA = g.sA;
    i32x8 At8[F8 ? 4 : 1], B08[F8 ? 2 : 1], B18[F8 ? 2 : 1];
    const char* cA = (const char*)g.A + (size_t)cur.pm * tstep; const char* cB = (const char*)g.Bt + (size_t)cur.pn * tstep;
    S.a_ready(cur);
    if constexpr (SP2) {
        PG8_STAGE(PG8_SB(0, 0), cB, voffB); PG8_STAGE(PG8_SB(0, 1), cB + hstep, voffB); PG8_STAGE(PG8_SA(0, 0), cA, voffA); PG8_STAGE(PG8_SA(0, 1), cA + hstep, voffA);
        if (wr == 1) PG8_BAR;
        PG8_WAIT_V(2); PG8_BAR;
        PG8_STAGE(PG8_SB(1, 0), cB + kstep, voffB); PG8_STAGE(PG8_SA(1, 0), cA + kstep, voffA); PG8_STAGE(PG8_SB(1, 1), cB + hstep + kstep, voffB);
        PG8_WAIT_V(6); PG8_BAR;
    } else {
        PG8_STAGE(PG8_SB(0, 0), cB, voffB); PG8_STAGE(PG8_SA(0, 0), cA, voffA); PG8_STAGE(PG8_SB(0, 1), cB + hstep, voffB); PG8_STAGE(PG8_SA(0, 1), cA + hstep, voffA);
        if (wr == 1) PG8_BAR;
        PG8_WAIT_V(4); PG8_BAR;
        PG8_STAGE(PG8_SB(1, 0), cB + kstep, voffB); PG8_STAGE(PG8_SA(1, 0), cA + kstep, voffA); PG8_STAGE(PG8_SB(1, 1), cB + hstep + kstep, voffB);
        PG8_WAIT_V(6); PG8_BAR;
    }
    for (;;) {
        const bool has_next = S.next(ui + 1, nxt);
        const char* nA = has_next ? (const char*)g.A + (size_t)nxt.pm * tstep : cA; const char* nB = has_next ? (const char*)g.Bt + (size_t)nxt.pn * tstep : cB;
        for (int t = 0; t < nt; t += 2) {
            const bool last = (t == nt - 2);
            const char* a1 = cA + (size_t)(t + 1) * kstep;
            const char* a2 = last ? nA : cA + (size_t)(t + 2) * kstep; const char* b2 = last ? nB : cB + (size_t)(t + 2) * kstep;
            const char* a3 = a2 + kstep; const char* b3 = b2 + kstep;
            if (last && has_next) S.a_ready(nxt);
            if constexpr (SP2) {
            PG8_LDB(B0, 0, 0); PG8_LDB(B1, 0, 1); PG8_SCHED; PG8_LDA(At, 0, 0); PG8_STAGE(PG8_SA(1, 1), a1 + hstep, voffA);
            PG8_WAIT_V(8); PG8_WAIT_L(0); PG8_BAR; PG8_MMA(0, 0, At, B0); PG8_MMA(0, 1, At, B1); PG8_BAR; PG8_SCHED;
            PG8_LDA(At, 0, 1); PG8_STAGE(PG8_SB(0, 0), b2, voffB); PG8_STAGE(PG8_SB(0, 1), b2 + hstep, voffB); PG8_STAGE(PG8_SA(0, 0), a2, voffA);
            PG8_WAIT_V(8); PG8_WAIT_L(0); PG8_BAR; PG8_MMA(1, 0, At, B0); PG8_MMA(1, 1, At, B1); PG8_BAR; PG8_SCHED;
            PG8_LDB(B0, 1, 0); PG8_LDB(B1, 1, 1); PG8_SCHED; PG8_LDA(At, 1, 0); PG8_STAGE(PG8_SA(0, 1), a2 + hstep, voffA);
            PG8_WAIT_V(8); PG8_WAIT_L(0); PG8_BAR; PG8_MMA(0, 0, At, B0); PG8_MMA(0, 1, At, B1); PG8_BAR; PG8_SCHED;
            PG8_LDA(At, 1, 1); PG8_STAGE(PG8_SB(1, 0), b3, voffB); PG8_STAGE(PG8_SB(1, 1), b3 + hstep, voffB); PG8_STAGE(PG8_SA(1, 0), a3, voffA);
            PG8_WAIT_V(8); PG8_WAIT_L(0); PG8_BAR; PG8_MMA(1, 0, At, B0); PG8_MMA(1, 1, At, B1); PG8_BAR; PG8_SCHED;
            } else {
            PG8_LDB(B0, 0, 0); PG8_SCHED; PG8_LDA(At, 0, 0); PG8_STAGE(PG8_SA(1, 1), a1 + hstep, voffA);
            PG8_WAIT_L(8); PG8_BAR; PG8_WAIT_L(0); PG8_MMA(0, 0, At, B0); PG8_BAR; PG8_SCHED;
            PG8_LDB(B1, 0, 1); PG8_STAGE(PG8_SB(0, 0), b2, voffB);
            PG8_BAR; PG8_WAIT_L(0); PG8_MMA(0, 1, At, B1); PG8_BAR;
            PG8_LDA(At, 0, 1); PG8_STAGE(PG8_SA(0, 0), a2, voffA);
            PG8_BAR; PG8_WAIT_L(0); PG8_MMA(1, 0, At, B0); PG8_BAR; PG8_SCHED;
            PG8_STAGE(PG8_SB(0, 1), b2 + hstep, voffB);
            PG8_WAIT_V(6); PG8_BAR; PG8_MMA(1, 1, At, B1); PG8_BAR;
            PG8_LDB(B0, 1, 0); PG8_SCHED; PG8_LDA(At, 1, 0); PG8_STAGE(PG8_SA(0, 1), a2 + hstep, voffA);
            PG8_WAIT_L(8); PG8_BAR; PG8_WAIT_L(0); PG8_MMA(0, 0, At, B0); PG8_BAR; PG8_SCHED;
            PG8_LDB(B1, 1, 1); PG8_STAGE(PG8_SB(1, 0), b3, voffB);
            PG8_BAR; PG8_WAIT_L(0); PG8_MMA(0, 1, At, B1); PG8_BAR;
            PG8_LDA(At, 1, 1); PG8_STAGE(PG8_SA(1, 0), a3, voffA);
            PG8_BAR; PG8_WAIT_L(0); PG8_MMA(1, 0, At, B0); PG8_BAR; PG8_SCHED;
            PG8_STAGE(PG8_SB(1, 1), b3 + hstep, voffB);
            PG8_WAIT_V(6); PG8_BAR; PG8_MMA(1, 1, At, B1); PG8_BAR;
            }
        }
        if constexpr (F8) asm volatile("s_nop 15\n\ts_nop 15" ::: "memory");
        if constexpr (ALIGN_EPI) { if (wr == 0) PG8_BAR; }
        if constexpr (!Epi::AFTER_DRAIN) { E(acc, cur, wr, wc, fr, fq); S.done(cur); }
        if (!has_next) break;
        if constexpr (Epi::INIT) E.init(acc, nxt, wr, wc, fr, fq);
        else {
#pragma unroll
        for (int a = 0; a < 2; ++a)
#pragma unroll
            for (int b = 0; b < 2; ++b)
#pragma unroll
                for (int m = 0; m < 4; ++m)
#pragma unroll
                    for (int n = 0; n < 2; ++n) acc[a][b][m][n] = (f32x4){0.f, 0.f, 0.f, 0.f};
        }
        cur = nxt; cA = nA; cB = nB; ++ui;
        if constexpr (ALIGN_EPI) { if (wr == 1) PG8_BAR; }
    }
    PG8_WAIT_V(0);
    if constexpr (!ALIGN_EPI) { if (wr == 0) PG8_BAR; }
    PG8_BAR;
    if constexpr (Epi::AFTER_DRAIN) { E.fused(acc, cur, wr, wc, fr, fq, lds, wid, lane); S.done(cur); }
#undef PG8_SA
#undef PG8_SB
#undef PG8_STAGE
#undef PG8_LDA
#undef PG8_LDB
#undef PG8_MMA
#undef PG8_WAIT_V
#undef PG8_WAIT_L
#undef PG8_BAR
#undef PG8_SCHED
}
}

constexpr int BATCH = 4, SEQ = 4096, DM = 4096, NMETA = 16, MR = BATCH * SEQ  , MT = MR + NMETA  ;
constexpr int MHEADS = 8, MDK = 256, MDV = 512, NPROJ = 12288  , NIN = 12304  ;
constexpr int AH = 64, QLORA = 1024, KVLORA = 512, NOPE = 128, ROPE = 64, QKD = 192, VHD = 128;
constexpr int DFF = 11008, NGU = 2 * DFF;
constexpr int NKT = 65;
constexpr int NKVQ = 1792;
constexpr float EPS = 1e-6f;
constexpr float W_O_SCALE = 256.0f, ATT_O_SCALE = 16.0f, F8_W_SCALE = 256.0f, F8_A_SCALE = 16.0f;
constexpr int NWAVES = 8, NTHR = 512;

constexpr size_t MiB = 1u << 20;
constexpr size_t WS_CTL = 0, CTL_ZERO_BYTES = 1 * MiB;
constexpr size_t WS_HMETA = 1 * MiB;
constexpr size_t WS_GATES = 2 * MiB;
constexpr size_t WS_ROPE = 3 * MiB + 512 * 1024;
constexpr size_t WS_W_IN = 8 * MiB, WS_W_OUT = 105 * MiB, WS_W_GU0 = 137 * MiB, WS_W_GU1 = 309 * MiB, WS_W_DN0 = 481 * MiB, WS_W_DN1 = 567 * MiB;
constexpr size_t WS_W_KVQ = 653 * MiB, WS_W_KVUP = 667 * MiB, WS_W_UQ = 683 * MiB, WS_W_O = 707 * MiB;
constexpr size_t WS_W_O8 = WS_W_O, WS_W_KVQ8 = WS_W_O + 32 * MiB, WS_W_INO8 = WS_W_O + 39 * MiB, WS_W_UQ8 = WS_W_UQ, WS_W_KVUP8 = WS_W_O + 55 * MiB;
constexpr size_t WS_XN = 771 * MiB;
constexpr size_t WS_BIG = 900 * MiB;
constexpr size_t WS_HH = 1285 * MiB;
constexpr size_t WS_LAT = WS_HH, WS_CKVN = WS_HH + 113 * MiB;
constexpr size_t WS_CQN = 1415 * MiB;
constexpr size_t WS_KNOPE = 1447 * MiB;
constexpr size_t WS_V = 1704 * MiB;
constexpr size_t WS_K = 1964 * MiB;
constexpr size_t WS_H16 = 2354 * MiB;
constexpr size_t WS_PRE = 2482 * MiB;
constexpr size_t WS_SSR = 2486 * MiB;
constexpr size_t WS_END = 2488 * MiB;
static_assert(WS_W_IN + (size_t)NIN * DM * 2 <= WS_W_OUT && WS_W_GU0 + (size_t)NGU * DM * 2 <= WS_W_GU1 && WS_W_DN0 + (size_t)DM * DFF * 2 <= WS_W_DN1 && WS_W_KVQ + (size_t)NKVQ * DM * 2 <= WS_W_KVUP, "ws map");
static_assert(WS_XN + (size_t)MT * DM * 2 <= WS_BIG && WS_BIG + (size_t)MT * NPROJ * 2 <= WS_HH && WS_LAT + (size_t)MT * NKVQ * 4 <= WS_CKVN && WS_CKVN + (size_t)MT * KVLORA * 2 <= WS_CQN, "ws map");
static_assert(WS_KNOPE + (size_t)MT * 8192 * 2 <= WS_V && WS_V + (size_t)256 * NKT * 8192 <= WS_K && WS_K + (size_t)256 * NKT * 12288 <= WS_END && WS_ROPE + (size_t)MT * 64 * 4 <= WS_W_IN && WS_GATES + (size_t)16 * MT * 4 <= WS_ROPE, "ws map");

constexpr int RING_BYTES = 131072;
constexpr int LDSCTL_OFF = 143360, MISC_OFF = LDSCTL_OFF + 320;
constexpr int EPI_RED_OFF = 147456;
constexpr int LDS_BYTES = 151552;

#define GAS __attribute__((address_space(1)))
#define LAS __attribute__((address_space(3)))
typedef unsigned short bf16;
typedef unsigned v4u __attribute__((ext_vector_type(4)));
typedef unsigned v2u __attribute__((ext_vector_type(2)));
typedef float f32x4 __attribute__((ext_vector_type(4)));
typedef float f32x16 __attribute__((ext_vector_type(16)));
typedef short bf16x8 __attribute__((ext_vector_type(8)));
typedef short s16x4 __attribute__((ext_vector_type(4)));
typedef GAS unsigned gu32;
#define RLX_AGENT __ATOMIC_RELAXED, __HIP_MEMORY_SCOPE_AGENT
#define LDS_WAIT() asm volatile("s_waitcnt lgkmcnt(0)" ::: "memory")
#define VM_WAIT() asm volatile("s_waitcnt vmcnt(0)" ::: "memory")
#define SBAR() __builtin_amdgcn_sched_barrier(0)
__device__ __forceinline__ unsigned pk2(float lo, float hi) { return pg8::cvt_pk_bf16(lo, hi); }
__device__ __forceinline__ unsigned pk2a(float lo, float hi) { unsigned r; asm volatile("v_cvt_pk_bf16_f32 %0, %1, %2" : "=v"(r) : "v"(lo), "v"(hi)); return r; }
__device__ __forceinline__ float bf2f(unsigned short b) { return __uint_as_float((unsigned)b << 16); }
__device__ __forceinline__ float bflo(unsigned w) { return __uint_as_float(w << 16); }
__device__ __forceinline__ float bfhi(unsigned w) { return __uint_as_float(w & 0xffff0000u); }
#define XB_TMO      128
#define XB_XCNT(j)  (256  + 64 * (j))
#define XB_XSUB(j)  (1280 + 64 * (j))
#define XB_XGEN(j)  (2304 + 64 * (j))
#define XB_TOP      3328
#define XB_TOPGEN   3392
#define XCD_BAR_WORDS 3456
#define XB_SPIN_CAP (1u << 18)

__device__ __forceinline__ unsigned xb_ld(unsigned* p)              { return __hip_atomic_load(p, __ATOMIC_RELAXED, __HIP_MEMORY_SCOPE_AGENT); }
__device__ __forceinline__ unsigned xb_add(unsigned* p, unsigned v) { return __hip_atomic_fetch_add(p, v, __ATOMIC_RELAXED, __HIP_MEMORY_SCOPE_AGENT); }
__device__ __forceinline__ unsigned xb_xcc_id() { return (unsigned)__builtin_amdgcn_s_getreg((3 << 11) | 20) & 0xFu; }
#define XB_SPIN(cond, bar) do { unsigned _sp = 0; while (cond) { __builtin_amdgcn_s_sleep(1); \
    if ((++_sp & 255u) == 0u) { if (xb_ld(&(bar)[XB_TMO])) break; if (_sp > XB_SPIN_CAP) { atomicAdd(&(bar)[XB_TMO], 1u); break; } } } } while (0)

struct XcdBarrier {
    unsigned* bar; unsigned x;
    int wave;
    volatile LAS unsigned* st;
};

__device__ __forceinline__ XcdBarrier xcd_barrier_post(unsigned* bar, volatile LAS unsigned* st) {
    XcdBarrier b; b.bar = bar; b.x = xb_xcc_id(); b.st = st;
    if (threadIdx.x == 0) (void)xb_add(&bar[XB_XCNT(b.x)], 1u);
    return b;
}
__device__ __forceinline__ void xcd_barrier_complete(unsigned* bar, unsigned x, unsigned& nloc, unsigned& nx) {
    const unsigned G = gridDim.x * gridDim.y * gridDim.z;
    unsigned sum, cnt, mine, sp = 0u;
    for (;;) {
        sum = 0u; cnt = 0u; mine = 0u;
#pragma unroll
        for (unsigned j = 0; j < 16; ++j) { const unsigned c = xb_ld(&bar[XB_XCNT(j)]); sum += c; cnt += (c > 0u) ? 1u : 0u; mine = (j == x) ? c : mine; }
        if (sum == G) break;
        __builtin_amdgcn_s_sleep(1);
        if ((++sp & 255u) == 0u) { if (xb_ld(&bar[XB_TMO])) break; if (sp > XB_SPIN_CAP) { atomicAdd(&bar[XB_TMO], 1u); break; } }
    }
    nloc = mine > 0u ? mine : 1u; nx = cnt > 0u ? cnt : 1u;
}

__device__ __forceinline__ void xcd_barrier(const XcdBarrier& b) {
    asm volatile("s_waitcnt vmcnt(0)" ::: "memory");
    __syncthreads();
    if (b.wave == 0 && __builtin_amdgcn_mbcnt_hi(~0u, __builtin_amdgcn_mbcnt_lo(~0u, 0u)) == 0u) {
        unsigned* bar = b.bar;
        __builtin_amdgcn_s_waitcnt(0);
        unsigned nloc = b.st[0], nx = b.st[1];
        if (nloc == 0u) { xcd_barrier_complete(bar, b.x, nloc, nx); b.st[0] = nloc; b.st[1] = nx; }
        const unsigned old = xb_add(&bar[XB_XSUB(b.x)], 1u);
        const unsigned gen = old / nloc;
        if (old + 1u == (gen + 1u) * nloc) {
            __builtin_amdgcn_fence(__ATOMIC_RELEASE, "agent");
            asm volatile("s_waitcnt vmcnt(0)" ::: "memory");
            const unsigned og = xb_add(&bar[XB_TOP], 1u);
            const unsigned tg = og / nx;
            if (og + 1u == (tg + 1u) * nx) xb_add(&bar[XB_TOPGEN], 1u);
            else XB_SPIN(xb_ld(&bar[XB_TOPGEN]) == tg, bar);
            __builtin_amdgcn_fence(__ATOMIC_ACQUIRE, "agent");
            xb_add(&bar[XB_XGEN(b.x)], 1u);
            asm volatile("s_waitcnt vmcnt(0)" ::: "memory");
        } else {
            XB_SPIN(xb_ld(&bar[XB_XGEN(b.x)]) == gen, bar);
            __builtin_amdgcn_fence(__ATOMIC_ACQUIRE, "agent");
            asm volatile("s_waitcnt vmcnt(0)" ::: "memory");
        }
    }
    __syncthreads();
}


struct Args { const void* in[23]; float* out; unsigned char* ws; int ph_lo, ph_hi, dry, pad; };
struct Frame { LAS unsigned char* lds; int tid, lane, wave, vcu, G, gw, ngw; };

__device__ __forceinline__ float wave_sum(float v) {
#pragma unroll
    for (int o = 1; o < 64; o <<= 1) v += __shfl_xor(v, o);
    return v;
}
__device__ __forceinline__ bf16x8 ld8g(const bf16* p) { return *(const bf16x8*)p; }

__device__ __forceinline__ void tr_item(const float* __restrict__ W, int ldw, int scol, int nvalid, const float* __restrict__ gain, bf16* WT, int K, int drow, int k0, LAS float* scr, int lane) {
    const int nn = (lane & 31) < nvalid ? (lane & 31) : (nvalid - 1);
    float v[32]; const float* wp = W + (size_t)(k0 + (lane >> 5)) * ldw + scol + nn;
#pragma unroll
    for (int i = 0; i < 32; ++i) v[i] = wp[(size_t)(2 * i) * ldw];
    if (gain) {
#pragma unroll
        for (int i = 0; i < 32; ++i) v[i] *= gain[k0 + 2 * i + (lane >> 5)]; }
#pragma unroll
    for (int i = 0; i < 32; ++i) scr[(2 * i + (lane >> 5)) * 33 + (lane & 31)] = v[i];
    LDS_WAIT(); asm volatile("" ::: "memory");
    const int c = lane & 7;
#pragma unroll
    for (int j = 0; j < 4; ++j) { const int n = (lane >> 3) + 8 * j; const LAS float* s = scr + (8 * c) * 33 + n;
        v4u o; o.x = pk2(s[0 * 33], s[1 * 33]); o.y = pk2(s[2 * 33], s[3 * 33]); o.z = pk2(s[4 * 33], s[5 * 33]); o.w = pk2(s[6 * 33], s[7 * 33]);
        if (n < nvalid) *(GAS v4u*)(WT + (size_t)(drow + n) * K + k0 + 8 * c) = o; }
    LDS_WAIT(); asm volatile("" ::: "memory");
}
__device__ __forceinline__ void tr_item_f8(const float* __restrict__ W, int ldw, int scol, const float* __restrict__ gain, float scale, unsigned char* WT8, int K, int drow, int k0, LAS float* scr, int lane) {
    float v[32]; const float* wp = W + (size_t)(k0 + (lane >> 5)) * ldw + scol + (lane & 31);
#pragma unroll
    for (int i = 0; i < 32; ++i) v[i] = wp[(size_t)(2 * i) * ldw];
    if (gain) {
#pragma unroll
        for (int i = 0; i < 32; ++i) v[i] *= gain[k0 + 2 * i + (lane >> 5)]; }
#pragma unroll
    for (int i = 0; i < 32; ++i) scr[(2 * i + (lane >> 5)) * 33 + (lane & 31)] = v[i] * scale;
    LDS_WAIT(); asm volatile("" ::: "memory");
    const int c = lane & 7;
#pragma unroll
    for (int j = 0; j < 4; ++j) { const int n = (lane >> 3) + 8 * j; const LAS float* s = scr + (8 * c) * 33 + n;
        v2u o; int w = __builtin_amdgcn_cvt_pk_fp8_f32(s[0 * 33], s[1 * 33], 0, false); w = __builtin_amdgcn_cvt_pk_fp8_f32(s[2 * 33], s[3 * 33], w, true); o.x = (unsigned)w;
        w = __builtin_amdgcn_cvt_pk_fp8_f32(s[4 * 33], s[5 * 33], 0, false); w = __builtin_amdgcn_cvt_pk_fp8_f32(s[6 * 33], s[7 * 33], w, true); o.y = (unsigned)w;
        *(GAS v2u*)(WT8 + (size_t)(drow + n) * K + k0 + 8 * c) = o; }
    LDS_WAIT(); asm volatile("" ::: "memory");
}
__device__ __forceinline__ void norm_row(const float* src, bf16* dst, unsigned char* dst8, int lane) {
    const GAS f32x4* xr = (const GAS f32x4*)src + lane;
    f32x4 v[16]; float s = 0.f;
#pragma unroll
    for (int j = 0; j < 16; ++j) { v[j] = xr[64 * j]; s += (v[j].x * v[j].x + v[j].y * v[j].y) + (v[j].z * v[j].z + v[j].w * v[j].w); }
    const float r = 1.0f / sqrtf(wave_sum(s) * (1.0f / DM) + EPS);
    if (dst) { GAS v2u* o8 = (GAS v2u*)dst + lane;
#pragma unroll
        for (int j = 0; j < 16; ++j) { v2u w; w.x = pk2(v[j].x * r, v[j].y * r); w.y = pk2(v[j].z * r, v[j].w * r); o8[64 * j] = w; } }
    if (dst8) { GAS unsigned* o4 = (GAS unsigned*)dst8 + lane; const float r8 = r * F8_A_SCALE;
#pragma unroll
        for (int j = 0; j < 16; ++j) { int w = __builtin_amdgcn_cvt_pk_fp8_f32(v[j].x * r8, v[j].y * r8, 0, false); w = __builtin_amdgcn_cvt_pk_fp8_f32(v[j].z * r8, v[j].w * r8, w, true); o4[64 * j] = (unsigned)w; } }
}
__device__ __forceinline__ void norm_row_h(const pg8::f16_t* src, bf16* dst, unsigned char* dst8, int lane) {
    const GAS v4u* xr = (const GAS v4u*)src + lane;
    v4u h[8]; float s = 0.f;
#pragma unroll
    for (int j = 0; j < 8; ++j) { h[j] = xr[64 * j];
        const float a0 = pg8::f16lo(h[j].x), a1 = pg8::f16hi(h[j].x), a2 = pg8::f16lo(h[j].y), a3 = pg8::f16hi(h[j].y), a4 = pg8::f16lo(h[j].z), a5 = pg8::f16hi(h[j].z), a6 = pg8::f16lo(h[j].w), a7 = pg8::f16hi(h[j].w);
        s += ((a0 * a0 + a1 * a1) + (a2 * a2 + a3 * a3)) + ((a4 * a4 + a5 * a5) + (a6 * a6 + a7 * a7)); }
    const float r = 1.0f / sqrtf(wave_sum(s) * (1.0f / DM) + EPS);
    if (dst) { GAS v4u* o = (GAS v4u*)dst + lane;
#pragma unroll
        for (int j = 0; j < 8; ++j) { v4u w; w.x = pk2(pg8::f16lo(h[j].x) * r, pg8::f16hi(h[j].x) * r); w.y = pk2(pg8::f16lo(h[j].y) * r, pg8::f16hi(h[j].y) * r);
            w.z = pk2(pg8::f16lo(h[j].z) * r, pg8::f16hi(h[j].z) * r); w.w = pk2(pg8::f16lo(h[j].w) * r, pg8::f16hi(h[j].w) * r); o[64 * j] = w; } }
    if (dst8) { GAS v2u* o = (GAS v2u*)dst8 + lane; const float r8 = r * F8_A_SCALE;
#pragma unroll
        for (int j = 0; j < 8; ++j) { v2u w; int x = __builtin_amdgcn_cvt_pk_fp8_f32(pg8::f16lo(h[j].x) * r8, pg8::f16hi(h[j].x) * r8, 0, false); x = __builtin_amdgcn_cvt_pk_fp8_f32(pg8::f16lo(h[j].y) * r8, pg8::f16hi(h[j].y) * r8, x, true); w.x = (unsigned)x;
            x = __builtin_amdgcn_cvt_pk_fp8_f32(pg8::f16lo(h[j].z) * r8, pg8::f16hi(h[j].z) * r8, 0, false); x = __builtin_amdgcn_cvt_pk_fp8_f32(pg8::f16lo(h[j].w) * r8, pg8::f16hi(h[j].w) * r8, x, true); w.y = (unsigned)x; o[64 * j] = w; } }
}
__device__ __forceinline__ void norm_phase(Frame& F, const float* real, const float* meta, bf16* XN, unsigned char* X8, int nrows, int mode) {
    for (int m = F.gw; m < nrows; m += F.ngw) { const bool isreal = m < MR;
        norm_row(isreal ? real + (size_t)m * DM : meta + (size_t)(m - MR) * DM, (isreal && mode == 2) ? nullptr : XN + (size_t)m * DM, (isreal && mode != 0) ? X8 + (size_t)m * DM : nullptr, F.lane); }
}
__device__ __forceinline__ void norm_phase_h(Frame& F, const pg8::f16_t* real, const float* meta, bf16* XN, unsigned char* X8, int nrows, int mode) {
    for (int m = F.gw; m < nrows; m += F.ngw) {
        if (m < MR) norm_row_h(real + (size_t)m * DM, mode == 2 ? nullptr : XN + (size_t)m * DM, mode != 0 ? X8 + (size_t)m * DM : nullptr, F.lane);
        else norm_row(meta + (size_t)(m - MR) * DM, XN + (size_t)m * DM, nullptr, F.lane); }
}

struct P0Item { const float* wp; const float* gp; unsigned char* dp; int ldw, rowstep, kind, nvalid; float scale; };
constexpr int P0_I_IN = 64 * 385, P0_I_OUT = 64 * 128, P0_I_GU = 64 * 688, P0_I_DN = 172 * 128, P0_I_KVQ = 64 * 56, P0_I_KVU = 8 * 512, P0_I_UQ = 16 * 384, P0_I_O = 128 * 128, P0_I_INO = 64 * 128;
constexpr int P0_NITEMS = P0_I_IN + P0_I_OUT + 2 * P0_I_GU + 2 * P0_I_DN + P0_I_KVQ + P0_I_KVU + P0_I_UQ + P0_I_KVQ + P0_I_KVU + P0_I_INO + P0_I_O;
constexpr int P0_DEFER_A = 16384, P0_DEFER_B = 16384;
static_assert(P0_DEFER_B <= P0_I_DN && P0_DEFER_A + P0_DEFER_B <= P0_I_DN + P0_I_GU, "deferred items must be layer-1 FFN weights, the P16 share down-projection only");
__device__ __forceinline__ P0Item p0_decode(const Args& a, int it, int lane) {
    unsigned char* ws = a.ws;
    const float* w_in = (const float*)a.in[4]; const float* w_out = (const float*)a.in[8]; const float* w_gu = (const float*)a.in[10]; const float* w_dn = (const float*)a.in[11];
    const float* w_kvd = (const float*)a.in[13]; const float* w_kvu = (const float*)a.in[15]; const float* w_dq = (const float*)a.in[18]; const float* w_uq = (const float*)a.in[20]; const float* w_o = (const float*)a.in[22];
    const float* g_a = (const float*)a.in[3]; const float* g_ffn = (const float*)a.in[9]; const float* g_kv = (const float*)a.in[12]; const float* g_kvl = (const float*)a.in[14];
    const float* g_b = (const float*)a.in[17]; const float* g_ql = (const float*)a.in[19];
    const float* W = nullptr; const float* gain = nullptr; unsigned char* dst = nullptr; int ldw = 0, scol = 0, nvalid = 32, kind = 0, K = 0, drow = 0, k0 = 0; float scale = 1.f;
    int r = it;
    if (r < P0_I_IN) { const int kb = r / 385, nb = r % 385; W = w_in; ldw = NIN; scol = 32 * nb; nvalid = nb == 384 ? 16 : 32; gain = g_a; dst = ws + WS_W_IN; K = DM; drow = 32 * nb; k0 = 64 * kb; }
    else if ((r -= P0_I_IN) < P0_I_OUT) { const int kb = r / 128, nb = r % 128; W = w_out; ldw = DM; scol = 32 * nb; dst = ws + WS_W_OUT; K = DM; drow = 32 * nb; k0 = 64 * kb; }
    else if ((r -= P0_I_OUT) < P0_I_GU) { const int kb = r / 688, nb = r % 688, n0 = 32 * nb, j = n0 >> 8, i0 = n0 & 255;
        W = w_gu; ldw = NGU; scol = i0 < 128 ? 128 * j + i0 : DFF + 128 * j + (i0 - 128); gain = g_ffn; dst = ws + WS_W_GU0; K = DM; drow = n0; k0 = 64 * kb; }
    else if ((r -= P0_I_GU) < P0_I_DN) { const int kb = r / 128, nb = r % 128; W = w_dn; ldw = DM; scol = 32 * nb; dst = ws + WS_W_DN0; K = DFF; drow = 32 * nb; k0 = 64 * kb; }
    else if ((r -= P0_I_DN) < P0_I_KVQ) { const int kb = r / 56, nb = r % 56; dst = ws + WS_W_KVQ; K = DM; drow = 32 * nb; k0 = 64 * kb;
        if (nb < 18) { W = w_kvd; ldw = KVLORA + ROPE; scol = 32 * nb; gain = g_kv; } else if (nb >= 24) { W = w_dq; ldw = QLORA; scol = 32 * (nb - 24); gain = g_b; } else kind = 2; }
    else if ((r -= P0_I_KVQ) < P0_I_KVU) { const int kb = r / 512, nb = r % 512; W = w_kvu; ldw = 16384; scol = 32 * nb; gain = g_kvl; dst = ws + WS_W_KVUP; K = KVLORA; drow = 32 * nb; k0 = 64 * kb; }
    else if ((r -= P0_I_KVU) < P0_I_UQ) { const int kb = r / 384, nb = r % 384; W = w_uq; ldw = AH * QKD; scol = 32 * nb; gain = g_ql; kind = 1; scale = F8_W_SCALE; dst = ws + WS_W_UQ8; K = QLORA; drow = 32 * nb; k0 = 64 * kb; }
    else if ((r -= P0_I_UQ) < P0_I_KVQ) { const int kb = r / 56, nb = r % 56; kind = 1; scale = F8_W_SCALE; dst = ws + WS_W_KVQ8; K = DM; drow = 32 * nb; k0 = 64 * kb;
        if (nb < 18) { W = w_kvd; ldw = KVLORA + ROPE; scol = 32 * nb; gain = g_kv; } else if (nb >= 24) { W = w_dq; ldw = QLORA; scol = 32 * (nb - 24); gain = g_b; } else kind = 3; }
    else if ((r -= P0_I_KVQ) < P0_I_KVU) { const int kb = r / 512, nb = r % 512; W = w_kvu; ldw = 16384; scol = 32 * nb; gain = g_kvl; kind = 1; scale = F8_W_SCALE; dst = ws + WS_W_KVUP8; K = KVLORA; drow = 32 * nb; k0 = 64 * kb; }
    else if ((r -= P0_I_KVU) < P0_I_INO) { const int kb = r / 128, nb = r % 128; W = w_in; ldw = NIN; scol = 8192 + 32 * nb; gain = g_a; kind = 1; scale = F8_W_SCALE; dst = ws + WS_W_INO8; K = DM; drow = 32 * nb; k0 = 64 * kb; }
    else if ((r -= P0_I_INO) < P0_I_O) { const int kb = r / 128, nb = r % 128; W = w_o; ldw = DM; scol = 32 * nb; kind = 1; scale = W_O_SCALE; dst = ws + WS_W_O8; K = AH * VHD; drow = 32 * nb; k0 = 64 * kb; }
    else if ((r -= P0_I_O) < P0_I_GU) { const int kb = r / 688, nb = r % 688, n0 = 32 * nb, j = n0 >> 8, i0 = n0 & 255;
        W = w_gu + (size_t)DM * NGU; ldw = NGU; scol = i0 < 128 ? 128 * j + i0 : DFF + 128 * j + (i0 - 128); gain = g_ffn + DM; dst = ws + WS_W_GU1; K = DM; drow = n0; k0 = 64 * kb; }
    else { r -= P0_I_GU; const int kb = r / 128, nb = r % 128; W = w_dn + (size_t)DFF * DM; ldw = DM; scol = 32 * nb; dst = ws + WS_W_DN1; K = DFF; drow = 32 * nb; k0 = 64 * kb; }
    P0Item d; const int nn = (lane & 31) < nvalid ? (lane & 31) : (nvalid - 1); const int esz = (kind & 1) ? 1 : 2;
    d.wp = W + (size_t)(k0 + (lane >> 5)) * ldw + scol + nn; d.gp = gain ? gain + k0 + 8 * (lane & 7) : nullptr;
    d.dp = dst + ((size_t)(drow + (lane >> 3)) * K + k0 + 8 * (lane & 7)) * esz; d.ldw = ldw; d.rowstep = 8 * K * esz; d.kind = kind; d.nvalid = nvalid; d.scale = scale;
    return d;
}
__device__ __forceinline__ void p0_load(const P0Item& d, float (&v)[32], f32x4& g0, f32x4& g1) {
    g0 = (f32x4){1.f, 1.f, 1.f, 1.f}; g1 = g0;
    if (d.kind < 2) {
#pragma unroll
        for (int i = 0; i < 32; ++i) v[i] = d.wp[(size_t)(2 * i) * d.ldw];
        if (d.gp) { g0 = *(const GAS f32x4*)d.gp; g1 = *(const GAS f32x4*)(d.gp + 4); } }
}
__device__ __forceinline__ void p0_process(const P0Item& d, const float (&v)[32], f32x4 g0, f32x4 g1, LAS float* scr, int lane) {
    if (d.kind < 2) {
#pragma unroll
        for (int i = 0; i < 32; ++i) scr[(2 * i + (lane >> 5)) * 33 + (lane & 31)] = v[i];
        LDS_WAIT(); asm volatile("" ::: "memory");
        const int c = lane & 7;
#pragma unroll
        for (int j = 0; j < 4; ++j) { const int n = (lane >> 3) + 8 * j; const LAS float* s = scr + (8 * c) * 33 + n;
            const float f0 = s[0 * 33] * g0.x, f1 = s[1 * 33] * g0.y, f2 = s[2 * 33] * g0.z, f3 = s[3 * 33] * g0.w, f4 = s[4 * 33] * g1.x, f5 = s[5 * 33] * g1.y, f6 = s[6 * 33] * g1.z, f7 = s[7 * 33] * g1.w;
            if (d.kind == 0) { v4u o; o.x = pk2(f0, f1); o.y = pk2(f2, f3); o.z = pk2(f4, f5); o.w = pk2(f6, f7);
                if (n < d.nvalid) *(GAS v4u*)(d.dp + (size_t)j * d.rowstep) = o; }
            else { const float sc = d.scale; v2u o; int w = __builtin_amdgcn_cvt_pk_fp8_f32(f0 * sc, f1 * sc, 0, false); w = __builtin_amdgcn_cvt_pk_fp8_f32(f2 * sc, f3 * sc, w, true); o.x = (unsigned)w;
                w = __builtin_amdgcn_cvt_pk_fp8_f32(f4 * sc, f5 * sc, 0, false); w = __builtin_amdgcn_cvt_pk_fp8_f32(f6 * sc, f7 * sc, w, true); o.y = (unsigned)w;
                *(GAS v2u*)(d.dp + (size_t)j * d.rowstep) = o; } }
        LDS_WAIT(); asm volatile("" ::: "memory");
    } else {
#pragma unroll
        for (int j = 0; j < 4; ++j) { if (d.kind == 2) *(GAS v4u*)(d.dp + (size_t)j * d.rowstep) = (v4u){0u, 0u, 0u, 0u}; else *(GAS v2u*)(d.dp + (size_t)j * d.rowstep) = (v2u){0u, 0u}; } }
}
__device__ __forceinline__ void p0_items(Frame& F, const Args& a, int first, int last, int w, int stride, LAS float* scr) {
    int it = first + w; if (it >= last) return;
    P0Item d = p0_decode(a, it, F.lane); float v[32]; f32x4 g0, g1; p0_load(d, v, g0, g1);
    for (;;) { const int itn = it + stride; const bool more = itn < last;
        P0Item dn = d; float vn[32]; f32x4 gn0 = g0, gn1 = g1;
#pragma unroll
        for (int i = 0; i < 32; ++i) vn[i] = 0.f;
        if (more) { dn = p0_decode(a, itn, F.lane); p0_load(dn, vn, gn0, gn1); }
        asm volatile("" ::: "memory");
        p0_process(d, v, g0, g1, scr, F.lane);
        if (!more) break;
        d = dn; g0 = gn0; g1 = gn1; it = itn;
#pragma unroll
        for (int i = 0; i < 32; ++i) v[i] = vn[i]; }
}
__device__ __forceinline__ void p0_deferred(Frame& F, const Args& a, int nunits, int first, int count) {
    const int c = (int)blockIdx.x, G = F.G, rem = nunits % G;
    if (rem == 0) { p0_items(F, a, first, first + count, F.gw, F.ngw, (LAS float*)(F.lds + F.wave * 16384)); return; }
    if (c >= rem) p0_items(F, a, first, first + count, (c - rem) * NWAVES + F.wave, (G - rem) * NWAVES, (LAS float*)(F.lds + F.wave * 16384));
}

__device__ __forceinline__ void p0_prologue(Frame& F, const Args& a) {
    unsigned char* ws = a.ws;
    LAS float* scr = (LAS float*)(F.lds + F.wave * 16384);
    const float* w_in = (const float*)a.in[4]; const float* w_out = (const float*)a.in[8]; const float* w_gu = (const float*)a.in[10]; const float* w_dn = (const float*)a.in[11];
    const float* w_kvd = (const float*)a.in[13]; const float* w_kvu = (const float*)a.in[15]; const float* w_dq = (const float*)a.in[18]; const float* w_uq = (const float*)a.in[20]; const float* w_o = (const float*)a.in[22];
    const float* g_a = (const float*)a.in[3]; const float* g_ffn = (const float*)a.in[9]; const float* g_kv = (const float*)a.in[12]; const float* g_kvl = (const float*)a.in[14];
    const float* g_b = (const float*)a.in[17]; const float* g_ql = (const float*)a.in[19];
    p0_items(F, a, 0, P0_NITEMS - P0_DEFER_A - P0_DEFER_B, F.gw, F.ngw, scr);
    { const int* positions = (const int*)a.in[1]; float* rope = (float*)(ws + WS_ROPE);
        for (int e = F.vcu * NTHR + F.tid; e < MT * 32; e += F.G * NTHR) { const int row = e >> 5, i = e & 31;
            const int pos = row < MR ? positions[row] + NMETA : row - MR;
            const float inv = 1.0f / powf(10000.0f, (float)(2 * i) * (1.0f / 64.0f));
            const float ang = (float)pos * inv;
            rope[(size_t)row * 64 + i] = cosf(ang); rope[(size_t)row * 64 + 32 + i] = sinf(ang); } }
    { for (int e = F.vcu * NTHR + F.tid; e < 256 * 1280; e += F.G * NTHR) { const int bh = e / 1280, c = e % 1280;
            if (c < 768) *(GAS v4u*)(ws + WS_K + ((size_t)(bh * NKT + 64)) * 12288 + (size_t)c * 16) = (v4u){0u, 0u, 0u, 0u};
            else *(GAS v4u*)(ws + WS_V + ((size_t)(bh * NKT + 64)) * 8192 + (size_t)(c - 768) * 16) = (v4u){0u, 0u, 0u, 0u}; } }
    norm_phase(F, (const float*)a.in[0], (const float*)a.in[2], (bf16*)(ws + WS_XN), ws + WS_HH, MT, 1);
}

template <int NT>
__device__ __forceinline__ void skinny_wg(Frame& F, const bf16* __restrict__ A16, const bf16* __restrict__ Brows0, const bf16* __restrict__ Brows1, int K, f32x4 (&res)[NT]) {
    const int lane = F.lane, kw = K >> 3, k_lo = F.wave * kw;
    const bf16* pb = A16 + (size_t)(lane & 15) * K + 8 * (lane >> 4) + k_lo;
    const bf16* pa0 = Brows0 + (size_t)(lane & 15) * K + 8 * (lane >> 4) + k_lo;
    const bf16* pa1 = Brows1 + (size_t)(lane & 15) * K + 8 * (lane >> 4) + k_lo;
    f32x4 acc[NT];
#pragma unroll
    for (int i = 0; i < NT; ++i) acc[i] = (f32x4){0.f, 0.f, 0.f, 0.f};
#pragma unroll 8
    for (int k0 = 0; k0 < kw; k0 += 32) { const bf16x8 y = ld8g(pb + k0); const bf16x8 x0 = ld8g(pa0 + k0); acc[0] = __builtin_amdgcn_mfma_f32_16x16x32_bf16(x0, y, acc[0], 0, 0, 0);
        if (NT == 2) { const bf16x8 x1 = ld8g(pa1 + k0); acc[NT - 1] = __builtin_amdgcn_mfma_f32_16x16x32_bf16(x1, y, acc[NT - 1], 0, 0, 0); } }
    LAS f32x4* red = (LAS f32x4*)F.lds;
#pragma unroll
    for (int i = 0; i < NT; ++i) red[(i * NWAVES + F.wave) * 64 + lane] = acc[i];
    LDS_WAIT(); __syncthreads();
    if (F.wave == 0) {
#pragma unroll
        for (int i = 0; i < NT; ++i) { f32x4 sacc = red[(i * NWAVES) * 64 + lane];
#pragma unroll
            for (int w = 1; w < NWAVES; ++w) sacc = sacc + red[(i * NWAVES + w) * 64 + lane];
            res[i] = sacc; } }
    LDS_WAIT(); __syncthreads();
}

__device__ __forceinline__ void gate_norm_phase(Frame& F, const Args& a) {
    const bf16* HH = (const bf16*)(a.ws + WS_HH); const bf16* PROJ = (const bf16*)(a.ws + WS_BIG); bf16* A2 = (bf16*)(a.ws + WS_XN); const float* g_out = (const float*)a.in[7];
    for (int m = F.gw; m < MT; m += F.ngw) {
#pragma unroll
        for (int j = 0; j < 8; ++j) { const int e = j * 512 + F.lane * 8;
            const v4u hw = *(const GAS v4u*)(HH + (size_t)m * DM + e), ow = *(const GAS v4u*)(PROJ + (size_t)m * NPROJ + 8192 + e);
            const f32x4 g0 = *(const GAS f32x4*)(g_out + e), g1 = *(const GAS f32x4*)(g_out + e + 4);
            float hv[8] = {bflo(hw.x), bfhi(hw.x), bflo(hw.y), bfhi(hw.y), bflo(hw.z), bfhi(hw.z), bflo(hw.w), bfhi(hw.w)};
            const float ov[8] = {bflo(ow.x), bfhi(ow.x), bflo(ow.y), bfhi(ow.y), bflo(ow.z), bfhi(ow.z), bflo(ow.w), bfhi(ow.w)};
            const float gv[8] = {g0.x, g0.y, g0.z, g0.w, g1.x, g1.y, g1.z, g1.w};
            float s = 0.f;
#pragma unroll
            for (int i = 0; i < 8; ++i) s += hv[i] * hv[i];
            const float r = 1.0f / sqrtf(wave_sum(s) * (1.0f / MDV) + EPS);
#pragma unroll
            for (int i = 0; i < 8; ++i) hv[i] = hv[i] * r * gv[i] * (1.0f / (1.0f + __expf(-ov[i])));
            v4u o; o.x = pk2(hv[0], hv[1]); o.y = pk2(hv[2], hv[3]); o.z = pk2(hv[4], hv[5]); o.w = pk2(hv[6], hv[7]);
            *(GAS v4u*)(A2 + (size_t)m * DM + e) = o; }
    }
}

__device__ __forceinline__ void latent_norm_phase(Frame& F, const Args& a) {
    const float* LAT = (const float*)(a.ws + WS_LAT); const pg8::f16_t* LAT16 = (const pg8::f16_t*)(a.ws + WS_LAT); bf16* CKVN = (bf16*)(a.ws + WS_CKVN); bf16* CQN = (bf16*)(a.ws + WS_CQN);
    for (int m = F.gw; m < MT; m += F.ngw) {
        if (m < MR) { const pg8::f16_t* row = LAT16 + (size_t)m * NKVQ;
            { const v4u xw = *(const GAS v4u*)(row + 8 * F.lane);
                const float x0 = pg8::f16lo(xw.x), x1 = pg8::f16hi(xw.x), x2 = pg8::f16lo(xw.y), x3 = pg8::f16hi(xw.y), x4 = pg8::f16lo(xw.z), x5 = pg8::f16hi(xw.z), x6 = pg8::f16lo(xw.w), x7 = pg8::f16hi(xw.w);
                const float s = ((x0 * x0 + x1 * x1) + (x2 * x2 + x3 * x3)) + ((x4 * x4 + x5 * x5) + (x6 * x6 + x7 * x7));
                const float r8 = F8_A_SCALE / sqrtf(wave_sum(s) * (1.0f / KVLORA) + EPS); v2u o;
                int w = __builtin_amdgcn_cvt_pk_fp8_f32(x0 * r8, x1 * r8, 0, false); w = __builtin_amdgcn_cvt_pk_fp8_f32(x2 * r8, x3 * r8, w, true); o.x = (unsigned)w;
                w = __builtin_amdgcn_cvt_pk_fp8_f32(x4 * r8, x5 * r8, 0, false); w = __builtin_amdgcn_cvt_pk_fp8_f32(x6 * r8, x7 * r8, w, true); o.y = (unsigned)w;
                *(GAS v2u*)((unsigned char*)CKVN + (size_t)m * KVLORA + 8 * F.lane) = o; }
            {
                const pg8::f16_t* lrow = row + KVLORA; const float* rt = (const float*)(a.ws + WS_ROPE) + (size_t)m * 64; const float* g_k = (const float*)a.in[16]; const int i = F.lane & 31;
                const float t1 = (float)lrow[i] * g_k[128 + i], t2 = (float)lrow[32 + i] * g_k[160 + i], cs = rt[i], sn = rt[32 + i]; const float krl = (float)lrow[F.lane]; const float ssr = wave_sum(krl * krl);
                ((float*)(a.ws + WS_PRE))[(size_t)m * 64 + F.lane] = (F.lane & 32) ? (t1 * sn + t2 * cs) : (t1 * cs - t2 * sn);
                if (F.lane == 0) ((float*)(a.ws + WS_SSR))[m] = ssr; }
            { v2u v[4]; float s = 0.f;
#pragma unroll
                for (int j = 0; j < 4; ++j) { v[j] = *(const GAS v2u*)(row + 768 + (j * 64 + F.lane) * 4);
                    const float q0 = pg8::f16lo(v[j].x), q1 = pg8::f16hi(v[j].x), q2 = pg8::f16lo(v[j].y), q3 = pg8::f16hi(v[j].y); s += (q0 * q0 + q1 * q1) + (q2 * q2 + q3 * q3); }
                const float r8 = F8_A_SCALE / sqrtf(wave_sum(s) * (1.0f / QLORA) + EPS);
#pragma unroll
                for (int j = 0; j < 4; ++j) { int w = __builtin_amdgcn_cvt_pk_fp8_f32(pg8::f16lo(v[j].x) * r8, pg8::f16hi(v[j].x) * r8, 0, false); w = __builtin_amdgcn_cvt_pk_fp8_f32(pg8::f16lo(v[j].y) * r8, pg8::f16hi(v[j].y) * r8, w, true);
                    *(GAS unsigned*)((unsigned char*)CQN + (size_t)m * QLORA + (j * 64 + F.lane) * 4) = (unsigned)w; } }
        } else { const float* row = LAT + (size_t)m * NKVQ;
            const f32x4 x0 = *(const GAS f32x4*)(row + 8 * F.lane), x1 = *(const GAS f32x4*)(row + 8 * F.lane + 4);
            const float s = (x0.x * x0.x + x0.y * x0.y) + (x0.z * x0.z + x0.w * x0.w) + (x1.x * x1.x + x1.y * x1.y) + (x1.z * x1.z + x1.w * x1.w);
            const float r = 1.0f / sqrtf(wave_sum(s) * (1.0f / KVLORA) + EPS);
            v4u o; o.x = pk2(x0.x * r, x0.y * r); o.y = pk2(x0.z * r, x0.w * r); o.z = pk2(x1.x * r, x1.y * r); o.w = pk2(x1.z * r, x1.w * r);
            *(GAS v4u*)(CKVN + (size_t)m * KVLORA + 8 * F.lane) = o; }
    }
}

using pg8::k_img_off8;
__device__ __forceinline__ v2u f8x8(const float (&x)[8], float sc) { v2u o; int w = __builtin_amdgcn_cvt_pk_fp8_f32(x[0] * sc, x[1] * sc, 0, false); w = __builtin_amdgcn_cvt_pk_fp8_f32(x[2] * sc, x[3] * sc, w, true); o.x = (unsigned)w;
    w = __builtin_amdgcn_cvt_pk_fp8_f32(x[4] * sc, x[5] * sc, 0, false); w = __builtin_amdgcn_cvt_pk_fp8_f32(x[6] * sc, x[7] * sc, w, true); o.y = (unsigned)w; return o; }
__device__ __forceinline__ void k_final_phase(Frame& F, const Args& a) {
    const float* LAT = (const float*)(a.ws + WS_LAT); const bf16* KN = (const bf16*)(a.ws + WS_KNOPE); const float* ROPEt = (const float*)(a.ws + WS_ROPE); const float* g_k = (const float*)a.in[16];
    unsigned char* Kimg = a.ws + WS_K; const int lane = F.lane, c = lane & 15, hq = lane >> 4;
    float gn[8];
#pragma unroll
    for (int i = 0; i < 8; ++i) gn[i] = g_k[8 * c + i];
    for (int m = MR + F.gw; m < MT; m += F.ngw) {
        const float* lrow = LAT + (size_t)m * NKVQ + KVLORA;
        const float krl = lrow[lane]; const float ss_rope = wave_sum(krl * krl);
        float pre[8];
        { const int i0 = 8 * (c & 3); const float* rt = ROPEt + (size_t)m * 64;
#pragma unroll
            for (int i = 0; i < 8; ++i) { const float t1 = lrow[i0 + i] * g_k[128 + i0 + i], t2 = lrow[32 + i0 + i] * g_k[160 + i0 + i], cs = rt[i0 + i], sn = rt[32 + i0 + i];
                pre[i] = (c & 4) ? (t1 * sn + t2 * cs) : (t1 * cs - t2 * sn); } }
        const int nb = m < MR ? 1 : BATCH; const int key = m < MR ? NMETA + (m & (SEQ - 1)) : m - MR; const int b0 = m < MR ? (m >> 12) : 0;
        const int kt = key >> 6, kr = key & 63;
#pragma unroll 4
        for (int j = 0; j < 16; ++j) { const int h = 4 * j + hq;
            const v4u kw = *(const GAS v4u*)(KN + (size_t)m * 8192 + h * 128 + 8 * c);
            float kv[8] = {bflo(kw.x), bfhi(kw.x), bflo(kw.y), bfhi(kw.y), bflo(kw.z), bfhi(kw.z), bflo(kw.w), bfhi(kw.w)};
            float s = 0.f;
#pragma unroll
            for (int i = 0; i < 8; ++i) s += kv[i] * kv[i];
            s += __shfl_xor(s, 1); s += __shfl_xor(s, 2); s += __shfl_xor(s, 4); s += __shfl_xor(s, 8);
            const float r = 1.0f / sqrtf((s + ss_rope) * (1.0f / QKD) + EPS);
#pragma unroll
            for (int i = 0; i < 8; ++i) kv[i] *= gn[i];
            const v2u o = f8x8(kv, r * F8_A_SCALE), p = f8x8(pre, r * F8_A_SCALE);
            for (int bb = 0; bb < nb; ++bb) { unsigned char* img = Kimg + ((size_t)(((b0 + bb) * AH + h) * NKT + kt)) * 12288;
                *(GAS v2u*)(img + k_img_off8(kr, 8 * c)) = o;
                if (c < 8) *(GAS v2u*)(img + k_img_off8(kr, 128 + 8 * c)) = p; } }
    }
}

constexpr int ML_KP = 528, ML_VP = 144, ML_KR0 = 0, ML_KRSZ = 64 * ML_KP, ML_VR0 = 2 * ML_KRSZ, ML_VRSZ = 64 * ML_VP, ML_CT = ML_VR0 + 2 * ML_VRSZ, ML_WS = ML_CT + 80 * ML_KP, ML_END = ML_WS + NWAVES * 512;
static_assert(ML_END <= LDSCTL_OFF, "mLSTM LDS");
__device__ __forceinline__ s16x4 lds_tr(LAS const unsigned char* p) { typedef short v4i16_t __attribute__((ext_vector_type(4))); return __builtin_bit_cast(s16x4, __builtin_amdgcn_ds_read_tr16_b64_v4i16((LAS v4i16_t*)p)); }
__device__ __forceinline__ bf16x8 cat4(s16x4 lo, s16x4 hi) { return (bf16x8){lo[0], lo[1], lo[2], lo[3], hi[0], hi[1], hi[2], hi[3]}; }
__device__ __forceinline__ float prefix_sum64(float v, int lane) {
#pragma unroll
    for (int d = 1; d < 64; d <<= 1) { const float t = __shfl_up(v, d); if (lane >= d) v += t; }
    return v;
}
__device__ __forceinline__ float prefix_max64(float v, int lane) {
#pragma unroll
    for (int d = 1; d < 64; d <<= 1) { const float t = __shfl_up(v, d); if (lane >= d) v = fmaxf(v, t); }
    return v;
}
__device__ __forceinline__ float log_sigmoid(float x) { return fminf(x, 0.f) - log1pf(expf(-fabsf(x))); }

template <int TBV>
__device__ __forceinline__ void mlstm_unit_tb(Frame& F, const Args& a, int unit) {
    const int bh = unit >> 3, sl = unit & 7, b = bh >> 3, h = bh & 7;
    const int tid = F.tid, lane = F.lane, wave = F.wave, eh = wave & 1, c15 = lane & 15, q4 = lane >> 4; constexpr int tb = TBV;
    LAS unsigned char* lds = F.lds;
    const bf16* PROJ = (const bf16*)(a.ws + WS_BIG); const float* GATES = (const float*)(a.ws + WS_GATES); bf16* HH = (bf16*)(a.ws + WS_HH);
    const float b_i = ((const float*)a.in[5])[h], b_f = ((const float*)a.in[6])[h];
    f32x4 Cacc[2][5];
#pragma unroll
    for (int i = 0; i < 2; ++i)
#pragma unroll
        for (int e = 0; e < 5; ++e) Cacc[i][e] = (f32x4){0.f, 0.f, 0.f, 0.f};
    float m_state = 0.f;
    for (int i = tid; i < (80 * ML_KP) / 16; i += NTHR) *(LAS v4u*)(lds + ML_CT + 16 * i) = (v4u){0u, 0u, 0u, 0u};
#define ML_ROW(c, i) ((c) == 0 ? MR + ((i) & 15) : b * SEQ + 64 * ((c) - 1) + (i))
#define ML_VALID(c, i) ((c) > 0 || (i) < NMETA)
    v4u kst[4], vst; bf16x8 qf[8], qn[8]; float bc_c, u_c, pm_c, bc_n, u_n, pm_n;
    const GAS unsigned char* Pb = (const GAS unsigned char*)PROJ;
    const unsigned kofs = (unsigned)(((tid >> 5) * NPROJ + 2048 + h * MDK + (tid & 31) * 8) * 2);
    const unsigned vofs = (unsigned)(((tid >> 3) * NPROJ + 4096 + h * MDV + sl * 64 + (tid & 7) * 8) * 2);
    const unsigned qofs = (unsigned)(((16 * tb + c15) * NPROJ + h * MDK + 8 * q4) * 2);
    constexpr unsigned ROWB = NPROJ * 2;
    {
#pragma unroll
        for (int j = 0; j < 4; ++j) { const int id = tid + NTHR * j, i = id >> 5, ch = id & 31; const v4u x = *(const GAS v4u*)(Pb + (size_t)(MR + (i & 15)) * ROWB + (2048 + h * MDK + ch * 8) * 2);
            *(LAS v4u*)(lds + ML_KR0 + i * ML_KP + ch * 16) = ML_VALID(0, i) ? x : (v4u){0u, 0u, 0u, 0u}; }
        { const int i = tid >> 3, ch = tid & 7; const v4u x = *(const GAS v4u*)(Pb + (size_t)(MR + (i & 15)) * ROWB + (4096 + h * MDV + sl * 64 + ch * 8) * 2);
            *(LAS v4u*)(lds + ML_VR0 + i * ML_VP + ch * 16) = ML_VALID(0, i) ? x : (v4u){0u, 0u, 0u, 0u}; }
        { const int i = 16 * tb + c15;
#pragma unroll
            for (int ks = 0; ks < 8; ++ks) { const bf16x8 x = *(const GAS bf16x8*)(Pb + (size_t)(MR + (i & 15)) * ROWB + (h * MDK + 32 * ks + 8 * q4) * 2); qf[ks] = ML_VALID(0, i) ? x : (bf16x8){0, 0, 0, 0, 0, 0, 0, 0}; } }
    }
    float* GSC = (float*)(a.ws + WS_KNOPE) + (size_t)unit * (65 * 192);
    for (int c = wave; c <= 64; c += NWAVES) {
        const bool tokv = ML_VALID(c, lane);
        const float gi = GATES[(size_t)h * MT + ML_ROW(c, lane)], gf = GATES[(size_t)(8 + h) * MT + ML_ROW(c, lane)];
        const float logi = tokv ? 15.0f * tanhf((gi + b_i) * (1.0f / 15.0f)) : -__builtin_inff();
        const float logf = tokv ? log_sigmoid(15.0f * tanhf((gf + b_f) * (1.0f / 15.0f))) : 0.f;
        const float bcum = prefix_sum64(logf, lane);
        const float u = logi - bcum;
        const float pm = prefix_max64(u, lane);
        GSC[c * 192 + lane] = bcum; GSC[c * 192 + 64 + lane] = u; GSC[c * 192 + 128 + lane] = pm;
    }
    VM_WAIT(); __syncthreads();
#define ML_GLOAD(c, B, U, P) do { B = __hip_atomic_load(GSC + (c) * 192 + lane, __ATOMIC_RELAXED, __HIP_MEMORY_SCOPE_AGENT); U = __hip_atomic_load(GSC + (c) * 192 + 64 + lane, __ATOMIC_RELAXED, __HIP_MEMORY_SCOPE_AGENT); \
        P = __hip_atomic_load(GSC + (c) * 192 + 128 + lane, __ATOMIC_RELAXED, __HIP_MEMORY_SCOPE_AGENT); } while (0)
    ML_GLOAD(0, bc_c, u_c, pm_c);
    LDS_WAIT(); __syncthreads();
    for (int c = 0; c <= 64; ++c) {
        const int cur = c & 1, nx = cur ^ 1, cn = c < 64 ? c + 1 : 64;
        LAS const unsigned char* KRc = lds + ML_KR0 + cur * ML_KRSZ; LAS const unsigned char* VRc = lds + ML_VR0 + cur * ML_VRSZ;
        const GAS unsigned char* Pn = Pb + (size_t)(b * SEQ + 64 * (cn - 1)) * ROWB;
#pragma unroll
        for (int j = 0; j < 4; ++j) kst[j] = *(const GAS v4u*)(Pn + (kofs + (unsigned)j * (16u * ROWB)));
        vst = *(const GAS v4u*)(Pn + vofs);
        ML_GLOAD(cn, bc_n, u_n, pm_n);
        const float bcum = bc_c, u = u_c;
        const float Mv = fmaxf(m_state, pm_c);
        const float av = __expf(m_state - Mv);
        const float mt = bcum + Mv;
        const float M63 = __shfl(Mv, 63), b63 = __shfl(bcum, 63);
        const float wl = __expf(u - M63) * 0.0625f;
        const float decay = __shfl(av, 63);
        LAS float* uS = (LAS float*)(lds + ML_WS + wave * 512); LAS float* wS = uS + 64;
        uS[lane] = u; wS[lane] = wl; LDS_WAIT();
        f32x4 Sacc[4];
#pragma unroll
        for (int sb = 0; sb < 4; ++sb) Sacc[sb] = (f32x4){0.f, 0.f, 0.f, 0.f};
        f32x4 a1[3], a2[3];
#pragma unroll
        for (int x = 0; x < 3; ++x) { a1[x] = (f32x4){0.f, 0.f, 0.f, 0.f}; a2[x] = (f32x4){0.f, 0.f, 0.f, 0.f}; }
#pragma unroll
        for (int kp = 0; kp < 1; ++kp) {
#pragma unroll
            for (int ks = 8 * kp; ks < 8 * kp + 8; ++ks) {
#pragma unroll
                for (int sb = 0; sb < 4; ++sb) if (sb <= tb) { const bf16x8 kf = *(LAS const bf16x8*)(KRc + (16 * sb + c15) * ML_KP + (32 * ks + 8 * q4) * 2); Sacc[sb] = __builtin_amdgcn_mfma_f32_16x16x32_bf16(kf, qf[ks], Sacc[sb], 0, 0, 0); }
#pragma unroll
                for (int x = 0; x < 3; ++x) { const int eb = x < 2 ? 2 * eh + x : 4; const bf16x8 cf = *(LAS const bf16x8*)(lds + ML_CT + (16 * eb + c15) * ML_KP + (32 * ks + 8 * q4) * 2);
                    a1[x] = __builtin_amdgcn_mfma_f32_16x16x32_bf16(cf, qf[ks], a1[x], 0, 0, 0); } }
            SBAR(); }
        const float Mt = __shfl(Mv, 16 * tb + c15), at = __shfl(av, 16 * tb + c15), mtt = __shfl(mt, 16 * tb + c15);
        bf16x8 pf[2];
        {   float sp[4][4];
#pragma unroll
            for (int sb = 0; sb < 4; ++sb) { const f32x4 u4 = *(LAS const f32x4*)(uS + 16 * sb + 4 * q4);
#pragma unroll
                for (int j = 0; j < 4; ++j) { const int s_abs = 16 * sb + 4 * q4 + j; const float us = u4[j];
                    const float w = (s_abs <= 16 * tb + c15) ? __expf(us - Mt) : 0.f; sp[sb][j] = (sb <= tb) ? Sacc[sb][j] * 0.0625f * w : 0.f; } }
#pragma unroll
            for (int k2 = 0; k2 < 2; ++k2) { v4u w; w.x = pk2(sp[2 * k2][0], sp[2 * k2][1]); w.y = pk2(sp[2 * k2][2], sp[2 * k2][3]); w.z = pk2(sp[2 * k2 + 1][0], sp[2 * k2 + 1][1]); w.w = pk2(sp[2 * k2 + 1][2], sp[2 * k2 + 1][3]);
                pf[k2] = __builtin_bit_cast(bf16x8, w); } }
        const bf16x8 onesf = (c15 == 0) ? (bf16x8){0x3F80, 0x3F80, 0x3F80, 0x3F80, 0x3F80, 0x3F80, 0x3F80, 0x3F80} : (bf16x8){0, 0, 0, 0, 0, 0, 0, 0};
#pragma unroll
        for (int k2 = 0; k2 < 2; ++k2) {
#pragma unroll
            for (int x = 0; x < 2; ++x) { const int eb = 2 * eh + x; LAS const unsigned char* p = VRc + (32 * k2 + 4 * q4 + (c15 >> 2)) * ML_VP + (16 * eb + 4 * (c15 & 3)) * 2;
                const s16x4 lo = lds_tr(p), hi = lds_tr(p + 16 * ML_VP);
                a2[x] = __builtin_amdgcn_mfma_f32_16x16x32_bf16(cat4(lo, hi), pf[k2], a2[x], 0, 0, 0); }
            a2[2] = __builtin_amdgcn_mfma_f32_16x16x32_bf16(onesf, pf[k2], a2[2], 0, 0, 0); }
        {   const float den0 = at * a1[2][0] + a2[2][0];
            const float den = __shfl(den0, c15);
            const float inv = 1.0f / fmaxf(fabsf(den), __expf(-mtt));
            const int tl = 16 * tb + c15;
            if (ML_VALID(c, tl)) { const unsigned ho = (unsigned)((ML_ROW(c, tl) * DM + h * MDV + sl * 64 + 4 * q4 + 32 * eh) * 2);
#pragma unroll
                for (int x = 0; x < 2; ++x) { v2u w; w.x = pk2((at * a1[x][0] + a2[x][0]) * inv, (at * a1[x][1] + a2[x][1]) * inv); w.y = pk2((at * a1[x][2] + a2[x][2]) * inv, (at * a1[x][3] + a2[x][3]) * inv);
                    *(GAS v2u*)((GAS unsigned char*)HH + (ho + 32u * x)) = w; } } }
#pragma unroll
        for (int ks = 0; ks < 8; ++ks) qn[ks] = *(const GAS bf16x8*)(Pn + (qofs + 64u * ks));
#pragma unroll
        for (int i = 0; i < 2; ++i)
#pragma unroll
            for (int e = 0; e < 5; ++e) Cacc[i][e] = Cacc[i][e] * decay;
#pragma unroll
        for (int k2 = 0; k2 < 2; ++k2) {
            const f32x4 wv0 = *(LAS const f32x4*)(wS + 32 * k2 + 8 * q4), wv1 = *(LAS const f32x4*)(wS + 32 * k2 + 8 * q4 + 4);
            const float wlv[8] = {wv0.x, wv0.y, wv0.z, wv0.w, wv1.x, wv1.y, wv1.z, wv1.w};
            bf16x8 bfr[5];
#pragma unroll
            for (int eb = 0; eb < 4; ++eb) { LAS const unsigned char* p = VRc + (32 * k2 + 8 * q4 + (c15 >> 2)) * ML_VP + (16 * eb + 4 * (c15 & 3)) * 2;
                const s16x4 lo = lds_tr(p), hi = lds_tr(p + 4 * ML_VP);
                v4u w; w.x = pk2(bf2f((unsigned short)lo[0]) * wlv[0], bf2f((unsigned short)lo[1]) * wlv[1]); w.y = pk2(bf2f((unsigned short)lo[2]) * wlv[2], bf2f((unsigned short)lo[3]) * wlv[3]);
                w.z = pk2(bf2f((unsigned short)hi[0]) * wlv[4], bf2f((unsigned short)hi[1]) * wlv[5]); w.w = pk2(bf2f((unsigned short)hi[2]) * wlv[6], bf2f((unsigned short)hi[3]) * wlv[7]);
                bfr[eb] = __builtin_bit_cast(bf16x8, w); }
            { v4u w; w.x = pk2(wlv[0], wlv[1]); w.y = pk2(wlv[2], wlv[3]); w.z = pk2(wlv[4], wlv[5]); w.w = pk2(wlv[6], wlv[7]); if (c15 != 0) w = (v4u){0u, 0u, 0u, 0u}; bfr[4] = __builtin_bit_cast(bf16x8, w); }
#pragma unroll
            for (int i = 0; i < 2; ++i) { const int rb = 2 * wave + i; LAS const unsigned char* p = KRc + (32 * k2 + 8 * q4 + (c15 >> 2)) * ML_KP + (16 * rb + 4 * (c15 & 3)) * 2;
                const s16x4 lo = lds_tr(p), hi = lds_tr(p + 4 * ML_KP); const bf16x8 af = cat4(lo, hi);
#pragma unroll
                for (int eb = 0; eb < 5; ++eb) Cacc[i][eb] = __builtin_amdgcn_mfma_f32_16x16x32_bf16(af, bfr[eb], Cacc[i][eb], 0, 0, 0); }
        }
        LDS_WAIT(); __syncthreads();
#pragma unroll
        for (int i = 0; i < 2; ++i)
#pragma unroll
            for (int eb = 0; eb < 5; ++eb) { v2u w; w.x = pk2(Cacc[i][eb][0], Cacc[i][eb][1]); w.y = pk2(Cacc[i][eb][2], Cacc[i][eb][3]);
                *(LAS v2u*)(lds + ML_CT + (16 * eb + c15) * ML_KP + (16 * (2 * wave + i) + 4 * q4) * 2) = w; }
#pragma unroll
        for (int j = 0; j < 4; ++j) { const int id = tid + NTHR * j, i = id >> 5, ch = id & 31; *(LAS v4u*)(lds + ML_KR0 + nx * ML_KRSZ + i * ML_KP + ch * 16) = kst[j]; }
        { const int i = tid >> 3, ch = tid & 7; *(LAS v4u*)(lds + ML_VR0 + nx * ML_VRSZ + i * ML_VP + ch * 16) = vst; }
#pragma unroll
        for (int ks = 0; ks < 8; ++ks) qf[ks] = qn[ks];
        bc_c = bc_n; u_c = u_n; pm_c = pm_n;
        m_state = b63 + M63;
        LDS_WAIT(); __syncthreads();
    }
#undef ML_ROW
#undef ML_VALID
#undef ML_GLOAD
}
__device__ __forceinline__ void mlstm_unit(Frame& F, const Args& a, int unit) {
    switch (F.wave >> 1) { case 0: mlstm_unit_tb<0>(F, a, unit); break; case 1: mlstm_unit_tb<1>(F, a, unit); break; case 2: mlstm_unit_tb<2>(F, a, unit); break; default: mlstm_unit_tb<3>(F, a, unit); break; }
}

constexpr int AT_KSZ = 12288, AT_VSZ = 8192, AT_K0 = 0, AT_V0 = 2 * AT_KSZ, AT_WS = AT_V0 + 2 * AT_VSZ, AT_GQ = AT_WS + NWAVES * 256, AT_OST = AT_GQ + 768, AT_END = AT_OST + NWAVES * 4096;
static_assert(AT_END <= RING_BYTES, "attention LDS");
constexpr float AT_SCALE = 0.07216878364870322f / 256.0f;
constexpr float AT_THR = 2.5f;
__device__ __forceinline__ int crow(int r, int hi) { return (r & 3) + 8 * (r >> 2) + 4 * hi; }
__device__ __forceinline__ int v_rd_base(int lane) { return ((lane & 3) << 3) | (((lane >> 2) & 3) << 6) | (((lane >> 4) & 1) << 5) | (((lane >> 5) & 1) << 8); }
constexpr int v_rd_off(int d0, int ks, int half) { return d0 * 512 + ks * 4096 + half * 2048; }
__device__ __forceinline__ void at_mask(f32x16& p0, f32x16& p1, int dq) {
    const float NEG = -__builtin_inff();
#pragma unroll
    for (int r = 0; r < 16; ++r) { const int c = (r & 3) + 8 * (r >> 2); if (dq - c < 0) p0[r] = NEG; if (dq - c - 32 < 0) p1[r] = NEG; }
}
__device__ __forceinline__ void at_partialSM(f32x16& p0, f32x16& p1, float& m_reg, float& mn, float& alpha) {
    float pmax = p0[0];
#pragma unroll
    for (int r = 1; r < 16; ++r) pmax = fmaxf(pmax, p0[r]);
#pragma unroll
    for (int r = 0; r < 16; ++r) pmax = fmaxf(pmax, p1[r]);
    { auto rr = __builtin_amdgcn_permlane32_swap(__float_as_uint(pmax), __float_as_uint(pmax), false, false); pmax = fmaxf(__uint_as_float(rr[0]), __uint_as_float(rr[1])); }
    constexpr float C2 = 1.4426950408889634f * AT_SCALE;
    if (__builtin_expect(__all((pmax - m_reg) * AT_SCALE <= AT_THR), 1)) { mn = m_reg; alpha = 1.f; }
    else { mn = fmaxf(m_reg, pmax); alpha = __builtin_amdgcn_exp2f((m_reg - mn) * C2); m_reg = mn; }
    const float mnL = 5.0f - mn * C2;
#pragma unroll
    for (int r = 0; r < 16; ++r) p0[r] = __builtin_amdgcn_exp2f(fmaf(p0[r], C2, mnL));
#pragma unroll
    for (int r = 0; r < 16; ++r) p1[r] = __builtin_amdgcn_exp2f(fmaf(p1[r], C2, mnL));
}
__device__ __forceinline__ void at_finishSM(const f32x16& p0, const f32x16& p1, float alpha, float& l_reg, bf16x8& pa0, bf16x8& pa1, bf16x8& pa2, bf16x8& pa3) {
    float ps = 0.f;
#pragma unroll
    for (int r = 0; r < 16; ++r) ps += p0[r];
#pragma unroll
    for (int r = 0; r < 16; ++r) ps += p1[r];
    { auto rr = __builtin_amdgcn_permlane32_swap(__float_as_uint(ps), __float_as_uint(ps), false, false); ps = __uint_as_float(rr[0]) + __uint_as_float(rr[1]); }
    l_reg = l_reg * alpha + ps;
#define AT_PK4(P, B_, OUT) do { unsigned a0 = pk2a(P[B_+0], P[B_+1]), a1 = pk2a(P[B_+2], P[B_+3]); unsigned b0 = pk2a(P[B_+4], P[B_+5]), b1 = pk2a(P[B_+6], P[B_+7]); \
        auto r0 = __builtin_amdgcn_permlane32_swap(a0, b0, false, false); auto r1 = __builtin_amdgcn_permlane32_swap(a1, b1, false, false); \
        v4u w = {r0[0], r1[0], r0[1], r1[1]}; OUT = __builtin_bit_cast(bf16x8, w); } while (0)
    AT_PK4(p0, 0, pa0); AT_PK4(p0, 8, pa1); AT_PK4(p1, 0, pa2); AT_PK4(p1, 8, pa3);
#undef AT_PK4
}
__device__ __forceinline__ void at_qkt(f32x16& p0, f32x16& p1, LAS const unsigned char* Kb, int r32, int hi, const bf16x8* qr) {
    p0 = (f32x16){0.f, 0.f, 0.f, 0.f, 0.f, 0.f, 0.f, 0.f, 0.f, 0.f, 0.f, 0.f, 0.f, 0.f, 0.f, 0.f}; p1 = p0;
    LAS const unsigned char* kb[4];
#pragma unroll
    for (int dd = 0; dd < 4; ++dd) kb[dd] = Kb + r32 * 384 + (((2 * dd + hi) ^ ((r32 >> 1) & 7)) << 4);
    bf16x8 c0[2], c1[2], n0[2], n1[2];
#pragma unroll
    for (int dd = 0; dd < 2; ++dd) { LAS const unsigned char* p = kb[dd]; c0[dd] = *(LAS const bf16x8*)p; c1[dd] = *(LAS const bf16x8*)(p + 32 * 384); }
#pragma unroll
    for (int g = 0; g < 6; ++g) {
        if (g < 5) {
#pragma unroll
            for (int dd = 0; dd < 2; ++dd) { LAS const unsigned char* p = kb[2 * ((g + 1) & 1) + dd] + ((g + 1) >> 1) * 128; n0[dd] = *(LAS const bf16x8*)p; n1[dd] = *(LAS const bf16x8*)(p + 32 * 384); } }
        SBAR();
#pragma unroll
        for (int dd = 0; dd < 2; ++dd) { p0 = __builtin_amdgcn_mfma_f32_32x32x16_bf16(c0[dd], qr[2 * g + dd], p0, 0, 0, 0); p1 = __builtin_amdgcn_mfma_f32_32x32x16_bf16(c1[dd], qr[2 * g + dd], p1, 0, 0, 0); }
        SBAR();
#pragma unroll
        for (int dd = 0; dd < 2; ++dd) { c0[dd] = n0[dd]; c1[dd] = n1[dd]; } }
}
__device__ __forceinline__ void at_qkt8(f32x16& p0, f32x16& p1, LAS const unsigned char* Kb, const int (&ko)[6], int kmask, const pg8::i32x8* q8) {
#define AT_KO2(x) (ko[x] + 6080 + 192 * ((kmask >> (x)) & 1))
    p0 = (f32x16){0.f, 0.f, 0.f, 0.f, 0.f, 0.f, 0.f, 0.f, 0.f, 0.f, 0.f, 0.f, 0.f, 0.f, 0.f, 0.f}; p1 = p0;
    pg8::i32x8 a0 = pg8::cat8(*(LAS const bf16x8*)(Kb + ko[0]), *(LAS const bf16x8*)(Kb + ko[1])), a1 = pg8::cat8(*(LAS const bf16x8*)(Kb + AT_KO2(0)), *(LAS const bf16x8*)(Kb + AT_KO2(1)));
#pragma unroll
    for (int j = 0; j < 3; ++j) { pg8::i32x8 n0 = a0, n1 = a1;
        if (j < 2) { n0 = pg8::cat8(*(LAS const bf16x8*)(Kb + ko[2 * j + 2]), *(LAS const bf16x8*)(Kb + ko[2 * j + 3])); n1 = pg8::cat8(*(LAS const bf16x8*)(Kb + AT_KO2(2 * j + 2)), *(LAS const bf16x8*)(Kb + AT_KO2(2 * j + 3))); }
        SBAR(); __builtin_amdgcn_s_setprio(1);
        p0 = __builtin_amdgcn_mfma_scale_f32_32x32x64_f8f6f4(a0, q8[j], p0, 0, 0, 0, 0, 0, 0);
        p1 = __builtin_amdgcn_mfma_scale_f32_32x32x64_f8f6f4(a1, q8[j], p1, 0, 0, 0, 0, 0, 0);
        __builtin_amdgcn_s_setprio(0); SBAR(); a0 = n0; a1 = n1; }
#undef AT_KO2
}
__device__ __forceinline__ void at_pv(f32x16* o, unsigned vb0, bf16x8 pa0, bf16x8 pa1, bf16x8 pa2, bf16x8 pa3) {
#define AT_TRRD(dst, off) asm volatile("ds_read_b64_tr_b16 %0, %1 offset:%2" : "=&v"(dst) : "v"(vb0), "i"(off) : "memory")
#define AT_LOADV(L, H, d0) do { constexpr int b_ = v_rd_off(d0, 0, 0); AT_TRRD(L[0], b_); AT_TRRD(H[0], b_ + 2048); AT_TRRD(L[1], b_ + 4096); AT_TRRD(H[1], b_ + 6144); \
        AT_TRRD(L[2], b_ + 8192); AT_TRRD(H[2], b_ + 10240); AT_TRRD(L[3], b_ + 12288); AT_TRRD(H[3], b_ + 14336); } while (0)
#define AT_MMAV(L, H, d0) do { o[d0] = __builtin_amdgcn_mfma_f32_32x32x16_bf16(pa0, cat4(L[0], H[0]), o[d0], 0, 0, 0); o[d0] = __builtin_amdgcn_mfma_f32_32x32x16_bf16(pa1, cat4(L[1], H[1]), o[d0], 0, 0, 0); \
        o[d0] = __builtin_amdgcn_mfma_f32_32x32x16_bf16(pa2, cat4(L[2], H[2]), o[d0], 0, 0, 0); o[d0] = __builtin_amdgcn_mfma_f32_32x32x16_bf16(pa3, cat4(L[3], H[3]), o[d0], 0, 0, 0); } while (0)
    s16x4 la[4], ha[4], lb[4], hb[4];
    AT_LOADV(la, ha, 0); AT_LOADV(lb, hb, 1);
    asm volatile("s_waitcnt lgkmcnt(8)" ::: "memory"); SBAR(); AT_MMAV(la, ha, 0); SBAR();
    AT_LOADV(la, ha, 2);
    asm volatile("s_waitcnt lgkmcnt(8)" ::: "memory"); SBAR(); AT_MMAV(lb, hb, 1); SBAR();
    AT_LOADV(lb, hb, 3);
    asm volatile("s_waitcnt lgkmcnt(8)" ::: "memory"); SBAR(); AT_MMAV(la, ha, 2); SBAR();
    asm volatile("s_waitcnt lgkmcnt(0)" ::: "memory"); SBAR(); AT_MMAV(lb, hb, 3); SBAR();
#undef AT_MMAV
#undef AT_LOADV
#undef AT_TRRD
}
__device__ __forceinline__ pg8::i32x8 at_finishSM8(const f32x16& p0, const f32x16& p1, float alpha, float& l_reg) {
    float ps = 0.f;
#pragma unroll
    for (int r = 0; r < 16; ++r) ps += p0[r];
#pragma unroll
    for (int r = 0; r < 16; ++r) ps += p1[r];
    { auto rr = __builtin_amdgcn_permlane32_swap(__float_as_uint(ps), __float_as_uint(ps), false, false); ps = __uint_as_float(rr[0]) + __uint_as_float(rr[1]); }
    l_reg = l_reg * alpha + ps;
    int w[8];
#pragma unroll
    for (int k = 0; k < 4; ++k) { int x = __builtin_amdgcn_cvt_pk_fp8_f32(p0[4 * k], p0[4 * k + 1], 0, false); x = __builtin_amdgcn_cvt_pk_fp8_f32(p0[4 * k + 2], p0[4 * k + 3], x, true); w[k] = x;
        x = __builtin_amdgcn_cvt_pk_fp8_f32(p1[4 * k], p1[4 * k + 1], 0, false); x = __builtin_amdgcn_cvt_pk_fp8_f32(p1[4 * k + 2], p1[4 * k + 3], x, true); w[4 + k] = x; }
    return (pg8::i32x8){w[0], w[1], w[2], w[3], w[4], w[5], w[6], w[7]};
}
__device__ __forceinline__ s16x4 lds_tr8(LAS const unsigned char* p) { typedef int v2i_t __attribute__((ext_vector_type(2))); return __builtin_bit_cast(s16x4, __builtin_amdgcn_ds_read_tr8_b64_v2i32((LAS v2i_t*)p)); }
__device__ __forceinline__ void at_pv8(f32x16* o, LAS const unsigned char* const (&va)[4], pg8::i32x8 P8) {
#pragma unroll
    for (int d0 = 0; d0 < 4; ++d0) { const s16x4 t0 = lds_tr8(va[d0]), t1 = lds_tr8(va[d0] + 2048), t2 = lds_tr8(va[d0] + 4096), t3 = lds_tr8(va[d0] + 6144);
        const pg8::i32x8 B = pg8::cat8(cat4(t0, t1), cat4(t2, t3));
        asm volatile("v_mfma_f32_32x32x64_f8f6f4 %0, %1, %2, %0" : "+v"(o[d0]) : "v"(P8), "v"(B)); }
}
__device__ __forceinline__ void at_dma_tile(LAS unsigned char* lds, const unsigned char* Kt, const unsigned char* Vt, int buf, int wave, int lane) {
    unsigned lo = (unsigned)lane * 16u; asm volatile("" : "+v"(lo));
#pragma unroll
    for (int i = 0; i < 2; ++i) { const int pc = wave + 8 * i; if (pc < 12) __builtin_amdgcn_global_load_lds((const unsigned*)((Kt + pc * 1024) + lo), (LAS unsigned*)(lds + AT_K0 + buf * AT_KSZ + pc * 1024), 16, 0, 0); }
    __builtin_amdgcn_global_load_lds((const unsigned*)((Vt + wave * 1024) + lo), (LAS unsigned*)(lds + AT_V0 + buf * AT_VSZ + wave * 1024), 16, 0, 0);
}
__device__ __forceinline__ void attn_block(Frame& F, const Args& a, int bh, int qb) {
    const int lane = F.lane, wave = F.wave, r32 = lane & 31, hi = lane >> 5, b = bh >> 6, h = bh & 63;
    LAS unsigned char* lds = F.lds;
    const bf16* QRAW = (const bf16*)(a.ws + WS_BIG); const float* ROPEt = (const float*)(a.ws + WS_ROPE);
    const unsigned char* Kimg = a.ws + WS_K + (size_t)bh * NKT * AT_KSZ; const unsigned char* Vimg = a.ws + WS_V + (size_t)bh * NKT * AT_VSZ;
    bf16* ATO = (bf16*)(a.ws + WS_KNOPE);
    const int NT = 4 * qb + 5;
    at_dma_tile(lds, Kimg, Vimg, 0, wave, lane);
    const int m = b * SEQ + 256 * qb + 32 * wave + r32;
    pg8::i32x8 q8[3];
#define Q8F(word, b) __builtin_amdgcn_cvt_f32_fp8((int)(word), b)
    {   v2u qraw[12]; float ss = 0.f;
        const unsigned qo = (unsigned)(m * (AH * QKD) + h * QKD);
#pragma unroll
        for (int j = 0; j < 3; ++j)
#pragma unroll
            for (int i = 0; i < 4; ++i) { const int d = j < 2 ? 64 * j + 32 * hi + 8 * i : (i < 2 ? 128 + 16 * hi + 8 * i : 160 + 16 * hi + 8 * (i - 2));
                qraw[4 * j + i] = *(const GAS v2u*)((const GAS unsigned char*)QRAW + (qo + (unsigned)d)); }
#pragma unroll
        for (int d0 = 0; d0 < 12; ++d0) { const v2u w = qraw[d0];
            ss += (Q8F(w.x, 0) * Q8F(w.x, 0) + Q8F(w.x, 1) * Q8F(w.x, 1)) + (Q8F(w.x, 2) * Q8F(w.x, 2) + Q8F(w.x, 3) * Q8F(w.x, 3)) + (Q8F(w.y, 0) * Q8F(w.y, 0) + Q8F(w.y, 1) * Q8F(w.y, 1)) + (Q8F(w.y, 2) * Q8F(w.y, 2) + Q8F(w.y, 3) * Q8F(w.y, 3)); }
        ss += __shfl_xor(ss, 32);
        const float r = (F8_A_SCALE / 16.0f) / sqrtf(ss * (1.0f / (256.0f * QKD)) + EPS);
        LAS const float* gq = (LAS const float*)(lds + AT_GQ);
#pragma unroll
        for (int j = 0; j < 2; ++j) { int wds[8];
#pragma unroll
            for (int i = 0; i < 4; ++i) { const v2u w = qraw[4 * j + i]; const int d = 64 * j + 32 * hi + 8 * i; const f32x4 g0 = *(LAS const f32x4*)(gq + d), g1 = *(LAS const f32x4*)(gq + d + 4);
                int x = __builtin_amdgcn_cvt_pk_fp8_f32(Q8F(w.x, 0) * r * g0.x, Q8F(w.x, 1) * r * g0.y, 0, false); x = __builtin_amdgcn_cvt_pk_fp8_f32(Q8F(w.x, 2) * r * g0.z, Q8F(w.x, 3) * r * g0.w, x, true); wds[2 * i] = x;
                x = __builtin_amdgcn_cvt_pk_fp8_f32(Q8F(w.y, 0) * r * g1.x, Q8F(w.y, 1) * r * g1.y, 0, false); x = __builtin_amdgcn_cvt_pk_fp8_f32(Q8F(w.y, 2) * r * g1.z, Q8F(w.y, 3) * r * g1.w, x, true); wds[2 * i + 1] = x; }
            q8[j] = (pg8::i32x8){wds[0], wds[1], wds[2], wds[3], wds[4], wds[5], wds[6], wds[7]}; }
        {
            const float* rt = ROPEt + (size_t)m * 64; float o1[16], o2[16];
#pragma unroll
            for (int i = 0; i < 2; ++i) { const v2u w1 = qraw[8 + i], w2 = qraw[10 + i]; const int i0 = 16 * hi + 8 * i;
                const f32x4 ga = *(LAS const f32x4*)(gq + 128 + i0), gb = *(LAS const f32x4*)(gq + 128 + i0 + 4), gc = *(LAS const f32x4*)(gq + 160 + i0), gd = *(LAS const f32x4*)(gq + 160 + i0 + 4);
                const f32x4 c0 = *(const GAS f32x4*)(rt + i0), c1 = *(const GAS f32x4*)(rt + i0 + 4), s0 = *(const GAS f32x4*)(rt + 32 + i0), s1 = *(const GAS f32x4*)(rt + 32 + i0 + 4);
                const float t1[8] = {Q8F(w1.x, 0) * r * ga.x, Q8F(w1.x, 1) * r * ga.y, Q8F(w1.x, 2) * r * ga.z, Q8F(w1.x, 3) * r * ga.w, Q8F(w1.y, 0) * r * gb.x, Q8F(w1.y, 1) * r * gb.y, Q8F(w1.y, 2) * r * gb.z, Q8F(w1.y, 3) * r * gb.w};
                const float t2[8] = {Q8F(w2.x, 0) * r * gc.x, Q8F(w2.x, 1) * r * gc.y, Q8F(w2.x, 2) * r * gc.z, Q8F(w2.x, 3) * r * gc.w, Q8F(w2.y, 0) * r * gd.x, Q8F(w2.y, 1) * r * gd.y, Q8F(w2.y, 2) * r * gd.z, Q8F(w2.y, 3) * r * gd.w};
                const float cs[8] = {c0.x, c0.y, c0.z, c0.w, c1.x, c1.y, c1.z, c1.w}, sn[8] = {s0.x, s0.y, s0.z, s0.w, s1.x, s1.y, s1.z, s1.w};
#pragma unroll
                for (int e = 0; e < 8; ++e) { o1[8 * i + e] = t1[e] * cs[e] - t2[e] * sn[e]; o2[8 * i + e] = t1[e] * sn[e] + t2[e] * cs[e]; } }
            int wds[8];
#pragma unroll
            for (int k = 0; k < 4; ++k) { int x = __builtin_amdgcn_cvt_pk_fp8_f32(o1[4 * k], o1[4 * k + 1], 0, false); x = __builtin_amdgcn_cvt_pk_fp8_f32(o1[4 * k + 2], o1[4 * k + 3], x, true); wds[k] = x;
                x = __builtin_amdgcn_cvt_pk_fp8_f32(o2[4 * k], o2[4 * k + 1], 0, false); x = __builtin_amdgcn_cvt_pk_fp8_f32(o2[4 * k + 2], o2[4 * k + 3], x, true); wds[4 + k] = x; }
            q8[2] = (pg8::i32x8){wds[0], wds[1], wds[2], wds[3], wds[4], wds[5], wds[6], wds[7]}; }
    }
#undef Q8F
    int ko[6], kmask = 0;
    { int rq = r32; asm volatile("" : "+v"(rq));
#pragma unroll
      for (int j = 0; j < 3; ++j)
#pragma unroll
        for (int w = 0; w < 2; ++w) { const int c = j < 2 ? 4 * j + 2 * hi + w : 8 + hi + 2 * w; const int cp = (c + (rq >> 2)) % 12;
            ko[2 * j + w] = rq * 192 + (cp << 4); kmask |= (cp < 4 ? 1 : 0) << (2 * j + w); } }
    LAS float* wsf = (LAS float*)(lds + AT_WS + wave * 256); LAS float* li_l = wsf; LAS float* al_l = wsf + 32;
    float m_reg = -1e30f, l_reg = 0.f; f32x16 o[4];
#pragma unroll
    for (int d = 0; d < 4; ++d) o[d] = (f32x16){0.f, 0.f, 0.f, 0.f, 0.f, 0.f, 0.f, 0.f, 0.f, 0.f, 0.f, 0.f, 0.f, 0.f, 0.f, 0.f};
    const int qlo = NMETA + 256 * qb + 32 * wave;
    const int qm = qlo + r32 - 4 * hi;
    int vrow0, vsk;
    { const int q = (lane & 15) >> 1; vrow0 = ((q & 3) + 8 * (q >> 2) + 4 * hi) * 128 + 16 * ((lane >> 4) & 1) + 8 * (lane & 1); vsk = ((q >> 1) & 1) | (((q >> 2) & 1) << 1); }
    VM_WAIT(); __syncthreads();
    for (int t = 0; t < NT; ++t) {
        const int buf = t & 1;
        if (t + 1 < NT) at_dma_tile(lds, Kimg + (size_t)(t + 1) * AT_KSZ, Vimg + (size_t)(t + 1) * AT_VSZ, buf ^ 1, wave, lane);
        const int kb = 64 * t;
        if (kb <= qlo + 31) {
            f32x16 p0, p1; float mn, alpha;
            at_qkt8(p0, p1, lds + AT_K0 + buf * AT_KSZ, ko, kmask, q8);
            if (kb + 63 > qlo) at_mask(p0, p1, qm - kb);
            at_partialSM(p0, p1, m_reg, mn, alpha);
            if (__any(alpha < 1.f)) { if (hi == 0) al_l[r32] = alpha; LDS_WAIT();
#pragma unroll
                for (int d = 0; d < 4; ++d)
#pragma unroll
                    for (int r = 0; r < 16; ++r) o[d][r] *= al_l[crow(r, hi)]; }
            const pg8::i32x8 P8 = at_finishSM8(p0, p1, alpha, l_reg);
            LAS const unsigned char* vt = lds + AT_V0 + buf * AT_VSZ + vrow0;
            LAS const unsigned char* const va[4] = {vt + ((0 ^ vsk) << 5), vt + ((1 ^ vsk) << 5), vt + ((2 ^ vsk) << 5), vt + ((3 ^ vsk) << 5)};
            at_pv8(o, va, P8);
        }
        VM_WAIT(); LDS_WAIT(); __syncthreads();
    }
    asm volatile("s_nop 15\n\ts_nop 15" ::: "memory");
    if (hi == 0) li_l[r32] = l_reg;
    LDS_WAIT();
    {   LAS unsigned char* ost = lds + AT_OST + wave * 4096 + 4 * hi * 128 + r32;
#pragma unroll
        for (int r = 0; r < 16; ++r) { const float rl = (ATT_O_SCALE / F8_A_SCALE) * __builtin_amdgcn_rcpf(li_l[crow(r, hi)]);
#pragma unroll
            for (int d0 = 0; d0 < 4; d0 += 2) { const int w = __builtin_amdgcn_cvt_pk_fp8_f32(o[d0][r] * rl, o[d0 + 1][r] * rl, 0, false);
                ost[((r & 3) + 8 * (r >> 2)) * 128 + d0 * 32] = (unsigned char)w; ost[((r & 3) + 8 * (r >> 2)) * 128 + d0 * 32 + 32] = (unsigned char)(w >> 8); } }
        LDS_WAIT();
        unsigned ob = (unsigned)((b * SEQ + 256 * qb + 32 * wave + (lane >> 3)) * (AH * VHD) + h * VHD + 16 * (lane & 7));
        asm volatile("" : "+v"(ob));
#pragma unroll
        for (int j = 0; j < 4; ++j) { const v4u x = *(LAS const v4u*)(lds + AT_OST + wave * 4096 + ((lane >> 3) + 8 * j) * 128 + 16 * (lane & 7));
            *(GAS v4u*)((GAS unsigned char*)ATO + (ob + (unsigned)(8 * j * (AH * VHD)))) = x; } }
    LDS_WAIT(); __syncthreads();
}
__device__ __forceinline__ void attn_phase(Frame& F, const Args& a) {
    if (F.tid < QKD) ((LAS float*)(F.lds + AT_GQ))[F.tid] = ((const float*)a.in[21])[F.tid];
    LDS_WAIT(); __syncthreads();
    for (int n = F.vcu; n < 2048; n += F.G) { const int st = n >> 8, cu = n & 255, xcd = cu >> 5, j = cu & 31; const int bh = 32 * xcd + 4 * st + (j >> 3), p = j & 7;
        attn_block(F, a, bh, 15 - p); attn_block(F, a, bh, p); }
}

__device__ __forceinline__ void meta_in_phase(Frame& F, const Args& a) {
    const bf16* XN = (const bf16*)(a.ws + WS_XN); const bf16* WT = (const bf16*)(a.ws + WS_W_IN); bf16* PROJ = (bf16*)(a.ws + WS_BIG); float* GATES = (float*)(a.ws + WS_GATES);
    const int lane = F.lane, r = lane & 15, q4 = lane >> 4;
    for (int t = F.vcu; t < 769 + 1024; t += F.G) { f32x4 acc[1];
        if (t < 769) { skinny_wg<1>(F, XN + (size_t)MR * DM, WT + (size_t)(16 * t) * DM, WT, DM, acc);
            if (F.wave == 0) {
                if (t < 768) { v2u w; w.x = pk2(acc[0][0], acc[0][1]); w.y = pk2(acc[0][2], acc[0][3]); *(GAS v2u*)(PROJ + (size_t)(MR + r) * NPROJ + 16 * t + 4 * q4) = w; }
                else {
#pragma unroll
                    for (int j = 0; j < 4; ++j) GATES[(size_t)(4 * q4 + j) * MT + MR + r] = acc[0][j]; } } }
        else { const int tt = t - 769;
            skinny_wg<1>(F, WT + (size_t)NPROJ * DM, XN + (size_t)(16 * tt) * DM, XN, DM, acc);
            if (F.wave == 0) *(GAS f32x4*)(GATES + (size_t)r * MT + 16 * tt + 4 * q4) = acc[0]; }
    }
}
__device__ __forceinline__ void meta_out_phase(Frame& F, const Args& a) {
    const bf16* A2 = (const bf16*)(a.ws + WS_XN); const bf16* WT = (const bf16*)(a.ws + WS_W_OUT); float* HM = (float*)(a.ws + WS_HMETA); const float* mt = (const float*)a.in[2];
    const int lane = F.lane, r = lane & 15, q4 = lane >> 4;
    for (int t = F.vcu; t < 256; t += F.G) { f32x4 acc[1]; skinny_wg<1>(F, A2 + (size_t)MR * DM, WT + (size_t)(16 * t) * DM, WT, DM, acc);
        if (F.wave == 0) { const size_t o = (size_t)r * DM + 16 * t + 4 * q4; *(GAS f32x4*)(HM + o) = *(const GAS f32x4*)(mt + o) + acc[0]; } }
}
__device__ __forceinline__ void meta_gu_phase(Frame& F, const Args& a) {
    const bf16* XN = (const bf16*)(a.ws + WS_XN); const bf16* WT = (const bf16*)(a.ws + WS_W_GU0); bf16* ACT = (bf16*)(a.ws + WS_BIG);
    const int lane = F.lane, r = lane & 15, q4 = lane >> 4;
    for (int t = F.vcu; t < DFF / 16; t += F.G) { const int c0 = 16 * t, j = c0 >> 7, i = c0 & 127; f32x4 gu[2];
        skinny_wg<2>(F, XN + (size_t)MR * DM, WT + (size_t)(256 * j + i) * DM, WT + (size_t)(256 * j + 128 + i) * DM, DM, gu);
        if (F.wave == 0) { v2u w; w.x = pk2(pg8::silu_mul(gu[0][0], gu[1][0]), pg8::silu_mul(gu[0][1], gu[1][1])); w.y = pk2(pg8::silu_mul(gu[0][2], gu[1][2]), pg8::silu_mul(gu[0][3], gu[1][3]));
            *(GAS v2u*)(ACT + (size_t)(MR + r) * DFF + c0 + 4 * q4) = w; } }
}
__device__ __forceinline__ void meta_down_phase(Frame& F, const Args& a) {
    const bf16* ACT = (const bf16*)(a.ws + WS_BIG); const bf16* WT = (const bf16*)(a.ws + WS_W_DN0); float* HM = (float*)(a.ws + WS_HMETA);
    const int lane = F.lane, r = lane & 15, q4 = lane >> 4;
    for (int t = F.vcu; t < 256; t += F.G) { f32x4 acc[1]; skinny_wg<1>(F, ACT + (size_t)MR * DFF, WT + (size_t)(16 * t) * DFF, WT, DFF, acc);
        if (F.wave == 0) { const size_t o = (size_t)r * DM + 16 * t + 4 * q4; *(GAS f32x4*)(HM + o) = *(const GAS f32x4*)(HM + o) + acc[0]; } }
}
__device__ __forceinline__ void meta_kvq_phase(Frame& F, const Args& a) {
    const bf16* XN = (const bf16*)(a.ws + WS_XN); const bf16* WT = (const bf16*)(a.ws + WS_W_KVQ); float* LAT = (float*)(a.ws + WS_LAT);
    const int lane = F.lane, r = lane & 15, q4 = lane >> 4;
    for (int t = F.vcu; t < 36; t += F.G) { f32x4 acc[1]; skinny_wg<1>(F, XN + (size_t)MR * DM, WT + (size_t)(16 * t) * DM, WT, DM, acc);
        if (F.wave == 0) *(GAS f32x4*)(LAT + (size_t)(MR + r) * NKVQ + 16 * t + 4 * q4) = acc[0]; }
}
__device__ __forceinline__ void meta_kvup_phase(Frame& F, const Args& a) {
    const bf16* CK = (const bf16*)(a.ws + WS_CKVN); const bf16* WT = (const bf16*)(a.ws + WS_W_KVUP); bf16* KN = (bf16*)(a.ws + WS_KNOPE); unsigned char* Vimg = a.ws + WS_V;
    const int lane = F.lane, r = lane & 15, q4 = lane >> 4;
    for (int t = F.vcu; t < 1024; t += F.G) { f32x4 acc[1]; skinny_wg<1>(F, CK + (size_t)MR * KVLORA, WT + (size_t)(16 * t) * KVLORA, WT, KVLORA, acc);
        if (F.wave == 0) { const int n = 16 * t + 4 * q4, hd = n >> 8, wi = n & 255; v2u w; w.x = pk2(acc[0][0], acc[0][1]); w.y = pk2(acc[0][2], acc[0][3]);
            if (wi < 128) *(GAS v2u*)(KN + (size_t)(MR + r) * 8192 + hd * 128 + wi) = w;
            else { const int c0 = wi - 128; int x = __builtin_amdgcn_cvt_pk_fp8_f32(acc[0][0] * 16.f, acc[0][1] * 16.f, 0, false); x = __builtin_amdgcn_cvt_pk_fp8_f32(acc[0][2] * 16.f, acc[0][3] * 16.f, x, true);
                for (int bb = 0; bb < BATCH; ++bb) *(GAS unsigned*)(Vimg + ((size_t)((bb * AH + hd) * NKT)) * 8192 + pg8::v_img_off8(r, c0)) = (unsigned)x; } } }
}

constexpr int NPH = 18;
__global__ void __launch_bounds__(NTHR, 2) mk_fwd(Args args) {
    extern __shared__ __attribute__((aligned(16))) unsigned char lds_raw[];
    Frame F;
    F.lds = (LAS unsigned char*)lds_raw;
    F.tid = threadIdx.x; F.lane = F.tid & 63; F.wave = __builtin_amdgcn_readfirstlane(F.tid >> 6);
    F.G = gridDim.x; { const int bx = blockIdx.x; F.vcu = (F.G % 8 == 0) ? (bx % 8) * (F.G / 8) + bx / 8 : bx; }
    F.gw = F.vcu * NWAVES + F.wave; F.ngw = F.G * NWAVES;
    volatile LAS unsigned* MISC = (volatile LAS unsigned*)(F.lds + MISC_OFF);
    for (int u = F.tid; u < (LDS_BYTES - LDSCTL_OFF) / 4; u += NTHR) ((LAS unsigned*)(F.lds + LDSCTL_OFF))[u] = 0u;
    __syncthreads();
    unsigned char* ws = args.ws;
    const int lo = args.ph_lo, hi = args.ph_hi;
    const bool one_launch = (hi - lo) > 1;
    XcdBarrier bar; bar.bar = (unsigned*)(ws + WS_CTL); bar.x = 0; bar.st = nullptr;
    if (one_launch) bar = xcd_barrier_post((unsigned*)(ws + WS_CTL), MISC + 8);
    bar.wave = F.wave;
#ifndef MK_PHASES
#define MK_PHASES 0x3ffff
#endif
#define IN(k) ((((MK_PHASES) >> (k)) & 1) && lo <= (k) && (k) < hi)
#define SEAM(k) do { if (IN((k) + 1)) xcd_barrier(bar); } while (0)
    pg8::f16_t* H = (pg8::f16_t*)(ws + WS_H16);
#define REFRESH() do { F.lane = (int)__builtin_amdgcn_mbcnt_hi(~0u, __builtin_amdgcn_mbcnt_lo(~0u, 0u)); F.tid = F.wave * 64 + F.lane; } while (0)
    pg8::f16_t* Hw = args.dry ? (pg8::f16_t*)(ws + WS_END) : H;

    if (IN(0)) { REFRESH(); p0_prologue(F, args); SEAM(0); }
    if (IN(1)) { REFRESH();
        { pg8::Gemm g{(const bf16*)(ws + WS_XN), (const bf16*)(ws + WS_W_IN), MR, 8192, DM}; pg8::StaticOrder S; S.init(MR, 8192, F.G, (int)blockIdx.x);
          pg8::EpiBf16 E{(bf16*)(ws + WS_BIG), NPROJ};
          pg8::gemm_phase<pg8::EpiBf16, pg8::StaticOrder, true, true>(F.lds, g, S, E, F.wave); }
        { pg8::Gemm g{(const bf16*)(ws + WS_HH), (const bf16*)(ws + WS_W_INO8), MR, DM, DM / 2, 0x77777777, 0x7B7B7B7B}; pg8::StaticOrder S; S.init(MR, DM, F.G, (int)blockIdx.x);
          pg8::EpiBf16 E{(bf16*)(ws + WS_BIG) + 8192, NPROJ};
          pg8::gemm_phase<pg8::EpiBf16, pg8::StaticOrder, true, true, true>(F.lds, g, S, E, F.wave); }
        meta_in_phase(F, args); SEAM(1); }
    if (IN(2)) { REFRESH(); for (int u = F.vcu; u < 256; u += F.G) mlstm_unit(F, args, u); SEAM(2); }
    if (IN(3)) { REFRESH(); gate_norm_phase(F, args); SEAM(3); }
    if (IN(4)) { REFRESH();
        pg8::Gemm g{(const bf16*)(ws + WS_XN), (const bf16*)(ws + WS_W_OUT), MR, DM, DM}; pg8::StaticOrder S; S.init(MR, DM, F.G, (int)blockIdx.x);
        pg8::EpiRes<float, pg8::f16_t> E{(const float*)args.in[0], H, DM};
        pg8::gemm_phase<pg8::EpiRes<float, pg8::f16_t>, pg8::StaticOrder, true, true>(F.lds, g, S, E, F.wave);
        meta_out_phase(F, args); SEAM(4); }
    if (IN(5)) { REFRESH(); norm_phase_h(F, H, (const float*)(ws + WS_HMETA), (bf16*)(ws + WS_XN), nullptr, MT, 0); SEAM(5); }
    if (IN(6)) { REFRESH();
        pg8::Gemm g{(const bf16*)(ws + WS_XN), (const bf16*)(ws + WS_W_GU0), MR, NGU, DM}; pg8::StaticOrder S; S.init(MR, NGU, F.G, (int)blockIdx.x);
        pg8::EpiSwiglu E{(bf16*)(ws + WS_BIG), DFF};
        pg8::gemm_phase<pg8::EpiSwiglu, pg8::StaticOrder, true, true>(F.lds, g, S, E, F.wave);
        p0_deferred(F, args, (MR / 256) * (NGU / 256), P0_NITEMS - P0_DEFER_A - P0_DEFER_B, P0_DEFER_A); __syncthreads();
        meta_gu_phase(F, args); SEAM(6); }
    if (IN(7)) { REFRESH();
        pg8::Gemm g{(const bf16*)(ws + WS_BIG), (const bf16*)(ws + WS_W_DN0), MR, DM, DFF}; pg8::StaticOrder S; S.init(MR, DM, F.G, (int)blockIdx.x);
        pg8::EpiRes<pg8::f16_t, pg8::f16_t> E{H, Hw, DM};
        pg8::gemm_phase<pg8::EpiRes<pg8::f16_t, pg8::f16_t>, pg8::StaticOrder, true, true>(F.lds, g, S, E, F.wave);
        meta_down_phase(F, args); SEAM(7); }
    if (IN(8)) { REFRESH(); norm_phase_h(F, H, (const float*)(ws + WS_HMETA), (bf16*)(ws + WS_XN), ws + WS_XN, MT, 2); SEAM(8); }
    if (IN(9)) { REFRESH();
        pg8::Gemm g{(const bf16*)(ws + WS_XN), (const bf16*)(ws + WS_W_KVQ8), MR, NKVQ, DM / 2, 0x77777777, 0x7B7B7B7B}; pg8::StaticOrder S; S.init(MR, NKVQ, F.G, (int)blockIdx.x);
        pg8::EpiF16 E{(pg8::f16_t*)(ws + WS_LAT), NKVQ};
        pg8::gemm_phase<pg8::EpiF16, pg8::StaticOrder, true, true, true>(F.lds, g, S, E, F.wave);
        meta_kvq_phase(F, args); SEAM(9); }
    if (IN(10)) { REFRESH(); latent_norm_phase(F, args); SEAM(10); }
    if (IN(11)) { REFRESH();
        { pg8::Gemm g{(const bf16*)(ws + WS_CKVN), (const bf16*)(ws + WS_W_KVUP8), MR, AH * 256, KVLORA / 2, 0x77777777, 0x7B7B7B7B}; pg8::StaticOrder S; S.init(MR, AH * 256, F.G, (int)blockIdx.x);
          pg8::EpiKvUpK E{ws + WS_K, (bf16*)(ws + WS_V), (const float*)(ws + WS_PRE), (const float*)(ws + WS_SSR), (const float*)args.in[16], (LAS float*)(F.lds + EPI_RED_OFF)};
          pg8::gemm_phase<pg8::EpiKvUpK, pg8::StaticOrder, true, true, true>(F.lds, g, S, E, F.wave); }
        { pg8::Gemm g{(const bf16*)(ws + WS_CQN), (const bf16*)(ws + WS_W_UQ8), MR, AH * QKD, QLORA / 2, 0x77777777, 0x7B7B7B7B}; pg8::StaticOrder S; S.init(MR, AH * QKD, F.G, (int)blockIdx.x);
          pg8::EpiF8 E{ws + WS_BIG, AH * QKD};
          pg8::gemm_phase<pg8::EpiF8, pg8::StaticOrder, true, true, true>(F.lds, g, S, E, F.wave); }
        meta_kvup_phase(F, args); SEAM(11); }
    if (IN(12)) { REFRESH(); k_final_phase(F, args); SEAM(12); }
    if (IN(13)) { REFRESH(); attn_phase(F, args); SEAM(13); }
    if (IN(14)) { REFRESH();
        pg8::Gemm g{(const bf16*)(ws + WS_KNOPE), (const bf16*)(ws + WS_W_O), MR, DM, AH * VHD / 2, 0x77777777, 0x7B7B7B7B}; pg8::StaticOrder S; S.init(MR, DM, F.G, (int)blockIdx.x);
        pg8::EpiRes<pg8::f16_t, pg8::f16_t> E{H, Hw, DM};
        pg8::gemm_phase<pg8::EpiRes<pg8::f16_t, pg8::f16_t>, pg8::StaticOrder, true, true, true>(F.lds, g, S, E, F.wave); SEAM(14); }
    if (IN(15)) { REFRESH(); norm_phase_h(F, H, (const float*)(ws + WS_HMETA), (bf16*)(ws + WS_XN), nullptr, MR, 0); SEAM(15); }
    if (IN(16)) { REFRESH();
        pg8::Gemm g{(const bf16*)(ws + WS_XN), (const bf16*)(ws + WS_W_GU1), MR, NGU, DM}; pg8::StaticOrder S; S.init(MR, NGU, F.G, (int)blockIdx.x);
        pg8::EpiSwiglu E{(bf16*)(ws + WS_BIG), DFF};
        pg8::gemm_phase<pg8::EpiSwiglu, pg8::StaticOrder, true, true>(F.lds, g, S, E, F.wave);
        p0_deferred(F, args, (MR / 256) * (NGU / 256), P0_NITEMS - P0_DEFER_B, P0_DEFER_B); SEAM(16); }
    if (IN(17)) { REFRESH();
        pg8::Gemm g{(const bf16*)(ws + WS_BIG), (const bf16*)(ws + WS_W_DN1), MR, DM, DFF}; pg8::StaticOrder S; S.init(MR, DM, F.G, (int)blockIdx.x);
        pg8::EpiRes<pg8::f16_t, float> E{H, args.dry ? (float*)(ws + WS_END) : args.out, DM};
        pg8::gemm_phase<pg8::EpiRes<pg8::f16_t, float>, pg8::StaticOrder, true, true>(F.lds, g, S, E, F.wave); }
#undef REFRESH
#undef IN
#undef SEAM
}

__global__ void mk_dump(const unsigned char* src, int is_bf16, size_t n_src, float* out, size_t n_out) {
    for (size_t i = (size_t)blockIdx.x * blockDim.x + threadIdx.x; i < n_out; i += (size_t)gridDim.x * blockDim.x) { const size_t j = i % n_src;
        out[i] = is_bf16 ? bf2f(((const unsigned short*)src)[j]) : ((const float*)src)[j]; }
}
extern "C" void kernel_launch(void* const* d_in, const int* in_sizes, int n_in, void* d_out, int out_size, void* d_ws, size_t ws_size, hipStream_t stream) {
    static int grid = 0;
    if (grid == 0) {
        if (n_in != 23 || out_size != MR * DM || ws_size < WS_END) { fprintf(stderr, "kernel_launch: unexpected shapes (n_in %d, out %d, ws %zu < %zu)\n", n_in, out_size, ws_size, (size_t)WS_END); grid = -1; return; }
        int dev = 0, cus = 0, per_cu = 0;
        if (hipGetDevice(&dev) != hipSuccess || hipDeviceGetAttribute(&cus, hipDeviceAttributeMultiprocessorCount, dev) != hipSuccess) { grid = -1; return; }
        if (hipFuncSetAttribute((const void*)mk_fwd, hipFuncAttributeMaxDynamicSharedMemorySize, LDS_BYTES) != hipSuccess) { fprintf(stderr, "kernel_launch: hipFuncSetAttribute failed\n"); grid = -1; return; }
        if (hipOccupancyMaxActiveBlocksPerMultiprocessor(&per_cu, (const void*)mk_fwd, NTHR, LDS_BYTES) != hipSuccess || per_cu < 1) fprintf(stderr, "kernel_launch: occupancy query reports %d\n", per_cu);
        (void)hipGetLastError();
        grid = cus;
    }
    if (grid < 0) return;
    (void)hipMemsetAsync((char*)d_ws + WS_CTL, 0, CTL_ZERO_BYTES, stream);
    Args a{};
    for (int i = 0; i < 23; ++i) a.in[i] = d_in[i];
    a.out = (float*)d_out; a.ws = (unsigned char*)d_ws;
#if defined(MK_STOP_AFTER)
    for (int p = 0; p <= MK_STOP_AFTER; ++p) { a.ph_lo = p; a.ph_hi = p + 1; hipLaunchKernelGGL(mk_fwd, dim3(grid), dim3(NTHR), LDS_BYTES, stream, a); }
#if defined(MK_DUMP_OFF)
    hipLaunchKernelGGL(mk_dump, dim3(2048), dim3(256), 0, stream, (const unsigned char*)d_ws + (size_t)(MK_DUMP_OFF) * MiB, (int)(MK_DUMP_BF16), (size_t)(MK_DUMP_N), (float*)d_out, (size_t)out_size);
#endif
#elif MK_N_LAUNCHES == 1
    a.ph_lo = 0; a.ph_hi = NPH;
    hipLaunchKernelGGL(mk_fwd, dim3(grid), dim3(NTHR), LDS_BYTES, stream, a);
#else
    for (int p = 0; p < NPH; ++p) { a.ph_lo = p; a.ph_hi = p + 1;
#if defined(MK_REPEAT_PHASE)
        if (((MK_REPEAT_PHASE) >> p) & 1) { a.dry = 1; for (int rr = 0; rr < (MK_REPEAT_N); ++rr) hipLaunchKernelGGL(mk_fwd, dim3(grid), dim3(NTHR), LDS_BYTES, stream, a); a.dry = 0; }
#endif
        hipLaunchKernelGGL(mk_fwd, dim3(grid), dim3(NTHR), LDS_BYTES, stream, a);
#if defined(MK_REPEAT_PHASE)
#endif
    }
#endif
}
```

```cpp
#include <hip/hip_runtime.h>
#include <cstdio>
#include <cstdint>
#ifndef MK_N_LAUNCHES
#define MK_N_LAUNCHES 0
#endif
#undef MK_N_LAUNCHES
#define MK_N_LAUNCHES 1
namespace pg8 {
#define PG8_LAS __attribute__((address_space(3)))
typedef unsigned short bf16_t;
typedef short bf16x8 __attribute__((ext_vector_type(8)));
typedef float f32x4 __attribute__((ext_vector_type(4)));
typedef unsigned u32x4 __attribute__((ext_vector_type(4)));
constexpr int BM = 256, BK = 64, HALF = 128, HTB = HALF * BK * 2  , STAGE_BYTES = 8 * HTB, NXCD = 8, WGM = 8;

__host__ __device__ __forceinline__ int lds_byte(int r, int c) { const int st = (r >> 4) * 2 + (c >> 5), rr = r & 15, cc = c & 31, ob = rr * 64 + cc * 2; return st * 1024 + (ob ^ (((ob >> 9) & 1) << 5)); }
__host__ __device__ __forceinline__ void stage_rc(int b, int& R, int& C) { const int st = b / 1024, sb = b % 1024, swz = sb ^ (((sb >> 9) & 1) << 5); R = (st >> 1) * 16 + swz / 64; C = (st & 1) * 32 + (swz % 64) / 2; }
__host__ __device__ __forceinline__ int perm32(int rho) { const int n = rho >> 4, i = rho & 15; return 8 * (i >> 2) + 4 * n + (i & 3); }

struct Unit { int pm, pn; };
struct Gemm { const bf16_t* A; const bf16_t* Bt; int M, N, K; int sB = 0x7F7F7F7F, sA = 0x7F7F7F7F; };
typedef int i32x8 __attribute__((ext_vector_type(8))); typedef int i32x4 __attribute__((ext_vector_type(4)));
__device__ __forceinline__ i32x8 cat8(bf16x8 a, bf16x8 b) { const i32x4 x = __builtin_bit_cast(i32x4, a), y = __builtin_bit_cast(i32x4, b); return __builtin_shufflevector(x, y, 0, 1, 2, 3, 4, 5, 6, 7); }

struct StaticOrder {
    int nM, nN, nwg, G, c;
    __host__ __device__ void init(int M, int N, int G_, int c_) { nM = M / BM; nN = N / BM; nwg = nM * nN; G = G_; c = c_; }
    __host__ __device__ bool next(int i, Unit& u) const {
        const long L = (long)i * G + c; if (L >= nwg) return false;
        int wgid = (int)L; { const int q = nwg / NXCD, r = nwg % NXCD, xcd = wgid % NXCD, off = wgid / NXCD; wgid = (xcd < r ? xcd * (q + 1) : r * (q + 1) + (xcd - r) * q) + off; }
        const int nig = WGM * nN, gid = wgid / nig, fm = gid * WGM, gsz = (nM - fm) < WGM ? (nM - fm) : WGM;
        u.pm = fm + ((wgid % nig) % gsz); u.pn = (wgid % nig) / gsz; return true;
    }
    __device__ __forceinline__ void a_ready(const Unit&) const {}
    __device__ __forceinline__ void done(const Unit&) const {}
};

typedef float f32x2_cv __attribute__((ext_vector_type(2))); typedef __bf16 bf16x2_cv __attribute__((ext_vector_type(2)));
__device__ __forceinline__ unsigned cvt_pk_bf16(float lo, float hi) { const f32x2_cv v = {lo, hi}; const bf16x2_cv b = __builtin_convertvector(v, bf16x2_cv); return __builtin_bit_cast(unsigned, b); }
__host__ __device__ __forceinline__ int v_img_off8(int k, int d) { return k * 128 + ((((d >> 5) ^ (((k >> 1) & 1) | (((k >> 3) & 1) << 1))) & 3) << 5) + (d & 31); }
__host__ __device__ __forceinline__ int v_st(int k, int c) { const int kk = (k & ~0xC) | ((k & 4) << 1) | ((k & 8) >> 1); return ((kk >> 3) * 4 + (c >> 5)) * 512 + ((kk & 7) * 32 + (c & 31)) * 2; }

struct EpiBf16 {
    static constexpr bool PERM = true, AFTER_DRAIN = false, INIT = false;
    bf16_t* O; int ldc;
    __device__ __forceinline__ void operator()(const f32x4 (&acc)[2][2][4][2], const Unit& u, int wr, int wc, int fr, int fq) const {
        const int row0 = u.pm * BM + wr * 64 + fr, col0 = u.pn * BM + wc * 32 + 8 * fq;
#pragma unroll
        for (int ai = 0; ai < 2; ++ai)
#pragma unroll
            for (int m = 0; m < 4; ++m) { bf16_t* rowp = O + (size_t)(row0 + ai * HALF + m * 16) * ldc + col0;
#pragma unroll
                for (int bj = 0; bj < 2; ++bj) { const f32x4 v0 = acc[ai][bj][m][0], v1 = acc[ai][bj][m][1];
                    u32x4 w; w.x = cvt_pk_bf16(v0[0], v0[1]); w.y = cvt_pk_bf16(v0[2], v0[3]); w.z = cvt_pk_bf16(v1[0], v1[1]); w.w = cvt_pk_bf16(v1[2], v1[3]);
                    *(u32x4*)(rowp + bj * HALF) = w; } }
    }
};
struct EpiF32 {
    static constexpr bool PERM = false, AFTER_DRAIN = false, INIT = false;
    float* C; int ldc;
    __device__ __forceinline__ void operator()(const f32x4 (&acc)[2][2][4][2], const Unit& u, int wr, int wc, int fr, int fq) const {
        const int row0 = u.pm * BM + wr * 64 + fr, col0 = u.pn * BM + wc * 32 + 4 * fq;
#pragma unroll
        for (int ai = 0; ai < 2; ++ai)
#pragma unroll
            for (int m = 0; m < 4; ++m) { float* rowp = C + (size_t)(row0 + ai * HALF + m * 16) * ldc + col0;
#pragma unroll
                for (int bj = 0; bj < 2; ++bj)
#pragma unroll
                    for (int n = 0; n < 2; ++n) *(f32x4*)(rowp + bj * HALF + n * 16) = acc[ai][bj][m][n]; }
    }
};
struct EpiResF32 {
    static constexpr bool PERM = false, AFTER_DRAIN = false, INIT = false;
    const float* base; float* out; int ldc;
    __device__ __forceinline__ void init(f32x4 (&acc)[2][2][4][2], const Unit& u, int wr, int wc, int fr, int fq) const {}
    __device__ __forceinline__ void operator()(const f32x4 (&acc)[2][2][4][2], const Unit& u, int wr, int wc, int fr, int fq) const {
        const int row0 = u.pm * BM + wr * 64 + fr, col0 = u.pn * BM + wc * 32 + 4 * fq;
#pragma unroll
        for (int ai = 0; ai < 2; ++ai)
#pragma unroll
            for (int m = 0; m < 4; ++m) { const size_t off = (size_t)(row0 + ai * HALF + m * 16) * ldc + col0;
#pragma unroll
                for (int bj = 0; bj < 2; ++bj)
#pragma unroll
                    for (int n = 0; n < 2; ++n) { const f32x4 b = *(const f32x4*)(base + off + bj * HALF + n * 16); *(f32x4*)(out + off + bj * HALF + n * 16) = b + acc[ai][bj][m][n]; } }
    }
};
typedef _Float16 f16_t; typedef _Float16 f16x2_cv __attribute__((ext_vector_type(2)));
__device__ __forceinline__ unsigned cvt_pk_f16(float lo, float hi) { const f32x2_cv v = {lo, hi}; const f16x2_cv b = __builtin_convertvector(v, f16x2_cv); return __builtin_bit_cast(unsigned, b); }
__device__ __forceinline__ float f16lo(unsigned w) { return (float)__builtin_bit_cast(f16x2_cv, w)[0]; }
__device__ __forceinline__ float f16hi(unsigned w) { return (float)__builtin_bit_cast(f16x2_cv, w)[1]; }
template <class TI, class TO> struct EpiRes {
    static constexpr bool PERM = true, AFTER_DRAIN = false, INIT = false;
    const TI* base; TO* out; int ldc;
    __device__ __forceinline__ void operator()(const f32x4 (&acc)[2][2][4][2], const Unit& u, int wr, int wc, int fr, int fq) const {
        const int row0 = u.pm * BM + wr * 64 + fr, col0 = u.pn * BM + wc * 32 + 8 * fq;
#pragma unroll
        for (int ai = 0; ai < 2; ++ai)
#pragma unroll
            for (int m = 0; m < 4; ++m) { const size_t off = (size_t)(row0 + ai * HALF + m * 16) * ldc + col0;
#pragma unroll
                for (int bj = 0; bj < 2; ++bj) { f32x4 v0 = acc[ai][bj][m][0], v1 = acc[ai][bj][m][1];
                    if constexpr (sizeof(TI) == 4) { v0 += *(const f32x4*)(base + off + bj * HALF); v1 += *(const f32x4*)(base + off + bj * HALF + 4); }
                    else { const u32x4 b = *(const u32x4*)(base + off + bj * HALF);
                        v0[0] += f16lo(b.x); v0[1] += f16hi(b.x); v0[2] += f16lo(b.y); v0[3] += f16hi(b.y); v1[0] += f16lo(b.z); v1[1] += f16hi(b.z); v1[2] += f16lo(b.w); v1[3] += f16hi(b.w); }
                    if constexpr (sizeof(TO) == 4) { *(f32x4*)(out + off + bj * HALF) = v0; *(f32x4*)(out + off + bj * HALF + 4) = v1; }
                    else { u32x4 w; w.x = cvt_pk_f16(v0[0], v0[1]); w.y = cvt_pk_f16(v0[2], v0[3]); w.z = cvt_pk_f16(v1[0], v1[1]); w.w = cvt_pk_f16(v1[2], v1[3]); *(u32x4*)(out + off + bj * HALF) = w; } } }
    }
};
__device__ __forceinline__ float silu_mul(float g, float u) { return g * __builtin_amdgcn_rcpf(1.0f + __expf(-g)) * u; }
struct EpiSwiglu {
    static constexpr bool PERM = true, AFTER_DRAIN = false, INIT = false;
    bf16_t* O; int ldc;
    __device__ __forceinline__ void operator()(const f32x4 (&acc)[2][2][4][2], const Unit& u, int wr, int wc, int fr, int fq) const {
        const int row0 = u.pm * BM + wr * 64 + fr, col0 = u.pn * HALF + wc * 32 + 8 * fq;
#pragma unroll
        for (int ai = 0; ai < 2; ++ai)
#pragma unroll
            for (int m = 0; m < 4; ++m) { bf16_t* rowp = O + (size_t)(row0 + ai * HALF + m * 16) * ldc + col0;
                const f32x4 g0 = acc[ai][0][m][0], g1 = acc[ai][0][m][1], u0 = acc[ai][1][m][0], u1 = acc[ai][1][m][1];
                u32x4 w; w.x = cvt_pk_bf16(silu_mul(g0[0], u0[0]), silu_mul(g0[1], u0[1])); w.y = cvt_pk_bf16(silu_mul(g0[2], u0[2]), silu_mul(g0[3], u0[3]));
                w.z = cvt_pk_bf16(silu_mul(g1[0], u1[0]), silu_mul(g1[1], u1[1])); w.w = cvt_pk_bf16(silu_mul(g1[2], u1[2]), silu_mul(g1[3], u1[3]));
                *(u32x4*)rowp = w; }
    }
};
struct EpiKvUp {
    static constexpr bool PERM = true, AFTER_DRAIN = false, INIT = false;
    bf16_t* KN; bf16_t* V;
    __device__ __forceinline__ void operator()(const f32x4 (&acc)[2][2][4][2], const Unit& u, int wr, int wc, int fr, int fq) const {
        const int row0 = u.pm * BM + wr * 64 + fr, colL = wc * 32 + 8 * fq;
#pragma unroll
        for (int ai = 0; ai < 2; ++ai)
#pragma unroll
            for (int m = 0; m < 4; ++m) { const int row = row0 + ai * HALF + m * 16, b = row >> 12, key = 16 + (row & 4095);
#pragma unroll
                for (int bj = 0; bj < 2; ++bj) { const f32x4 v0 = acc[ai][bj][m][0], v1 = acc[ai][bj][m][1];
                    u32x4 w; w.x = cvt_pk_bf16(v0[0], v0[1]); w.y = cvt_pk_bf16(v0[2], v0[3]); w.z = cvt_pk_bf16(v1[0], v1[1]); w.w = cvt_pk_bf16(v1[2], v1[3]);
                    if (bj == 0) *(u32x4*)(KN + (size_t)row * 8192 + u.pn * HALF + colL) = w;
                    else { typedef unsigned u32x2 __attribute__((ext_vector_type(2))); u32x2 w8;
                        int x = __builtin_amdgcn_cvt_pk_fp8_f32(v0[0] * 16.f, v0[1] * 16.f, 0, false); x = __builtin_amdgcn_cvt_pk_fp8_f32(v0[2] * 16.f, v0[3] * 16.f, x, true); w8.x = (unsigned)x;
                        x = __builtin_amdgcn_cvt_pk_fp8_f32(v1[0] * 16.f, v1[1] * 16.f, 0, false); x = __builtin_amdgcn_cvt_pk_fp8_f32(v1[2] * 16.f, v1[3] * 16.f, x, true); w8.y = (unsigned)x;
                        *(u32x2*)((char*)V + ((size_t)((b * 64 + u.pn) * 65 + (key >> 6))) * 8192 + v_img_off8(key & 63, colL)) = w8; } } }
    }
};
struct EpiF16 {
    static constexpr bool PERM = true, AFTER_DRAIN = false, INIT = false;
    f16_t* O; int ldc;
    __device__ __forceinline__ void operator()(const f32x4 (&acc)[2][2][4][2], const Unit& u, int wr, int wc, int fr, int fq) const {
        const int row0 = u.pm * BM + wr * 64 + fr, col0 = u.pn * BM + wc * 32 + 8 * fq;
#pragma unroll
        for (int ai = 0; ai < 2; ++ai)
#pragma unroll
            for (int m = 0; m < 4; ++m) { f16_t* rowp = O + (size_t)(row0 + ai * HALF + m * 16) * ldc + col0;
#pragma unroll
                for (int bj = 0; bj < 2; ++bj) { const f32x4 v0 = acc[ai][bj][m][0], v1 = acc[ai][bj][m][1];
                    u32x4 w; w.x = cvt_pk_f16(v0[0], v0[1]); w.y = cvt_pk_f16(v0[2], v0[3]); w.z = cvt_pk_f16(v1[0], v1[1]); w.w = cvt_pk_f16(v1[2], v1[3]);
                    *(u32x4*)(rowp + bj * HALF) = w; } }
    }
};
struct EpiF8 {
    static constexpr bool PERM = true, AFTER_DRAIN = false, INIT = false;
    unsigned char* O; int ldc;
    __device__ __forceinline__ void operator()(const f32x4 (&acc)[2][2][4][2], const Unit& u, int wr, int wc, int fr, int fq) const {
        typedef unsigned u32x2 __attribute__((ext_vector_type(2)));
        const int row0 = u.pm * BM + wr * 64 + fr, col0 = u.pn * BM + wc * 32 + 8 * fq;
#pragma unroll
        for (int ai = 0; ai < 2; ++ai)
#pragma unroll
            for (int m = 0; m < 4; ++m) { unsigned char* rowp = O + (size_t)(row0 + ai * HALF + m * 16) * ldc + col0;
#pragma unroll
                for (int bj = 0; bj < 2; ++bj) { const f32x4 v0 = acc[ai][bj][m][0], v1 = acc[ai][bj][m][1]; u32x2 w8;
                    int x = __builtin_amdgcn_cvt_pk_fp8_f32(v0[0] * 16.f, v0[1] * 16.f, 0, false); x = __builtin_amdgcn_cvt_pk_fp8_f32(v0[2] * 16.f, v0[3] * 16.f, x, true); w8.x = (unsigned)x;
                    x = __builtin_amdgcn_cvt_pk_fp8_f32(v1[0] * 16.f, v1[1] * 16.f, 0, false); x = __builtin_amdgcn_cvt_pk_fp8_f32(v1[2] * 16.f, v1[3] * 16.f, x, true); w8.y = (unsigned)x;
                    *(u32x2*)(rowp + bj * HALF) = w8; } }
    }
};
__host__ __device__ __forceinline__ int k_img_off8(int r, int d) { return r * 192 + ((((d >> 4) + (r >> 2)) % 12) << 4) + (d & 15); }
struct EpiKvUpK {
    static constexpr bool PERM = true, AFTER_DRAIN = false, INIT = false;
    unsigned char* Kimg; bf16_t* V; const float* PRE; const float* SSR; const float* gk; PG8_LAS float* red;
    __device__ __forceinline__ void operator()(const f32x4 (&acc)[2][2][4][2], const Unit& u, int wr, int wc, int fr, int fq) const {
        typedef unsigned u32x2 __attribute__((ext_vector_type(2)));
        asm volatile("" : "+v"(fr), "+v"(fq));
        const int rl0 = wr * 64 + fr, colL = wc * 32 + 8 * fq;
#pragma unroll
        for (int j = 0; j < 8; ++j) { const f32x4 v0 = acc[j >> 2][0][j & 3][0], v1 = acc[j >> 2][0][j & 3][1];
            float s = ((v0[0] * v0[0] + v0[1] * v0[1]) + (v0[2] * v0[2] + v0[3] * v0[3])) + ((v1[0] * v1[0] + v1[1] * v1[1]) + (v1[2] * v1[2] + v1[3] * v1[3]));
            s += __shfl_xor(s, 16); s += __shfl_xor(s, 32);
            if (fq == 0) red[(rl0 + (j >> 2) * HALF + (j & 3) * 16) * 4 + wc] = s; }
        asm volatile("s_waitcnt lgkmcnt(0)" ::: "memory"); __builtin_amdgcn_s_barrier(); asm volatile("" ::: "memory");
        int rowv = u.pm * BM + rl0; asm volatile("" : "+v"(rowv));
        const int rlA = rl0 + (fq >> 1) * HALF + (fq & 1) * 32, rowA = rowv + (fq >> 1) * HALF + (fq & 1) * 32;
        float rA, rB;
        { const float sA = SSR[(unsigned)rowA], sB = SSR[(unsigned)rowA + 16u]; const f32x4 tA = *(const PG8_LAS f32x4*)(red + rlA * 4), tB = *(const PG8_LAS f32x4*)(red + (rlA + 16) * 4);
          rA = 16.0f / sqrtf((((tA[0] + tA[1]) + (tA[2] + tA[3])) + sA) * (1.0f / 192.0f) + 1e-6f); rB = 16.0f / sqrtf((((tB[0] + tB[1]) + (tB[2] + tB[3])) + sB) * (1.0f / 192.0f) + 1e-6f); }
        __builtin_amdgcn_sched_barrier(0);
        const f32x4 ga = *(const f32x4*)(gk + colL), gb = *(const f32x4*)(gk + colL + 4);
#pragma unroll
        for (int j = 0; j < 8; ++j) { const int row = rowv + (j >> 2) * HALF + (j & 3) * 16, key = 16 + (row & 4095); const unsigned tile = (unsigned)(((row >> 12) * 64 + u.pn) * 65 + (key >> 6));
            const float rr = __shfl((j & 1) ? rB : rA, fr + 16 * (j >> 1));
            { const f32x4 v0 = acc[j >> 2][0][j & 3][0], v1 = acc[j >> 2][0][j & 3][1]; u32x2 w8;
                int x = __builtin_amdgcn_cvt_pk_fp8_f32(v0[0] * ga[0] * rr, v0[1] * ga[1] * rr, 0, false); x = __builtin_amdgcn_cvt_pk_fp8_f32(v0[2] * ga[2] * rr, v0[3] * ga[3] * rr, x, true); w8.x = (unsigned)x;
                x = __builtin_amdgcn_cvt_pk_fp8_f32(v1[0] * gb[0] * rr, v1[1] * gb[1] * rr, 0, false); x = __builtin_amdgcn_cvt_pk_fp8_f32(v1[2] * gb[2] * rr, v1[3] * gb[3] * rr, x, true); w8.y = (unsigned)x;
                *(u32x2*)(Kimg + (tile * 12288u + (unsigned)k_img_off8(key & 63, colL))) = w8; }
            { const f32x4 v0 = acc[j >> 2][1][j & 3][0], v1 = acc[j >> 2][1][j & 3][1]; u32x2 w8;
                int x = __builtin_amdgcn_cvt_pk_fp8_f32(v0[0] * 16.f, v0[1] * 16.f, 0, false); x = __builtin_amdgcn_cvt_pk_fp8_f32(v0[2] * 16.f, v0[3] * 16.f, x, true); w8.x = (unsigned)x;
                x = __builtin_amdgcn_cvt_pk_fp8_f32(v1[0] * 16.f, v1[1] * 16.f, 0, false); x = __builtin_amdgcn_cvt_pk_fp8_f32(v1[2] * 16.f, v1[3] * 16.f, x, true); w8.y = (unsigned)x;
                *(u32x2*)((unsigned char*)V + (tile * 8192u + (unsigned)v_img_off8(key & 63, colL))) = w8; }
            if (j & 1) __builtin_amdgcn_sched_barrier(0); }
#pragma unroll
        for (int x2 = 0; x2 < 2; ++x2) { const float rr = x2 ? rB : rA;
            const int row = rowA + 16 * x2, key = 16 + (row & 4095); const unsigned tile = (unsigned)(((row >> 12) * 64 + u.pn) * 65 + (key >> 6));
            const float* pp = (const float*)((const char*)PRE + (unsigned)(row * 256 + 64 * wc)); const f32x4 p0 = *(const f32x4*)pp, p1 = *(const f32x4*)(pp + 4), p2 = *(const f32x4*)(pp + 8), p3 = *(const f32x4*)(pp + 12);
            u32x4 w; int x = __builtin_amdgcn_cvt_pk_fp8_f32(p0[0] * rr, p0[1] * rr, 0, false); x = __builtin_amdgcn_cvt_pk_fp8_f32(p0[2] * rr, p0[3] * rr, x, true); w.x = (unsigned)x;
            x = __builtin_amdgcn_cvt_pk_fp8_f32(p1[0] * rr, p1[1] * rr, 0, false); x = __builtin_amdgcn_cvt_pk_fp8_f32(p1[2] * rr, p1[3] * rr, x, true); w.y = (unsigned)x;
            x = __builtin_amdgcn_cvt_pk_fp8_f32(p2[0] * rr, p2[1] * rr, 0, false); x = __builtin_amdgcn_cvt_pk_fp8_f32(p2[2] * rr, p2[3] * rr, x, true); w.z = (unsigned)x;
            x = __builtin_amdgcn_cvt_pk_fp8_f32(p3[0] * rr, p3[1] * rr, 0, false); x = __builtin_amdgcn_cvt_pk_fp8_f32(p3[2] * rr, p3[3] * rr, x, true); w.w = (unsigned)x;
            *(u32x4*)(Kimg + (tile * 12288u + (unsigned)k_img_off8(key & 63, 128 + 16 * wc))) = w;
            __builtin_amdgcn_sched_barrier(0); }
    }
};

template <class Epi, class Sched, bool ALIGN_EPI = false, bool SP2 = false, bool F8 = false>
__device__ __forceinline__ void gemm_phase(PG8_LAS unsigned char* lds, const Gemm g, const Sched& S, const Epi& E, int wave_id) {
    const int wid = wave_id, lane = (int)__builtin_amdgcn_mbcnt_hi(~0u, __builtin_amdgcn_mbcnt_lo(~0u, 0u)), tid = wid * 64 + lane, wr = wid >> 2, wc = wid & 3, fr = lane & 15, fq = lane >> 4;
    const int K = g.K, nt = K / BK;
    unsigned voffA[2], voffB[2];
#pragma unroll
    for (int i = 0; i < 2; ++i) { int R, C; stage_rc(tid * 16 + i * 8192, R, C); const int Rb = Epi::PERM ? ((R & ~31) + perm32(R & 31)) : R;
        voffA[i] = (unsigned)(R * K + C) * 2u; voffB[i] = (unsigned)(Rb * K + C) * 2u; }
    const size_t kstep = (size_t)(BK * 2);
    const size_t hstep = (size_t)HALF * K * 2;
    const size_t tstep = 2 * hstep;
    const unsigned ldsw = (unsigned)wid * 1024u;
    const int aoff = lds_byte(wr * 64 + fr, fq * 8), boff = lds_byte(wc * 32 + fr, fq * 8);
#define PG8_SA(b, h) (((b) * 2 + (h)) * HTB)
#define PG8_SB(b, h) ((4 + (b) * 2 + (h)) * HTB)
#define PG8_STAGE(bufoff, gbase, voff) do { _Pragma("unroll") for (int _i = 0; _i < 2; ++_i) \
        __builtin_amdgcn_global_load_lds((const unsigned*)((const char*)(gbase) + (voff)[_i]), (PG8_LAS unsigned*)(lds + (bufoff) + ldsw + _i * 8192), 16, 0, 0); } while (0)
#define PG8_LDA(dst, b, h) do { if constexpr (F8) { _Pragma("unroll") for (int m = 0; m < 4; ++m) dst##8[m] = cat8(*(const PG8_LAS bf16x8*)(lds + PG8_SA(b, h) + aoff + m * 2048), *(const PG8_LAS bf16x8*)(lds + PG8_SA(b, h) + aoff + m * 2048 + 1024)); } \
        else { _Pragma("unroll") for (int m = 0; m < 4; ++m) _Pragma("unroll") for (int k = 0; k < 2; ++k) dst[m][k] = *(const PG8_LAS bf16x8*)(lds + PG8_SA(b, h) + aoff + m * 2048 + k * 1024); } } while (0)
#define PG8_LDB(dst, b, h) do { if constexpr (F8) { _Pragma("unroll") for (int n = 0; n < 2; ++n) dst##8[n] = cat8(*(const PG8_LAS bf16x8*)(lds + PG8_SB(b, h) + boff + n * 2048), *(const PG8_LAS bf16x8*)(lds + PG8_SB(b, h) + boff + n * 2048 + 1024)); } \
        else { _Pragma("unroll") for (int n = 0; n < 2; ++n) _Pragma("unroll") for (int k = 0; k < 2; ++k) dst[n][k] = *(const PG8_LAS bf16x8*)(lds + PG8_SB(b, h) + boff + n * 2048 + k * 1024); } } while (0)
#define PG8_MMA(ai, bj, At, Bt) do { __builtin_amdgcn_s_setprio(1); \
        if constexpr (F8) { _Pragma("unroll") for (int m = 0; m < 4; ++m) _Pragma("unroll") for (int n = 0; n < 2; ++n) \
            asm volatile("v_mfma_f32_16x16x128_f8f6f4 %0, %1, %2, %0" : "+v"(acc[ai][bj][m][n]) : "v"(Bt##8[n]), "v"(At##8[m])); } \
        else { _Pragma("unroll") for (int m = 0; m < 4; ++m) _Pragma("unroll") for (int n = 0; n < 2; ++n) _Pragma("unroll") for (int k = 0; k < 2; ++k) \
            acc[ai][bj][m][n] = __builtin_amdgcn_mfma_f32_16x16x32_bf16(Bt[n][k], At[m][k], acc[ai][bj][m][n], 0, 0, 0); } \
        __builtin_amdgcn_s_setprio(0); } while (0)
#define PG8_WAIT_V(n) asm volatile("s_waitcnt vmcnt(" #n ")" ::: "memory")
#define PG8_WAIT_L(n) asm volatile("s_waitcnt lgkmcnt(" #n ")" ::: "memory")
#define PG8_BAR __builtin_amdgcn_s_barrier()
#define PG8_SCHED __builtin_amdgcn_sched_barrier(0)
    Unit cur, nxt; int ui = 0;
    if (!S.next(0, cur)) return;
    f32x4 acc[2][2][4][2];
    if constexpr (Epi::INIT) E.init(acc, cur, wr, wc, fr, fq);
    else {
#pragma unroll
    for (int a = 0; a < 2; ++a)
#pragma unroll
        for (int b = 0; b < 2; ++b)
#pragma unroll
            for (int m = 0; m < 4; ++m)
#pragma unroll
                for (int n = 0; n < 2; ++n) acc[a][b][m][n] = (f32x4){0.f, 0.f, 0.f, 0.f};
    }
    bf16x8 At[F8 ? 1 : 4][2], B0[F8 ? 1 : 2][2], B1[F8 ? 1 : 2][2];
    const int f8sB = g.sB, f8sA = g.sA;
    i32x8 At8[F8 ? 4 : 1], B08[F8 ? 2 : 1], B18[F8 ? 2 : 1];
    const char* cA = (const char*)g.A + (size_t)cur.pm * tstep; const char* cB = (const char*)g.Bt + (size_t)cur.pn * tstep;
    S.a_ready(cur);
    if constexpr (SP2) {
        PG8_STAGE(PG8_SB(0, 0), cB, voffB); PG8_STAGE(PG8_SB(0, 1), cB + hstep, voffB); PG8_STAGE(PG8_SA(0, 0), cA, voffA); PG8_STAGE(PG8_SA(0, 1), cA + hstep, voffA);
        if (wr == 1) PG8_BAR;
        PG8_WAIT_V(2); PG8_BAR;
        PG8_STAGE(PG8_SB(1, 0), cB + kstep, voffB); PG8_STAGE(PG8_SA(1, 0), cA + kstep, voffA); PG8_STAGE(PG8_SB(1, 1), cB + hstep + kstep, voffB);
        PG8_WAIT_V(6); PG8_BAR;
    } else {
        PG8_STAGE(PG8_SB(0, 0), cB, voffB); PG8_STAGE(PG8_SA(0, 0), cA, voffA); PG8_STAGE(PG8_SB(0, 1), cB + hstep, voffB); PG8_STAGE(PG8_SA(0, 1), cA + hstep, voffA);
        if (wr == 1) PG8_BAR;
        PG8_WAIT_V(4); PG8_BAR;
        PG8_STAGE(PG8_SB(1, 0), cB + kstep, voffB); PG8_STAGE(PG8_SA(1, 0), cA + kstep, voffA); PG8_STAGE(PG8_SB(1, 1), cB + hstep + kstep, voffB);
        PG8_WAIT_V(6); PG8_BAR;
    }
    for (;;) {
        const bool has_next = S.next(ui + 1, nxt);
        const char* nA = has_next ? (const char*)g.A + (size_t)nxt.pm * tstep : cA; const char* nB = has_next ? (const char*)g.Bt + (size_t)nxt.pn * tstep : cB;
        for (int t = 0; t < nt; t += 2) {
            const bool last = (t == nt - 2);
            const char* a1 = cA + (size_t)(t + 1) * kstep;
            const char* a2 = last ? nA : cA + (size_t)(t + 2) * kstep; const char* b2 = last ? nB : cB + (size_t)(t + 2) * kstep;
            const char* a3 = a2 + kstep; const char* b3 = b2 + kstep;
            if (last && has_next) S.a_ready(nxt);
            if constexpr (SP2) {
            PG8_LDB(B0, 0, 0); PG8_LDB(B1, 0, 1); PG8_SCHED; PG8_LDA(At, 0, 0); PG8_STAGE(PG8_SA(1, 1), a1 + hstep, voffA);
            PG8_WAIT_V(8); PG8_WAIT_L(0); PG8_BAR; PG8_MMA(0, 0, At, B0); PG8_MMA(0, 1, At, B1); PG8_BAR; PG8_SCHED;
            PG8_LDA(At, 0, 1); PG8_STAGE(PG8_SB(0, 0), b2, voffB); PG8_STAGE(PG8_SB(0, 1), b2 + hstep, voffB); PG8_STAGE(PG8_SA(0, 0), a2, voffA);
            PG8_WAIT_V(8); PG8_WAIT_L(0); PG8_BAR; PG8_MMA(1, 0, At, B0); PG8_MMA(1, 1, At, B1); PG8_BAR; PG8_SCHED;
            PG8_LDB(B0, 1, 0); PG8_LDB(B1, 1, 1); PG8_SCHED; PG8_LDA(At, 1, 0); PG8_STAGE(PG8_SA(0, 1), a2 + hstep, voffA);
            PG8_WAIT_V(8); PG8_WAIT_L(0); PG8_BAR; PG8_MMA(0, 0, At, B0); PG8_MMA(0, 1, At, B1); PG8_BAR; PG8_SCHED;
            PG8_LDA(At, 1, 1); PG8_STAGE(PG8_SB(1, 0), b3, voffB); PG8_STAGE(PG8_SB(1, 1), b3 + hstep, voffB); PG8_STAGE(PG8_SA(1, 0), a3, voffA);
            PG8_WAIT_V(8); PG8_WAIT_L(0); PG8_BAR; PG8_MMA(1, 0, At, B0); PG8_MMA(1, 1, At, B1); PG8_BAR; PG8_SCHED;
            } else {
            PG8_LDB(B0, 0, 0); PG8_SCHED; PG8_LDA(At, 0, 0); PG8_STAGE(PG8_SA(1, 1), a1 + hstep, voffA);
            PG8_WAIT_L(8); PG8_BAR; PG8_WAIT_L(0); PG8_MMA(0, 0, At, B0); PG8_BAR; PG8_SCHED;
            PG8_LDB(B1, 0, 1); PG8_STAGE(PG8_SB(0, 0), b2, voffB);
            PG8_BAR; PG8_WAIT_L(0); PG8_MMA(0, 1, At, B1); PG8_BAR;
            PG8_LDA(At, 0, 1); PG8_STAGE(PG8_SA(0, 0), a2, voffA);
            PG8_BAR; PG8_WAIT_L(0); PG8_MMA(1, 0, At, B0); PG8_BAR; PG8_SCHED;
            PG8_STAGE(PG8_SB(0, 1), b2 + hstep, voffB);
            PG8_WAIT_V(6); PG8_BAR; PG8_MMA(1, 1, At, B1); PG8_BAR;
            PG8_LDB(B0, 1, 0); PG8_SCHED; PG8_LDA(At, 1, 0); PG8_STAGE(PG8_SA(0, 1), a2 + hstep, voffA);
            PG8_WAIT_L(8); PG8_BAR; PG8_WAIT_L(0); PG8_MMA(0, 0, At, B0); PG8_BAR; PG8_SCHED;
            PG8_LDB(B1, 1, 1); PG8_STAGE(PG8_SB(1, 0), b3, voffB);
            PG8_BAR; PG8_WAIT_L(0); PG8_MMA(0, 1, At, B1); PG8_BAR;
            PG8_LDA(At, 1, 1); PG8_STAGE(PG8_SA(1, 0), a3, voffA);
            PG8_BAR; PG8_WAIT_L(0); PG8_MMA(1, 0, At, B0); PG8_BAR; PG8_SCHED;
            PG8_STAGE(PG8_SB(1, 1), b3 + hstep, voffB);
            PG8_WAIT_V(6); PG8_BAR; PG8_MMA(1, 1, At, B1); PG8_BAR;
            }
        }
        if constexpr (F8) { asm volatile("s_nop 15\n\ts_nop 15" ::: "memory");
            const float f8f = __builtin_ldexpf(1.0f, (f8sA & 0xff) + (f8sB & 0xff) - 254);
#pragma unroll
            for (int a_ = 0; a_ < 2; ++a_)
#pragma unroll
                for (int b_ = 0; b_ < 2; ++b_)
#pragma unroll
                    for (int m_ = 0; m_ < 4; ++m_)
#pragma unroll
                        for (int n_ = 0; n_ < 2; ++n_) acc[a_][b_][m_][n_] = acc[a_][b_][m_][n_] * f8f; }
        if constexpr (false) asm volatile("" ::: "memory");
        if constexpr (ALIGN_EPI) { if (wr == 0) PG8_BAR; }
        if constexpr (!Epi::AFTER_DRAIN) { E(acc, cur, wr, wc, fr, fq); S.done(cur); }
        if (!has_next) break;
        if constexpr (Epi::INIT) E.init(acc, nxt, wr, wc, fr, fq);
        else {
#pragma unroll
        for (int a = 0; a < 2; ++a)
#pragma unroll
            for (int b = 0; b < 2; ++b)
#pragma unroll
                for (int m = 0; m < 4; ++m)
#pragma unroll
                    for (int n = 0; n < 2; ++n) acc[a][b][m][n] = (f32x4){0.f, 0.f, 0.f, 0.f};
        }
        cur = nxt; cA = nA; cB = nB; ++ui;
        if constexpr (ALIGN_EPI) { if (wr == 1) PG8_BAR; }
    }
    PG8_WAIT_V(0);
    if constexpr (!ALIGN_EPI) { if (wr == 0) PG8_BAR; }
    PG8_BAR;
    if constexpr (Epi::AFTER_DRAIN) { E.fused(acc, cur, wr, wc, fr, fq, lds, wid, lane); S.done(cur); }
#undef PG8_SA
#undef PG8_SB
#undef PG8_STAGE
#undef PG8_LDA
#undef PG8_LDB
#undef PG8_MMA
#undef PG8_WAIT_V
#undef PG8_WAIT_L
#undef PG8_BAR
#undef PG8_SCHED
}
}

constexpr int BATCH = 4, SEQ = 4096, DM = 4096, NMETA = 16, MR = BATCH * SEQ  , MT = MR + NMETA  ;
constexpr int MHEADS = 8, MDK = 256, MDV = 512, NPROJ = 12288  , NIN = 12304  ;
constexpr int AH = 64, QLORA = 1024, KVLORA = 512, NOPE = 128, ROPE = 64, QKD = 192, VHD = 128;
constexpr int DFF = 11008, NGU = 2 * DFF;
constexpr int NKT = 65;
constexpr int NKVQ = 1792;
constexpr float EPS = 1e-6f;
constexpr float W_O_SCALE = 256.0f, ATT_O_SCALE = 16.0f, F8_W_SCALE = 256.0f, F8_A_SCALE = 16.0f;
constexpr int NWAVES = 8, NTHR = 512;

constexpr size_t MiB = 1u << 20;
constexpr size_t WS_CTL = 0, CTL_ZERO_BYTES = 1 * MiB;
constexpr size_t WS_HMETA = 1 * MiB;
constexpr size_t WS_GATES = 2 * MiB;
constexpr size_t WS_ROPE = 3 * MiB + 512 * 1024;
constexpr size_t WS_W_IN = 8 * MiB, WS_W_OUT = 105 * MiB, WS_W_GU0 = 137 * MiB, WS_W_GU1 = 309 * MiB, WS_W_DN0 = 481 * MiB, WS_W_DN1 = 567 * MiB;
constexpr size_t WS_W_KVQ = 653 * MiB, WS_W_KVUP = 667 * MiB, WS_W_UQ = 683 * MiB, WS_W_O = 707 * MiB;
constexpr size_t WS_W_O8 = WS_W_O, WS_W_KVQ8 = WS_W_O + 32 * MiB, WS_W_INO8 = WS_W_O + 39 * MiB, WS_W_UQ8 = WS_W_UQ, WS_W_KVUP8 = WS_W_O + 55 * MiB;
constexpr size_t WS_XN = 771 * MiB;
constexpr size_t WS_BIG = 900 * MiB;
constexpr size_t WS_HH = 1285 * MiB;
constexpr size_t WS_LAT = WS_HH, WS_CKVN = WS_HH + 113 * MiB;
constexpr size_t WS_CQN = 1415 * MiB;
constexpr size_t WS_KNOPE = 1447 * MiB;
constexpr size_t WS_V = 1704 * MiB;
constexpr size_t WS_K = 1964 * MiB;
constexpr size_t WS_H16 = 2354 * MiB;
constexpr size_t WS_PRE = 2482 * MiB;
constexpr size_t WS_SSR = 2486 * MiB;
constexpr size_t WS_END = 2488 * MiB;
static_assert(WS_W_IN + (size_t)NIN * DM * 2 <= WS_W_OUT && WS_W_GU0 + (size_t)NGU * DM * 2 <= WS_W_GU1 && WS_W_DN0 + (size_t)DM * DFF * 2 <= WS_W_DN1 && WS_W_KVQ + (size_t)NKVQ * DM * 2 <= WS_W_KVUP, "ws map");
static_assert(WS_XN + (size_t)MT * DM * 2 <= WS_BIG && WS_BIG + (size_t)MT * NPROJ * 2 <= WS_HH && WS_LAT + (size_t)MT * NKVQ * 4 <= WS_CKVN && WS_CKVN + (size_t)MT * KVLORA * 2 <= WS_CQN, "ws map");
static_assert(WS_KNOPE + (size_t)MT * 8192 * 2 <= WS_V && WS_V + (size_t)256 * NKT * 8192 <= WS_K && WS_K + (size_t)256 * NKT * 12288 <= WS_END && WS_ROPE + (size_t)MT * 64 * 4 <= WS_W_IN && WS_GATES + (size_t)16 * MT * 4 <= WS_ROPE, "ws map");

constexpr int RING_BYTES = 131072;
constexpr int LDSCTL_OFF = 143360, MISC_OFF = LDSCTL_OFF + 320;
constexpr int EPI_RED_OFF = 147456;
constexpr int LDS_BYTES = 151552;

#define GAS __attribute__((address_space(1)))
#define LAS __attribute__((address_space(3)))
typedef unsigned short bf16;
typedef unsigned v4u __attribute__((ext_vector_type(4)));
typedef unsigned v2u __attribute__((ext_vector_type(2)));
typedef float f32x4 __attribute__((ext_vector_type(4)));
typedef float f32x16 __attribute__((ext_vector_type(16)));
typedef short bf16x8 __attribute__((ext_vector_type(8)));
typedef short s16x4 __attribute__((ext_vector_type(4)));
typedef GAS unsigned gu32;
#define RLX_AGENT __ATOMIC_RELAXED, __HIP_MEMORY_SCOPE_AGENT
#define LDS_WAIT() asm volatile("s_waitcnt lgkmcnt(0)" ::: "memory")
#define VM_WAIT() asm volatile("s_waitcnt vmcnt(0)" ::: "memory")
#define SBAR() __builtin_amdgcn_sched_barrier(0)
__device__ __forceinline__ unsigned pk2(float lo, float hi) { return pg8::cvt_pk_bf16(lo, hi); }
__device__ __forceinline__ unsigned pk2a(float lo, float hi) { unsigned r; asm volatile("v_cvt_pk_bf16_f32 %0, %1, %2" : "=v"(r) : "v"(lo), "v"(hi)); return r; }
__device__ __forceinline__ float bf2f(unsigned short b) { return __uint_as_float((unsigned)b << 16); }
__device__ __forceinline__ float bflo(unsigned w) { return __uint_as_float(w << 16); }
__device__ __forceinline__ float bfhi(unsigned w) { return __uint_as_float(w & 0xffff0000u); }
#define XB_TMO      128
#define XB_XCNT(j)  (256  + 64 * (j))
#define XB_XSUB(j)  (1280 + 64 * (j))
#define XB_XGEN(j)  (2304 + 64 * (j))
#define XB_TOP      3328
#define XB_TOPGEN   3392
#define XCD_BAR_WORDS 3456
#define XB_SPIN_CAP (1u << 18)

__device__ __forceinline__ unsigned xb_ld(unsigned* p)              { return __hip_atomic_load(p, __ATOMIC_RELAXED, __HIP_MEMORY_SCOPE_AGENT); }
__device__ __forceinline__ unsigned xb_add(unsigned* p, unsigned v) { return __hip_atomic_fetch_add(p, v, __ATOMIC_RELAXED, __HIP_MEMORY_SCOPE_AGENT); }
__device__ __forceinline__ unsigned xb_xcc_id() { return (unsigned)__builtin_amdgcn_s_getreg((3 << 11) | 20) & 0xFu; }
#define XB_SPIN(cond, bar) do { unsigned _sp = 0; while (cond) { __builtin_amdgcn_s_sleep(1); \
    if ((++_sp & 255u) == 0u) { if (xb_ld(&(bar)[XB_TMO])) break; if (_sp > XB_SPIN_CAP) { atomicAdd(&(bar)[XB_TMO], 1u); break; } } } } while (0)

struct XcdBarrier {
    unsigned* bar; unsigned x;
    int wave;
    volatile LAS unsigned* st;
};

__device__ __forceinline__ XcdBarrier xcd_barrier_post(unsigned* bar, volatile LAS unsigned* st) {
    XcdBarrier b; b.bar = bar; b.x = xb_xcc_id(); b.st = st;
    if (threadIdx.x == 0) (void)xb_add(&bar[XB_XCNT(b.x)], 1u);
    return b;
}
__device__ __forceinline__ void xcd_barrier_complete(unsigned* bar, unsigned x, unsigned& nloc, unsigned& nx) {
    const unsigned G = gridDim.x * gridDim.y * gridDim.z;
    unsigned sum, cnt, mine, sp = 0u;
    for (;;) {
        sum = 0u; cnt = 0u; mine = 0u;
#pragma unroll
        for (unsigned j = 0; j < 16; ++j) { const unsigned c = xb_ld(&bar[XB_XCNT(j)]); sum += c; cnt += (c > 0u) ? 1u : 0u; mine = (j == x) ? c : mine; }
        if (sum == G) break;
        __builtin_amdgcn_s_sleep(1);
        if ((++sp & 255u) == 0u) { if (xb_ld(&bar[XB_TMO])) break; if (sp > XB_SPIN_CAP) { atomicAdd(&bar[XB_TMO], 1u); break; } }
    }
    nloc = mine > 0u ? mine : 1u; nx = cnt > 0u ? cnt : 1u;
}

__device__ __forceinline__ void xcd_barrier(const XcdBarrier& b) {
    asm volatile("s_waitcnt vmcnt(0)" ::: "memory");
    __syncthreads();
    if (b.wave == 0 && __builtin_amdgcn_mbcnt_hi(~0u, __builtin_amdgcn_mbcnt_lo(~0u, 0u)) == 0u) {
        unsigned* bar = b.bar;
        __builtin_amdgcn_s_waitcnt(0);
        unsigned nloc = b.st[0], nx = b.st[1];
        if (nloc == 0u) { xcd_barrier_complete(bar, b.x, nloc, nx); b.st[0] = nloc; b.st[1] = nx; }
        const unsigned old = xb_add(&bar[XB_XSUB(b.x)], 1u);
        const unsigned gen = old / nloc;
        if (old + 1u == (gen + 1u) * nloc) {
            __builtin_amdgcn_fence(__ATOMIC_RELEASE, "agent");
            asm volatile("s_waitcnt vmcnt(0)" ::: "memory");
            const unsigned og = xb_add(&bar[XB_TOP], 1u);
            const unsigned tg = og / nx;
            if (og + 1u == (tg + 1u) * nx) xb_add(&bar[XB_TOPGEN], 1u);
            else XB_SPIN(xb_ld(&bar[XB_TOPGEN]) == tg, bar);
            __builtin_amdgcn_fence(__ATOMIC_ACQUIRE, "agent");
            xb_add(&bar[XB_XGEN(b.x)], 1u);
            asm volatile("s_waitcnt vmcnt(0)" ::: "memory");
        } else {
            XB_SPIN(xb_ld(&bar[XB_XGEN(b.x)]) == gen, bar);
            __builtin_amdgcn_fence(__ATOMIC_ACQUIRE, "agent");
            asm volatile("s_waitcnt vmcnt(0)" ::: "memory");
        }
    }
    __syncthreads();
}


struct Args { const void* in[23]; float* out; unsigned char* ws; int ph_lo, ph_hi, dry, pad; };
struct Frame { LAS unsigned char* lds; int tid, lane, wave, vcu, G, gw, ngw; };

__device__ __forceinline__ float wave_sum(float v) {
#pragma unroll
    for (int o = 1; o < 64; o <<= 1) v += __shfl_xor(v, o);
    return v;
}
__device__ __forceinline__ bf16x8 ld8g(const bf16* p) { return *(const bf16x8*)p; }

__device__ __forceinline__ void tr_item(const float* __restrict__ W, int ldw, int scol, int nvalid, const float* __restrict__ gain, bf16* WT, int K, int drow, int k0, LAS float* scr, int lane) {
    const int nn = (lane & 31) < nvalid ? (lane & 31) : (nvalid - 1);
    float v[32]; const float* wp = W + (size_t)(k0 + (lane >> 5)) * ldw + scol + nn;
#pragma unroll
    for (int i = 0; i < 32; ++i) v[i] = wp[(size_t)(2 * i) * ldw];
    if (gain) {
#pragma unroll
        for (int i = 0; i < 32; ++i) v[i] *= gain[k0 + 2 * i + (lane >> 5)]; }
#pragma unroll
    for (int i = 0; i < 32; ++i) scr[(2 * i + (lane >> 5)) * 33 + (lane & 31)] = v[i];
    LDS_WAIT(); asm volatile("" ::: "memory");
    const int c = lane & 7;
#pragma unroll
    for (int j = 0; j < 4; ++j) { const int n = (lane >> 3) + 8 * j; const LAS float* s = scr + (8 * c) * 33 + n;
        v4u o; o.x = pk2(s[0 * 33], s[1 * 33]); o.y = pk2(s[2 * 33], s[3 * 33]); o.z = pk2(s[4 * 33], s[5 * 33]); o.w = pk2(s[6 * 33], s[7 * 33]);
        if (n < nvalid) *(GAS v4u*)(WT + (size_t)(drow + n) * K + k0 + 8 * c) = o; }
    LDS_WAIT(); asm volatile("" ::: "memory");
}
__device__ __forceinline__ void tr_item_f8(const float* __restrict__ W, int ldw, int scol, const float* __restrict__ gain, float scale, unsigned char* WT8, int K, int drow, int k0, LAS float* scr, int lane) {
    float v[32]; const float* wp = W + (size_t)(k0 + (lane >> 5)) * ldw + scol + (lane & 31);
#pragma unroll
    for (int i = 0; i < 32; ++i) v[i] = wp[(size_t)(2 * i) * ldw];
    if (gain) {
#pragma unroll
        for (int i = 0; i < 32; ++i) v[i] *= gain[k0 + 2 * i + (lane >> 5)]; }
#pragma unroll
    for (int i = 0; i < 32; ++i) scr[(2 * i + (lane >> 5)) * 33 + (lane & 31)] = v[i] * scale;
    LDS_WAIT(); asm volatile("" ::: "memory");
    const int c = lane & 7;
#pragma unroll
    for (int j = 0; j < 4; ++j) { const int n = (lane >> 3) + 8 * j; const LAS float* s = scr + (8 * c) * 33 + n;
        v2u o; int w = __builtin_amdgcn_cvt_pk_fp8_f32(s[0 * 33], s[1 * 33], 0, false); w = __builtin_amdgcn_cvt_pk_fp8_f32(s[2 * 33], s[3 * 33], w, true); o.x = (unsigned)w;
        w = __builtin_amdgcn_cvt_pk_fp8_f32(s[4 * 33], s[5 * 33], 0, false); w = __builtin_amdgcn_cvt_pk_fp8_f32(s[6 * 33], s[7 * 33], w, true); o.y = (unsigned)w;
        *(GAS v2u*)(WT8 + (size_t)(drow + n) * K + k0 + 8 * c) = o; }
    LDS_WAIT(); asm volatile("" ::: "memory");
}
__device__ __forceinline__ void norm_row(const float* src, bf16* dst, unsigned char* dst8, int lane) {
    const GAS f32x4* xr = (const GAS f32x4*)src + lane;
    f32x4 v[16]; float s = 0.f;
#pragma unroll
    for (int j = 0; j < 16; ++j) { v[j] = xr[64 * j]; s += (v[j].x * v[j].x + v[j].y * v[j].y) + (v[j].z * v[j].z + v[j].w * v[j].w); }
    const float r = 1.0f / sqrtf(wave_sum(s) * (1.0f / DM) + EPS);
    if (dst) { GAS v2u* o8 = (GAS v2u*)dst + lane;
#pragma unroll
        for (int j = 0; j < 16; ++j) { v2u w; w.x = pk2(v[j].x * r, v[j].y * r); w.y = pk2(v[j].z * r, v[j].w * r); o8[64 * j] = w; } }
    if (dst8) { GAS unsigned* o4 = (GAS unsigned*)dst8 + lane; const float r8 = r * F8_A_SCALE;
#pragma unroll
        for (int j = 0; j < 16; ++j) { int w = __builtin_amdgcn_cvt_pk_fp8_f32(v[j].x * r8, v[j].y * r8, 0, false); w = __builtin_amdgcn_cvt_pk_fp8_f32(v[j].z * r8, v[j].w * r8, w, true); o4[64 * j] = (unsigned)w; } }
}
__device__ __forceinline__ void norm_row_h(const pg8::f16_t* src, bf16* dst, unsigned char* dst8, int lane) {
    const GAS v4u* xr = (const GAS v4u*)src + lane;
    v4u h[8]; float s = 0.f;
#pragma unroll
    for (int j = 0; j < 8; ++j) { h[j] = xr[64 * j];
        const float a0 = pg8::f16lo(h[j].x), a1 = pg8::f16hi(h[j].x), a2 = pg8::f16lo(h[j].y), a3 = pg8::f16hi(h[j].y), a4 = pg8::f16lo(h[j].z), a5 = pg8::f16hi(h[j].z), a6 = pg8::f16lo(h[j].w), a7 = pg8::f16hi(h[j].w);
        s += ((a0 * a0 + a1 * a1) + (a2 * a2 + a3 * a3)) + ((a4 * a4 + a5 * a5) + (a6 * a6 + a7 * a7)); }
    const float r = 1.0f / sqrtf(wave_sum(s) * (1.0f / DM) + EPS);
    if (dst) { GAS v4u* o = (GAS v4u*)dst + lane;
#pragma unroll
        for (int j = 0; j < 8; ++j) { v4u w; w.x = pk2(pg8::f16lo(h[j].x) * r, pg8::f16hi(h[j].x) * r); w.y = pk2(pg8::f16lo(h[j].y) * r, pg8::f16hi(h[j].y) * r);
            w.z = pk2(pg8::f16lo(h[j].z) * r, pg8::f16hi(h[j].z) * r); w.w = pk2(pg8::f16lo(h[j].w) * r, pg8::f16hi(h[j].w) * r); o[64 * j] = w; } }
    if (dst8) { GAS v2u* o = (GAS v2u*)dst8 + lane; const float r8 = r * F8_A_SCALE;
#pragma unroll
        for (int j = 0; j < 8; ++j) { v2u w; int x = __builtin_amdgcn_cvt_pk_fp8_f32(pg8::f16lo(h[j].x) * r8, pg8::f16hi(h[j].x) * r8, 0, false); x = __builtin_amdgcn_cvt_pk_fp8_f32(pg8::f16lo(h[j].y) * r8, pg8::f16hi(h[j].y) * r8, x, true); w.x = (unsigned)x;
            x = __builtin_amdgcn_cvt_pk_fp8_f32(pg8::f16lo(h[j].z) * r8, pg8::f16hi(h[j].z) * r8, 0, false); x = __builtin_amdgcn_cvt_pk_fp8_f32(pg8::f16lo(h[j].w) * r8, pg8::f16hi(h[j].w) * r8, x, true); w.y = (unsigned)x; o[64 * j] = w; } }
}
__device__ __forceinline__ void norm_phase(Frame& F, const float* real, const float* meta, bf16* XN, unsigned char* X8, int nrows, int mode) {
    for (int m = F.gw; m < nrows; m += F.ngw) { const bool isreal = m < MR;
        norm_row(isreal ? real + (size_t)m * DM : meta + (size_t)(m - MR) * DM, (isreal && mode == 2) ? nullptr : XN + (size_t)m * DM, (isreal && mode != 0) ? X8 + (size_t)m * DM : nullptr, F.lane); }
}
__device__ __forceinline__ void norm_phase_h(Frame& F, const pg8::f16_t* real, const float* meta, bf16* XN, unsigned char* X8, int nrows, int mode) {
    for (int m = F.gw; m < nrows; m += F.ngw) {
        if (m < MR) norm_row_h(real + (size_t)m * DM, mode == 2 ? nullptr : XN + (size_t)m * DM, mode != 0 ? X8 + (size_t)m * DM : nullptr, F.lane);
        else norm_row(meta + (size_t)(m - MR) * DM, XN + (size_t)m * DM, nullptr, F.lane); }
}

struct P0Item { const float* wp; const float* gp; unsigned char* dp; int ldw, rowstep, kind, nvalid; float scale; };
constexpr int P0_I_IN = 64 * 385, P0_I_OUT = 64 * 128, P0_I_GU = 64 * 688, P0_I_DN = 172 * 128, P0_I_KVQ = 64 * 56, P0_I_KVU = 8 * 512, P0_I_UQ = 16 * 384, P0_I_O = 128 * 128, P0_I_INO = 64 * 128;
constexpr int P0_NITEMS = P0_I_IN + P0_I_OUT + 2 * P0_I_GU + 2 * P0_I_DN + P0_I_KVQ + P0_I_KVU + P0_I_UQ + P0_I_KVQ + P0_I_KVU + P0_I_INO + P0_I_O;
constexpr int P0_DEFER_A = 16384, P0_DEFER_B = 16384;
static_assert(P0_DEFER_B <= P0_I_DN && P0_DEFER_A + P0_DEFER_B <= P0_I_DN + P0_I_GU, "deferred items must be layer-1 FFN weights, the P16 share down-projection only");
__device__ __forceinline__ P0Item p0_decode(const Args& a, int it, int lane) {
    unsigned char* ws = a.ws;
    const float* w_in = (const float*)a.in[4]; const float* w_out = (const float*)a.in[8]; const float* w_gu = (const float*)a.in[10]; const float* w_dn = (const float*)a.in[11];
    const float* w_kvd = (const float*)a.in[13]; const float* w_kvu = (const float*)a.in[15]; const float* w_dq = (const float*)a.in[18]; const float* w_uq = (const float*)a.in[20]; const float* w_o = (const float*)a.in[22];
    const float* g_a = (const float*)a.in[3]; const float* g_ffn = (const float*)a.in[9]; const float* g_kv = (const float*)a.in[12]; const float* g_kvl = (const float*)a.in[14];
    const float* g_b = (const float*)a.in[17]; const float* g_ql = (const float*)a.in[19];
    const float* W = nullptr; const float* gain = nullptr; unsigned char* dst = nullptr; int ldw = 0, scol = 0, nvalid = 32, kind = 0, K = 0, drow = 0, k0 = 0; float scale = 1.f;
    int r = it;
    if (r < P0_I_IN) { const int kb = r / 385, nb = r % 385; W = w_in; ldw = NIN; scol = 32 * nb; nvalid = nb == 384 ? 16 : 32; gain = g_a; dst = ws + WS_W_IN; K = DM; drow = 32 * nb; k0 = 64 * kb; }
    else if ((r -= P0_I_IN) < P0_I_OUT) { const int kb = r / 128, nb = r % 128; W = w_out; ldw = DM; scol = 32 * nb; dst = ws + WS_W_OUT; K = DM; drow = 32 * nb; k0 = 64 * kb; }
    else if ((r -= P0_I_OUT) < P0_I_GU) { const int kb = r / 688, nb = r % 688, n0 = 32 * nb, j = n0 >> 8, i0 = n0 & 255;
        W = w_gu; ldw = NGU; scol = i0 < 128 ? 128 * j + i0 : DFF + 128 * j + (i0 - 128); gain = g_ffn; dst = ws + WS_W_GU0; K = DM; drow = n0; k0 = 64 * kb; }
    else if ((r -= P0_I_GU) < P0_I_DN) { const int kb = r / 128, nb = r % 128; W = w_dn; ldw = DM; scol = 32 * nb; dst = ws + WS_W_DN0; K = DFF; drow = 32 * nb; k0 = 64 * kb; }
    else if ((r -= P0_I_DN) < P0_I_KVQ) { const int kb = r / 56, nb = r % 56; dst = ws + WS_W_KVQ; K = DM; drow = 32 * nb; k0 = 64 * kb;
        if (nb < 18) { W = w_kvd; ldw = KVLORA + ROPE; scol = 32 * nb; gain = g_kv; } else if (nb >= 24) { W = w_dq; ldw = QLORA; scol = 32 * (nb - 24); gain = g_b; } else kind = 2; }
    else if ((r -= P0_I_KVQ) < P0_I_KVU) { const int kb = r / 512, nb = r % 512; W = w_kvu; ldw = 16384; scol = 32 * nb; gain = g_kvl; dst = ws + WS_W_KVUP; K = KVLORA; drow = 32 * nb; k0 = 64 * kb; }
    else if ((r -= P0_I_KVU) < P0_I_UQ) { const int kb = r / 384, nb = r % 384; W = w_uq; ldw = AH * QKD; scol = 32 * nb; gain = g_ql; kind = 1; scale = F8_W_SCALE; dst = ws + WS_W_UQ8; K = QLORA; drow = 32 * nb; k0 = 64 * kb; }
    else if ((r -= P0_I_UQ) < P0_I_KVQ) { const int kb = r / 56, nb = r % 56; kind = 1; scale = F8_W_SCALE; dst = ws + WS_W_KVQ8; K = DM; drow = 32 * nb; k0 = 64 * kb;
        if (nb < 18) { W = w_kvd; ldw = KVLORA + ROPE; scol = 32 * nb; gain = g_kv; } else if (nb >= 24) { W = w_dq; ldw = QLORA; scol = 32 * (nb - 24); gain = g_b; } else kind = 3; }
    else if ((r -= P0_I_KVQ) < P0_I_KVU) { const int kb = r / 512, nb = r % 512; W = w_kvu; ldw = 16384; scol = 32 * nb; gain = g_kvl; kind = 1; scale = F8_W_SCALE; dst = ws + WS_W_KVUP8; K = KVLORA; drow = 32 * nb; k0 = 64 * kb; }
    else if ((r -= P0_I_KVU) < P0_I_INO) { const int kb = r / 128, nb = r % 128; W = w_in; ldw = NIN; scol = 8192 + 32 * nb; gain = g_a; kind = 1; scale = F8_W_SCALE; dst = ws + WS_W_INO8; K = DM; drow = 32 * nb; k0 = 64 * kb; }
    else if ((r -= P0_I_INO) < P0_I_O) { const int kb = r / 128, nb = r % 128; W = w_o; ldw = DM; scol = 32 * nb; kind = 1; scale = W_O_SCALE; dst = ws + WS_W_O8; K = AH * VHD; drow = 32 * nb; k0 = 64 * kb; }
    else if ((r -= P0_I_O) < P0_I_GU) { const int kb = r / 688, nb = r % 688, n0 = 32 * nb, j = n0 >> 8, i0 = n0 & 255;
        W = w_gu + (size_t)DM * NGU; ldw = NGU; scol = i0 < 128 ? 128 * j + i0 : DFF + 128 * j + (i0 - 128); gain = g_ffn + DM; dst = ws + WS_W_GU1; K = DM; drow = n0; k0 = 64 * kb; }
    else { r -= P0_I_GU; const int kb = r / 128, nb = r % 128; W = w_dn + (size_t)DFF * DM; ldw = DM; scol = 32 * nb; dst = ws + WS_W_DN1; K = DFF; drow = 32 * nb; k0 = 64 * kb; }
    P0Item d; const int nn = (lane & 31) < nvalid ? (lane & 31) : (nvalid - 1); const int esz = (kind & 1) ? 1 : 2;
    d.wp = W + (size_t)(k0 + (lane >> 5)) * ldw + scol + nn; d.gp = gain ? gain + k0 + 8 * (lane & 7) : nullptr;
    d.dp = dst + ((size_t)(drow + (lane >> 3)) * K + k0 + 8 * (lane & 7)) * esz; d.ldw = ldw; d.rowstep = 8 * K * esz; d.kind = kind; d.nvalid = nvalid; d.scale = scale;
    return d;
}
__device__ __forceinline__ void p0_load(const P0Item& d, float (&v)[32], f32x4& g0, f32x4& g1) {
    g0 = (f32x4){1.f, 1.f, 1.f, 1.f}; g1 = g0;
    if (d.kind < 2) {
#pragma unroll
        for (int i = 0; i < 32; ++i) v[i] = d.wp[(size_t)(2 * i) * d.ldw];
        if (d.gp) { g0 = *(const GAS f32x4*)d.gp; g1 = *(const GAS f32x4*)(d.gp + 4); } }
}
__device__ __forceinline__ void p0_process(const P0Item& d, const float (&v)[32], f32x4 g0, f32x4 g1, LAS float* scr, int lane) {
    if (d.kind < 2) {
#pragma unroll
        for (int i = 0; i < 32; ++i) scr[(2 * i + (lane >> 5)) * 33 + (lane & 31)] = v[i];
        LDS_WAIT(); asm volatile("" ::: "memory");
        const int c = lane & 7;
#pragma unroll
        for (int j = 0; j < 4; ++j) { const int n = (lane >> 3) + 8 * j; const LAS float* s = scr + (8 * c) * 33 + n;
            const float f0 = s[0 * 33] * g0.x, f1 = s[1 * 33] * g0.y, f2 = s[2 * 33] * g0.z, f3 = s[3 * 33] * g0.w, f4 = s[4 * 33] * g1.x, f5 = s[5 * 33] * g1.y, f6 = s[6 * 33] * g1.z, f7 = s[7 * 33] * g1.w;
            if (d.kind == 0) { v4u o; o.x = pk2(f0, f1); o.y = pk2(f2, f3); o.z = pk2(f4, f5); o.w = pk2(f6, f7);
                if (n < d.nvalid) *(GAS v4u*)(d.dp + (size_t)j * d.rowstep) = o; }
            else { const float sc = d.scale; v2u o; int w = __builtin_amdgcn_cvt_pk_fp8_f32(f0 * sc, f1 * sc, 0, false); w = __builtin_amdgcn_cvt_pk_fp8_f32(f2 * sc, f3 * sc, w, true); o.x = (unsigned)w;
                w = __builtin_amdgcn_cvt_pk_fp8_f32(f4 * sc, f5 * sc, 0, false); w = __builtin_amdgcn_cvt_pk_fp8_f32(f6 * sc, f7 * sc, w, true); o.y = (unsigned)w;
                *(GAS v2u*)(d.dp + (size_t)j * d.rowstep) = o; } }
        LDS_WAIT(); asm volatile("" ::: "memory");
    } else {
#pragma unroll
        for (int j = 0; j < 4; ++j) { if (d.kind == 2) *(GAS v4u*)(d.dp + (size_t)j * d.rowstep) = (v4u){0u, 0u, 0u, 0u}; else *(GAS v2u*)(d.dp + (size_t)j * d.rowstep) = (v2u){0u, 0u}; } }
}
__device__ __forceinline__ void p0_items(Frame& F, const Args& a, int first, int last, int w, int stride, LAS float* scr) {
    int it = first + w; if (it >= last) return;
    P0Item d = p0_decode(a, it, F.lane); float v[32]; f32x4 g0, g1; p0_load(d, v, g0, g1);
    for (;;) { const int itn = it + stride; const bool more = itn < last;
        P0Item dn = d; float vn[32]; f32x4 gn0 = g0, gn1 = g1;
#pragma unroll
        for (int i = 0; i < 32; ++i) vn[i] = 0.f;
        if (more) { dn = p0_decode(a, itn, F.lane); p0_load(dn, vn, gn0, gn1); }
        asm volatile("" ::: "memory");
        p0_process(d, v, g0, g1, scr, F.lane);
        if (!more) break;
        d = dn; g0 = gn0; g1 = gn1; it = itn;
#pragma unroll
        for (int i = 0; i < 32; ++i) v[i] = vn[i]; }
}
__device__ __forceinline__ void p0_deferred(Frame& F, const Args& a, int nunits, int first, int count) {
    const int c = (int)blockIdx.x, G = F.G, rem = nunits % G;
    if (rem == 0) { p0_items(F, a, first, first + count, F.gw, F.ngw, (LAS float*)(F.lds + F.wave * 16384)); return; }
    if (c >= rem) p0_items(F, a, first, first + count, (c - rem) * NWAVES + F.wave, (G - rem) * NWAVES, (LAS float*)(F.lds + F.wave * 16384));
}

__device__ __forceinline__ void p0_prologue(Frame& F, const Args& a) {
    unsigned char* ws = a.ws;
    LAS float* scr = (LAS float*)(F.lds + F.wave * 16384);
    const float* w_in = (const float*)a.in[4]; const float* w_out = (const float*)a.in[8]; const float* w_gu = (const float*)a.in[10]; const float* w_dn = (const float*)a.in[11];
    const float* w_kvd = (const float*)a.in[13]; const float* w_kvu = (const float*)a.in[15]; const float* w_dq = (const float*)a.in[18]; const float* w_uq = (const float*)a.in[20]; const float* w_o = (const float*)a.in[22];
    const float* g_a = (const float*)a.in[3]; const float* g_ffn = (const float*)a.in[9]; const float* g_kv = (const float*)a.in[12]; const float* g_kvl = (const float*)a.in[14];
    const float* g_b = (const float*)a.in[17]; const float* g_ql = (const float*)a.in[19];
    p0_items(F, a, 0, P0_NITEMS - P0_DEFER_A - P0_DEFER_B, F.gw, F.ngw, scr);
    { const int* positions = (const int*)a.in[1]; float* rope = (float*)(ws + WS_ROPE);
        for (int e = F.vcu * NTHR + F.tid; e < MT * 32; e += F.G * NTHR) { const int row = e >> 5, i = e & 31;
            const int pos = row < MR ? positions[row] + NMETA : row - MR;
            const float inv = 1.0f / powf(10000.0f, (float)(2 * i) * (1.0f / 64.0f));
            const float ang = (float)pos * inv;
            rope[(size_t)row * 64 + i] = cosf(ang); rope[(size_t)row * 64 + 32 + i] = sinf(ang); } }
    { for (int e = F.vcu * NTHR + F.tid; e < 256 * 1280; e += F.G * NTHR) { const int bh = e / 1280, c = e % 1280;
            if (c < 768) *(GAS v4u*)(ws + WS_K + ((size_t)(bh * NKT + 64)) * 12288 + (size_t)c * 16) = (v4u){0u, 0u, 0u, 0u};
            else *(GAS v4u*)(ws + WS_V + ((size_t)(bh * NKT + 64)) * 8192 + (size_t)(c - 768) * 16) = (v4u){0u, 0u, 0u, 0u}; } }
    norm_phase(F, (const float*)a.in[0], (const float*)a.in[2], (bf16*)(ws + WS_XN), ws + WS_HH, MT, 1);
}

template <int NT>
__device__ __forceinline__ void skinny_wg(Frame& F, const bf16* __restrict__ A16, const bf16* __restrict__ Brows0, const bf16* __restrict__ Brows1, int K, f32x4 (&res)[NT]) {
    const int lane = F.lane, kw = K >> 3, k_lo = F.wave * kw;
    const bf16* pb = A16 + (size_t)(lane & 15) * K + 8 * (lane >> 4) + k_lo;
    const bf16* pa0 = Brows0 + (size_t)(lane & 15) * K + 8 * (lane >> 4) + k_lo;
    const bf16* pa1 = Brows1 + (size_t)(lane & 15) * K + 8 * (lane >> 4) + k_lo;
    f32x4 acc[NT];
#pragma unroll
    for (int i = 0; i < NT; ++i) acc[i] = (f32x4){0.f, 0.f, 0.f, 0.f};
#pragma unroll 8
    for (int k0 = 0; k0 < kw; k0 += 32) { const bf16x8 y = ld8g(pb + k0); const bf16x8 x0 = ld8g(pa0 + k0); acc[0] = __builtin_amdgcn_mfma_f32_16x16x32_bf16(x0, y, acc[0], 0, 0, 0);
        if (NT == 2) { const bf16x8 x1 = ld8g(pa1 + k0); acc[NT - 1] = __builtin_amdgcn_mfma_f32_16x16x32_bf16(x1, y, acc[NT - 1], 0, 0, 0); } }
    LAS f32x4* red = (LAS f32x4*)F.lds;
#pragma unroll
    for (int i = 0; i < NT; ++i) red[(i * NWAVES + F.wave) * 64 + lane] = acc[i];
    LDS_WAIT(); __syncthreads();
    if (F.wave == 0) {
#pragma unroll
        for (int i = 0; i < NT; ++i) { f32x4 sacc = red[(i * NWAVES) * 64 + lane];
#pragma unroll
            for (int w = 1; w < NWAVES; ++w) sacc = sacc + red[(i * NWAVES + w) * 64 + lane];
            res[i] = sacc; } }
    LDS_WAIT(); __syncthreads();
}

__device__ __forceinline__ void gate_norm_phase(Frame& F, const Args& a) {
    const bf16* HH = (const bf16*)(a.ws + WS_HH); const bf16* PROJ = (const bf16*)(a.ws + WS_BIG); bf16* A2 = (bf16*)(a.ws + WS_XN); const float* g_out = (const float*)a.in[7];
    for (int m = F.gw; m < MT; m += F.ngw) {
#pragma unroll
        for (int j = 0; j < 8; ++j) { const int e = j * 512 + F.lane * 8;
            const v4u hw = *(const GAS v4u*)(HH + (size_t)m * DM + e), ow = *(const GAS v4u*)(PROJ + (size_t)m * NPROJ + 8192 + e);
            const f32x4 g0 = *(const GAS f32x4*)(g_out + e), g1 = *(const GAS f32x4*)(g_out + e + 4);
            float hv[8] = {bflo(hw.x), bfhi(hw.x), bflo(hw.y), bfhi(hw.y), bflo(hw.z), bfhi(hw.z), bflo(hw.w), bfhi(hw.w)};
            const float ov[8] = {bflo(ow.x), bfhi(ow.x), bflo(ow.y), bfhi(ow.y), bflo(ow.z), bfhi(ow.z), bflo(ow.w), bfhi(ow.w)};
            const float gv[8] = {g0.x, g0.y, g0.z, g0.w, g1.x, g1.y, g1.z, g1.w};
            float s = 0.f;
#pragma unroll
            for (int i = 0; i < 8; ++i) s += hv[i] * hv[i];
            const float r = 1.0f / sqrtf(wave_sum(s) * (1.0f / MDV) + EPS);
#pragma unroll
            for (int i = 0; i < 8; ++i) hv[i] = hv[i] * r * gv[i] * (1.0f / (1.0f + __expf(-ov[i])));
            v4u o; o.x = pk2(hv[0], hv[1]); o.y = pk2(hv[2], hv[3]); o.z = pk2(hv[4], hv[5]); o.w = pk2(hv[6], hv[7]);
            *(GAS v4u*)(A2 + (size_t)m * DM + e) = o; }
    }
}

__device__ __forceinline__ void latent_norm_phase(Frame& F, const Args& a) {
    const float* LAT = (const float*)(a.ws + WS_LAT); const pg8::f16_t* LAT16 = (const pg8::f16_t*)(a.ws + WS_LAT); bf16* CKVN = (bf16*)(a.ws + WS_CKVN); bf16* CQN = (bf16*)(a.ws + WS_CQN);
    for (int m = F.gw; m < MT; m += F.ngw) {
        if (m < MR) { const pg8::f16_t* row = LAT16 + (size_t)m * NKVQ;
            { const v4u xw = *(const GAS v4u*)(row + 8 * F.lane);
                const float x0 = pg8::f16lo(xw.x), x1 = pg8::f16hi(xw.x), x2 = pg8::f16lo(xw.y), x3 = pg8::f16hi(xw.y), x4 = pg8::f16lo(xw.z), x5 = pg8::f16hi(xw.z), x6 = pg8::f16lo(xw.w), x7 = pg8::f16hi(xw.w);
                const float s = ((x0 * x0 + x1 * x1) + (x2 * x2 + x3 * x3)) + ((x4 * x4 + x5 * x5) + (x6 * x6 + x7 * x7));
                const float r8 = F8_A_SCALE / sqrtf(wave_sum(s) * (1.0f / KVLORA) + EPS); v2u o;
                int w = __builtin_amdgcn_cvt_pk_fp8_f32(x0 * r8, x1 * r8, 0, false); w = __builtin_amdgcn_cvt_pk_fp8_f32(x2 * r8, x3 * r8, w, true); o.x = (unsigned)w;
                w = __builtin_amdgcn_cvt_pk_fp8_f32(x4 * r8, x5 * r8, 0, false); w = __builtin_amdgcn_cvt_pk_fp8_f32(x6 * r8, x7 * r8, w, true); o.y = (unsigned)w;
                *(GAS v2u*)((unsigned char*)CKVN + (size_t)m * KVLORA + 8 * F.lane) = o; }
            {
                const pg8::f16_t* lrow = row + KVLORA; const float* rt = (const float*)(a.ws + WS_ROPE) + (size_t)m * 64; const float* g_k = (const float*)a.in[16]; const int i = F.lane & 31;
                const float t1 = (float)lrow[i] * g_k[128 + i], t2 = (float)lrow[32 + i] * g_k[160 + i], cs = rt[i], sn = rt[32 + i]; const float krl = (float)lrow[F.lane]; const float ssr = wave_sum(krl * krl);
                ((float*)(a.ws + WS_PRE))[(size_t)m * 64 + F.lane] = (F.lane & 32) ? (t1 * sn + t2 * cs) : (t1 * cs - t2 * sn);
                if (F.lane == 0) ((float*)(a.ws + WS_SSR))[m] = ssr; }
            { v2u v[4]; float s = 0.f;
#pragma unroll
                for (int j = 0; j < 4; ++j) { v[j] = *(const GAS v2u*)(row + 768 + (j * 64 + F.lane) * 4);
                    const float q0 = pg8::f16lo(v[j].x), q1 = pg8::f16hi(v[j].x), q2 = pg8::f16lo(v[j].y), q3 = pg8::f16hi(v[j].y); s += (q0 * q0 + q1 * q1) + (q2 * q2 + q3 * q3); }
                const float r8 = F8_A_SCALE / sqrtf(wave_sum(s) * (1.0f / QLORA) + EPS);
#pragma unroll
                for (int j = 0; j < 4; ++j) { int w = __builtin_amdgcn_cvt_pk_fp8_f32(pg8::f16lo(v[j].x) * r8, pg8::f16hi(v[j].x) * r8, 0, false); w = __builtin_amdgcn_cvt_pk_fp8_f32(pg8::f16lo(v[j].y) * r8, pg8::f16hi(v[j].y) * r8, w, true);
                    *(GAS unsigned*)((unsigned char*)CQN + (size_t)m * QLORA + (j * 64 + F.lane) * 4) = (unsigned)w; } }
        } else { const float* row = LAT + (size_t)m * NKVQ;
            const f32x4 x0 = *(const GAS f32x4*)(row + 8 * F.lane), x1 = *(const GAS f32x4*)(row + 8 * F.lane + 4);
            const float s = (x0.x * x0.x + x0.y * x0.y) + (x0.z * x0.z + x0.w * x0.w) + (x1.x * x1.x + x1.y * x1.y) + (x1.z * x1.z + x1.w * x1.w);
            const float r = 1.0f / sqrtf(wave_sum(s) * (1.0f / KVLORA) + EPS);
            v4u o; o.x = pk2(x0.x * r, x0.y * r); o.y = pk2(x0.z * r, x0.w * r); o.z = pk2(x1.x * r, x1.y * r); o.w = pk2(x1.z * r, x1.w * r);
            *(GAS v4u*)(CKVN + (size_t)m * KVLORA + 8 * F.lane) = o; }
    }
}

using pg8::k_img_off8;
__device__ __forceinline__ v2u f8x8(const float (&x)[8], float sc) { v2u o; int w = __builtin_amdgcn_cvt_pk_fp8_f32(x[0] * sc, x[1] * sc, 0, false); w = __builtin_amdgcn_cvt_pk_fp8_f32(x[2] * sc, x[3] * sc, w, true); o.x = (unsigned)w;
    w = __builtin_amdgcn_cvt_pk_fp8_f32(x[4] * sc, x[5] * sc, 0, false); w = __builtin_amdgcn_cvt_pk_fp8_f32(x[6] * sc, x[7] * sc, w, true); o.y = (unsigned)w; return o; }
__device__ __forceinline__ void k_final_phase(Frame& F, const Args& a) {
    const float* LAT = (const float*)(a.ws + WS_LAT); const bf16* KN = (const bf16*)(a.ws + WS_KNOPE); const float* ROPEt = (const float*)(a.ws + WS_ROPE); const float* g_k = (const float*)a.in[16];
    unsigned char* Kimg = a.ws + WS_K; const int lane = F.lane, c = lane & 15, hq = lane >> 4;
    float gn[8];
#pragma unroll
    for (int i = 0; i < 8; ++i) gn[i] = g_k[8 * c + i];
    for (int m = MR + F.gw; m < MT; m += F.ngw) {
        const float* lrow = LAT + (size_t)m * NKVQ + KVLORA;
        const float krl = lrow[lane]; const float ss_rope = wave_sum(krl * krl);
        float pre[8];
        { const int i0 = 8 * (c & 3); const float* rt = ROPEt + (size_t)m * 64;
#pragma unroll
            for (int i = 0; i < 8; ++i) { const float t1 = lrow[i0 + i] * g_k[128 + i0 + i], t2 = lrow[32 + i0 + i] * g_k[160 + i0 + i], cs = rt[i0 + i], sn = rt[32 + i0 + i];
                pre[i] = (c & 4) ? (t1 * sn + t2 * cs) : (t1 * cs - t2 * sn); } }
        const int nb = m < MR ? 1 : BATCH; const int key = m < MR ? NMETA + (m & (SEQ - 1)) : m - MR; const int b0 = m < MR ? (m >> 12) : 0;
        const int kt = key >> 6, kr = key & 63;
#pragma unroll 4
        for (int j = 0; j < 16; ++j) { const int h = 4 * j + hq;
            const v4u kw = *(const GAS v4u*)(KN + (size_t)m * 8192 + h * 128 + 8 * c);
            float kv[8] = {bflo(kw.x), bfhi(kw.x), bflo(kw.y), bfhi(kw.y), bflo(kw.z), bfhi(kw.z), bflo(kw.w), bfhi(kw.w)};
            float s = 0.f;
#pragma unroll
            for (int i = 0; i < 8; ++i) s += kv[i] * kv[i];
            s += __shfl_xor(s, 1); s += __shfl_xor(s, 2); s += __shfl_xor(s, 4); s += __shfl_xor(s, 8);
            const float r = 1.0f / sqrtf((s + ss_rope) * (1.0f / QKD) + EPS);
#pragma unroll
            for (int i = 0; i < 8; ++i) kv[i] *= gn[i];
            const v2u o = f8x8(kv, r * F8_A_SCALE), p = f8x8(pre, r * F8_A_SCALE);
            for (int bb = 0; bb < nb; ++bb) { unsigned char* img = Kimg + ((size_t)(((b0 + bb) * AH + h) * NKT + kt)) * 12288;
                *(GAS v2u*)(img + k_img_off8(kr, 8 * c)) = o;
                if (c < 8) *(GAS v2u*)(img + k_img_off8(kr, 128 + 8 * c)) = p; } }
    }
}

constexpr int ML_KP = 528, ML_VP = 144, ML_KR0 = 0, ML_KRSZ = 64 * ML_KP, ML_VR0 = 2 * ML_KRSZ, ML_VRSZ = 64 * ML_VP, ML_CT = ML_VR0 + 2 * ML_VRSZ, ML_WS = ML_CT + 80 * ML_KP, ML_END = ML_WS + NWAVES * 512;
static_assert(ML_END <= LDSCTL_OFF, "mLSTM LDS");
__device__ __forceinline__ s16x4 lds_tr(LAS const unsigned char* p) { typedef short v4i16_t __attribute__((ext_vector_type(4))); return __builtin_bit_cast(s16x4, __builtin_amdgcn_ds_read_tr16_b64_v4i16((LAS v4i16_t*)p)); }
__device__ __forceinline__ bf16x8 cat4(s16x4 lo, s16x4 hi) { return (bf16x8){lo[0], lo[1], lo[2], lo[3], hi[0], hi[1], hi[2], hi[3]}; }
__device__ __forceinline__ float prefix_sum64(float v, int lane) {
#pragma unroll
    for (int d = 1; d < 64; d <<= 1) { const float t = __shfl_up(v, d); if (lane >= d) v += t; }
    return v;
}
__device__ __forceinline__ float prefix_max64(float v, int lane) {
#pragma unroll
    for (int d = 1; d < 64; d <<= 1) { const float t = __shfl_up(v, d); if (lane >= d) v = fmaxf(v, t); }
    return v;
}
__device__ __forceinline__ float log_sigmoid(float x) { return fminf(x, 0.f) - log1pf(expf(-fabsf(x))); }

template <int TBV>
__device__ __forceinline__ void mlstm_unit_tb(Frame& F, const Args& a, int unit) {
    const int bh = unit >> 3, sl = unit & 7, b = bh >> 3, h = bh & 7;
    const int tid = F.tid, lane = F.lane, wave = F.wave, eh = wave & 1, c15 = lane & 15, q4 = lane >> 4; constexpr int tb = TBV;
    LAS unsigned char* lds = F.lds;
    const bf16* PROJ = (const bf16*)(a.ws + WS_BIG); const float* GATES = (const float*)(a.ws + WS_GATES); bf16* HH = (bf16*)(a.ws + WS_HH);
    const float b_i = ((const float*)a.in[5])[h], b_f = ((const float*)a.in[6])[h];
    f32x4 Cacc[2][5];
#pragma unroll
    for (int i = 0; i < 2; ++i)
#pragma unroll
        for (int e = 0; e < 5; ++e) Cacc[i][e] = (f32x4){0.f, 0.f, 0.f, 0.f};
    float m_state = 0.f;
    for (int i = tid; i < (80 * ML_KP) / 16; i += NTHR) *(LAS v4u*)(lds + ML_CT + 16 * i) = (v4u){0u, 0u, 0u, 0u};
#define ML_ROW(c, i) ((c) == 0 ? MR + ((i) & 15) : b * SEQ + 64 * ((c) - 1) + (i))
#define ML_VALID(c, i) ((c) > 0 || (i) < NMETA)
    v4u kst[4], vst; bf16x8 qf[8], qn[8]; float bc_c, u_c, pm_c, bc_n, u_n, pm_n;
    const GAS unsigned char* Pb = (const GAS unsigned char*)PROJ;
    const unsigned kofs = (unsigned)(((tid >> 5) * NPROJ + 2048 + h * MDK + (tid & 31) * 8) * 2);
    const unsigned vofs = (unsigned)(((tid >> 3) * NPROJ + 4096 + h * MDV + sl * 64 + (tid & 7) * 8) * 2);
    const unsigned qofs = (unsigned)(((16 * tb + c15) * NPROJ + h * MDK + 8 * q4) * 2);
    constexpr unsigned ROWB = NPROJ * 2;
    {
#pragma unroll
        for (int j = 0; j < 4; ++j) { const int id = tid + NTHR * j, i = id >> 5, ch = id & 31; const v4u x = *(const GAS v4u*)(Pb + (size_t)(MR + (i & 15)) * ROWB + (2048 + h * MDK + ch * 8) * 2);
            *(LAS v4u*)(lds + ML_KR0 + i * ML_KP + ch * 16) = ML_VALID(0, i) ? x : (v4u){0u, 0u, 0u, 0u}; }
        { const int i = tid >> 3, ch = tid & 7; const v4u x = *(const GAS v4u*)(Pb + (size_t)(MR + (i & 15)) * ROWB + (4096 + h * MDV + sl * 64 + ch * 8) * 2);
            *(LAS v4u*)(lds + ML_VR0 + i * ML_VP + ch * 16) = ML_VALID(0, i) ? x : (v4u){0u, 0u, 0u, 0u}; }
        { const int i = 16 * tb + c15;
#pragma unroll
            for (int ks = 0; ks < 8; ++ks) { const bf16x8 x = *(const GAS bf16x8*)(Pb + (size_t)(MR + (i & 15)) * ROWB + (h * MDK + 32 * ks + 8 * q4) * 2); qf[ks] = ML_VALID(0, i) ? x : (bf16x8){0, 0, 0, 0, 0, 0, 0, 0}; } }
    }
    float* GSC = (float*)(a.ws + WS_KNOPE) + (size_t)unit * (65 * 192);
    for (int c = wave; c <= 64; c += NWAVES) {
        const bool tokv = ML_VALID(c, lane);
        const float gi = GATES[(size_t)h * MT + ML_ROW(c, lane)], gf = GATES[(size_t)(8 + h) * MT + ML_ROW(c, lane)];
        const float logi = tokv ? 15.0f * tanhf((gi + b_i) * (1.0f / 15.0f)) : -__builtin_inff();
        const float logf = tokv ? log_sigmoid(15.0f * tanhf((gf + b_f) * (1.0f / 15.0f))) : 0.f;
        const float bcum = prefix_sum64(logf, lane);
        const float u = logi - bcum;
        const float pm = prefix_max64(u, lane);
        GSC[c * 192 + lane] = bcum; GSC[c * 192 + 64 + lane] = u; GSC[c * 192 + 128 + lane] = pm;
    }
    VM_WAIT(); __syncthreads();
#define ML_GLOAD(c, B, U, P) do { B = __hip_atomic_load(GSC + (c) * 192 + lane, __ATOMIC_RELAXED, __HIP_MEMORY_SCOPE_AGENT); U = __hip_atomic_load(GSC + (c) * 192 + 64 + lane, __ATOMIC_RELAXED, __HIP_MEMORY_SCOPE_AGENT); \
        P = __hip_atomic_load(GSC + (c) * 192 + 128 + lane, __ATOMIC_RELAXED, __HIP_MEMORY_SCOPE_AGENT); } while (0)
    ML_GLOAD(0, bc_c, u_c, pm_c);
    LDS_WAIT(); __syncthreads();
    for (int c = 0; c <= 64; ++c) {
        const int cur = c & 1, nx = cur ^ 1, cn = c < 64 ? c + 1 : 64;
        LAS const unsigned char* KRc = lds + ML_KR0 + cur * ML_KRSZ; LAS const unsigned char* VRc = lds + ML_VR0 + cur * ML_VRSZ;
        const GAS unsigned char* Pn = Pb + (size_t)(b * SEQ + 64 * (cn - 1)) * ROWB;
#pragma unroll
        for (int j = 0; j < 4; ++j) kst[j] = *(const GAS v4u*)(Pn + (kofs + (unsigned)j * (16u * ROWB)));
        vst = *(const GAS v4u*)(Pn + vofs);
        ML_GLOAD(cn, bc_n, u_n, pm_n);
        const float bcum = bc_c, u = u_c;
        const float Mv = fmaxf(m_state, pm_c);
        const float av = __expf(m_state - Mv);
        const float mt = bcum + Mv;
        const float M63 = __shfl(Mv, 63), b63 = __shfl(bcum, 63);
        const float wl = __expf(u - M63) * 0.0625f;
        const float decay = __shfl(av, 63);
        LAS float* uS = (LAS float*)(lds + ML_WS + wave * 512); LAS float* wS = uS + 64;
        uS[lane] = u; wS[lane] = wl; LDS_WAIT();
        f32x4 Sacc[4];
#pragma unroll
        for (int sb = 0; sb < 4; ++sb) Sacc[sb] = (f32x4){0.f, 0.f, 0.f, 0.f};
        f32x4 a1[3], a2[3];
#pragma unroll
        for (int x = 0; x < 3; ++x) { a1[x] = (f32x4){0.f, 0.f, 0.f, 0.f}; a2[x] = (f32x4){0.f, 0.f, 0.f, 0.f}; }
#pragma unroll
        for (int kp = 0; kp < 1; ++kp) {
#pragma unroll
            for (int ks = 8 * kp; ks < 8 * kp + 8; ++ks) {
#pragma unroll
                for (int sb = 0; sb < 4; ++sb) if (sb <= tb) { const bf16x8 kf = *(LAS const bf16x8*)(KRc + (16 * sb + c15) * ML_KP + (32 * ks + 8 * q4) * 2); Sacc[sb] = __builtin_amdgcn_mfma_f32_16x16x32_bf16(kf, qf[ks], Sacc[sb], 0, 0, 0); }
#pragma unroll
                for (int x = 0; x < 3; ++x) { const int eb = x < 2 ? 2 * eh + x : 4; const bf16x8 cf = *(LAS const bf16x8*)(lds + ML_CT + (16 * eb + c15) * ML_KP + (32 * ks + 8 * q4) * 2);
                    a1[x] = __builtin_amdgcn_mfma_f32_16x16x32_bf16(cf, qf[ks], a1[x], 0, 0, 0); } }
            SBAR(); }
        const float Mt = __shfl(Mv, 16 * tb + c15), at = __shfl(av, 16 * tb + c15), mtt = __shfl(mt, 16 * tb + c15);
        bf16x8 pf[2];
        {   float sp[4][4];
#pragma unroll
            for (int sb = 0; sb < 4; ++sb) { const f32x4 u4 = *(LAS const f32x4*)(uS + 16 * sb + 4 * q4);
#pragma unroll
                for (int j = 0; j < 4; ++j) { const int s_abs = 16 * sb + 4 * q4 + j; const float us = u4[j];
                    const float w = (s_abs <= 16 * tb + c15) ? __expf(us - Mt) : 0.f; sp[sb][j] = (sb <= tb) ? Sacc[sb][j] * 0.0625f * w : 0.f; } }
#pragma unroll
            for (int k2 = 0; k2 < 2; ++k2) { v4u w; w.x = pk2(sp[2 * k2][0], sp[2 * k2][1]); w.y = pk2(sp[2 * k2][2], sp[2 * k2][3]); w.z = pk2(sp[2 * k2 + 1][0], sp[2 * k2 + 1][1]); w.w = pk2(sp[2 * k2 + 1][2], sp[2 * k2 + 1][3]);
                pf[k2] = __builtin_bit_cast(bf16x8, w); } }
        const bf16x8 onesf = (c15 == 0) ? (bf16x8){0x3F80, 0x3F80, 0x3F80, 0x3F80, 0x3F80, 0x3F80, 0x3F80, 0x3F80} : (bf16x8){0, 0, 0, 0, 0, 0, 0, 0};
#pragma unroll
        for (int k2 = 0; k2 < 2; ++k2) {
#pragma unroll
            for (int x = 0; x < 2; ++x) { const int eb = 2 * eh + x; LAS const unsigned char* p = VRc + (32 * k2 + 4 * q4 + (c15 >> 2)) * ML_VP + (16 * eb + 4 * (c15 & 3)) * 2;
                const s16x4 lo = lds_tr(p), hi = lds_tr(p + 16 * ML_VP);
                a2[x] = __builtin_amdgcn_mfma_f32_16x16x32_bf16(cat4(lo, hi), pf[k2], a2[x], 0, 0, 0); }
            a2[2] = __builtin_amdgcn_mfma_f32_16x16x32_bf16(onesf, pf[k2], a2[2], 0, 0, 0); }
        {   const float den0 = at * a1[2][0] + a2[2][0];
            const float den = __shfl(den0, c15);
            const float inv = 1.0f / fmaxf(fabsf(den), __expf(-mtt));
            const int tl = 16 * tb + c15;
            if (ML_VALID(c, tl)) { const unsigned ho = (unsigned)((ML_ROW(c, tl) * DM + h * MDV + sl * 64 + 4 * q4 + 32 * eh) * 2);
#pragma unroll
                for (int x = 0; x < 2; ++x) { v2u w; w.x = pk2((at * a1[x][0] + a2[x][0]) * inv, (at * a1[x][1] + a2[x][1]) * inv); w.y = pk2((at * a1[x][2] + a2[x][2]) * inv, (at * a1[x][3] + a2[x][3]) * inv);
                    *(GAS v2u*)((GAS unsigned char*)HH + (ho + 32u * x)) = w; } } }
#pragma unroll
        for (int ks = 0; ks < 8; ++ks) qn[ks] = *(const GAS bf16x8*)(Pn + (qofs + 64u * ks));
#pragma unroll
        for (int i = 0; i < 2; ++i)
#pragma unroll
            for (int e = 0; e < 5; ++e) Cacc[i][e] = Cacc[i][e] * decay;
#pragma unroll
        for (int k2 = 0; k2 < 2; ++k2) {
            const f32x4 wv0 = *(LAS const f32x4*)(wS + 32 * k2 + 8 * q4), wv1 = *(LAS const f32x4*)(wS + 32 * k2 + 8 * q4 + 4);
            const float wlv[8] = {wv0.x, wv0.y, wv0.z, wv0.w, wv1.x, wv1.y, wv1.z, wv1.w};
            bf16x8 bfr[5];
#pragma unroll
            for (int eb = 0; eb < 4; ++eb) { LAS const unsigned char* p = VRc + (32 * k2 + 8 * q4 + (c15 >> 2)) * ML_VP + (16 * eb + 4 * (c15 & 3)) * 2;
                const s16x4 lo = lds_tr(p), hi = lds_tr(p + 4 * ML_VP);
                v4u w; w.x = pk2(bf2f((unsigned short)lo[0]) * wlv[0], bf2f((unsigned short)lo[1]) * wlv[1]); w.y = pk2(bf2f((unsigned short)lo[2]) * wlv[2], bf2f((unsigned short)lo[3]) * wlv[3]);
                w.z = pk2(bf2f((unsigned short)hi[0]) * wlv[4], bf2f((unsigned short)hi[1]) * wlv[5]); w.w = pk2(bf2f((unsigned short)hi[2]) * wlv[6], bf2f((unsigned short)hi[3]) * wlv[7]);
                bfr[eb] = __builtin_bit_cast(bf16x8, w); }
            { v4u w; w.x = pk2(wlv[0], wlv[1]); w.y = pk2(wlv[2], wlv[3]); w.z = pk2(wlv[4], wlv[5]); w.w = pk2(wlv[6], wlv[7]); if (c15 != 0) w = (v4u){0u, 0u, 0u, 0u}; bfr[4] = __builtin_bit_cast(bf16x8, w); }
#pragma unroll
            for (int i = 0; i < 2; ++i) { const int rb = 2 * wave + i; LAS const unsigned char* p = KRc + (32 * k2 + 8 * q4 + (c15 >> 2)) * ML_KP + (16 * rb + 4 * (c15 & 3)) * 2;
                const s16x4 lo = lds_tr(p), hi = lds_tr(p + 4 * ML_KP); const bf16x8 af = cat4(lo, hi);
#pragma unroll
                for (int eb = 0; eb < 5; ++eb) Cacc[i][eb] = __builtin_amdgcn_mfma_f32_16x16x32_bf16(af, bfr[eb], Cacc[i][eb], 0, 0, 0); }
        }
        LDS_WAIT(); __syncthreads();
#pragma unroll
        for (int i = 0; i < 2; ++i)
#pragma unroll
            for (int eb = 0; eb < 5; ++eb) { v2u w; w.x = pk2(Cacc[i][eb][0], Cacc[i][eb][1]); w.y = pk2(Cacc[i][eb][2], Cacc[i][eb][3]);
                *(LAS v2u*)(lds + ML_CT + (16 * eb + c15) * ML_KP + (16 * (2 * wave + i) + 4 * q4) * 2) = w; }
#pragma unroll
        for (int j = 0; j < 4; ++j) { const int id = tid + NTHR * j, i = id >> 5, ch = id & 31; *(LAS v4u*)(lds + ML_KR0 + nx * ML_KRSZ + i * ML_KP + ch * 16) = kst[j]; }
        { const int i = tid >> 3, ch = tid & 7; *(LAS v4u*)(lds + ML_VR0 + nx * ML_VRSZ + i * ML_VP + ch * 16) = vst; }
#pragma unroll
        for (int ks = 0; ks < 8; ++ks) qf[ks] = qn[ks];
        bc_c = bc_n; u_c = u_n; pm_c = pm_n;
        m_state = b63 + M63;
        LDS_WAIT(); __syncthreads();
    }
#undef ML_ROW
#undef ML_VALID
#undef ML_GLOAD
}
__device__ __forceinline__ void mlstm_unit(Frame& F, const Args& a, int unit) {
    switch (F.wave >> 1) { case 0: mlstm_unit_tb<0>(F, a, unit); break; case 1: mlstm_unit_tb<1>(F, a, unit); break; case 2: mlstm_unit_tb<2>(F, a, unit); break; default: mlstm_unit_tb<3>(F, a, unit); break; }
}

constexpr int AT_KSZ = 12288, AT_VSZ = 8192, AT_K0 = 0, AT_V0 = 2 * AT_KSZ, AT_WS = AT_V0 + 2 * AT_VSZ, AT_GQ = AT_WS + NWAVES * 256, AT_OST = AT_GQ + 768, AT_END = AT_OST + NWAVES * 4096;
static_assert(AT_END <= RING_BYTES, "attention LDS");
constexpr float AT_SCALE = 0.07216878364870322f / 256.0f;
constexpr float AT_THR = 2.5f;
__device__ __forceinline__ int crow(int r, int hi) { return (r & 3) + 8 * (r >> 2) + 4 * hi; }
__device__ __forceinline__ int v_rd_base(int lane) { return ((lane & 3) << 3) | (((lane >> 2) & 3) << 6) | (((lane >> 4) & 1) << 5) | (((lane >> 5) & 1) << 8); }
constexpr int v_rd_off(int d0, int ks, int half) { return d0 * 512 + ks * 4096 + half * 2048; }
__device__ __forceinline__ void at_mask(f32x16& p0, f32x16& p1, int dq) {
    const float NEG = -__builtin_inff();
#pragma unroll
    for (int r = 0; r < 16; ++r) { const int c = (r & 3) + 8 * (r >> 2); if (dq - c < 0) p0[r] = NEG; if (dq - c - 32 < 0) p1[r] = NEG; }
}
__device__ __forceinline__ void at_partialSM(f32x16& p0, f32x16& p1, float& m_reg, float& mn, float& alpha) {
    float pmax = p0[0];
#pragma unroll
    for (int r = 1; r < 16; ++r) pmax = fmaxf(pmax, p0[r]);
#pragma unroll
    for (int r = 0; r < 16; ++r) pmax = fmaxf(pmax, p1[r]);
    { auto rr = __builtin_amdgcn_permlane32_swap(__float_as_uint(pmax), __float_as_uint(pmax), false, false); pmax = fmaxf(__uint_as_float(rr[0]), __uint_as_float(rr[1])); }
    constexpr float C2 = 1.4426950408889634f * AT_SCALE;
    if (__builtin_expect(__all((pmax - m_reg) * AT_SCALE <= AT_THR), 1)) { mn = m_reg; alpha = 1.f; }
    else { mn = fmaxf(m_reg, pmax); alpha = __builtin_amdgcn_exp2f((m_reg - mn) * C2); m_reg = mn; }
    const float mnL = 5.0f - mn * C2;
#pragma unroll
    for (int r = 0; r < 16; ++r) p0[r] = __builtin_amdgcn_exp2f(fmaf(p0[r], C2, mnL));
#pragma unroll
    for (int r = 0; r < 16; ++r) p1[r] = __builtin_amdgcn_exp2f(fmaf(p1[r], C2, mnL));
}
__device__ __forceinline__ void at_finishSM(const f32x16& p0, const f32x16& p1, float alpha, float& l_reg, bf16x8& pa0, bf16x8& pa1, bf16x8& pa2, bf16x8& pa3) {
    float ps = 0.f;
#pragma unroll
    for (int r = 0; r < 16; ++r) ps += p0[r];
#pragma unroll
    for (int r = 0; r < 16; ++r) ps += p1[r];
    { auto rr = __builtin_amdgcn_permlane32_swap(__float_as_uint(ps), __float_as_uint(ps), false, false); ps = __uint_as_float(rr[0]) + __uint_as_float(rr[1]); }
    l_reg = l_reg * alpha + ps;
#define AT_PK4(P, B_, OUT) do { unsigned a0 = pk2a(P[B_+0], P[B_+1]), a1 = pk2a(P[B_+2], P[B_+3]); unsigned b0 = pk2a(P[B_+4], P[B_+5]), b1 = pk2a(P[B_+6], P[B_+7]); \
        auto r0 = __builtin_amdgcn_permlane32_swap(a0, b0, false, false); auto r1 = __builtin_amdgcn_permlane32_swap(a1, b1, false, false); \
        v4u w = {r0[0], r1[0], r0[1], r1[1]}; OUT = __builtin_bit_cast(bf16x8, w); } while (0)
    AT_PK4(p0, 0, pa0); AT_PK4(p0, 8, pa1); AT_PK4(p1, 0, pa2); AT_PK4(p1, 8, pa3);
#undef AT_PK4
}
__device__ __forceinline__ void at_qkt(f32x16& p0, f32x16& p1, LAS const unsigned char* Kb, int r32, int hi, const bf16x8* qr) {
    p0 = (f32x16){0.f, 0.f, 0.f, 0.f, 0.f, 0.f, 0.f, 0.f, 0.f, 0.f, 0.f, 0.f, 0.f, 0.f, 0.f, 0.f}; p1 = p0;
    LAS const unsigned char* kb[4];
#pragma unroll
    for (int dd = 0; dd < 4; ++dd) kb[dd] = Kb + r32 * 384 + (((2 * dd + hi) ^ ((r32 >> 1) & 7)) << 4);
    bf16x8 c0[2], c1[2], n0[2], n1[2];
#pragma unroll
    for (int dd = 0; dd < 2; ++dd) { LAS const unsigned char* p = kb[dd]; c0[dd] = *(LAS const bf16x8*)p; c1[dd] = *(LAS const bf16x8*)(p + 32 * 384); }
#pragma unroll
    for (int g = 0; g < 6; ++g) {
        if (g < 5) {
#pragma unroll
            for (int dd = 0; dd < 2; ++dd) { LAS const unsigned char* p = kb[2 * ((g + 1) & 1) + dd] + ((g + 1) >> 1) * 128; n0[dd] = *(LAS const bf16x8*)p; n1[dd] = *(LAS const bf16x8*)(p + 32 * 384); } }
        SBAR();
#pragma unroll
        for (int dd = 0; dd < 2; ++dd) { p0 = __builtin_amdgcn_mfma_f32_32x32x16_bf16(c0[dd], qr[2 * g + dd], p0, 0, 0, 0); p1 = __builtin_amdgcn_mfma_f32_32x32x16_bf16(c1[dd], qr[2 * g + dd], p1, 0, 0, 0); }
        SBAR();
#pragma unroll
        for (int dd = 0; dd < 2; ++dd) { c0[dd] = n0[dd]; c1[dd] = n1[dd]; } }
}
__device__ __forceinline__ void at_qkt8(f32x16& p0, f32x16& p1, LAS const unsigned char* Kb, const int (&ko)[6], int kmask, const pg8::i32x8* q8) {
#define AT_KO2(x) (ko[x] + 6080 + 192 * ((kmask >> (x)) & 1))
    p0 = (f32x16){0.f, 0.f, 0.f, 0.f, 0.f, 0.f, 0.f, 0.f, 0.f, 0.f, 0.f, 0.f, 0.f, 0.f, 0.f, 0.f}; p1 = p0;
    pg8::i32x8 a0 = pg8::cat8(*(LAS const bf16x8*)(Kb + ko[0]), *(LAS const bf16x8*)(Kb + ko[1])), a1 = pg8::cat8(*(LAS const bf16x8*)(Kb + AT_KO2(0)), *(LAS const bf16x8*)(Kb + AT_KO2(1)));
#pragma unroll
    for (int j = 0; j < 3; ++j) { pg8::i32x8 n0 = a0, n1 = a1;
        if (j < 2) { n0 = pg8::cat8(*(LAS const bf16x8*)(Kb + ko[2 * j + 2]), *(LAS const bf16x8*)(Kb + ko[2 * j + 3])); n1 = pg8::cat8(*(LAS const bf16x8*)(Kb + AT_KO2(2 * j + 2)), *(LAS const bf16x8*)(Kb + AT_KO2(2 * j + 3))); }
        SBAR(); __builtin_amdgcn_s_setprio(1);
        p0 = __builtin_amdgcn_mfma_scale_f32_32x32x64_f8f6f4(a0, q8[j], p0, 0, 0, 0, 0, 0, 0);
        p1 = __builtin_amdgcn_mfma_scale_f32_32x32x64_f8f6f4(a1, q8[j], p1, 0, 0, 0, 0, 0, 0);
        __builtin_amdgcn_s_setprio(0); SBAR(); a0 = n0; a1 = n1; }
#undef AT_KO2
}
__device__ __forceinline__ void at_pv(f32x16* o, unsigned vb0, bf16x8 pa0, bf16x8 pa1, bf16x8 pa2, bf16x8 pa3) {
#define AT_TRRD(dst, off) asm volatile("ds_read_b64_tr_b16 %0, %1 offset:%2" : "=&v"(dst) : "v"(vb0), "i"(off) : "memory")
#define AT_LOADV(L, H, d0) do { constexpr int b_ = v_rd_off(d0, 0, 0); AT_TRRD(L[0], b_); AT_TRRD(H[0], b_ + 2048); AT_TRRD(L[1], b_ + 4096); AT_TRRD(H[1], b_ + 6144); \
        AT_TRRD(L[2], b_ + 8192); AT_TRRD(H[2], b_ + 10240); AT_TRRD(L[3], b_ + 12288); AT_TRRD(H[3], b_ + 14336); } while (0)
#define AT_MMAV(L, H, d0) do { o[d0] = __builtin_amdgcn_mfma_f32_32x32x16_bf16(pa0, cat4(L[0], H[0]), o[d0], 0, 0, 0); o[d0] = __builtin_amdgcn_mfma_f32_32x32x16_bf16(pa1, cat4(L[1], H[1]), o[d0], 0, 0, 0); \
        o[d0] = __builtin_amdgcn_mfma_f32_32x32x16_bf16(pa2, cat4(L[2], H[2]), o[d0], 0, 0, 0); o[d0] = __builtin_amdgcn_mfma_f32_32x32x16_bf16(pa3, cat4(L[3], H[3]), o[d0], 0, 0, 0); } while (0)
    s16x4 la[4], ha[4], lb[4], hb[4];
    AT_LOADV(la, ha, 0); AT_LOADV(lb, hb, 1);
    asm volatile("s_waitcnt lgkmcnt(8)" ::: "memory"); SBAR(); AT_MMAV(la, ha, 0); SBAR();
    AT_LOADV(la, ha, 2);
    asm volatile("s_waitcnt lgkmcnt(8)" ::: "memory"); SBAR(); AT_MMAV(lb, hb, 1); SBAR();
    AT_LOADV(lb, hb, 3);
    asm volatile("s_waitcnt lgkmcnt(8)" ::: "memory"); SBAR(); AT_MMAV(la, ha, 2); SBAR();
    asm volatile("s_waitcnt lgkmcnt(0)" ::: "memory"); SBAR(); AT_MMAV(lb, hb, 3); SBAR();
#undef AT_MMAV
#undef AT_LOADV
#undef AT_TRRD
}
__device__ __forceinline__ pg8::i32x8 at_finishSM8(const f32x16& p0, const f32x16& p1, float alpha, float& l_reg) {
    float ps = 0.f;
#pragma unroll
    for (int r = 0; r < 16; ++r) ps += p0[r];
#pragma unroll
    for (int r = 0; r < 16; ++r) ps += p1[r];
    { auto rr = __builtin_amdgcn_permlane32_swap(__float_as_uint(ps), __float_as_uint(ps), false, false); ps = __uint_as_float(rr[0]) + __uint_as_float(rr[1]); }
    l_reg = l_reg * alpha + ps;
    int w[8];
#pragma unroll
    for (int k = 0; k < 4; ++k) { int x = __builtin_amdgcn_cvt_pk_fp8_f32(p0[4 * k], p0[4 * k + 1], 0, false); x = __builtin_amdgcn_cvt_pk_fp8_f32(p0[4 * k + 2], p0[4 * k + 3], x, true); w[k] = x;
        x = __builtin_amdgcn_cvt_pk_fp8_f32(p1[4 * k], p1[4 * k + 1], 0, false); x = __builtin_amdgcn_cvt_pk_fp8_f32(p1[4 * k + 2], p1[4 * k + 3], x, true); w[4 + k] = x; }
    return (pg8::i32x8){w[0], w[1], w[2], w[3], w[4], w[5], w[6], w[7]};
}
__device__ __forceinline__ s16x4 lds_tr8(LAS const unsigned char* p) { typedef int v2i_t __attribute__((ext_vector_type(2))); return __builtin_bit_cast(s16x4, __builtin_amdgcn_ds_read_tr8_b64_v2i32((LAS v2i_t*)p)); }
__device__ __forceinline__ void at_pv8(f32x16* o, LAS const unsigned char* const (&va)[4], pg8::i32x8 P8) {
#pragma unroll
    for (int d0 = 0; d0 < 4; ++d0) { const s16x4 t0 = lds_tr8(va[d0]), t1 = lds_tr8(va[d0] + 2048), t2 = lds_tr8(va[d0] + 4096), t3 = lds_tr8(va[d0] + 6144);
        const pg8::i32x8 B = pg8::cat8(cat4(t0, t1), cat4(t2, t3));
        asm volatile("v_mfma_f32_32x32x64_f8f6f4 %0, %1, %2, %0" : "+v"(o[d0]) : "v"(P8), "v"(B)); }
}
__device__ __forceinline__ void at_dma_tile(LAS unsigned char* lds, const unsigned char* Kt, const unsigned char* Vt, int buf, int wave, int lane) {
    unsigned lo = (unsigned)lane * 16u; asm volatile("" : "+v"(lo));
#pragma unroll
    for (int i = 0; i < 2; ++i) { const int pc = wave + 8 * i; if (pc < 12) __builtin_amdgcn_global_load_lds((const unsigned*)((Kt + pc * 1024) + lo), (LAS unsigned*)(lds + AT_K0 + buf * AT_KSZ + pc * 1024), 16, 0, 0); }
    __builtin_amdgcn_global_load_lds((const unsigned*)((Vt + wave * 1024) + lo), (LAS unsigned*)(lds + AT_V0 + buf * AT_VSZ + wave * 1024), 16, 0, 0);
}
__device__ __forceinline__ void attn_block(Frame& F, const Args& a, int bh, int qb) {
    const int lane = F.lane, wave = F.wave, r32 = lane & 31, hi = lane >> 5, b = bh >> 6, h = bh & 63;
    LAS unsigned char* lds = F.lds;
    const bf16* QRAW = (const bf16*)(a.ws + WS_BIG); const float* ROPEt = (const float*)(a.ws + WS_ROPE);
    const unsigned char* Kimg = a.ws + WS_K + (size_t)bh * NKT * AT_KSZ; const unsigned char* Vimg = a.ws + WS_V + (size_t)bh * NKT * AT_VSZ;
    bf16* ATO = (bf16*)(a.ws + WS_KNOPE);
    const int NT = 4 * qb + 5;
    at_dma_tile(lds, Kimg, Vimg, 0, wave, lane);
    const int m = b * SEQ + 256 * qb + 32 * wave + r32;
    pg8::i32x8 q8[3];
#define Q8F(word, b) __builtin_amdgcn_cvt_f32_fp8((int)(word), b)
    {   v2u qraw[12]; float ss = 0.f;
        const unsigned qo = (unsigned)(m * (AH * QKD) + h * QKD);
#pragma unroll
        for (int j = 0; j < 3; ++j)
#pragma unroll
            for (int i = 0; i < 4; ++i) { const int d = j < 2 ? 64 * j + 32 * hi + 8 * i : (i < 2 ? 128 + 16 * hi + 8 * i : 160 + 16 * hi + 8 * (i - 2));
                qraw[4 * j + i] = *(const GAS v2u*)((const GAS unsigned char*)QRAW + (qo + (unsigned)d)); }
#pragma unroll
        for (int d0 = 0; d0 < 12; ++d0) { const v2u w = qraw[d0];
            ss += (Q8F(w.x, 0) * Q8F(w.x, 0) + Q8F(w.x, 1) * Q8F(w.x, 1)) + (Q8F(w.x, 2) * Q8F(w.x, 2) + Q8F(w.x, 3) * Q8F(w.x, 3)) + (Q8F(w.y, 0) * Q8F(w.y, 0) + Q8F(w.y, 1) * Q8F(w.y, 1)) + (Q8F(w.y, 2) * Q8F(w.y, 2) + Q8F(w.y, 3) * Q8F(w.y, 3)); }
        ss += __shfl_xor(ss, 32);
        const float r = (F8_A_SCALE / 16.0f) / sqrtf(ss * (1.0f / (256.0f * QKD)) + EPS);
        LAS const float* gq = (LAS const float*)(lds + AT_GQ);
#pragma unroll
        for (int j = 0; j < 2; ++j) { int wds[8];
#pragma unroll
            for (int i = 0; i < 4; ++i) { const v2u w = qraw[4 * j + i]; const int d = 64 * j + 32 * hi + 8 * i; const f32x4 g0 = *(LAS const f32x4*)(gq + d), g1 = *(LAS const f32x4*)(gq + d + 4);
                int x = __builtin_amdgcn_cvt_pk_fp8_f32(Q8F(w.x, 0) * r * g0.x, Q8F(w.x, 1) * r * g0.y, 0, false); x = __builtin_amdgcn_cvt_pk_fp8_f32(Q8F(w.x, 2) * r * g0.z, Q8F(w.x, 3) * r * g0.w, x, true); wds[2 * i] = x;
                x = __builtin_amdgcn_cvt_pk_fp8_f32(Q8F(w.y, 0) * r * g1.x, Q8F(w.y, 1) * r * g1.y, 0, false); x = __builtin_amdgcn_cvt_pk_fp8_f32(Q8F(w.y, 2) * r * g1.z, Q8F(w.y, 3) * r * g1.w, x, true); wds[2 * i + 1] = x; }
            q8[j] = (pg8::i32x8){wds[0], wds[1], wds[2], wds[3], wds[4], wds[5], wds[6], wds[7]}; }
        {
            const float* rt = ROPEt + (size_t)m * 64; float o1[16], o2[16];
#pragma unroll
            for (int i = 0; i < 2; ++i) { const v2u w1 = qraw[8 + i], w2 = qraw[10 + i]; const int i0 = 16 * hi + 8 * i;
                const f32x4 ga = *(LAS const f32x4*)(gq + 128 + i0), gb = *(LAS const f32x4*)(gq + 128 + i0 + 4), gc = *(LAS const f32x4*)(gq + 160 + i0), gd = *(LAS const f32x4*)(gq + 160 + i0 + 4);
                const f32x4 c0 = *(const GAS f32x4*)(rt + i0), c1 = *(const GAS f32x4*)(rt + i0 + 4), s0 = *(const GAS f32x4*)(rt + 32 + i0), s1 = *(const GAS f32x4*)(rt + 32 + i0 + 4);
                const float t1[8] = {Q8F(w1.x, 0) * r * ga.x, Q8F(w1.x, 1) * r * ga.y, Q8F(w1.x, 2) * r * ga.z, Q8F(w1.x, 3) * r * ga.w, Q8F(w1.y, 0) * r * gb.x, Q8F(w1.y, 1) * r * gb.y, Q8F(w1.y, 2) * r * gb.z, Q8F(w1.y, 3) * r * gb.w};
                const float t2[8] = {Q8F(w2.x, 0) * r * gc.x, Q8F(w2.x, 1) * r * gc.y, Q8F(w2.x, 2) * r * gc.z, Q8F(w2.x, 3) * r * gc.w, Q8F(w2.y, 0) * r * gd.x, Q8F(w2.y, 1) * r * gd.y, Q8F(w2.y, 2) * r * gd.z, Q8F(w2.y, 3) * r * gd.w};
                const float cs[8] = {c0.x, c0.y, c0.z, c0.w, c1.x, c1.y, c1.z, c1.w}, sn[8] = {s0.x, s0.y, s0.z, s0.w, s1.x, s1.y, s1.z, s1.w};
#pragma unroll
                for (int e = 0; e < 8; ++e) { o1[8 * i + e] = t1[e] * cs[e] - t2[e] * sn[e]; o2[8 * i + e] = t1[e] * sn[e] + t2[e] * cs[e]; } }
            int wds[8];
#pragma unroll
            for (int k = 0; k < 4; ++k) { int x = __builtin_amdgcn_cvt_pk_fp8_f32(o1[4 * k], o1[4 * k + 1], 0, false); x = __builtin_amdgcn_cvt_pk_fp8_f32(o1[4 * k + 2], o1[4 * k + 3], x, true); wds[k] = x;
                x = __builtin_amdgcn_cvt_pk_fp8_f32(o2[4 * k], o2[4 * k + 1], 0, false); x = __builtin_amdgcn_cvt_pk_fp8_f32(o2[4 * k + 2], o2[4 * k + 3], x, true); wds[4 + k] = x; }
            q8[2] = (pg8::i32x8){wds[0], wds[1], wds[2], wds[3], wds[4], wds[5], wds[6], wds[7]}; }
    }
#undef Q8F
    int ko[6], kmask = 0;
    { int rq = r32; asm volatile("" : "+v"(rq));
#pragma unroll
      for (int j = 0; j < 3; ++j)
#pragma unroll
        for (int w = 0; w < 2; ++w) { const int c = j < 2 ? 4 * j + 2 * hi + w : 8 + hi + 2 * w; const int cp = (c + (rq >> 2)) % 12;
            ko[2 * j + w] = rq * 192 + (cp << 4); kmask |= (cp < 4 ? 1 : 0) << (2 * j + w); } }
    LAS float* wsf = (LAS float*)(lds + AT_WS + wave * 256); LAS float* li_l = wsf; LAS float* al_l = wsf + 32;
    float m_reg = -1e30f, l_reg = 0.f; f32x16 o[4];
#pragma unroll
    for (int d = 0; d < 4; ++d) o[d] = (f32x16){0.f, 0.f, 0.f, 0.f, 0.f, 0.f, 0.f, 0.f, 0.f, 0.f, 0.f, 0.f, 0.f, 0.f, 0.f, 0.f};
    const int qlo = NMETA + 256 * qb + 32 * wave;
    const int qm = qlo + r32 - 4 * hi;
    int vrow0, vsk;
    { const int q = (lane & 15) >> 1; vrow0 = ((q & 3) + 8 * (q >> 2) + 4 * hi) * 128 + 16 * ((lane >> 4) & 1) + 8 * (lane & 1); vsk = ((q >> 1) & 1) | (((q >> 2) & 1) << 1); }
    VM_WAIT(); __syncthreads();
    for (int t = 0; t < NT; ++t) {
        const int buf = t & 1;
        if (t + 1 < NT) at_dma_tile(lds, Kimg + (size_t)(t + 1) * AT_KSZ, Vimg + (size_t)(t + 1) * AT_VSZ, buf ^ 1, wave, lane);
        const int kb = 64 * t;
        if (kb <= qlo + 31) {
            f32x16 p0, p1; float mn, alpha;
            at_qkt8(p0, p1, lds + AT_K0 + buf * AT_KSZ, ko, kmask, q8);
            if (kb + 63 > qlo) at_mask(p0, p1, qm - kb);
            at_partialSM(p0, p1, m_reg, mn, alpha);
            if (__any(alpha < 1.f)) { if (hi == 0) al_l[r32] = alpha; LDS_WAIT();
#pragma unroll
                for (int d = 0; d < 4; ++d)
#pragma unroll
                    for (int r = 0; r < 16; ++r) o[d][r] *= al_l[crow(r, hi)]; }
            const pg8::i32x8 P8 = at_finishSM8(p0, p1, alpha, l_reg);
            LAS const unsigned char* vt = lds + AT_V0 + buf * AT_VSZ + vrow0;
            LAS const unsigned char* const va[4] = {vt + ((0 ^ vsk) << 5), vt + ((1 ^ vsk) << 5), vt + ((2 ^ vsk) << 5), vt + ((3 ^ vsk) << 5)};
            at_pv8(o, va, P8);
        }
        VM_WAIT(); LDS_WAIT(); __syncthreads();
    }
    asm volatile("s_nop 15\n\ts_nop 15" ::: "memory");
    if (hi == 0) li_l[r32] = l_reg;
    LDS_WAIT();
    {   LAS unsigned char* ost = lds + AT_OST + wave * 4096 + 4 * hi * 128 + r32;
#pragma unroll
        for (int r = 0; r < 16; ++r) { const float rl = (ATT_O_SCALE / F8_A_SCALE) * __builtin_amdgcn_rcpf(li_l[crow(r, hi)]);
#pragma unroll
            for (int d0 = 0; d0 < 4; d0 += 2) { const int w = __builtin_amdgcn_cvt_pk_fp8_f32(o[d0][r] * rl, o[d0 + 1][r] * rl, 0, false);
                ost[((r & 3) + 8 * (r >> 2)) * 128 + d0 * 32] = (unsigned char)w; ost[((r & 3) + 8 * (r >> 2)) * 128 + d0 * 32 + 32] = (unsigned char)(w >> 8); } }
        LDS_WAIT();
        unsigned ob = (unsigned)((b * SEQ + 256 * qb + 32 * wave + (lane >> 3)) * (AH * VHD) + h * VHD + 16 * (lane & 7));
        asm volatile("" : "+v"(ob));
#pragma unroll
        for (int j = 0; j < 4; ++j) { const v4u x = *(LAS const v4u*)(lds + AT_OST + wave * 4096 + ((lane >> 3) + 8 * j) * 128 + 16 * (lane & 7));
            *(GAS v4u*)((GAS unsigned char*)ATO + (ob + (unsigned)(8 * j * (AH * VHD)))) = x; } }
    LDS_WAIT(); __syncthreads();
}
__device__ __forceinline__ void attn_phase(Frame& F, const Args& a) {
    if (F.tid < QKD) ((LAS float*)(F.lds + AT_GQ))[F.tid] = ((const float*)a.in[21])[F.tid];
    LDS_WAIT(); __syncthreads();
    for (int n = F.vcu; n < 2048; n += F.G) { const int st = n >> 8, cu = n & 255, xcd = cu >> 5, j = cu & 31; const int bh = 32 * xcd + 4 * st + (j >> 3), p = j & 7;
        attn_block(F, a, bh, 15 - p); attn_block(F, a, bh, p); }
}

__device__ __forceinline__ void meta_in_phase(Frame& F, const Args& a) {
    const bf16* XN = (const bf16*)(a.ws + WS_XN); const bf16* WT = (const bf16*)(a.ws + WS_W_IN); bf16* PROJ = (bf16*)(a.ws + WS_BIG); float* GATES = (float*)(a.ws + WS_GATES);
    const int lane = F.lane, r = lane & 15, q4 = lane >> 4;
    for (int t = F.vcu; t < 769 + 1024; t += F.G) { f32x4 acc[1];
        if (t < 769) { skinny_wg<1>(F, XN + (size_t)MR * DM, WT + (size_t)(16 * t) * DM, WT, DM, acc);
            if (F.wave == 0) {
                if (t < 768) { v2u w; w.x = pk2(acc[0][0], acc[0][1]); w.y = pk2(acc[0][2], acc[0][3]); *(GAS v2u*)(PROJ + (size_t)(MR + r) * NPROJ + 16 * t + 4 * q4) = w; }
                else {
#pragma unroll
                    for (int j = 0; j < 4; ++j) GATES[(size_t)(4 * q4 + j) * MT + MR + r] = acc[0][j]; } } }
        else { const int tt = t - 769;
            skinny_wg<1>(F, WT + (size_t)NPROJ * DM, XN + (size_t)(16 * tt) * DM, XN, DM, acc);
            if (F.wave == 0) *(GAS f32x4*)(GATES + (size_t)r * MT + 16 * tt + 4 * q4) = acc[0]; }
    }
}
__device__ __forceinline__ void meta_out_phase(Frame& F, const Args& a) {
    const bf16* A2 = (const bf16*)(a.ws + WS_XN); const bf16* WT = (const bf16*)(a.ws + WS_W_OUT); float* HM = (float*)(a.ws + WS_HMETA); const float* mt = (const float*)a.in[2];
    const int lane = F.lane, r = lane & 15, q4 = lane >> 4;
    for (int t = F.vcu; t < 256; t += F.G) { f32x4 acc[1]; skinny_wg<1>(F, A2 + (size_t)MR * DM, WT + (size_t)(16 * t) * DM, WT, DM, acc);
        if (F.wave == 0) { const size_t o = (size_t)r * DM + 16 * t + 4 * q4; *(GAS f32x4*)(HM + o) = *(const GAS f32x4*)(mt + o) + acc[0]; } }
}
__device__ __forceinline__ void meta_gu_phase(Frame& F, const Args& a) {
    const bf16* XN = (const bf16*)(a.ws + WS_XN); const bf16* WT = (const bf16*)(a.ws + WS_W_GU0); bf16* ACT = (bf16*)(a.ws + WS_BIG);
    const int lane = F.lane, r = lane & 15, q4 = lane >> 4;
    for (int t = F.vcu; t < DFF / 16; t += F.G) { const int c0 = 16 * t, j = c0 >> 7, i = c0 & 127; f32x4 gu[2];
        skinny_wg<2>(F, XN + (size_t)MR * DM, WT + (size_t)(256 * j + i) * DM, WT + (size_t)(256 * j + 128 + i) * DM, DM, gu);
        if (F.wave == 0) { v2u w; w.x = pk2(pg8::silu_mul(gu[0][0], gu[1][0]), pg8::silu_mul(gu[0][1], gu[1][1])); w.y = pk2(pg8::silu_mul(gu[0][2], gu[1][2]), pg8::silu_mul(gu[0][3], gu[1][3]));
            *(GAS v2u*)(ACT + (size_t)(MR + r) * DFF + c0 + 4 * q4) = w; } }
}
__device__ __forceinline__ void meta_down_phase(Frame& F, const Args& a) {
    const bf16* ACT = (const bf16*)(a.ws + WS_BIG); const bf16* WT = (const bf16*)(a.ws + WS_W_DN0); float* HM = (float*)(a.ws + WS_HMETA);
    const int lane = F.lane, r = lane & 15, q4 = lane >> 4;
    for (int t = F.vcu; t < 256; t += F.G) { f32x4 acc[1]; skinny_wg<1>(F, ACT + (size_t)MR * DFF, WT + (size_t)(16 * t) * DFF, WT, DFF, acc);
        if (F.wave == 0) { const size_t o = (size_t)r * DM + 16 * t + 4 * q4; *(GAS f32x4*)(HM + o) = *(const GAS f32x4*)(HM + o) + acc[0]; } }
}
__device__ __forceinline__ void meta_kvq_phase(Frame& F, const Args& a) {
    const bf16* XN = (const bf16*)(a.ws + WS_XN); const bf16* WT = (const bf16*)(a.ws + WS_W_KVQ); float* LAT = (float*)(a.ws + WS_LAT);
    const int lane = F.lane, r = lane & 15, q4 = lane >> 4;
    for (int t = F.vcu; t < 36; t += F.G) { f32x4 acc[1]; skinny_wg<1>(F, XN + (size_t)MR * DM, WT + (size_t)(16 * t) * DM, WT, DM, acc);
        if (F.wave == 0) *(GAS f32x4*)(LAT + (size_t)(MR + r) * NKVQ + 16 * t + 4 * q4) = acc[0]; }
}
__device__ __forceinline__ void meta_kvup_phase(Frame& F, const Args& a) {
    const bf16* CK = (const bf16*)(a.ws + WS_CKVN); const bf16* WT = (const bf16*)(a.ws + WS_W_KVUP); bf16* KN = (bf16*)(a.ws + WS_KNOPE); unsigned char* Vimg = a.ws + WS_V;
    const int lane = F.lane, r = lane & 15, q4 = lane >> 4;
    for (int t = F.vcu; t < 1024; t += F.G) { f32x4 acc[1]; skinny_wg<1>(F, CK + (size_t)MR * KVLORA, WT + (size_t)(16 * t) * KVLORA, WT, KVLORA, acc);
        if (F.wave == 0) { const int n = 16 * t + 4 * q4, hd = n >> 8, wi = n & 255; v2u w; w.x = pk2(acc[0][0], acc[0][1]); w.y = pk2(acc[0][2], acc[0][3]);
            if (wi < 128) *(GAS v2u*)(KN + (size_t)(MR + r) * 8192 + hd * 128 + wi) = w;
            else { const int c0 = wi - 128; int x = __builtin_amdgcn_cvt_pk_fp8_f32(acc[0][0] * 16.f, acc[0][1] * 16.f, 0, false); x = __builtin_amdgcn_cvt_pk_fp8_f32(acc[0][2] * 16.f, acc[0][3] * 16.f, x, true);
                for (int bb = 0; bb < BATCH; ++bb) *(GAS unsigned*)(Vimg + ((size_t)((bb * AH + hd) * NKT)) * 8192 + pg8::v_img_off8(r, c0)) = (unsigned)x; } } }
}

constexpr int NPH = 18;
__global__ void __launch_bounds__(NTHR, 2) mk_fwd(Args args) {
    extern __shared__ __attribute__((aligned(16))) unsigned char lds_raw[];
    Frame F;
    F.lds = (LAS unsigned char*)lds_raw;
    F.tid = threadIdx.x; F.lane = F.tid & 63; F.wave = __builtin_amdgcn_readfirstlane(F.tid >> 6);
    F.G = gridDim.x; { const int bx = blockIdx.x; F.vcu = (F.G % 8 == 0) ? (bx % 8) * (F.G / 8) + bx / 8 : bx; }
    F.gw = F.vcu * NWAVES + F.wave; F.ngw = F.G * NWAVES;
    volatile LAS unsigned* MISC = (volatile LAS unsigned*)(F.lds + MISC_OFF);
    for (int u = F.tid; u < (LDS_BYTES - LDSCTL_OFF) / 4; u += NTHR) ((LAS unsigned*)(F.lds + LDSCTL_OFF))[u] = 0u;
    __syncthreads();
    unsigned char* ws = args.ws;
    const int lo = args.ph_lo, hi = args.ph_hi;
    const bool one_launch = (hi - lo) > 1;
    XcdBarrier bar; bar.bar = (unsigned*)(ws + WS_CTL); bar.x = 0; bar.st = nullptr;
    if (one_launch) bar = xcd_barrier_post((unsigned*)(ws + WS_CTL), MISC + 8);
    bar.wave = F.wave;
#ifndef MK_PHASES
#define MK_PHASES 0x3ffff
#endif
#define IN(k) ((((MK_PHASES) >> (k)) & 1) && lo <= (k) && (k) < hi)
#define SEAM(k) do { if (IN((k) + 1)) xcd_barrier(bar); } while (0)
    pg8::f16_t* H = (pg8::f16_t*)(ws + WS_H16);
#define REFRESH() do { F.lane = (int)__builtin_amdgcn_mbcnt_hi(~0u, __builtin_amdgcn_mbcnt_lo(~0u, 0u)); F.tid = F.wave * 64 + F.lane; } while (0)
    pg8::f16_t* Hw = args.dry ? (pg8::f16_t*)(ws + WS_END) : H;

    if (IN(0)) { REFRESH(); p0_prologue(F, args); SEAM(0); }
    if (IN(1)) { REFRESH();
        { pg8::Gemm g{(const bf16*)(ws + WS_XN), (const bf16*)(ws + WS_W_IN), MR, 8192, DM}; pg8::StaticOrder S; S.init(MR, 8192, F.G, (int)blockIdx.x);
          pg8::EpiBf16 E{(bf16*)(ws + WS_BIG), NPROJ};
          pg8::gemm_phase<pg8::EpiBf16, pg8::StaticOrder, true, true>(F.lds, g, S, E, F.wave); }
        { pg8::Gemm g{(const bf16*)(ws + WS_HH), (const bf16*)(ws + WS_W_INO8), MR, DM, DM / 2, 0x77777777, 0x7B7B7B7B}; pg8::StaticOrder S; S.init(MR, DM, F.G, (int)blockIdx.x);
          pg8::EpiBf16 E{(bf16*)(ws + WS_BIG) + 8192, NPROJ};
          pg8::gemm_phase<pg8::EpiBf16, pg8::StaticOrder, true, true, true>(F.lds, g, S, E, F.wave); }
        meta_in_phase(F, args); SEAM(1); }
    if (IN(2)) { REFRESH(); for (int u = F.vcu; u < 256; u += F.G) mlstm_unit(F, args, u); SEAM(2); }
    if (IN(3)) { REFRESH(); gate_norm_phase(F, args); SEAM(3); }
    if (IN(4)) { REFRESH();
        pg8::Gemm g{(const bf16*)(ws + WS_XN), (const bf16*)(ws + WS_W_OUT), MR, DM, DM}; pg8::StaticOrder S; S.init(MR, DM, F.G, (int)blockIdx.x);
        pg8::EpiRes<float, pg8::f16_t> E{(const float*)args.in[0], H, DM};
        pg8::gemm_phase<pg8::EpiRes<float, pg8::f16_t>, pg8::StaticOrder, true, true>(F.lds, g, S, E, F.wave);
        meta_out_phase(F, args); SEAM(4); }
    if (IN(5)) { REFRESH(); norm_phase_h(F, H, (const float*)(ws + WS_HMETA), (bf16*)(ws + WS_XN), nullptr, MT, 0); SEAM(5); }
    if (IN(6)) { REFRESH();
        pg8::Gemm g{(const bf16*)(ws + WS_XN), (const bf16*)(ws + WS_W_GU0), MR, NGU, DM}; pg8::StaticOrder S; S.init(MR, NGU, F.G, (int)blockIdx.x);
        pg8::EpiSwiglu E{(bf16*)(ws + WS_BIG), DFF};
        pg8::gemm_phase<pg8::EpiSwiglu, pg8::StaticOrder, true, true>(F.lds, g, S, E, F.wave);
        p0_deferred(F, args, (MR / 256) * (NGU / 256), P0_NITEMS - P0_DEFER_A - P0_DEFER_B, P0_DEFER_A); __syncthreads();
        meta_gu_phase(F, args); SEAM(6); }
    if (IN(7)) { REFRESH();
        pg8::Gemm g{(const bf16*)(ws + WS_BIG), (const bf16*)(ws + WS_W_DN0), MR, DM, DFF}; pg8::StaticOrder S; S.init(MR, DM, F.G, (int)blockIdx.x);
        pg8::EpiRes<pg8::f16_t, pg8::f16_t> E{H, Hw, DM};
        pg8::gemm_phase<pg8::EpiRes<pg8::f16_t, pg8::f16_t>, pg8::StaticOrder, true, true>(F.lds, g, S, E, F.wave);
        meta_down_phase(F, args); SEAM(7); }
    if (IN(8)) { REFRESH(); norm_phase_h(F, H, (const float*)(ws + WS_HMETA), (bf16*)(ws + WS_XN), ws + WS_XN, MT, 2); SEAM(8); }
    if (IN(9)) { REFRESH();
        pg8::Gemm g{(const bf16*)(ws + WS_XN), (const bf16*)(ws + WS_W_KVQ8), MR, NKVQ, DM / 2, 0x77777777, 0x7B7B7B7B}; pg8::StaticOrder S; S.init(MR, NKVQ, F.G, (int)blockIdx.x);
        pg8::EpiF16 E{(pg8::f16_t*)(ws + WS_LAT), NKVQ};
        pg8::gemm_phase<pg8::EpiF16, pg8::StaticOrder, true, true, true>(F.lds, g, S, E, F.wave);
        meta_kvq_phase(F, args); SEAM(9); }
    if (IN(10)) { REFRESH(); latent_norm_phase(F, args); SEAM(10); }
    if (IN(11)) { REFRESH();
        { pg8::Gemm g{(const bf16*)(ws + WS_CKVN), (const bf16*)(ws + WS_W_KVUP8), MR, AH * 256, KVLORA / 2, 0x77777777, 0x7B7B7B7B}; pg8::StaticOrder S; S.init(MR, AH * 256, F.G, (int)blockIdx.x);
          pg8::EpiKvUpK E{ws + WS_K, (bf16*)(ws + WS_V), (const float*)(ws + WS_PRE), (const float*)(ws + WS_SSR), (const float*)args.in[16], (LAS float*)(F.lds + EPI_RED_OFF)};
          pg8::gemm_phase<pg8::EpiKvUpK, pg8::StaticOrder, true, true, true>(F.lds, g, S, E, F.wave); }
        { pg8::Gemm g{(const bf16*)(ws + WS_CQN), (const bf16*)(ws + WS_W_UQ8), MR, AH * QKD, QLORA / 2, 0x77777777, 0x7B7B7B7B}; pg8::StaticOrder S; S.init(MR, AH * QKD, F.G, (int)blockIdx.x);
          pg8::EpiF8 E{ws + WS_BIG, AH * QKD};
          pg8::gemm_phase<pg8::EpiF8, pg8::StaticOrder, true, true, true>(F.lds, g, S, E, F.wave); }
        meta_kvup_phase(F, args); SEAM(11); }
    if (IN(12)) { REFRESH(); k_final_phase(F, args); SEAM(12); }
    if (IN(13)) { REFRESH(); attn_phase(F, args); SEAM(13); }
    if (IN(14)) { REFRESH();
        pg8::Gemm g{(const bf16*)(ws + WS_KNOPE), (const bf16*)(ws + WS_W_O), MR, DM, AH * VHD / 2, 0x77777777, 0x7B7B7B7B}; pg8::StaticOrder S; S.init(MR, DM, F.G, (int)blockIdx.x);
        pg8::EpiRes<pg8::f16_t, pg8::f16_t> E{H, Hw, DM};
        pg8::gemm_phase<pg8::EpiRes<pg8::f16_t, pg8::f16_t>, pg8::StaticOrder, true, true, true>(F.lds, g, S, E, F.wave); SEAM(14); }
    if (IN(15)) { REFRESH(); norm_phase_h(F, H, (const float*)(ws + WS_HMETA), (bf16*)(ws + WS_XN), nullptr, MR, 0); SEAM(15); }
    if (IN(16)) { REFRESH();
        pg8::Gemm g{(const bf16*)(ws + WS_XN), (const bf16*)(ws + WS_W_GU1), MR, NGU, DM}; pg8::StaticOrder S; S.init(MR, NGU, F.G, (int)blockIdx.x);
        pg8::EpiSwiglu E{(bf16*)(ws + WS_BIG), DFF};
        pg8::gemm_phase<pg8::EpiSwiglu, pg8::StaticOrder, true, true>(F.lds, g, S, E, F.wave);
        p0_deferred(F, args, (MR / 256) * (NGU / 256), P0_NITEMS - P0_DEFER_B, P0_DEFER_B); SEAM(16); }
    if (IN(17)) { REFRESH();
        pg8::Gemm g{(const bf16*)(ws + WS_BIG), (const bf16*)(ws + WS_W_DN1), MR, DM, DFF}; pg8::StaticOrder S; S.init(MR, DM, F.G, (int)blockIdx.x);
        pg8::EpiRes<pg8::f16_t, float> E{H, args.dry ? (float*)(ws + WS_END) : args.out, DM};
        pg8::gemm_phase<pg8::EpiRes<pg8::f16_t, float>, pg8::StaticOrder, true, true>(F.lds, g, S, E, F.wave); }
#undef REFRESH
#undef IN
#undef SEAM
}

__global__ void mk_dump(const unsigned char* src, int is_bf16, size_t n_src, float* out, size_t n_out) {
    for (size_t i = (size_t)blockIdx.x * blockDim.x + threadIdx.x; i < n_out; i += (size_t)gridDim.x * blockDim.x) { const size_t j = i % n_src;
        out[i] = is_bf16 ? bf2f(((const unsigned short*)src)[j]) : ((const float*)src)[j]; }
}
extern "C" void kernel_launch(void* const* d_in, const int* in_sizes, int n_in, void* d_out, int out_size, void* d_ws, size_t ws_size, hipStream_t stream) {
    static int grid = 0;
    if (grid == 0) {
        if (n_in != 23 || out_size != MR * DM || ws_size < WS_END) { fprintf(stderr, "kernel_launch: unexpected shapes (n_in %d, out %d, ws %zu < %zu)\n", n_in, out_size, ws_size, (size_t)WS_END); grid = -1; return; }
        int dev = 0, cus = 0, per_cu = 0;
        if (hipGetDevice(&dev) != hipSuccess || hipDeviceGetAttribute(&cus, hipDeviceAttributeMultiprocessorCount, dev) != hipSuccess) { grid = -1; return; }
        if (hipFuncSetAttribute((const void*)mk_fwd, hipFuncAttributeMaxDynamicSharedMemorySize, LDS_BYTES) != hipSuccess) { fprintf(stderr, "kernel_launch: hipFuncSetAttribute failed\n"); grid = -1; return; }
        if (hipOccupancyMaxActiveBlocksPerMultiprocessor(&per_cu, (const void*)mk_fwd, NTHR, LDS_BYTES) != hipSuccess || per_cu < 1) fprintf(stderr, "kernel_launch: occupancy query reports %d\n", per_cu);
        (void)hipGetLastError();
        grid = cus;
    }
    if (grid < 0) return;
    (void)hipMemsetAsync((char*)d_ws + WS_CTL, 0, CTL_ZERO_BYTES, stream);
    Args a{};
    for (int i = 0; i < 23; ++i) a.in[i] = d_in[i];
    a.out = (float*)d_out; a.ws = (unsigned char*)d_ws;
#if defined(MK_STOP_AFTER)
    for (int p = 0; p <= MK_STOP_AFTER; ++p) { a.ph_lo = p; a.ph_hi = p + 1; hipLaunchKernelGGL(mk_fwd, dim3(grid), dim3(NTHR), LDS_BYTES, stream, a); }
#if defined(MK_DUMP_OFF)
    hipLaunchKernelGGL(mk_dump, dim3(2048), dim3(256), 0, stream, (const unsigned char*)d_ws + (size_t)(MK_DUMP_OFF) * MiB, (int)(MK_DUMP_BF16), (size_t)(MK_DUMP_N), (float*)d_out, (size_t)out_size);
#endif
#elif MK_N_LAUNCHES == 1
    a.ph_lo = 0; a.ph_hi = NPH;
    hipLaunchKernelGGL(mk_fwd, dim3(grid), dim3(NTHR), LDS_BYTES, stream, a);
#else
    for (int p = 0; p < NPH; ++p) { a.ph_lo = p; a.ph_hi = p + 1;
#if defined(MK_REPEAT_PHASE)
        if (((MK_REPEAT_PHASE) >> p) & 1) { a.dry = 1; for (int rr = 0; rr < (MK_REPEAT_N); ++rr) hipLaunchKernelGGL(mk_fwd, dim3(grid), dim3(NTHR), LDS_BYTES, stream, a); a.dry = 0; }
#endif
        hipLaunchKernelGGL(mk_fwd, dim3(grid), dim3(NTHR), LDS_BYTES, stream, a);
#if defined(MK_REPEAT_PHASE)
#endif
    }
#endif
}
```

```cpp
#include <hip/hip_runtime.h>
#include <cstdio>
#include <cstdint>
#ifndef MK_N_LAUNCHES
#define MK_N_LAUNCHES 0
#endif
#undef MK_N_LAUNCHES
#define MK_N_LAUNCHES 1
namespace pg8 {
#define PG8_LAS __attribute__((address_space(3)))
typedef unsigned short bf16_t;
typedef short bf16x8 __attribute__((ext_vector_type(8)));
typedef float f32x4 __attribute__((ext_vector_type(4)));
typedef unsigned u32x4 __attribute__((ext_vector_type(4)));
constexpr int BM = 256, BK = 64, HALF = 128, HTB = HALF * BK * 2  , STAGE_BYTES = 8 * HTB, NXCD = 8, WGM = 8;

__host__ __device__ __forceinline__ int lds_byte(int r, int c) { const int st = (r >> 4) * 2 + (c >> 5), rr = r & 15, cc = c & 31, ob = rr * 64 + cc * 2; return st * 1024 + (ob ^ (((ob >> 9) & 1) << 5)); }
__host__ __device__ __forceinline__ void stage_rc(int b, int& R, int& C) { const int st = b / 1024, sb = b % 1024, swz = sb ^ (((sb >> 9) & 1) << 5); R = (st >> 1) * 16 + swz / 64; C = (st & 1) * 32 + (swz % 64) / 2; }
__host__ __device__ __forceinline__ int perm32(int rho) { const int n = rho >> 4, i = rho & 15; return 8 * (i >> 2) + 4 * n + (i & 3); }

struct Unit { int pm, pn; };
struct Gemm { const bf16_t* A; const bf16_t* Bt; int M, N, K; int sB = 0x7F7F7F7F, sA = 0x7F7F7F7F; };
typedef int i32x8 __attribute__((ext_vector_type(8))); typedef int i32x4 __attribute__((ext_vector_type(4)));
__device__ __forceinline__ i32x8 cat8(bf16x8 a, bf16x8 b) { const i32x4 x = __builtin_bit_cast(i32x4, a), y = __builtin_bit_cast(i32x4, b); return __builtin_shufflevector(x, y, 0, 1, 2, 3, 4, 5, 6, 7); }

struct StaticOrder {
    int nM, nN, nwg, G, c;
    __host__ __device__ void init(int M, int N, int G_, int c_) { nM = M / BM; nN = N / BM; nwg = nM * nN; G = G_; c = c_; }
    __host__ __device__ bool next(int i, Unit& u) const {
        const long L = (long)i * G + c; if (L >= nwg) return false;
        int wgid = (int)L; { const int q = nwg / NXCD, r = nwg % NXCD, xcd = wgid % NXCD, off = wgid / NXCD; wgid = (xcd < r ? xcd * (q + 1) : r * (q + 1) + (xcd - r) * q) + off; }
        const int nig = WGM * nN, gid = wgid / nig, fm = gid * WGM, gsz = (nM - fm) < WGM ? (nM - fm) : WGM;
        u.pm = fm + ((wgid % nig) % gsz); u.pn = (wgid % nig) / gsz; return true;
    }
    __device__ __forceinline__ void a_ready(const Unit&) const {}
    __device__ __forceinline__ void done(const Unit&) const {}
};

typedef float f32x2_cv __attribute__((ext_vector_type(2))); typedef __bf16 bf16x2_cv __attribute__((ext_vector_type(2)));
__device__ __forceinline__ unsigned cvt_pk_bf16(float lo, float hi) { const f32x2_cv v = {lo, hi}; const bf16x2_cv b = __builtin_convertvector(v, bf16x2_cv); return __builtin_bit_cast(unsigned, b); }
__host__ __device__ __forceinline__ int v_img_off8(int k, int d) { return k * 128 + ((((d >> 5) ^ (((k >> 1) & 1) | (((k >> 3) & 1) << 1))) & 3) << 5) + (d & 31); }
__host__ __device__ __forceinline__ int v_st(int k, int c) { const int kk = (k & ~0xC) | ((k & 4) << 1) | ((k & 8) >> 1); return ((kk >> 3) * 4 + (c >> 5)) * 512 + ((kk & 7) * 32 + (c & 31)) * 2; }

struct EpiBf16 {
    static constexpr bool PERM = true, AFTER_DRAIN = false, INIT = false;
    bf16_t* O; int ldc;
    __device__ __forceinline__ void operator()(const f32x4 (&acc)[2][2][4][2], const Unit& u, int wr, int wc, int fr, int fq) const {
        const int row0 = u.pm * BM + wr * 64 + fr, col0 = u.pn * BM + wc * 32 + 8 * fq;
#pragma unroll
        for (int ai = 0; ai < 2; ++ai)
#pragma unroll
            for (int m = 0; m < 4; ++m) { bf16_t* rowp = O + (size_t)(row0 + ai * HALF + m * 16) * ldc + col0;
#pragma unroll
                for (int bj = 0; bj < 2; ++bj) { const f32x4 v0 = acc[ai][bj][m][0], v1 = acc[ai][bj][m][1];
                    u32x4 w; w.x = cvt_pk_bf16(v0[0], v0[1]); w.y = cvt_pk_bf16(v0[2], v0[3]); w.z = cvt_pk_bf16(v1[0], v1[1]); w.w = cvt_pk_bf16(v1[2], v1[3]);
                    *(u32x4*)(rowp + bj * HALF) = w; } }
    }
};
struct EpiF32 {
    static constexpr bool PERM = false, AFTER_DRAIN = false, INIT = false;
    float* C; int ldc;
    __device__ __forceinline__ void operator()(const f32x4 (&acc)[2][2][4][2], const Unit& u, int wr, int wc, int fr, int fq) const {
        const int row0 = u.pm * BM + wr * 64 + fr, col0 = u.pn * BM + wc * 32 + 4 * fq;
#pragma unroll
        for (int ai = 0; ai < 2; ++ai)
#pragma unroll
            for (int m = 0; m < 4; ++m) { float* rowp = C + (size_t)(row0 + ai * HALF + m * 16) * ldc + col0;
#pragma unroll
                for (int bj = 0; bj < 2; ++bj)
#pragma unroll
                    for (int n = 0; n < 2; ++n) *(f32x4*)(rowp + bj * HALF + n * 16) = acc[ai][bj][m][n]; }
    }
};
struct EpiResF32 {
    static constexpr bool PERM = false, AFTER_DRAIN = false, INIT = false;
    const float* base; float* out; int ldc;
    __device__ __forceinline__ void init(f32x4 (&acc)[2][2][4][2], const Unit& u, int wr, int wc, int fr, int fq) const {}
    __device__ __forceinline__ void operator()(const f32x4 (&acc)[2][2][4][2], const Unit& u, int wr, int wc, int fr, int fq) const {
        const int row0 = u.pm * BM + wr * 64 + fr, col0 = u.pn * BM + wc * 32 + 4 * fq;
#pragma unroll
        for (int ai = 0; ai < 2; ++ai)
#pragma unroll
            for (int m = 0; m < 4; ++m) { const size_t off = (size_t)(row0 + ai * HALF + m * 16) * ldc + col0;
#pragma unroll
                for (int bj = 0; bj < 2; ++bj)
#pragma unroll
                    for (int n = 0; n < 2; ++n) { const f32x4 b = *(const f32x4*)(base + off + bj * HALF + n * 16); *(f32x4*)(out + off + bj * HALF + n * 16) = b + acc[ai][bj][m][n]; } }
    }
};
typedef _Float16 f16_t; typedef _Float16 f16x2_cv __attribute__((ext_vector_type(2)));
__device__ __forceinline__ unsigned cvt_pk_f16(float lo, float hi) { const f32x2_cv v = {lo, hi}; const f16x2_cv b = __builtin_convertvector(v, f16x2_cv); return __builtin_bit_cast(unsigned, b); }
__device__ __forceinline__ float f16lo(unsigned w) { return (float)__builtin_bit_cast(f16x2_cv, w)[0]; }
__device__ __forceinline__ float f16hi(unsigned w) { return (float)__builtin_bit_cast(f16x2_cv, w)[1]; }
template <class TI, class TO> struct EpiRes {
    static constexpr bool PERM = true, AFTER_DRAIN = false, INIT = false;
    const TI* base; TO* out; int ldc;
    __device__ __forceinline__ void operator()(const f32x4 (&acc)[2][2][4][2], const Unit& u, int wr, int wc, int fr, int fq) const {
        const int row0 = u.pm * BM + wr * 64 + fr, col0 = u.pn * BM + wc * 32 + 8 * fq;
#pragma unroll
        for (int ai = 0; ai < 2; ++ai)
#pragma unroll
            for (int m = 0; m < 4; ++m) { const size_t off = (size_t)(row0 + ai * HALF + m * 16) * ldc + col0;
#pragma unroll
                for (int bj = 0; bj < 2; ++bj) { f32x4 v0 = acc[ai][bj][m][0], v1 = acc[ai][bj][m][1];
                    if constexpr (sizeof(TI) == 4) { v0 += *(const f32x4*)(base + off + bj * HALF); v1 += *(const f32x4*)(base + off + bj * HALF + 4); }
                    else { const u32x4 b = *(const u32x4*)(base + off + bj * HALF);
                        v0[0] += f16lo(b.x); v0[1] += f16hi(b.x); v0[2] += f16lo(b.y); v0[3] += f16hi(b.y); v1[0] += f16lo(b.z); v1[1] += f16hi(b.z); v1[2] += f16lo(b.w); v1[3] += f16hi(b.w); }
                    if constexpr (sizeof(TO) == 4) { *(f32x4*)(out + off + bj * HALF) = v0; *(f32x4*)(out + off + bj * HALF + 4) = v1; }
                    else { u32x4 w; w.x = cvt_pk_f16(v0[0], v0[1]); w.y = cvt_pk_f16(v0[2], v0[3]); w.z = cvt_pk_f16(v1[0], v1[1]); w.w = cvt_pk_f16(v1[2], v1[3]); *(u32x4*)(out + off + bj * HALF) = w; } } }
    }
};
__device__ __forceinline__ float silu_mul(float g, float u) { return g * __builtin_amdgcn_rcpf(1.0f + __expf(-g)) * u; }
struct EpiSwiglu {
    static constexpr bool PERM = true, AFTER_DRAIN = false, INIT = false;
    bf16_t* O; int ldc;
    __device__ __forceinline__ void operator()(const f32x4 (&acc)[2][2][4][2], const Unit& u, int wr, int wc, int fr, int fq) const {
        const int row0 = u.pm * BM + wr * 64 + fr, col0 = u.pn * HALF + wc * 32 + 8 * fq;
#pragma unroll
        for (int ai = 0; ai < 2; ++ai)
#pragma unroll
            for (int m = 0; m < 4; ++m) { bf16_t* rowp = O + (size_t)(row0 + ai * HALF + m * 16) * ldc + col0;
                const f32x4 g0 = acc[ai][0][m][0], g1 = acc[ai][0][m][1], u0 = acc[ai][1][m][0], u1 = acc[ai][1][m][1];
                u32x4 w; w.x = cvt_pk_bf16(silu_mul(g0[0], u0[0]), silu_mul(g0[1], u0[1])); w.y = cvt_pk_bf16(silu_mul(g0[2], u0[2]), silu_mul(g0[3], u0[3]));
                w.z = cvt_pk_bf16(silu_mul(g1[0], u1[0]), silu_mul(g1[1], u1[1])); w.w = cvt_pk_bf16(silu_mul(g1[2], u1[2]), silu_mul(g1[3], u1[3]));
                *(u32x4*)rowp = w; }
    }
};
struct EpiKvUp {
    static constexpr bool PERM = true, AFTER_DRAIN = false, INIT = false;
    bf16_t* KN; bf16_t* V;
    __device__ __forceinline__ void operator()(const f32x4 (&acc)[2][2][4][2], const Unit& u, int wr, int wc, int fr, int fq) const {
        const int row0 = u.pm * BM + wr * 64 + fr, colL = wc * 32 + 8 * fq;
#pragma unroll
        for (int ai = 0; ai < 2; ++ai)
#pragma unroll
            for (int m = 0; m < 4; ++m) { const int row = row0 + ai * HALF + m * 16, b = row >> 12, key = 16 + (row & 4095);
#pragma unroll
                for (int bj = 0; bj < 2; ++bj) { const f32x4 v0 = acc[ai][bj][m][0], v1 = acc[ai][bj][m][1];
                    u32x4 w; w.x = cvt_pk_bf16(v0[0], v0[1]); w.y = cvt_pk_bf16(v0[2], v0[3]); w.z = cvt_pk_bf16(v1[0], v1[1]); w.w = cvt_pk_bf16(v1[2], v1[3]);
                    if (bj == 0) *(u32x4*)(KN + (size_t)row * 8192 + u.pn * HALF + colL) = w;
                    else { typedef unsigned u32x2 __attribute__((ext_vector_type(2))); u32x2 w8;
                        int x = __builtin_amdgcn_cvt_pk_fp8_f32(v0[0] * 16.f, v0[1] * 16.f, 0, false); x = __builtin_amdgcn_cvt_pk_fp8_f32(v0[2] * 16.f, v0[3] * 16.f, x, true); w8.x = (unsigned)x;
                        x = __builtin_amdgcn_cvt_pk_fp8_f32(v1[0] * 16.f, v1[1] * 16.f, 0, false); x = __builtin_amdgcn_cvt_pk_fp8_f32(v1[2] * 16.f, v1[3] * 16.f, x, true); w8.y = (unsigned)x;
                        *(u32x2*)((char*)V + ((size_t)((b * 64 + u.pn) * 65 + (key >> 6))) * 8192 + v_img_off8(key & 63, colL)) = w8; } } }
    }
};
struct EpiF16 {
    static constexpr bool PERM = true, AFTER_DRAIN = false, INIT = false;
    f16_t* O; int ldc;
    __device__ __forceinline__ void operator()(const f32x4 (&acc)[2][2][4][2], const Unit& u, int wr, int wc, int fr, int fq) const {
        const int row0 = u.pm * BM + wr * 64 + fr, col0 = u.pn * BM + wc * 32 + 8 * fq;
#pragma unroll
        for (int ai = 0; ai < 2; ++ai)
#pragma unroll
            for (int m = 0; m < 4; ++m) { f16_t* rowp = O + (size_t)(row0 + ai * HALF + m * 16) * ldc + col0;
#pragma unroll
                for (int bj = 0; bj < 2; ++bj) { const f32x4 v0 = acc[ai][bj][m][0], v1 = acc[ai][bj][m][1];
                    u32x4 w; w.x = cvt_pk_f16(v0[0], v0[1]); w.y = cvt_pk_f16(v0[2], v0[3]); w.z = cvt_pk_f16(v1[0], v1[1]); w.w = cvt_pk_f16(v1[2], v1[3]);
                    *(u32x4*)(rowp + bj * HALF) = w; } }
    }
};
struct EpiF8 {
    static constexpr bool PERM = true, AFTER_DRAIN = false, INIT = false;
    unsigned char* O; int ldc;
    __device__ __forceinline__ void operator()(const f32x4 (&acc)[2][2][4][2], const Unit& u, int wr, int wc, int fr, int fq) const {
        typedef unsigned u32x2 __attribute__((ext_vector_type(2)));
        const int row0 = u.pm * BM + wr * 64 + fr, col0 = u.pn * BM + wc * 32 + 8 * fq;
#pragma unroll
        for (int ai = 0; ai < 2; ++ai)
#pragma unroll
            for (int m = 0; m < 4; ++m) { unsigned char* rowp = O + (size_t)(row0 + ai * HALF + m * 16) * ldc + col0;
#pragma unroll
                for (int bj = 0; bj < 2; ++bj) { const f32x4 v0 = acc[ai][bj][m][0], v1 = acc[ai][bj][m][1]; u32x2 w8;
                    int x = __builtin_amdgcn_cvt_pk_fp8_f32(v0[0] * 16.f, v0[1] * 16.f, 0, false); x = __builtin_amdgcn_cvt_pk_fp8_f32(v0[2] * 16.f, v0[3] * 16.f, x, true); w8.x = (unsigned)x;
                    x = __builtin_amdgcn_cvt_pk_fp8_f32(v1[0] * 16.f, v1[1] * 16.f, 0, false); x = __builtin_amdgcn_cvt_pk_fp8_f32(v1[2] * 16.f, v1[3] * 16.f, x, true); w8.y = (unsigned)x;
                    *(u32x2*)(rowp + bj * HALF) = w8; } }
    }
};
__host__ __device__ __forceinline__ int k_img_off8(int r, int d) { return r * 192 + ((((d >> 4) + (r >> 2)) % 12) << 4) + (d & 15); }
struct EpiKvUpK {
    static constexpr bool PERM = true, AFTER_DRAIN = false, INIT = false;
    unsigned char* Kimg; bf16_t* V; const float* PRE; const float* SSR; const float* gk; PG8_LAS float* red;
    __device__ __forceinline__ void operator()(const f32x4 (&acc)[2][2][4][2], const Unit& u, int wr, int wc, int fr, int fq) const {
        typedef unsigned u32x2 __attribute__((ext_vector_type(2)));
        asm volatile("" : "+v"(fr), "+v"(fq));
        const int rl0 = wr * 64 + fr, colL = wc * 32 + 8 * fq;
        int rowv = u.pm * BM + rl0; asm volatile("" : "+v"(rowv));
        const int rlA = rl0 + (fq >> 1) * HALF + (fq & 1) * 32, rowA = rowv + (fq >> 1) * HALF + (fq & 1) * 32;
        const float sA = SSR[(unsigned)rowA], sB = SSR[(unsigned)rowA + 16u];
        const f32x4 ga = *(const f32x4*)(gk + colL), gb = *(const f32x4*)(gk + colL + 4);
#pragma unroll
        for (int j = 0; j < 8; ++j) { const f32x4 v0 = acc[j >> 2][0][j & 3][0], v1 = acc[j >> 2][0][j & 3][1];
            float s = ((v0[0] * v0[0] + v0[1] * v0[1]) + (v0[2] * v0[2] + v0[3] * v0[3])) + ((v1[0] * v1[0] + v1[1] * v1[1]) + (v1[2] * v1[2] + v1[3] * v1[3]));
            s += __shfl_xor(s, 16); s += __shfl_xor(s, 32);
            if (fq == 0) red[(rl0 + (j >> 2) * HALF + (j & 3) * 16) * 4 + wc] = s; }
        asm volatile("s_waitcnt lgkmcnt(0)" ::: "memory"); __builtin_amdgcn_s_barrier(); asm volatile("" ::: "memory");
        float rA, rB;
        { const f32x4 tA = *(const PG8_LAS f32x4*)(red + rlA * 4), tB = *(const PG8_LAS f32x4*)(red + (rlA + 16) * 4);
          rA = 16.0f / sqrtf((((tA[0] + tA[1]) + (tA[2] + tA[3])) + sA) * (1.0f / 192.0f) + 1e-6f); rB = 16.0f / sqrtf((((tB[0] + tB[1]) + (tB[2] + tB[3])) + sB) * (1.0f / 192.0f) + 1e-6f); }
        __builtin_amdgcn_sched_barrier(0);
#pragma unroll
        for (int j = 0; j < 8; ++j) { const int row = rowv + (j >> 2) * HALF + (j & 3) * 16, key = 16 + (row & 4095); const unsigned tile = (unsigned)(((row >> 12) * 64 + u.pn) * 65 + (key >> 6));
            const float rr = __shfl((j & 1) ? rB : rA, fr + 16 * (j >> 1));
            { const f32x4 v0 = acc[j >> 2][0][j & 3][0], v1 = acc[j >> 2][0][j & 3][1]; u32x2 w8;
                int x = __builtin_amdgcn_cvt_pk_fp8_f32(v0[0] * ga[0] * rr, v0[1] * ga[1] * rr, 0, false); x = __builtin_amdgcn_cvt_pk_fp8_f32(v0[2] * ga[2] * rr, v0[3] * ga[3] * rr, x, true); w8.x = (unsigned)x;
                x = __builtin_amdgcn_cvt_pk_fp8_f32(v1[0] * gb[0] * rr, v1[1] * gb[1] * rr, 0, false); x = __builtin_amdgcn_cvt_pk_fp8_f32(v1[2] * gb[2] * rr, v1[3] * gb[3] * rr, x, true); w8.y = (unsigned)x;
                *(u32x2*)(Kimg + (tile * 12288u + (unsigned)k_img_off8(key & 63, colL))) = w8; }
            { const f32x4 v0 = acc[j >> 2][1][j & 3][0], v1 = acc[j >> 2][1][j & 3][1]; u32x2 w8;
                int x = __builtin_amdgcn_cvt_pk_fp8_f32(v0[0] * 16.f, v0[1] * 16.f, 0, false); x = __builtin_amdgcn_cvt_pk_fp8_f32(v0[2] * 16.f, v0[3] * 16.f, x, true); w8.x = (unsigned)x;
                x = __builtin_amdgcn_cvt_pk_fp8_f32(v1[0] * 16.f, v1[1] * 16.f, 0, false); x = __builtin_amdgcn_cvt_pk_fp8_f32(v1[2] * 16.f, v1[3] * 16.f, x, true); w8.y = (unsigned)x;
                *(u32x2*)((unsigned char*)V + (tile * 8192u + (unsigned)v_img_off8(key & 63, colL))) = w8; }
            if (j & 1) __builtin_amdgcn_sched_barrier(0); }
#pragma unroll
        for (int x2 = 0; x2 < 2; ++x2) { const float rr = x2 ? rB : rA;
            const int row = rowA + 16 * x2, key = 16 + (row & 4095); const unsigned tile = (unsigned)(((row >> 12) * 64 + u.pn) * 65 + (key >> 6));
            const float* pp = (const float*)((const char*)PRE + (unsigned)(row * 256 + 64 * wc)); const f32x4 p0 = *(const f32x4*)pp, p1 = *(const f32x4*)(pp + 4), p2 = *(const f32x4*)(pp + 8), p3 = *(const f32x4*)(pp + 12);
            u32x4 w; int x = __builtin_amdgcn_cvt_pk_fp8_f32(p0[0] * rr, p0[1] * rr, 0, false); x = __builtin_amdgcn_cvt_pk_fp8_f32(p0[2] * rr, p0[3] * rr, x, true); w.x = (unsigned)x;
            x = __builtin_amdgcn_cvt_pk_fp8_f32(p1[0] * rr, p1[1] * rr, 0, false); x = __builtin_amdgcn_cvt_pk_fp8_f32(p1[2] * rr, p1[3] * rr, x, true); w.y = (unsigned)x;
            x = __builtin_amdgcn_cvt_pk_fp8_f32(p2[0] * rr, p2[1] * rr, 0, false); x = __builtin_amdgcn_cvt_pk_fp8_f32(p2[2] * rr, p2[3] * rr, x, true); w.z = (unsigned)x;
            x = __builtin_amdgcn_cvt_pk_fp8_f32(p3[0] * rr, p3[1] * rr, 0, false); x = __builtin_amdgcn_cvt_pk_fp8_f32(p3[2] * rr, p3[3] * rr, x, true); w.w = (unsigned)x;
            *(u32x4*)(Kimg + (tile * 12288u + (unsigned)k_img_off8(key & 63, 128 + 16 * wc))) = w;
            __builtin_amdgcn_sched_barrier(0); }
    }
};

template <class Epi, class Sched, bool ALIGN_EPI = false, bool SP2 = false, bool F8 = false>
__device__ __forceinline__ void gemm_phase(PG8_LAS unsigned char* lds, const Gemm g, const Sched& S, const Epi& E, int wave_id) {
    const int wid = wave_id, lane = (int)__builtin_amdgcn_mbcnt_hi(~0u, __builtin_amdgcn_mbcnt_lo(~0u, 0u)), tid = wid * 64 + lane, wr = wid >> 2, wc = wid & 3, fr = lane & 15, fq = lane >> 4;
    const int K = g.K, nt = K / BK;
    unsigned voffA[2], voffB[2];
#pragma unroll
    for (int i = 0; i < 2; ++i) { int R, C; stage_rc(tid * 16 + i * 8192, R, C); const int Rb = Epi::PERM ? ((R & ~31) + perm32(R & 31)) : R;
        voffA[i] = (unsigned)(R * K + C) * 2u; voffB[i] = (unsigned)(Rb * K + C) * 2u; }
    const size_t kstep = (size_t)(BK * 2);
    const size_t hstep = (size_t)HALF * K * 2;
    const size_t tstep = 2 * hstep;
    const unsigned ldsw = (unsigned)wid * 1024u;
    const int aoff = lds_byte(wr * 64 + fr, fq * 8), boff = lds_byte(wc * 32 + fr, fq * 8);
#define PG8_SA(b, h) (((b) * 2 + (h)) * HTB)
#define PG8_SB(b, h) ((4 + (b) * 2 + (h)) * HTB)
#define PG8_STAGE(bufoff, gbase, voff) do { _Pragma("unroll") for (int _i = 0; _i < 2; ++_i) \
        __builtin_amdgcn_global_load_lds((const unsigned*)((const char*)(gbase) + (voff)[_i]), (PG8_LAS unsigned*)(lds + (bufoff) + ldsw + _i * 8192), 16, 0, 0); } while (0)
#define PG8_LDA(dst, b, h) do { if constexpr (F8) { _Pragma("unroll") for (int m = 0; m < 4; ++m) dst##8[m] = cat8(*(const PG8_LAS bf16x8*)(lds + PG8_SA(b, h) + aoff + m * 2048), *(const PG8_LAS bf16x8*)(lds + PG8_SA(b, h) + aoff + m * 2048 + 1024)); } \
        else { _Pragma("unroll") for (int m = 0; m < 4; ++m) _Pragma("unroll") for (int k = 0; k < 2; ++k) dst[m][k] = *(const PG8_LAS bf16x8*)(lds + PG8_SA(b, h) + aoff + m * 2048 + k * 1024); } } while (0)
#define PG8_LDB(dst, b, h) do { if constexpr (F8) { _Pragma("unroll") for (int n = 0; n < 2; ++n) dst##8[n] = cat8(*(const PG8_LAS bf16x8*)(lds + PG8_SB(b, h) + boff + n * 2048), *(const PG8_LAS bf16x8*)(lds + PG8_SB(b, h) + boff + n * 2048 + 1024)); } \
        else { _Pragma("unroll") for (int n = 0; n < 2; ++n) _Pragma("unroll") for (int k = 0; k < 2; ++k) dst[n][k] = *(const PG8_LAS bf16x8*)(lds + PG8_SB(b, h) + boff + n * 2048 + k * 1024); } } while (0)
#define PG8_MMA(ai, bj, At, Bt) do { __builtin_amdgcn_s_setprio(1); \
        if constexpr (F8) { _Pragma("unroll") for (int m = 0; m < 4; ++m) _Pragma("unroll") for (int n = 0; n < 2; ++n) \
            asm volatile("v_mfma_f32_16x16x128_f8f6f4 %0, %1, %2, %0" : "+v"(acc[ai][bj][m][n]) : "v"(Bt##8[n]), "v"(At##8[m])); } \
        else { _Pragma("unroll") for (int m = 0; m < 4; ++m) _Pragma("unroll") for (int n = 0; n < 2; ++n) _Pragma("unroll") for (int k = 0; k < 2; ++k) \
            acc[ai][bj][m][n] = __builtin_amdgcn_mfma_f32_16x16x32_bf16(Bt[n][k], At[m][k], acc[ai][bj][m][n], 0, 0, 0); } \
        __builtin_amdgcn_s_setprio(0); } while (0)
#define PG8_WAIT_V(n) asm volatile("s_waitcnt vmcnt(" #n ")" ::: "memory")
#define PG8_WAIT_L(n) asm volatile("s_waitcnt lgkmcnt(" #n ")" ::: "memory")
#define PG8_BAR __builtin_amdgcn_s_barrier()
#define PG8_SCHED __builtin_amdgcn_sched_barrier(0)
    Unit cur, nxt; int ui = 0;
    if (!S.next(0, cur)) return;
    f32x4 acc[2][2][4][2];
    if constexpr (Epi::INIT) E.init(acc, cur, wr, wc, fr, fq);
    else {
#pragma unroll
    for (int a = 0; a < 2; ++a)
#pragma unroll
        for (int b = 0; b < 2; ++b)
#pragma unroll
            for (int m = 0; m < 4; ++m)
#pragma unroll
                for (int n = 0; n < 2; ++n) acc[a][b][m][n] = (f32x4){0.f, 0.f, 0.f, 0.f};
    }
    bf16x8 At[F8 ? 1 : 4][2], B0[F8 ? 1 : 2][2], B1[F8 ? 1 : 2][2];
    const int f8sB = g.sB, f8sA = g.sA;
    i32x8 At8[F8 ? 4 : 1], B08[F8 ? 2 : 1], B18[F8 ? 2 : 1];
    const char* cA = (const char*)g.A + (size_t)cur.pm * tstep; const char* cB = (const char*)g.Bt + (size_t)cur.pn * tstep;
    S.a_ready(cur);
    if constexpr (SP2) {
        PG8_STAGE(PG8_SB(0, 0), cB, voffB); PG8_STAGE(PG8_SB(0, 1), cB + hstep, voffB); PG8_STAGE(PG8_SA(0, 0), cA, voffA); PG8_STAGE(PG8_SA(0, 1), cA + hstep, voffA);
        if (wr == 1) PG8_BAR;
        PG8_WAIT_V(2); PG8_BAR;
        PG8_STAGE(PG8_SB(1, 0), cB + kstep, voffB); PG8_STAGE(PG8_SA(1, 0), cA + kstep, voffA); PG8_STAGE(PG8_SB(1, 1), cB + hstep + kstep, voffB);
        PG8_WAIT_V(6); PG8_BAR;
    } else {
        PG8_STAGE(PG8_SB(0, 0), cB, voffB); PG8_STAGE(PG8_SA(0, 0), cA, voffA); PG8_STAGE(PG8_SB(0, 1), cB + hstep, voffB); PG8_STAGE(PG8_SA(0, 1), cA + hstep, voffA);
        if (wr == 1) PG8_BAR;
        PG8_WAIT_V(4); PG8_BAR;
        PG8_STAGE(PG8_SB(1, 0), cB + kstep, voffB); PG8_STAGE(PG8_SA(1, 0), cA + kstep, voffA); PG8_STAGE(PG8_SB(1, 1), cB + hstep + kstep, voffB);
        PG8_WAIT_V(6); PG8_BAR;
    }
    for (;;) {
        const bool has_next = S.next(ui + 1, nxt);
        const char* nA = has_next ? (const char*)g.A + (size_t)nxt.pm * tstep : cA; const char* nB = has_next ? (const char*)g.Bt + (size_t)nxt.pn * tstep : cB;
        for (int t = 0; t < nt; t += 2) {
            const bool last = (t == nt - 2);
            const char* a1 = cA + (size_t)(t + 1) * kstep;
            const char* a2 = last ? nA : cA + (size_t)(t + 2) * kstep; const char* b2 = last ? nB : cB + (size_t)(t + 2) * kstep;
            const char* a3 = a2 + kstep; const char* b3 = b2 + kstep;
            if (last && has_next) S.a_ready(nxt);
            if constexpr (SP2) {
            PG8_LDB(B0, 0, 0); PG8_LDB(B1, 0, 1); PG8_SCHED; PG8_LDA(At, 0, 0); PG8_STAGE(PG8_SA(1, 1), a1 + hstep, voffA);
            PG8_WAIT_V(8); PG8_WAIT_L(0); PG8_BAR; PG8_MMA(0, 0, At, B0); PG8_MMA(0, 1, At, B1); PG8_BAR; PG8_SCHED;
            PG8_LDA(At, 0, 1); PG8_STAGE(PG8_SB(0, 0), b2, voffB); PG8_STAGE(PG8_SB(0, 1), b2 + hstep, voffB); PG8_STAGE(PG8_SA(0, 0), a2, voffA);
            PG8_WAIT_V(8); PG8_WAIT_L(0); PG8_BAR; PG8_MMA(1, 0, At, B0); PG8_MMA(1, 1, At, B1); PG8_BAR; PG8_SCHED;
            PG8_LDB(B0, 1, 0); PG8_LDB(B1, 1, 1); PG8_SCHED; PG8_LDA(At, 1, 0); PG8_STAGE(PG8_SA(0, 1), a2 + hstep, voffA);
            PG8_WAIT_V(8); PG8_WAIT_L(0); PG8_BAR; PG8_MMA(0, 0, At, B0); PG8_MMA(0, 1, At, B1); PG8_BAR; PG8_SCHED;
            PG8_LDA(At, 1, 1); PG8_STAGE(PG8_SB(1, 0), b3, voffB); PG8_STAGE(PG8_SB(1, 1), b3 + hstep, voffB); PG8_STAGE(PG8_SA(1, 0), a3, voffA);
            PG8_WAIT_V(8); PG8_WAIT_L(0); PG8_BAR; PG8_MMA(1, 0, At, B0); PG8_MMA(1, 1, At, B1); PG8_BAR; PG8_SCHED;
            } else {
            PG8_LDB(B0, 0, 0); PG8_SCHED; PG8_LDA(At, 0, 0); PG8_STAGE(PG8_SA(1, 1), a1 + hstep, voffA);
            PG8_WAIT_L(8); PG8_BAR; PG8_WAIT_L(0); PG8_MMA(0, 0, At, B0); PG8_BAR; PG8_SCHED;
            PG8_LDB(B1, 0, 1); PG8_STAGE(PG8_SB(0, 0), b2, voffB);
            PG8_BAR; PG8_WAIT_L(0); PG8_MMA(0, 1, At, B1); PG8_BAR;
            PG8_LDA(At, 0, 1); PG8_STAGE(PG8_SA(0, 0), a2, voffA);
            PG8_BAR; PG8_WAIT_L(0); PG8_MMA(1, 0, At, B0); PG8_BAR; PG8_SCHED;
            PG8_STAGE(PG8_SB(0, 1), b2 + hstep, voffB);
            PG8_WAIT_V(6); PG8_BAR; PG8_MMA(1, 1, At, B1); PG8_BAR;
            PG8_LDB(B0, 1, 0); PG8_SCHED; PG8_LDA(At, 1, 0); PG8_STAGE(PG8_SA(0, 1), a2 + hstep, voffA);
            PG8_WAIT_L(8); PG8_BAR; PG8_WAIT_L(0); PG8_MMA(0, 0, At, B0); PG8_BAR; PG8_SCHED;
            PG8_LDB(B1, 1, 1); PG8_STAGE(PG8_SB(1, 0), b3, voffB);
            PG8_BAR; PG8_WAIT_L(0); PG8_MMA(0, 1, At, B1); PG8_BAR;
            PG8_LDA(At, 1, 1); PG8_STAGE(PG8_SA(1, 0), a3, voffA);
            PG8_BAR; PG8_WAIT_L(0); PG8_MMA(1, 0, At, B0); PG8_BAR; PG8_SCHED;
            PG8_STAGE(PG8_SB(1, 1), b3 + hstep, voffB);
            PG8_WAIT_V(6); PG8_BAR; PG8_MMA(1, 1, At, B1); PG8_BAR;
            }
        }
        if constexpr (F8) { asm volatile("s_nop 15\n\ts_nop 15" ::: "memory");
            const float f8f = __builtin_ldexpf(1.0f, (f8sA & 0xff) + (f8sB & 0xff) - 254);
#pragma unroll
            for (int a_ = 0; a_ < 2; ++a_)
#pragma unroll
                for (int b_ = 0; b_ < 2; ++b_)
#pragma unroll
                    for (int m_ = 0; m_ < 4; ++m_)
#pragma unroll
                        for (int n_ = 0; n_ < 2; ++n_) acc[a_][b_][m_][n_] = acc[a_][b_][m_][n_] * f8f; }
        if constexpr (false) asm volatile("" ::: "memory");
        if constexpr (ALIGN_EPI) { if (wr == 0) PG8_BAR; }
        if constexpr (!Epi::AFTER_DRAIN) { E(acc, cur, wr, wc, fr, fq); S.done(cur); }
        if (!has_next) break;
        if constexpr (Epi::INIT) E.init(acc, nxt, wr, wc, fr, fq);
        else {
#pragma unroll
        for (int a = 0; a < 2; ++a)
#pragma unroll
            for (int b = 0; b < 2; ++b)
#pragma unroll
                for (int m = 0; m < 4; ++m)
#pragma unroll
                    for (int n = 0; n < 2; ++n) acc[a][b][m][n] = (f32x4){0.f, 0.f, 0.f, 0.f};
        }
        cur = nxt; cA = nA; cB = nB; ++ui;
        if constexpr (ALIGN_EPI) { if (wr == 1) PG8_BAR; }
    }
    PG8_WAIT_V(0);
    if constexpr (!ALIGN_EPI) { if (wr == 0) PG8_BAR; }
    PG8_BAR;
    if constexpr (Epi::AFTER_DRAIN) { E.fused(acc, cur, wr, wc, fr, fq, lds, wid, lane); S.done(cur); }
#undef PG8_SA
#undef PG8_SB
#undef PG8_STAGE
#undef PG8_LDA
#undef PG8_LDB
#undef PG8_MMA
#undef PG8_WAIT_V
#undef PG8_WAIT_L
#undef PG8_BAR
#undef PG8_SCHED
}
}

constexpr int BATCH = 4, SEQ = 4096, DM = 4096, NMETA = 16, MR = BATCH * SEQ  , MT = MR + NMETA  ;
constexpr int MHEADS = 8, MDK = 256, MDV = 512, NPROJ = 12288  , NIN = 12304  ;
constexpr int AH = 64, QLORA = 1024, KVLORA = 512, NOPE = 128, ROPE = 64, QKD = 192, VHD = 128;
constexpr int DFF = 11008, NGU = 2 * DFF;
constexpr int NKT = 65;
constexpr int NKVQ = 1792;
constexpr float EPS = 1e-6f;
constexpr float W_O_SCALE = 256.0f, ATT_O_SCALE = 16.0f, F8_W_SCALE = 256.0f, F8_A_SCALE = 16.0f;
constexpr int NWAVES = 8, NTHR = 512;

constexpr size_t MiB = 1u << 20;
constexpr size_t WS_CTL = 0, CTL_ZERO_BYTES = 1 * MiB;
constexpr size_t WS_HMETA = 1 * MiB;
constexpr size_t WS_GATES = 2 * MiB;
constexpr size_t WS_ROPE = 3 * MiB + 512 * 1024;
constexpr size_t WS_W_IN = 8 * MiB, WS_W_OUT = 105 * MiB, WS_W_GU0 = 137 * MiB, WS_W_GU1 = 309 * MiB, WS_W_DN0 = 481 * MiB, WS_W_DN1 = 567 * MiB;
constexpr size_t WS_W_KVQ = 653 * MiB, WS_W_KVUP = 667 * MiB, WS_W_UQ = 683 * MiB, WS_W_O = 707 * MiB;
constexpr size_t WS_W_O8 = WS_W_O, WS_W_KVQ8 = WS_W_O + 32 * MiB, WS_W_INO8 = WS_W_O + 39 * MiB, WS_W_UQ8 = WS_W_UQ, WS_W_KVUP8 = WS_W_O + 55 * MiB;
constexpr size_t WS_XN = 771 * MiB;
constexpr size_t WS_BIG = 900 * MiB;
constexpr size_t WS_HH = 1285 * MiB;
constexpr size_t WS_LAT = WS_HH, WS_CKVN = WS_HH + 113 * MiB;
constexpr size_t WS_CQN = 1415 * MiB;
constexpr size_t WS_KNOPE = 1447 * MiB;
constexpr size_t WS_V = 1704 * MiB;
constexpr size_t WS_K = 1964 * MiB;
constexpr size_t WS_H16 = 2354 * MiB;
constexpr size_t WS_PRE = 2482 * MiB;
constexpr size_t WS_SSR = 2486 * MiB;
constexpr size_t WS_END = 2488 * MiB;
static_assert(WS_W_IN + (size_t)NIN * DM * 2 <= WS_W_OUT && WS_W_GU0 + (size_t)NGU * DM * 2 <= WS_W_GU1 && WS_W_DN0 + (size_t)DM * DFF * 2 <= WS_W_DN1 && WS_W_KVQ + (size_t)NKVQ * DM * 2 <= WS_W_KVUP, "ws map");
static_assert(WS_XN + (size_t)MT * DM * 2 <= WS_BIG && WS_BIG + (size_t)MT * NPROJ * 2 <= WS_HH && WS_LAT + (size_t)MT * NKVQ * 4 <= WS_CKVN && WS_CKVN + (size_t)MT * KVLORA * 2 <= WS_CQN, "ws map");
static_assert(WS_KNOPE + (size_t)MT * 8192 * 2 <= WS_V && WS_V + (size_t)256 * NKT * 8192 <= WS_K && WS_K + (size_t)256 * NKT * 12288 <= WS_END && WS_ROPE + (size_t)MT * 64 * 4 <= WS_W_IN && WS_GATES + (size_t)16 * MT * 4 <= WS_ROPE, "ws map");

constexpr int RING_BYTES = 131072;
constexpr int LDSCTL_OFF = 143360, MISC_OFF = LDSCTL_OFF + 320;
constexpr int EPI_RED_OFF = 147456;
constexpr int LDS_BYTES = 151552;

#define GAS __attribute__((address_space(1)))
#define LAS __attribute__((address_space(3)))
typedef unsigned short bf16;
typedef unsigned v4u __attribute__((ext_vector_type(4)));
typedef unsigned v2u __attribute__((ext_vector_type(2)));
typedef float f32x4 __attribute__((ext_vector_type(4)));
typedef float f32x16 __attribute__((ext_vector_type(16)));
typedef short bf16x8 __attribute__((ext_vector_type(8)));
typedef short s16x4 __attribute__((ext_vector_type(4)));
typedef GAS unsigned gu32;
#define RLX_AGENT __ATOMIC_RELAXED, __HIP_MEMORY_SCOPE_AGENT
#define LDS_WAIT() asm volatile("s_waitcnt lgkmcnt(0)" ::: "memory")
#define VM_WAIT() asm volatile("s_waitcnt vmcnt(0)" ::: "memory")
#define SBAR() __builtin_amdgcn_sched_barrier(0)
__device__ __forceinline__ unsigned pk2(float lo, float hi) { return pg8::cvt_pk_bf16(lo, hi); }
__device__ __forceinline__ unsigned pk2a(float lo, float hi) { unsigned r; asm volatile("v_cvt_pk_bf16_f32 %0, %1, %2" : "=v"(r) : "v"(lo), "v"(hi)); return r; }
__device__ __forceinline__ float bf2f(unsigned short b) { return __uint_as_float((unsigned)b << 16); }
__device__ __forceinline__ float bflo(unsigned w) { return __uint_as_float(w << 16); }
__device__ __forceinline__ float bfhi(unsigned w) { return __uint_as_float(w & 0xffff0000u); }
#define XB_TMO      128
#define XB_XCNT(j)  (256  + 64 * (j))
#define XB_XSUB(j)  (1280 + 64 * (j))
#define XB_XGEN(j)  (2304 + 64 * (j))
#define XB_TOP      3328
#define XB_TOPGEN   3392
#define XCD_BAR_WORDS 3456
#define XB_SPIN_CAP (1u << 18)

__device__ __forceinline__ unsigned xb_ld(unsigned* p)              { return __hip_atomic_load(p, __ATOMIC_RELAXED, __HIP_MEMORY_SCOPE_AGENT); }
__device__ __forceinline__ unsigned xb_add(unsigned* p, unsigned v) { return __hip_atomic_fetch_add(p, v, __ATOMIC_RELAXED, __HIP_MEMORY_SCOPE_AGENT); }
__device__ __forceinline__ unsigned xb_xcc_id() { return (unsigned)__builtin_amdgcn_s_getreg((3 << 11) | 20) & 0xFu; }
#define XB_SPIN(cond, bar) do { unsigned _sp = 0; while (cond) { __builtin_amdgcn_s_sleep(1); \
    if ((++_sp & 255u) == 0u) { if (xb_ld(&(bar)[XB_TMO])) break; if (_sp > XB_SPIN_CAP) { atomicAdd(&(bar)[XB_TMO], 1u); break; } } } } while (0)

struct XcdBarrier {
    unsigned* bar; unsigned x;
    int wave;
    volatile LAS unsigned* st;
};

__device__ __forceinline__ XcdBarrier xcd_barrier_post(unsigned* bar, volatile LAS unsigned* st) {
    XcdBarrier b; b.bar = bar; b.x = xb_xcc_id(); b.st = st;
    if (threadIdx.x == 0) (void)xb_add(&bar[XB_XCNT(b.x)], 1u);
    return b;
}
__device__ __forceinline__ void xcd_barrier_complete(unsigned* bar, unsigned x, unsigned& nloc, unsigned& nx) {
    const unsigned G = gridDim.x * gridDim.y * gridDim.z;
    unsigned sum, cnt, mine, sp = 0u;
    for (;;) {
        sum = 0u; cnt = 0u; mine = 0u;
#pragma unroll
        for (unsigned j = 0; j < 16; ++j) { const unsigned c = xb_ld(&bar[XB_XCNT(j)]); sum += c; cnt += (c > 0u) ? 1u : 0u; mine = (j == x) ? c : mine; }
        if (sum == G) break;
        __builtin_amdgcn_s_sleep(1);
        if ((++sp & 255u) == 0u) { if (xb_ld(&bar[XB_TMO])) break; if (sp > XB_SPIN_CAP) { atomicAdd(&bar[XB_TMO], 1u); break; } }
    }
    nloc = mine > 0u ? mine : 1u; nx = cnt > 0u ? cnt : 1u;
}

__device__ __forceinline__ void xcd_barrier(const XcdBarrier& b) {
    asm volatile("s_waitcnt vmcnt(0)" ::: "memory");
    __syncthreads();
    if (b.wave == 0 && __builtin_amdgcn_mbcnt_hi(~0u, __builtin_amdgcn_mbcnt_lo(~0u, 0u)) == 0u) {
        unsigned* bar = b.bar;
        __builtin_amdgcn_s_waitcnt(0);
        unsigned nloc = b.st[0], nx = b.st[1];
        if (nloc == 0u) { xcd_barrier_complete(bar, b.x, nloc, nx); b.st[0] = nloc; b.st[1] = nx; }
        const unsigned old = xb_add(&bar[XB_XSUB(b.x)], 1u);
        const unsigned gen = old / nloc;
        if (old + 1u == (gen + 1u) * nloc) {
            __builtin_amdgcn_fence(__ATOMIC_RELEASE, "agent");
            asm volatile("s_waitcnt vmcnt(0)" ::: "memory");
            const unsigned og = xb_add(&bar[XB_TOP], 1u);
            const unsigned tg = og / nx;
            if (og + 1u == (tg + 1u) * nx) xb_add(&bar[XB_TOPGEN], 1u);
            else XB_SPIN(xb_ld(&bar[XB_TOPGEN]) == tg, bar);
            __builtin_amdgcn_fence(__ATOMIC_ACQUIRE, "agent");
            xb_add(&bar[XB_XGEN(b.x)], 1u);
            asm volatile("s_waitcnt vmcnt(0)" ::: "memory");
        } else {
            XB_SPIN(xb_ld(&bar[XB_XGEN(b.x)]) == gen, bar);
            __builtin_amdgcn_fence(__ATOMIC_ACQUIRE, "agent");
            asm volatile("s_waitcnt vmcnt(0)" ::: "memory");
        }
    }
    __syncthreads();
}


struct Args { const void* in[23]; float* out; unsigned char* ws; int ph_lo, ph_hi, dry, pad; };
struct Frame { LAS unsigned char* lds; int tid, lane, wave, vcu, G, gw, ngw; };

__device__ __forceinline__ float wave_sum(float v) {
#pragma unroll
    for (int o = 1; o < 64; o <<= 1) v += __shfl_xor(v, o);
    return v;
}
__device__ __forceinline__ bf16x8 ld8g(const bf16* p) { return *(const bf16x8*)p; }

__device__ __forceinline__ void tr_item(const float* __restrict__ W, int ldw, int scol, int nvalid, const float* __restrict__ gain, bf16* WT, int K, int drow, int k0, LAS float* scr, int lane) {
    const int nn = (lane & 31) < nvalid ? (lane & 31) : (nvalid - 1);
    float v[32]; const float* wp = W + (size_t)(k0 + (lane >> 5)) * ldw + scol + nn;
#pragma unroll
    for (int i = 0; i < 32; ++i) v[i] = wp[(size_t)(2 * i) * ldw];
    if (gain) {
#pragma unroll
        for (int i = 0; i < 32; ++i) v[i] *= gain[k0 + 2 * i + (lane >> 5)]; }
#pragma unroll
    for (int i = 0; i < 32; ++i) scr[(2 * i + (lane >> 5)) * 33 + (lane & 31)] = v[i];
    LDS_WAIT(); asm volatile("" ::: "memory");
    const int c = lane & 7;
#pragma unroll
    for (int j = 0; j < 4; ++j) { const int n = (lane >> 3) + 8 * j; const LAS float* s = scr + (8 * c) * 33 + n;
        v4u o; o.x = pk2(s[0 * 33], s[1 * 33]); o.y = pk2(s[2 * 33], s[3 * 33]); o.z = pk2(s[4 * 33], s[5 * 33]); o.w = pk2(s[6 * 33], s[7 * 33]);
        if (n < nvalid) *(GAS v4u*)(WT + (size_t)(drow + n) * K + k0 + 8 * c) = o; }
    LDS_WAIT(); asm volatile("" ::: "memory");
}
__device__ __forceinline__ void tr_item_f8(const float* __restrict__ W, int ldw, int scol, const float* __restrict__ gain, float scale, unsigned char* WT8, int K, int drow, int k0, LAS float* scr, int lane) {
    float v[32]; const float* wp = W + (size_t)(k0 + (lane >> 5)) * ldw + scol + (lane & 31);
#pragma unroll
    for (int i = 0; i < 32; ++i) v[i] = wp[(size_t)(2 * i) * ldw];
    if (gain) {
#pragma unroll
        for (int i = 0; i < 32; ++i) v[i] *= gain[k0 + 2 * i + (lane >> 5)]; }
#pragma unroll
    for (int i = 0; i < 32; ++i) scr[(2 * i + (lane >> 5)) * 33 + (lane & 31)] = v[i] * scale;
    LDS_WAIT(); asm volatile("" ::: "memory");
    const int c = lane & 7;
#pragma unroll
    for (int j = 0; j < 4; ++j) { const int n = (lane >> 3) + 8 * j; const LAS float* s = scr + (8 * c) * 33 + n;
        v2u o; int w = __builtin_amdgcn_cvt_pk_fp8_f32(s[0 * 33], s[1 * 33], 0, false); w = __builtin_amdgcn_cvt_pk_fp8_f32(s[2 * 33], s[3 * 33], w, true); o.x = (unsigned)w;
        w = __builtin_amdgcn_cvt_pk_fp8_f32(s[4 * 33], s[5 * 33], 0, false); w = __builtin_amdgcn_cvt_pk_fp8_f32(s[6 * 33], s[7 * 33], w, true); o.y = (unsigned)w;
        *(GAS v2u*)(WT8 + (size_t)(drow + n) * K + k0 + 8 * c) = o; }
    LDS_WAIT(); asm volatile("" ::: "memory");
}
__device__ __forceinline__ void norm_row(const float* src, bf16* dst, unsigned char* dst8, int lane) {
    const GAS f32x4* xr = (const GAS f32x4*)src + lane;
    f32x4 v[16]; float s = 0.f;
#pragma unroll
    for (int j = 0; j < 16; ++j) { v[j] = xr[64 * j]; s += (v[j].x * v[j].x + v[j].y * v[j].y) + (v[j].z * v[j].z + v[j].w * v[j].w); }
    const float r = 1.0f / sqrtf(wave_sum(s) * (1.0f / DM) + EPS);
    if (dst) { GAS v2u* o8 = (GAS v2u*)dst + lane;
#pragma unroll
        for (int j = 0; j < 16; ++j) { v2u w; w.x = pk2(v[j].x * r, v[j].y * r); w.y = pk2(v[j].z * r, v[j].w * r); o8[64 * j] = w; } }
    if (dst8) { GAS unsigned* o4 = (GAS unsigned*)dst8 + lane; const float r8 = r * F8_A_SCALE;
#pragma unroll
        for (int j = 0; j < 16; ++j) { int w = __builtin_amdgcn_cvt_pk_fp8_f32(v[j].x * r8, v[j].y * r8, 0, false); w = __builtin_amdgcn_cvt_pk_fp8_f32(v[j].z * r8, v[j].w * r8, w, true); o4[64 * j] = (unsigned)w; } }
}
__device__ __forceinline__ void norm_row_h(const pg8::f16_t* src, bf16* dst, unsigned char* dst8, int lane) {
    const GAS v4u* xr = (const GAS v4u*)src + lane;
    v4u h[8]; float s = 0.f;
#pragma unroll
    for (int j = 0; j < 8; ++j) { h[j] = xr[64 * j];
        const float a0 = pg8::f16lo(h[j].x), a1 = pg8::f16hi(h[j].x), a2 = pg8::f16lo(h[j].y), a3 = pg8::f16hi(h[j].y), a4 = pg8::f16lo(h[j].z), a5 = pg8::f16hi(h[j].z), a6 = pg8::f16lo(h[j].w), a7 = pg8::f16hi(h[j].w);
        s += ((a0 * a0 + a1 * a1) + (a2 * a2 + a3 * a3)) + ((a4 * a4 + a5 * a5) + (a6 * a6 + a7 * a7)); }
    const float r = 1.0f / sqrtf(wave_sum(s) * (1.0f / DM) + EPS);
    if (dst) { GAS v4u* o = (GAS v4u*)dst + lane;
#pragma unroll
        for (int j = 0; j < 8; ++j) { v4u w; w.x = pk2(pg8::f16lo(h[j].x) * r, pg8::f16hi(h[j].x) * r); w.y = pk2(pg8::f16lo(h[j].y) * r, pg8::f16hi(h[j].y) * r);
            w.z = pk2(pg8::f16lo(h[j].z) * r, pg8::f16hi(h[j].z) * r); w.w = pk2(pg8::f16lo(h[j].w) * r, pg8::f16hi(h[j].w) * r); o[64 * j] = w; } }
    if (dst8) { GAS v2u* o = (GAS v2u*)dst8 + lane; const float r8 = r * F8_A_SCALE;
#pragma unroll
        for (int j = 0; j < 8; ++j) { v2u w; int x = __builtin_amdgcn_cvt_pk_fp8_f32(pg8::f16lo(h[j].x) * r8, pg8::f16hi(h[j].x) * r8, 0, false); x = __builtin_amdgcn_cvt_pk_fp8_f32(pg8::f16lo(h[j].y) * r8, pg8::f16hi(h[j].y) * r8, x, true); w.x = (unsigned)x;
            x = __builtin_amdgcn_cvt_pk_fp8_f32(pg8::f16lo(h[j].z) * r8, pg8::f16hi(h[j].z) * r8, 0, false); x = __builtin_amdgcn_cvt_pk_fp8_f32(pg8::f16lo(h[j].w) * r8, pg8::f16hi(h[j].w) * r8, x, true); w.y = (unsigned)x; o[64 * j] = w; } }
}
__device__ __forceinline__ void norm_phase(Frame& F, const float* real, const float* meta, bf16* XN, unsigned char* X8, int nrows, int mode) {
    for (int m = F.gw; m < nrows; m += F.ngw) { const bool isreal = m < MR;
        norm_row(isreal ? real + (size_t)m * DM : meta + (size_t)(m - MR) * DM, (isreal && mode == 2) ? nullptr : XN + (size_t)m * DM, (isreal && mode != 0) ? X8 + (size_t)m * DM : nullptr, F.lane); }
}
__device__ __forceinline__ void norm_phase_h(Frame& F, const pg8::f16_t* real, const float* meta, bf16* XN, unsigned char* X8, int nrows, int mode) {
    for (int m = F.gw; m < nrows; m += F.ngw) {
        if (m < MR) norm_row_h(real + (size_t)m * DM, mode == 2 ? nullptr : XN + (size_t)m * DM, mode != 0 ? X8 + (size_t)m * DM : nullptr, F.lane);
        else norm_row(meta + (size_t)(m - MR) * DM, XN + (size_t)m * DM, nullptr, F.lane); }
}

struct P0Item { const float* wp; const float* gp; unsigned char* dp; int ldw, rowstep, kind, nvalid; float scale; };
constexpr int P0_I_IN = 64 * 385, P0_I_OUT = 64 * 128, P0_I_GU = 64 * 688, P0_I_DN = 172 * 128, P0_I_KVQ = 64 * 56, P0_I_KVU = 8 * 512, P0_I_UQ = 16 * 384, P0_I_O = 128 * 128, P0_I_INO = 64 * 128;
constexpr int P0_NITEMS = P0_I_IN + P0_I_OUT + 2 * P0_I_GU + 2 * P0_I_DN + P0_I_KVQ + P0_I_KVU + P0_I_UQ + P0_I_KVQ + P0_I_KVU + P0_I_INO + P0_I_O;
constexpr int P0_DEFER_A = 16384, P0_DEFER_B = 16384;
static_assert(P0_DEFER_B <= P0_I_DN && P0_DEFER_A + P0_DEFER_B <= P0_I_DN + P0_I_GU, "deferred items must be layer-1 FFN weights, the P16 share down-projection only");
__device__ __forceinline__ P0Item p0_decode(const Args& a, int it, int lane) {
    unsigned char* ws = a.ws;
    const float* w_in = (const float*)a.in[4]; const float* w_out = (const float*)a.in[8]; const float* w_gu = (const float*)a.in[10]; const float* w_dn = (const float*)a.in[11];
    const float* w_kvd = (const float*)a.in[13]; const float* w_kvu = (const float*)a.in[15]; const float* w_dq = (const float*)a.in[18]; const float* w_uq = (const float*)a.in[20]; const float* w_o = (const float*)a.in[22];
    const float* g_a = (const float*)a.in[3]; const float* g_ffn = (const float*)a.in[9]; const float* g_kv = (const float*)a.in[12]; const float* g_kvl = (const float*)a.in[14];
    const float* g_b = (const float*)a.in[17]; const float* g_ql = (const float*)a.in[19];
    const float* W = nullptr; const float* gain = nullptr; unsigned char* dst = nullptr; int ldw = 0, scol = 0, nvalid = 32, kind = 0, K = 0, drow = 0, k0 = 0; float scale = 1.f;
    int r = it;
    if (r < P0_I_IN) { const int kb = r / 385, nb = r % 385; W = w_in; ldw = NIN; scol = 32 * nb; nvalid = nb == 384 ? 16 : 32; gain = g_a; dst = ws + WS_W_IN; K = DM; drow = 32 * nb; k0 = 64 * kb; }
    else if ((r -= P0_I_IN) < P0_I_OUT) { const int kb = r / 128, nb = r % 128; W = w_out; ldw = DM; scol = 32 * nb; dst = ws + WS_W_OUT; K = DM; drow = 32 * nb; k0 = 64 * kb; }
    else if ((r -= P0_I_OUT) < P0_I_GU) { const int kb = r / 688, nb = r % 688, n0 = 32 * nb, j = n0 >> 8, i0 = n0 & 255;
        W = w_gu; ldw = NGU; scol = i0 < 128 ? 128 * j + i0 : DFF + 128 * j + (i0 - 128); gain = g_ffn; dst = ws + WS_W_GU0; K = DM; drow = n0; k0 = 64 * kb; }
    else if ((r -= P0_I_GU) < P0_I_DN) { const int kb = r / 128, nb = r % 128; W = w_dn; ldw = DM; scol = 32 * nb; dst = ws + WS_W_DN0; K = DFF; drow = 32 * nb; k0 = 64 * kb; }
    else if ((r -= P0_I_DN) < P0_I_KVQ) { const int kb = r / 56, nb = r % 56; dst = ws + WS_W_KVQ; K = DM; drow = 32 * nb; k0 = 64 * kb;
        if (nb < 18) { W = w_kvd; ldw = KVLORA + ROPE; scol = 32 * nb; gain = g_kv; } else if (nb >= 24) { W = w_dq; ldw = QLORA; scol = 32 * (nb - 24); gain = g_b; } else kind = 2; }
    else if ((r -= P0_I_KVQ) < P0_I_KVU) { const int kb = r / 512, nb = r % 512; W = w_kvu; ldw = 16384; scol = 32 * nb; gain = g_kvl; dst = ws + WS_W_KVUP; K = KVLORA; drow = 32 * nb; k0 = 64 * kb; }
    else if ((r -= P0_I_KVU) < P0_I_UQ) { const int kb = r / 384, nb = r % 384; W = w_uq; ldw = AH * QKD; scol = 32 * nb; gain = g_ql; kind = 1; scale = F8_W_SCALE; dst = ws + WS_W_UQ8; K = QLORA; drow = 32 * nb; k0 = 64 * kb; }
    else if ((r -= P0_I_UQ) < P0_I_KVQ) { const int kb = r / 56, nb = r % 56; kind = 1; scale = F8_W_SCALE; dst = ws + WS_W_KVQ8; K = DM; drow = 32 * nb; k0 = 64 * kb;
        if (nb < 18) { W = w_kvd; ldw = KVLORA + ROPE; scol = 32 * nb; gain = g_kv; } else if (nb >= 24) { W = w_dq; ldw = QLORA; scol = 32 * (nb - 24); gain = g_b; } else kind = 3; }
    else if ((r -= P0_I_KVQ) < P0_I_KVU) { const int kb = r / 512, nb = r % 512; W = w_kvu; ldw = 16384; scol = 32 * nb; gain = g_kvl; kind = 1; scale = F8_W_SCALE; dst = ws + WS_W_KVUP8; K = KVLORA; drow = 32 * nb; k0 = 64 * kb; }
    else if ((r -= P0_I_KVU) < P0_I_INO) { const int kb = r / 128, nb = r % 128; W = w_in; ldw = NIN; scol = 8192 + 32 * nb; gain = g_a; kind = 1; scale = F8_W_SCALE; dst = ws + WS_W_INO8; K = DM; drow = 32 * nb; k0 = 64 * kb; }
    else if ((r -= P0_I_INO) < P0_I_O) { const int kb = r / 128, nb = r % 128; W = w_o; ldw = DM; scol = 32 * nb; kind = 1; scale = W_O_SCALE; dst = ws + WS_W_O8; K = AH * VHD; drow = 32 * nb; k0 = 64 * kb; }
    else if ((r -= P0_I_O) < P0_I_GU) { const int kb = r / 688, nb = r % 688, n0 = 32 * nb, j = n0 >> 8, i0 = n0 & 255;
        W = w_gu + (size_t)DM * NGU; ldw = NGU; scol = i0 < 128 ? 128 * j + i0 : DFF + 128 * j + (i0 - 128); gain = g_ffn + DM; dst = ws + WS_W_GU1; K = DM; drow = n0; k0 = 64 * kb; }
    else { r -= P0_I_GU; const int kb = r / 128, nb = r % 128; W = w_dn + (size_t)DFF * DM; ldw = DM; scol = 32 * nb; dst = ws + WS_W_DN1; K = DFF; drow = 32 * nb; k0 = 64 * kb; }
    P0Item d; const int nn = (lane & 31) < nvalid ? (lane & 31) : (nvalid - 1); const int esz = (kind & 1) ? 1 : 2;
    d.wp = W + (size_t)(k0 + (lane >> 5)) * ldw + scol + nn; d.gp = gain ? gain + k0 + 8 * (lane & 7) : nullptr;
    d.dp = dst + ((size_t)(drow + (lane >> 3)) * K + k0 + 8 * (lane & 7)) * esz; d.ldw = ldw; d.rowstep = 8 * K * esz; d.kind = kind; d.nvalid = nvalid; d.scale = scale;
    return d;
}
__device__ __forceinline__ void p0_load(const P0Item& d, float (&v)[32], f32x4& g0, f32x4& g1) {
    g0 = (f32x4){1.f, 1.f, 1.f, 1.f}; g1 = g0;
    if (d.kind < 2) {
#pragma unroll
        for (int i = 0; i < 32; ++i) v[i] = d.wp[(size_t)(2 * i) * d.ldw];
        if (d.gp) { g0 = *(const GAS f32x4*)d.gp; g1 = *(const GAS f32x4*)(d.gp + 4); } }
}
__device__ __forceinline__ void p0_process(const P0Item& d, const float (&v)[32], f32x4 g0, f32x4 g1, LAS float* scr, int lane) {
    if (d.kind < 2) {
#pragma unroll
        for (int i = 0; i < 32; ++i) scr[(2 * i + (lane >> 5)) * 33 + (lane & 31)] = v[i];
        LDS_WAIT(); asm volatile("" ::: "memory");
        const int c = lane & 7;
#pragma unroll
        for (int j = 0; j < 4; ++j) { const int n = (lane >> 3) + 8 * j; const LAS float* s = scr + (8 * c) * 33 + n;
            const float f0 = s[0 * 33] * g0.x, f1 = s[1 * 33] * g0.y, f2 = s[2 * 33] * g0.z, f3 = s[3 * 33] * g0.w, f4 = s[4 * 33] * g1.x, f5 = s[5 * 33] * g1.y, f6 = s[6 * 33] * g1.z, f7 = s[7 * 33] * g1.w;
            if (d.kind == 0) { v4u o; o.x = pk2(f0, f1); o.y = pk2(f2, f3); o.z = pk2(f4, f5); o.w = pk2(f6, f7);
                if (n < d.nvalid) *(GAS v4u*)(d.dp + (size_t)j * d.rowstep) = o; }
            else { const float sc = d.scale; v2u o; int w = __builtin_amdgcn_cvt_pk_fp8_f32(f0 * sc, f1 * sc, 0, false); w = __builtin_amdgcn_cvt_pk_fp8_f32(f2 * sc, f3 * sc, w, true); o.x = (unsigned)w;
                w = __builtin_amdgcn_cvt_pk_fp8_f32(f4 * sc, f5 * sc, 0, false); w = __builtin_amdgcn_cvt_pk_fp8_f32(f6 * sc, f7 * sc, w, true); o.y = (unsigned)w;
                *(GAS v2u*)(d.dp + (size_t)j * d.rowstep) = o; } }
        LDS_WAIT(); asm volatile("" ::: "memory");
    } else {
#pragma unroll
        for (int j = 0; j < 4; ++j) { if (d.kind == 2) *(GAS v4u*)(d.dp + (size_t)j * d.rowstep) = (v4u){0u, 0u, 0u, 0u}; else *(GAS v2u*)(d.dp + (size_t)j * d.rowstep) = (v2u){0u, 0u}; } }
}
__device__ __forceinline__ void p0_items(Frame& F, const Args& a, int first, int last, int w, int stride, LAS float* scr) {
    int it = first + w; if (it >= last) return;
    P0Item d = p0_decode(a, it, F.lane); float v[32]; f32x4 g0, g1; p0_load(d, v, g0, g1);
    for (;;) { const int itn = it + stride; const bool more = itn < last;
        P0Item dn = d; float vn[32]; f32x4 gn0 = g0, gn1 = g1;
#pragma unroll
        for (int i = 0; i < 32; ++i) vn[i] = 0.f;
        if (more) { dn = p0_decode(a, itn, F.lane); p0_load(dn, vn, gn0, gn1); }
        asm volatile("" ::: "memory");
        p0_process(d, v, g0, g1, scr, F.lane);
        if (!more) break;
        d = dn; g0 = gn0; g1 = gn1; it = itn;
#pragma unroll
        for (int i = 0; i < 32; ++i) v[i] = vn[i]; }
}
__device__ __forceinline__ void p0_deferred(Frame& F, const Args& a, int nunits, int first, int count) {
    const int c = (int)blockIdx.x, G = F.G, rem = nunits % G;
    if (rem == 0) { p0_items(F, a, first, first + count, F.gw, F.ngw, (LAS float*)(F.lds + F.wave * 16384)); return; }
    if (c >= rem) p0_items(F, a, first, first + count, (c - rem) * NWAVES + F.wave, (G - rem) * NWAVES, (LAS float*)(F.lds + F.wave * 16384));
}

__device__ __forceinline__ void p0_prologue(Frame& F, const Args& a) {
    unsigned char* ws = a.ws;
    LAS float* scr = (LAS float*)(F.lds + F.wave * 16384);
    const float* w_in = (const float*)a.in[4]; const float* w_out = (const float*)a.in[8]; const float* w_gu = (const float*)a.in[10]; const float* w_dn = (const float*)a.in[11];
    const float* w_kvd = (const float*)a.in[13]; const float* w_kvu = (const float*)a.in[15]; const float* w_dq = (const float*)a.in[18]; const float* w_uq = (const float*)a.in[20]; const float* w_o = (const float*)a.in[22];
    const float* g_a = (const float*)a.in[3]; const float* g_ffn = (const float*)a.in[9]; const float* g_kv = (const float*)a.in[12]; const float* g_kvl = (const float*)a.in[14];
    const float* g_b = (const float*)a.in[17]; const float* g_ql = (const float*)a.in[19];
    p0_items(F, a, 0, P0_NITEMS - P0_DEFER_A - P0_DEFER_B, F.gw, F.ngw, scr);
    { const int* positions = (const int*)a.in[1]; float* rope = (float*)(ws + WS_ROPE);
        for (int e = F.vcu * NTHR + F.tid; e < MT * 32; e += F.G * NTHR) { const int row = e >> 5, i = e & 31;
            const int pos = row < MR ? positions[row] + NMETA : row - MR;
            const float inv = 1.0f / powf(10000.0f, (float)(2 * i) * (1.0f / 64.0f));
            const float ang = (float)pos * inv;
            rope[(size_t)row * 64 + i] = cosf(ang); rope[(size_t)row * 64 + 32 + i] = sinf(ang); } }
    { for (int e = F.vcu * NTHR + F.tid; e < 256 * 1280; e += F.G * NTHR) { const int bh = e / 1280, c = e % 1280;
            if (c < 768) *(GAS v4u*)(ws + WS_K + ((size_t)(bh * NKT + 64)) * 12288 + (size_t)c * 16) = (v4u){0u, 0u, 0u, 0u};
            else *(GAS v4u*)(ws + WS_V + ((size_t)(bh * NKT + 64)) * 8192 + (size_t)(c - 768) * 16) = (v4u){0u, 0u, 0u, 0u}; } }
    norm_phase(F, (const float*)a.in[0], (const float*)a.in[2], (bf16*)(ws + WS_XN), ws + WS_HH, MT, 1);
}

template <int NT>
__device__ __forceinline__ void skinny_wg(Frame& F, const bf16* __restrict__ A16, const bf16* __restrict__ Brows0, const bf16* __restrict__ Brows1, int K, f32x4 (&res)[NT]) {
    const int lane = F.lane, kw = K >> 3, k_lo = F.wave * kw;
    const bf16* pb = A16 + (size_t)(lane & 15) * K + 8 * (lane >> 4) + k_lo;
    const bf16* pa0 = Brows0 + (size_t)(lane & 15) * K + 8 * (lane >> 4) + k_lo;
    const bf16* pa1 = Brows1 + (size_t)(lane & 15) * K + 8 * (lane >> 4) + k_lo;
    f32x4 acc[NT];
#pragma unroll
    for (int i = 0; i < NT; ++i) acc[i] = (f32x4){0.f, 0.f, 0.f, 0.f};
#pragma unroll 8
    for (int k0 = 0; k0 < kw; k0 += 32) { const bf16x8 y = ld8g(pb + k0); const bf16x8 x0 = ld8g(pa0 + k0); acc[0] = __builtin_amdgcn_mfma_f32_16x16x32_bf16(x0, y, acc[0], 0, 0, 0);
        if (NT == 2) { const bf16x8 x1 = ld8g(pa1 + k0); acc[NT - 1] = __builtin_amdgcn_mfma_f32_16x16x32_bf16(x1, y, acc[NT - 1], 0, 0, 0); } }
    LAS f32x4* red = (LAS f32x4*)F.lds;
#pragma unroll
    for (int i = 0; i < NT; ++i) red[(i * NWAVES + F.wave) * 64 + lane] = acc[i];
    LDS_WAIT(); __syncthreads();
    if (F.wave == 0) {
#pragma unroll
        for (int i = 0; i < NT; ++i) { f32x4 sacc = red[(i * NWAVES) * 64 + lane];
#pragma unroll
            for (int w = 1; w < NWAVES; ++w) sacc = sacc + red[(i * NWAVES + w) * 64 + lane];
            res[i] = sacc; } }
    LDS_WAIT(); __syncthreads();
}

__device__ __forceinline__ void gate_norm_phase(Frame& F, const Args& a) {
    const bf16* HH = (const bf16*)(a.ws + WS_HH); const bf16* PROJ = (const bf16*)(a.ws + WS_BIG); bf16* A2 = (bf16*)(a.ws + WS_XN); const float* g_out = (const float*)a.in[7];
    for (int m = F.gw; m < MT; m += F.ngw) {
#pragma unroll
        for (int j = 0; j < 8; ++j) { const int e = j * 512 + F.lane * 8;
            const v4u hw = *(const GAS v4u*)(HH + (size_t)m * DM + e), ow = *(const GAS v4u*)(PROJ + (size_t)m * NPROJ + 8192 + e);
            const f32x4 g0 = *(const GAS f32x4*)(g_out + e), g1 = *(const GAS f32x4*)(g_out + e + 4);
            float hv[8] = {bflo(hw.x), bfhi(hw.x), bflo(hw.y), bfhi(hw.y), bflo(hw.z), bfhi(hw.z), bflo(hw.w), bfhi(hw.w)};
            const float ov[8] = {bflo(ow.x), bfhi(ow.x), bflo(ow.y), bfhi(ow.y), bflo(ow.z), bfhi(ow.z), bflo(ow.w), bfhi(ow.w)};
            const float gv[8] = {g0.x, g0.y, g0.z, g0.w, g1.x, g1.y, g1.z, g1.w};
            float s = 0.f;
#pragma unroll
            for (int i = 0; i < 8; ++i) s += hv[i] * hv[i];
            const float r = 1.0f / sqrtf(wave_sum(s) * (1.0f / MDV) + EPS);
#pragma unroll
            for (int i = 0; i < 8; ++i) hv[i] = hv[i] * r * gv[i] * (1.0f / (1.0f + __expf(-ov[i])));
            v4u o; o.x = pk2(hv[0], hv[1]); o.y = pk2(hv[2], hv[3]); o.z = pk2(hv[4], hv[5]); o.w = pk2(hv[6], hv[7]);
            *(GAS v4u*)(A2 + (size_t)m * DM + e) = o; }
    }
}

__device__ __forceinline__ void latent_norm_phase(Frame& F, const Args& a) {
    const float* LAT = (const float*)(a.ws + WS_LAT); const pg8::f16_t* LAT16 = (const pg8::f16_t*)(a.ws + WS_LAT); bf16* CKVN = (bf16*)(a.ws + WS_CKVN); bf16* CQN = (bf16*)(a.ws + WS_CQN);
    for (int m = F.gw; m < MT; m += F.ngw) {
        if (m < MR) { const pg8::f16_t* row = LAT16 + (size_t)m * NKVQ;
            { const v4u xw = *(const GAS v4u*)(row + 8 * F.lane);
                const float x0 = pg8::f16lo(xw.x), x1 = pg8::f16hi(xw.x), x2 = pg8::f16lo(xw.y), x3 = pg8::f16hi(xw.y), x4 = pg8::f16lo(xw.z), x5 = pg8::f16hi(xw.z), x6 = pg8::f16lo(xw.w), x7 = pg8::f16hi(xw.w);
                const float s = ((x0 * x0 + x1 * x1) + (x2 * x2 + x3 * x3)) + ((x4 * x4 + x5 * x5) + (x6 * x6 + x7 * x7));
                const float r8 = F8_A_SCALE / sqrtf(wave_sum(s) * (1.0f / KVLORA) + EPS); v2u o;
                int w = __builtin_amdgcn_cvt_pk_fp8_f32(x0 * r8, x1 * r8, 0, false); w = __builtin_amdgcn_cvt_pk_fp8_f32(x2 * r8, x3 * r8, w, true); o.x = (unsigned)w;
                w = __builtin_amdgcn_cvt_pk_fp8_f32(x4 * r8, x5 * r8, 0, false); w = __builtin_amdgcn_cvt_pk_fp8_f32(x6 * r8, x7 * r8, w, true); o.y = (unsigned)w;
                *(GAS v2u*)((unsigned char*)CKVN + (size_t)m * KVLORA + 8 * F.lane) = o; }
            {
                const pg8::f16_t* lrow = row + KVLORA; const float* rt = (const float*)(a.ws + WS_ROPE) + (size_t)m * 64; const float* g_k = (const float*)a.in[16]; const int i = F.lane & 31;
                const float t1 = (float)lrow[i] * g_k[128 + i], t2 = (float)lrow[32 + i] * g_k[160 + i], cs = rt[i], sn = rt[32 + i]; const float krl = (float)lrow[F.lane]; const float ssr = wave_sum(krl * krl);
                ((float*)(a.ws + WS_PRE))[(size_t)m * 64 + F.lane] = (F.lane & 32) ? (t1 * sn + t2 * cs) : (t1 * cs - t2 * sn);
                if (F.lane == 0) ((float*)(a.ws + WS_SSR))[m] = ssr; }
            { v2u v[4]; float s = 0.f;
#pragma unroll
                for (int j = 0; j < 4; ++j) { v[j] = *(const GAS v2u*)(row + 768 + (j * 64 + F.lane) * 4);
                    const float q0 = pg8::f16lo(v[j].x), q1 = pg8::f16hi(v[j].x), q2 = pg8::f16lo(v[j].y), q3 = pg8::f16hi(v[j].y); s += (q0 * q0 + q1 * q1) + (q2 * q2 + q3 * q3); }
                const float r8 = F8_A_SCALE / sqrtf(wave_sum(s) * (1.0f / QLORA) + EPS);
#pragma unroll
                for (int j = 0; j < 4; ++j) { int w = __builtin_amdgcn_cvt_pk_fp8_f32(pg8::f16lo(v[j].x) * r8, pg8::f16hi(v[j].x) * r8, 0, false); w = __builtin_amdgcn_cvt_pk_fp8_f32(pg8::f16lo(v[j].y) * r8, pg8::f16hi(v[j].y) * r8, w, true);
                    *(GAS unsigned*)((unsigned char*)CQN + (size_t)m * QLORA + (j * 64 + F.lane) * 4) = (unsigned)w; } }
        } else { const float* row = LAT + (size_t)m * NKVQ;
            const f32x4 x0 = *(const GAS f32x4*)(row + 8 * F.lane), x1 = *(const GAS f32x4*)(row + 8 * F.lane + 4);
            const float s = (x0.x * x0.x + x0.y * x0.y) + (x0.z * x0.z + x0.w * x0.w) + (x1.x * x1.x + x1.y * x1.y) + (x1.z * x1.z + x1.w * x1.w);
            const float r = 1.0f / sqrtf(wave_sum(s) * (1.0f / KVLORA) + EPS);
            v4u o; o.x = pk2(x0.x * r, x0.y * r); o.y = pk2(x0.z * r, x0.w * r); o.z = pk2(x1.x * r, x1.y * r); o.w = pk2(x1.z * r, x1.w * r);
            *(GAS v4u*)(CKVN + (size_t)m * KVLORA + 8 * F.lane) = o; }
    }
}

using pg8::k_img_off8;
__device__ __forceinline__ v2u f8x8(const float (&x)[8], float sc) { v2u o; int w = __builtin_amdgcn_cvt_pk_fp8_f32(x[0] * sc, x[1] * sc, 0, false); w = __builtin_amdgcn_cvt_pk_fp8_f32(x[2] * sc, x[3] * sc, w, true); o.x = (unsigned)w;
    w = __builtin_amdgcn_cvt_pk_fp8_f32(x[4] * sc, x[5] * sc, 0, false); w = __builtin_amdgcn_cvt_pk_fp8_f32(x[6] * sc, x[7] * sc, w, true); o.y = (unsigned)w; return o; }
__device__ __forceinline__ void k_final_phase(Frame& F, const Args& a) {
    const float* LAT = (const float*)(a.ws + WS_LAT); const bf16* KN = (const bf16*)(a.ws + WS_KNOPE); const float* ROPEt = (const float*)(a.ws + WS_ROPE); const float* g_k = (const float*)a.in[16];
    unsigned char* Kimg = a.ws + WS_K; const int lane = F.lane, c = lane & 15, hq = lane >> 4;
    float gn[8];
#pragma unroll
    for (int i = 0; i < 8; ++i) gn[i] = g_k[8 * c + i];
    for (int m = MR + F.gw; m < MT; m += F.ngw) {
        const float* lrow = LAT + (size_t)m * NKVQ + KVLORA;
        const float krl = lrow[lane]; const float ss_rope = wave_sum(krl * krl);
        float pre[8];
        { const int i0 = 8 * (c & 3); const float* rt = ROPEt + (size_t)m * 64;
#pragma unroll
            for (int i = 0; i < 8; ++i) { const float t1 = lrow[i0 + i] * g_k[128 + i0 + i], t2 = lrow[32 + i0 + i] * g_k[160 + i0 + i], cs = rt[i0 + i], sn = rt[32 + i0 + i];
                pre[i] = (c & 4) ? (t1 * sn + t2 * cs) : (t1 * cs - t2 * sn); } }
        const int nb = m < MR ? 1 : BATCH; const int key = m < MR ? NMETA + (m & (SEQ - 1)) : m - MR; const int b0 = m < MR ? (m >> 12) : 0;
        const int kt = key >> 6, kr = key & 63;
#pragma unroll 4
        for (int j = 0; j < 16; ++j) { const int h = 4 * j + hq;
            const v4u kw = *(const GAS v4u*)(KN + (size_t)m * 8192 + h * 128 + 8 * c);
            float kv[8] = {bflo(kw.x), bfhi(kw.x), bflo(kw.y), bfhi(kw.y), bflo(kw.z), bfhi(kw.z), bflo(kw.w), bfhi(kw.w)};
            float s = 0.f;
#pragma unroll
            for (int i = 0; i < 8; ++i) s += kv[i] * kv[i];
            s += __shfl_xor(s, 1); s += __shfl_xor(s, 2); s += __shfl_xor(s, 4); s += __shfl_xor(s, 8);
            const float r = 1.0f / sqrtf((s + ss_rope) * (1.0f / QKD) + EPS);
#pragma unroll
            for (int i = 0; i < 8; ++i) kv[i] *= gn[i];
            const v2u o = f8x8(kv, r * F8_A_SCALE), p = f8x8(pre, r * F8_A_SCALE);
            for (int bb = 0; bb < nb; ++bb) { unsigned char* img = Kimg + ((size_t)(((b0 + bb) * AH + h) * NKT + kt)) * 12288;
                *(GAS v2u*)(img + k_img_off8(kr, 8 * c)) = o;
                if (c < 8) *(GAS v2u*)(img + k_img_off8(kr, 128 + 8 * c)) = p; } }
    }
}

constexpr int ML_KP = 528, ML_VP = 144, ML_KR0 = 0, ML_KRSZ = 64 * ML_KP, ML_VR0 = 2 * ML_KRSZ, ML_VRSZ = 64 * ML_VP, ML_CT = ML_VR0 + 2 * ML_VRSZ, ML_WS = ML_CT + 80 * ML_KP, ML_END = ML_WS + NWAVES * 512;
static_assert(ML_END <= LDSCTL_OFF, "mLSTM LDS");
__device__ __forceinline__ s16x4 lds_tr(LAS const unsigned char* p) { typedef short v4i16_t __attribute__((ext_vector_type(4))); return __builtin_bit_cast(s16x4, __builtin_amdgcn_ds_read_tr16_b64_v4i16((LAS v4i16_t*)p)); }
__device__ __forceinline__ bf16x8 cat4(s16x4 lo, s16x4 hi) { return (bf16x8){lo[0], lo[1], lo[2], lo[3], hi[0], hi[1], hi[2], hi[3]}; }
__device__ __forceinline__ float prefix_sum64(float v, int lane) {
#pragma unroll
    for (int d = 1; d < 64; d <<= 1) { const float t = __shfl_up(v, d); if (lane >= d) v += t; }
    return v;
}
__device__ __forceinline__ float prefix_max64(float v, int lane) {
#pragma unroll
    for (int d = 1; d < 64; d <<= 1) { const float t = __shfl_up(v, d); if (lane >= d) v = fmaxf(v, t); }
    return v;
}
__device__ __forceinline__ float log_sigmoid(float x) { return fminf(x, 0.f) - log1pf(expf(-fabsf(x))); }

template <int TBV>
__device__ __forceinline__ void mlstm_unit_tb(Frame& F, const Args& a, int unit) {
    const int bh = unit >> 3, sl = unit & 7, b = bh >> 3, h = bh & 7;
    const int tid = F.tid, lane = F.lane, wave = F.wave, eh = wave & 1, c15 = lane & 15, q4 = lane >> 4; constexpr int tb = TBV;
    LAS unsigned char* lds = F.lds;
    const bf16* PROJ = (const bf16*)(a.ws + WS_BIG); const float* GATES = (const float*)(a.ws + WS_GATES); bf16* HH = (bf16*)(a.ws + WS_HH);
    const float b_i = ((const float*)a.in[5])[h], b_f = ((const float*)a.in[6])[h];
    f32x4 Cacc[2][5];
#pragma unroll
    for (int i = 0; i < 2; ++i)
#pragma unroll
        for (int e = 0; e < 5; ++e) Cacc[i][e] = (f32x4){0.f, 0.f, 0.f, 0.f};
    float m_state = 0.f;
    for (int i = tid; i < (80 * ML_KP) / 16; i += NTHR) *(LAS v4u*)(lds + ML_CT + 16 * i) = (v4u){0u, 0u, 0u, 0u};
#define ML_ROW(c, i) ((c) == 0 ? MR + ((i) & 15) : b * SEQ + 64 * ((c) - 1) + (i))
#define ML_VALID(c, i) ((c) > 0 || (i) < NMETA)
    v4u kst[4], vst; bf16x8 qf[8], qn[8]; float bc_c, u_c, pm_c, bc_n, u_n, pm_n;
    const GAS unsigned char* Pb = (const GAS unsigned char*)PROJ;
    const unsigned kofs = (unsigned)(((tid >> 5) * NPROJ + 2048 + h * MDK + (tid & 31) * 8) * 2);
    const unsigned vofs = (unsigned)(((tid >> 3) * NPROJ + 4096 + h * MDV + sl * 64 + (tid & 7) * 8) * 2);
    const unsigned qofs = (unsigned)(((16 * tb + c15) * NPROJ + h * MDK + 8 * q4) * 2);
    constexpr unsigned ROWB = NPROJ * 2;
    {
#pragma unroll
        for (int j = 0; j < 4; ++j) { const int id = tid + NTHR * j, i = id >> 5, ch = id & 31; const v4u x = *(const GAS v4u*)(Pb + (size_t)(MR + (i & 15)) * ROWB + (2048 + h * MDK + ch * 8) * 2);
            *(LAS v4u*)(lds + ML_KR0 + i * ML_KP + ch * 16) = ML_VALID(0, i) ? x : (v4u){0u, 0u, 0u, 0u}; }
        { const int i = tid >> 3, ch = tid & 7; const v4u x = *(const GAS v4u*)(Pb + (size_t)(MR + (i & 15)) * ROWB + (4096 + h * MDV + sl * 64 + ch * 8) * 2);
            *(LAS v4u*)(lds + ML_VR0 + i * ML_VP + ch * 16) = ML_VALID(0, i) ? x : (v4u){0u, 0u, 0u, 0u}; }
        { const int i = 16 * tb + c15;
#pragma unroll
            for (int ks = 0; ks < 8; ++ks) { const bf16x8 x = *(const GAS bf16x8*)(Pb + (size_t)(MR + (i & 15)) * ROWB + (h * MDK + 32 * ks + 8 * q4) * 2); qf[ks] = ML_VALID(0, i) ? x : (bf16x8){0, 0, 0, 0, 0, 0, 0, 0}; } }
    }
    float* GSC = (float*)(a.ws + WS_KNOPE) + (size_t)unit * (65 * 192);
    for (int c = wave; c <= 64; c += NWAVES) {
        const bool tokv = ML_VALID(c, lane);
        const float gi = GATES[(size_t)h * MT + ML_ROW(c, lane)], gf = GATES[(size_t)(8 + h) * MT + ML_ROW(c, lane)];
        const float logi = tokv ? 15.0f * tanhf((gi + b_i) * (1.0f / 15.0f)) : -__builtin_inff();
        const float logf = tokv ? log_sigmoid(15.0f * tanhf((gf + b_f) * (1.0f / 15.0f))) : 0.f;
        const float bcum = prefix_sum64(logf, lane);
        const float u = logi - bcum;
        const float pm = prefix_max64(u, lane);
        GSC[c * 192 + lane] = bcum; GSC[c * 192 + 64 + lane] = u; GSC[c * 192 + 128 + lane] = pm;
    }
    VM_WAIT(); __syncthreads();
#define ML_GLOAD(c, B, U, P) do { B = __hip_atomic_load(GSC + (c) * 192 + lane, __ATOMIC_RELAXED, __HIP_MEMORY_SCOPE_AGENT); U = __hip_atomic_load(GSC + (c) * 192 + 64 + lane, __ATOMIC_RELAXED, __HIP_MEMORY_SCOPE_AGENT); \
        P = __hip_atomic_load(GSC + (c) * 192 + 128 + lane, __ATOMIC_RELAXED, __HIP_MEMORY_SCOPE_AGENT); } while (0)
    ML_GLOAD(0, bc_c, u_c, pm_c);
    LDS_WAIT(); __syncthreads();
    for (int c = 0; c <= 64; ++c) {
        const int cur = c & 1, nx = cur ^ 1, cn = c < 64 ? c + 1 : 64;
        LAS const unsigned char* KRc = lds + ML_KR0 + cur * ML_KRSZ; LAS const unsigned char* VRc = lds + ML_VR0 + cur * ML_VRSZ;
        const GAS unsigned char* Pn = Pb + (size_t)(b * SEQ + 64 * (cn - 1)) * ROWB;
#pragma unroll
        for (int j = 0; j < 4; ++j) kst[j] = *(const GAS v4u*)(Pn + (kofs + (unsigned)j * (16u * ROWB)));
        vst = *(const GAS v4u*)(Pn + vofs);
        ML_GLOAD(cn, bc_n, u_n, pm_n);
        const float bcum = bc_c, u = u_c;
        const float Mv = fmaxf(m_state, pm_c);
        const float av = __expf(m_state - Mv);
        const float mt = bcum + Mv;
        const float M63 = __shfl(Mv, 63), b63 = __shfl(bcum, 63);
        const float wl = __expf(u - M63) * 0.0625f;
        const float decay = __shfl(av, 63);
        LAS float* uS = (LAS float*)(lds + ML_WS + wave * 512); LAS float* wS = uS + 64;
        uS[lane] = u; wS[lane] = wl; LDS_WAIT();
        f32x4 Sacc[4];
#pragma unroll
        for (int sb = 0; sb < 4; ++sb) Sacc[sb] = (f32x4){0.f, 0.f, 0.f, 0.f};
        f32x4 a1[3], a2[3];
#pragma unroll
        for (int x = 0; x < 3; ++x) { a1[x] = (f32x4){0.f, 0.f, 0.f, 0.f}; a2[x] = (f32x4){0.f, 0.f, 0.f, 0.f}; }
#pragma unroll
        for (int kp = 0; kp < 1; ++kp) {
#pragma unroll
            for (int ks = 8 * kp; ks < 8 * kp + 8; ++ks) {
#pragma unroll
                for (int sb = 0; sb < 4; ++sb) if (sb <= tb) { const bf16x8 kf = *(LAS const bf16x8*)(KRc + (16 * sb + c15) * ML_KP + (32 * ks + 8 * q4) * 2); Sacc[sb] = __builtin_amdgcn_mfma_f32_16x16x32_bf16(kf, qf[ks], Sacc[sb], 0, 0, 0); }
#pragma unroll
                for (int x = 0; x < 3; ++x) { const int eb = x < 2 ? 2 * eh + x : 4; const bf16x8 cf = *(LAS const bf16x8*)(lds + ML_CT + (16 * eb + c15) * ML_KP + (32 * ks + 8 * q4) * 2);
                    a1[x] = __builtin_amdgcn_mfma_f32_16x16x32_bf16(cf, qf[ks], a1[x], 0, 0, 0); } }
            SBAR(); }
        const float Mt = __shfl(Mv, 16 * tb + c15), at = __shfl(av, 16 * tb + c15), mtt = __shfl(mt, 16 * tb + c15);
        bf16x8 pf[2];
        {   float sp[4][4];
#pragma unroll
            for (int sb = 0; sb < 4; ++sb) { const f32x4 u4 = *(LAS const f32x4*)(uS + 16 * sb + 4 * q4);
#pragma unroll
                for (int j = 0; j < 4; ++j) { const int s_abs = 16 * sb + 4 * q4 + j; const float us = u4[j];
                    const float w = (s_abs <= 16 * tb + c15) ? __expf(us - Mt) : 0.f; sp[sb][j] = (sb <= tb) ? Sacc[sb][j] * 0.0625f * w : 0.f; } }
#pragma unroll
            for (int k2 = 0; k2 < 2; ++k2) { v4u w; w.x = pk2(sp[2 * k2][0], sp[2 * k2][1]); w.y = pk2(sp[2 * k2][2], sp[2 * k2][3]); w.z = pk2(sp[2 * k2 + 1][0], sp[2 * k2 + 1][1]); w.w = pk2(sp[2 * k2 + 1][2], sp[2 * k2 + 1][3]);
                pf[k2] = __builtin_bit_cast(bf16x8, w); } }
        const bf16x8 onesf = (c15 == 0) ? (bf16x8){0x3F80, 0x3F80, 0x3F80, 0x3F80, 0x3F80, 0x3F80, 0x3F80, 0x3F80} : (bf16x8){0, 0, 0, 0, 0, 0, 0, 0};
#pragma unroll
        for (int k2 = 0; k2 < 2; ++k2) {
#pragma unroll
            for (int x = 0; x < 2; ++x) { const int eb = 2 * eh + x; LAS const unsigned char* p = VRc + (32 * k2 + 4 * q4 + (c15 >> 2)) * ML_VP + (16 * eb + 4 * (c15 & 3)) * 2;
                const s16x4 lo = lds_tr(p), hi = lds_tr(p + 16 * ML_VP);
                a2[x] = __builtin_amdgcn_mfma_f32_16x16x32_bf16(cat4(lo, hi), pf[k2], a2[x], 0, 0, 0); }
            a2[2] = __builtin_amdgcn_mfma_f32_16x16x32_bf16(onesf, pf[k2], a2[2], 0, 0, 0); }
        {   const float den0 = at * a1[2][0] + a2[2][0];
            const float den = __shfl(den0, c15);
            const float inv = 1.0f / fmaxf(fabsf(den), __expf(-mtt));
            const int tl = 16 * tb + c15;
            if (ML_VALID(c, tl)) { const unsigned ho = (unsigned)((ML_ROW(c, tl) * DM + h * MDV + sl * 64 + 4 * q4 + 32 * eh) * 2);
#pragma unroll
                for (int x = 0; x < 2; ++x) { v2u w; w.x = pk2((at * a1[x][0] + a2[x][0]) * inv, (at * a1[x][1] + a2[x][1]) * inv); w.y = pk2((at * a1[x][2] + a2[x][2]) * inv, (at * a1[x][3] + a2[x][3]) * inv);
                    *(GAS v2u*)((GAS unsigned char*)HH + (ho + 32u * x)) = w; } } }
#pragma unroll
        for (int ks = 0; ks < 8; ++ks) qn[ks] = *(const GAS bf16x8*)(Pn + (qofs + 64u * ks));
#pragma unroll
        for (int i = 0; i < 2; ++i)
#pragma unroll
            for (int e = 0; e < 5; ++e) Cacc[i][e] = Cacc[i][e] * decay;
#pragma unroll
        for (int k2 = 0; k2 < 2; ++k2) {
            const f32x4 wv0 = *(LAS const f32x4*)(wS + 32 * k2 + 8 * q4), wv1 = *(LAS const f32x4*)(wS + 32 * k2 + 8 * q4 + 4);
            const float wlv[8] = {wv0.x, wv0.y, wv0.z, wv0.w, wv1.x, wv1.y, wv1.z, wv1.w};
            bf16x8 bfr[5];
#pragma unroll
            for (int eb = 0; eb < 4; ++eb) { LAS const unsigned char* p = VRc + (32 * k2 + 8 * q4 + (c15 >> 2)) * ML_VP + (16 * eb + 4 * (c15 & 3)) * 2;
                const s16x4 lo = lds_tr(p), hi = lds_tr(p + 4 * ML_VP);
                v4u w; w.x = pk2(bf2f((unsigned short)lo[0]) * wlv[0], bf2f((unsigned short)lo[1]) * wlv[1]); w.y = pk2(bf2f((unsigned short)lo[2]) * wlv[2], bf2f((unsigned short)lo[3]) * wlv[3]);
                w.z = pk2(bf2f((unsigned short)hi[0]) * wlv[4], bf2f((unsigned short)hi[1]) * wlv[5]); w.w = pk2(bf2f((unsigned short)hi[2]) * wlv[6], bf2f((unsigned short)hi[3]) * wlv[7]);
                bfr[eb] = __builtin_bit_cast(bf16x8, w); }
            { v4u w; w.x = pk2(wlv[0], wlv[1]); w.y = pk2(wlv[2], wlv[3]); w.z = pk2(wlv[4], wlv[5]); w.w = pk2(wlv[6], wlv[7]); if (c15 != 0) w = (v4u){0u, 0u, 0u, 0u}; bfr[4] = __builtin_bit_cast(bf16x8, w); }
#pragma unroll
            for (int i = 0; i < 2; ++i) { const int rb = 2 * wave + i; LAS const unsigned char* p = KRc + (32 * k2 + 8 * q4 + (c15 >> 2)) * ML_KP + (16 * rb + 4 * (c15 & 3)) * 2;
                const s16x4 lo = lds_tr(p), hi = lds_tr(p + 4 * ML_KP); const bf16x8 af = cat4(lo, hi);
#pragma unroll
                for (int eb = 0; eb < 5; ++eb) Cacc[i][eb] = __builtin_amdgcn_mfma_f32_16x16x32_bf16(af, bfr[eb], Cacc[i][eb], 0, 0, 0); }
        }
        LDS_WAIT(); __syncthreads();
#pragma unroll
        for (int i = 0; i < 2; ++i)
#pragma unroll
            for (int eb = 0; eb < 5; ++eb) { v2u w; w.x = pk2(Cacc[i][eb][0], Cacc[i][eb][1]); w.y = pk2(Cacc[i][eb][2], Cacc[i][eb][3]);
                *(LAS v2u*)(lds + ML_CT + (16 * eb + c15) * ML_KP + (16 * (2 * wave + i) + 4 * q4) * 2) = w; }
#pragma unroll
        for (int j = 0; j < 4; ++j) { const int id = tid + NTHR * j, i = id >> 5, ch = id & 31; *(LAS v4u*)(lds + ML_KR0 + nx * ML_KRSZ + i * ML_KP + ch * 16) = kst[j]; }
        { const int i = tid >> 3, ch = tid & 7; *(LAS v4u*)(lds + ML_VR0 + nx * ML_VRSZ + i * ML_VP + ch * 16) = vst; }
#pragma unroll
        for (int ks = 0; ks < 8; ++ks) qf[ks] = qn[ks];
        bc_c = bc_n; u_c = u_n; pm_c = pm_n;
        m_state = b63 + M63;
        LDS_WAIT(); __syncthreads();
    }
#undef ML_ROW
#undef ML_VALID
#undef ML_GLOAD
}
__device__ __forceinline__ void mlstm_unit(Frame& F, const Args& a, int unit) {
    switch (F.wave >> 1) { case 0: mlstm_unit_tb<0>(F, a, unit); break; case 1: mlstm_unit_tb<1>(F, a, unit); break; case 2: mlstm_unit_tb<2>(F, a, unit); break; default: mlstm_unit_tb<3>(F, a, unit); break; }
}

constexpr int AT_KSZ = 12288, AT_VSZ = 8192, AT_K0 = 0, AT_V0 = 2 * AT_KSZ, AT_WS = AT_V0 + 2 * AT_VSZ, AT_GQ = AT_WS + NWAVES * 256, AT_OST = AT_GQ + 768, AT_END = AT_OST + NWAVES * 4096;
static_assert(AT_END <= RING_BYTES, "attention LDS");
constexpr float AT_SCALE = 0.07216878364870322f / 256.0f;
constexpr float AT_THR = 2.5f;
__device__ __forceinline__ int crow(int r, int hi) { return (r & 3) + 8 * (r >> 2) + 4 * hi; }
__device__ __forceinline__ int v_rd_base(int lane) { return ((lane & 3) << 3) | (((lane >> 2) & 3) << 6) | (((lane >> 4) & 1) << 5) | (((lane >> 5) & 1) << 8); }
constexpr int v_rd_off(int d0, int ks, int half) { return d0 * 512 + ks * 4096 + half * 2048; }
__device__ __forceinline__ void at_mask(f32x16& p0, f32x16& p1, int dq) {
    const float NEG = -__builtin_inff();
#pragma unroll
    for (int r = 0; r < 16; ++r) { const int c = (r & 3) + 8 * (r >> 2); if (dq - c < 0) p0[r] = NEG; if (dq - c - 32 < 0) p1[r] = NEG; }
}
__device__ __forceinline__ void at_partialSM(f32x16& p0, f32x16& p1, float& m_reg, float& mn, float& alpha) {
    float pmax = p0[0];
#pragma unroll
    for (int r = 1; r < 16; ++r) pmax = fmaxf(pmax, p0[r]);
#pragma unroll
    for (int r = 0; r < 16; ++r) pmax = fmaxf(pmax, p1[r]);
    { auto rr = __builtin_amdgcn_permlane32_swap(__float_as_uint(pmax), __float_as_uint(pmax), false, false); pmax = fmaxf(__uint_as_float(rr[0]), __uint_as_float(rr[1])); }
    constexpr float C2 = 1.4426950408889634f * AT_SCALE;
    if (__builtin_expect(__all((pmax - m_reg) * AT_SCALE <= AT_THR), 1)) { mn = m_reg; alpha = 1.f; }
    else { mn = fmaxf(m_reg, pmax); alpha = __builtin_amdgcn_exp2f((m_reg - mn) * C2); m_reg = mn; }
    const float mnL = 5.0f - mn * C2;
#pragma unroll
    for (int r = 0; r < 16; ++r) p0[r] = __builtin_amdgcn_exp2f(fmaf(p0[r], C2, mnL));
#pragma unroll
    for (int r = 0; r < 16; ++r) p1[r] = __builtin_amdgcn_exp2f(fmaf(p1[r], C2, mnL));
}
__device__ __forceinline__ void at_finishSM(const f32x16& p0, const f32x16& p1, float alpha, float& l_reg, bf16x8& pa0, bf16x8& pa1, bf16x8& pa2, bf16x8& pa3) {
    float ps = 0.f;
#pragma unroll
    for (int r = 0; r < 16; ++r) ps += p0[r];
#pragma unroll
    for (int r = 0; r < 16; ++r) ps += p1[r];
    { auto rr = __builtin_amdgcn_permlane32_swap(__float_as_uint(ps), __float_as_uint(ps), false, false); ps = __uint_as_float(rr[0]) + __uint_as_float(rr[1]); }
    l_reg = l_reg * alpha + ps;
#define AT_PK4(P, B_, OUT) do { unsigned a0 = pk2a(P[B_+0], P[B_+1]), a1 = pk2a(P[B_+2], P[B_+3]); unsigned b0 = pk2a(P[B_+4], P[B_+5]), b1 = pk2a(P[B_+6], P[B_+7]); \
        auto r0 = __builtin_amdgcn_permlane32_swap(a0, b0, false, false); auto r1 = __builtin_amdgcn_permlane32_swap(a1, b1, false, false); \
        v4u w = {r0[0], r1[0], r0[1], r1[1]}; OUT = __builtin_bit_cast(bf16x8, w); } while (0)
    AT_PK4(p0, 0, pa0); AT_PK4(p0, 8, pa1); AT_PK4(p1, 0, pa2); AT_PK4(p1, 8, pa3);
#undef AT_PK4
}
__device__ __forceinline__ void at_qkt(f32x16& p0, f32x16& p1, LAS const unsigned char* Kb, int r32, int hi, const bf16x8* qr) {
    p0 = (f32x16){0.f, 0.f, 0.f, 0.f, 0.f, 0.f, 0.f, 0.f, 0.f, 0.f, 0.f, 0.f, 0.f, 0.f, 0.f, 0.f}; p1 = p0;
    LAS const unsigned char* kb[4];
#pragma unroll
    for (int dd = 0; dd < 4; ++dd) kb[dd] = Kb + r32 * 384 + (((2 * dd + hi) ^ ((r32 >> 1) & 7)) << 4);
    bf16x8 c0[2], c1[2], n0[2], n1[2];
#pragma unroll
    for (int dd = 0; dd < 2; ++dd) { LAS const unsigned char* p = kb[dd]; c0[dd] = *(LAS const bf16x8*)p; c1[dd] = *(LAS const bf16x8*)(p + 32 * 384); }
#pragma unroll
    for (int g = 0; g < 6; ++g) {
        if (g < 5) {
#pragma unroll
            for (int dd = 0; dd < 2; ++dd) { LAS const unsigned char* p = kb[2 * ((g + 1) & 1) + dd] + ((g + 1) >> 1) * 128; n0[dd] = *(LAS const bf16x8*)p; n1[dd] = *(LAS const bf16x8*)(p + 32 * 384); } }
        SBAR();
#pragma unroll
        for (int dd = 0; dd < 2; ++dd) { p0 = __builtin_amdgcn_mfma_f32_32x32x16_bf16(c0[dd], qr[2 * g + dd], p0, 0, 0, 0); p1 = __builtin_amdgcn_mfma_f32_32x32x16_bf16(c1[dd], qr[2 * g + dd], p1, 0, 0, 0); }
        SBAR();
#pragma unroll
        for (int dd = 0; dd < 2; ++dd) { c0[dd] = n0[dd]; c1[dd] = n1[dd]; } }
}
__device__ __forceinline__ void at_qkt8(f32x16& p0, f32x16& p1, LAS const unsigned char* Kb, const int (&ko)[6], int kmask, const pg8::i32x8* q8) {
#define AT_KO2(x) (ko[x] + 6080 + 192 * ((kmask >> (x)) & 1))
    p0 = (f32x16){0.f, 0.f, 0.f, 0.f, 0.f, 0.f, 0.f, 0.f, 0.f, 0.f, 0.f, 0.f, 0.f, 0.f, 0.f, 0.f}; p1 = p0;
    pg8::i32x8 a0 = pg8::cat8(*(LAS const bf16x8*)(Kb + ko[0]), *(LAS const bf16x8*)(Kb + ko[1])), a1 = pg8::cat8(*(LAS const bf16x8*)(Kb + AT_KO2(0)), *(LAS const bf16x8*)(Kb + AT_KO2(1)));
#pragma unroll
    for (int j = 0; j < 3; ++j) { pg8::i32x8 n0 = a0, n1 = a1;
        if (j < 2) { n0 = pg8::cat8(*(LAS const bf16x8*)(Kb + ko[2 * j + 2]), *(LAS const bf16x8*)(Kb + ko[2 * j + 3])); n1 = pg8::cat8(*(LAS const bf16x8*)(Kb + AT_KO2(2 * j + 2)), *(LAS const bf16x8*)(Kb + AT_KO2(2 * j + 3))); }
        SBAR(); __builtin_amdgcn_s_setprio(1);
        p0 = __builtin_amdgcn_mfma_scale_f32_32x32x64_f8f6f4(a0, q8[j], p0, 0, 0, 0, 0, 0, 0);
        p1 = __builtin_amdgcn_mfma_scale_f32_32x32x64_f8f6f4(a1, q8[j], p1, 0, 0, 0, 0, 0, 0);
        __builtin_amdgcn_s_setprio(0); SBAR(); a0 = n0; a1 = n1; }
#undef AT_KO2
}
__device__ __forceinline__ void at_pv(f32x16* o, unsigned vb0, bf16x8 pa0, bf16x8 pa1, bf16x8 pa2, bf16x8 pa3) {
#define AT_TRRD(dst, off) asm volatile("ds_read_b64_tr_b16 %0, %1 offset:%2" : "=&v"(dst) : "v"(vb0), "i"(off) : "memory")
#define AT_LOADV(L, H, d0) do { constexpr int b_ = v_rd_off(d0, 0, 0); AT_TRRD(L[0], b_); AT_TRRD(H[0], b_ + 2048); AT_TRRD(L[1], b_ + 4096); AT_TRRD(H[1], b_ + 6144); \
        AT_TRRD(L[2], b_ + 8192); AT_TRRD(H[2], b_ + 10240); AT_TRRD(L[3], b_ + 12288); AT_TRRD(H[3], b_ + 14336); } while (0)
#define AT_MMAV(L, H, d0) do { o[d0] = __builtin_amdgcn_mfma_f32_32x32x16_bf16(pa0, cat4(L[0], H[0]), o[d0], 0, 0, 0); o[d0] = __builtin_amdgcn_mfma_f32_32x32x16_bf16(pa1, cat4(L[1], H[1]), o[d0], 0, 0, 0); \
        o[d0] = __builtin_amdgcn_mfma_f32_32x32x16_bf16(pa2, cat4(L[2], H[2]), o[d0], 0, 0, 0); o[d0] = __builtin_amdgcn_mfma_f32_32x32x16_bf16(pa3, cat4(L[3], H[3]), o[d0], 0, 0, 0); } while (0)
    s16x4 la[4], ha[4], lb[4], hb[4];
    AT_LOADV(la, ha, 0); AT_LOADV(lb, hb, 1);
    asm volatile("s_waitcnt lgkmcnt(8)" ::: "memory"); SBAR(); AT_MMAV(la, ha, 0); SBAR();
    AT_LOADV(la, ha, 2);
    asm volatile("s_waitcnt lgkmcnt(8)" ::: "memory"); SBAR(); AT_MMAV(lb, hb, 1); SBAR();
    AT_LOADV(lb, hb, 3);
    asm volatile("s_waitcnt lgkmcnt(8)" ::: "memory"); SBAR(); AT_MMAV(la, ha, 2); SBAR();
    asm volatile("s_waitcnt lgkmcnt(0)" ::: "memory"); SBAR(); AT_MMAV(lb, hb, 3); SBAR();
#undef AT_MMAV
#undef AT_LOADV
#undef AT_TRRD
}
__device__ __forceinline__ pg8::i32x8 at_finishSM8(const f32x16& p0, const f32x16& p1, float alpha, float& l_reg) {
    float ps = 0.f;
#pragma unroll
    for (int r = 0; r < 16; ++r) ps += p0[r];
#pragma unroll
    for (int r = 0; r < 16; ++r) ps += p1[r];
    { auto rr = __builtin_amdgcn_permlane32_swap(__float_as_uint(ps), __float_as_uint(ps), false, false); ps = __uint_as_float(rr[0]) + __uint_as_float(rr[1]); }
    l_reg = l_reg * alpha + ps;
    int w[8];
#pragma unroll
    for (int k = 0; k < 4; ++k) { int x = __builtin_amdgcn_cvt_pk_fp8_f32(p0[4 * k], p0[4 * k + 1], 0, false); x = __builtin_amdgcn_cvt_pk_fp8_f32(p0[4 * k + 2], p0[4 * k + 3], x, true); w[k] = x;
        x = __builtin_amdgcn_cvt_pk_fp8_f32(p1[4 * k], p1[4 * k + 1], 0, false); x = __builtin_amdgcn_cvt_pk_fp8_f32(p1[4 * k + 2], p1[4 * k + 3], x, true); w[4 + k] = x; }
    return (pg8::i32x8){w[0], w[1], w[2], w[3], w[4], w[5], w[6], w[7]};
}
__device__ __forceinline__ s16x4 lds_tr8(LAS const unsigned char* p) { typedef int v2i_t __attribute__((ext_vector_type(2))); return __builtin_bit_cast(s16x4, __builtin_amdgcn_ds_read_tr8_b64_v2i32((LAS v2i_t*)p)); }
__device__ __forceinline__ void at_pv8(f32x16* o, LAS const unsigned char* const (&va)[4], pg8::i32x8 P8) {
#pragma unroll
    for (int d0 = 0; d0 < 4; ++d0) { const s16x4 t0 = lds_tr8(va[d0]), t1 = lds_tr8(va[d0] + 2048), t2 = lds_tr8(va[d0] + 4096), t3 = lds_tr8(va[d0] + 6144);
        const pg8::i32x8 B = pg8::cat8(cat4(t0, t1), cat4(t2, t3));
        asm volatile("v_mfma_f32_32x32x64_f8f6f4 %0, %1, %2, %0" : "+v"(o[d0]) : "v"(P8), "v"(B)); }
}
__device__ __forceinline__ void at_dma_tile(LAS unsigned char* lds, const unsigned char* Kt, const unsigned char* Vt, int buf, int wave, int lane) {
    unsigned lo = (unsigned)lane * 16u; asm volatile("" : "+v"(lo));
#pragma unroll
    for (int i = 0; i < 2; ++i) { const int pc = wave + 8 * i; if (pc < 12) __builtin_amdgcn_global_load_lds((const unsigned*)((Kt + pc * 1024) + lo), (LAS unsigned*)(lds + AT_K0 + buf * AT_KSZ + pc * 1024), 16, 0, 0); }
    __builtin_amdgcn_global_load_lds((const unsigned*)((Vt + wave * 1024) + lo), (LAS unsigned*)(lds + AT_V0 + buf * AT_VSZ + wave * 1024), 16, 0, 0);
}
__device__ __forceinline__ void attn_block(Frame& F, const Args& a, int bh, int qb) {
    const int lane = F.lane, wave = F.wave, r32 = lane & 31, hi = lane >> 5, b = bh >> 6, h = bh & 63;
    LAS unsigned char* lds = F.lds;
    const bf16* QRAW = (const bf16*)(a.ws + WS_BIG); const float* ROPEt = (const float*)(a.ws + WS_ROPE);
    const unsigned char* Kimg = a.ws + WS_K + (size_t)bh * NKT * AT_KSZ; const unsigned char* Vimg = a.ws + WS_V + (size_t)bh * NKT * AT_VSZ;
    bf16* ATO = (bf16*)(a.ws + WS_KNOPE);
    const int NT = 4 * qb + 5;
    at_dma_tile(lds, Kimg, Vimg, 0, wave, lane);
    const int m = b * SEQ + 256 * qb + 32 * wave + r32;
    pg8::i32x8 q8[3];
#define Q8F(word, b) __builtin_amdgcn_cvt_f32_fp8((int)(word), b)
    {   v2u qraw[12]; float ss = 0.f;
        const unsigned qo = (unsigned)(m * (AH * QKD) + h * QKD);
#pragma unroll
        for (int j = 0; j < 3; ++j)
#pragma unroll
            for (int i = 0; i < 4; ++i) { const int d = j < 2 ? 64 * j + 32 * hi + 8 * i : (i < 2 ? 128 + 16 * hi + 8 * i : 160 + 16 * hi + 8 * (i - 2));
                qraw[4 * j + i] = *(const GAS v2u*)((const GAS unsigned char*)QRAW + (qo + (unsigned)d)); }
#pragma unroll
        for (int d0 = 0; d0 < 12; ++d0) { const v2u w = qraw[d0];
            ss += (Q8F(w.x, 0) * Q8F(w.x, 0) + Q8F(w.x, 1) * Q8F(w.x, 1)) + (Q8F(w.x, 2) * Q8F(w.x, 2) + Q8F(w.x, 3) * Q8F(w.x, 3)) + (Q8F(w.y, 0) * Q8F(w.y, 0) + Q8F(w.y, 1) * Q8F(w.y, 1)) + (Q8F(w.y, 2) * Q8F(w.y, 2) + Q8F(w.y, 3) * Q8F(w.y, 3)); }
        ss += __shfl_xor(ss, 32);
        const float r = (F8_A_SCALE / 16.0f) / sqrtf(ss * (1.0f / (256.0f * QKD)) + EPS);
        LAS const float* gq = (LAS const float*)(lds + AT_GQ);
#pragma unroll
        for (int j = 0; j < 2; ++j) { int wds[8];
#pragma unroll
            for (int i = 0; i < 4; ++i) { const v2u w = qraw[4 * j + i]; const int d = 64 * j + 32 * hi + 8 * i; const f32x4 g0 = *(LAS const f32x4*)(gq + d), g1 = *(LAS const f32x4*)(gq + d + 4);
                int x = __builtin_amdgcn_cvt_pk_fp8_f32(Q8F(w.x, 0) * r * g0.x, Q8F(w.x, 1) * r * g0.y, 0, false); x = __builtin_amdgcn_cvt_pk_fp8_f32(Q8F(w.x, 2) * r * g0.z, Q8F(w.x, 3) * r * g0.w, x, true); wds[2 * i] = x;
                x = __builtin_amdgcn_cvt_pk_fp8_f32(Q8F(w.y, 0) * r * g1.x, Q8F(w.y, 1) * r * g1.y, 0, false); x = __builtin_amdgcn_cvt_pk_fp8_f32(Q8F(w.y, 2) * r * g1.z, Q8F(w.y, 3) * r * g1.w, x, true); wds[2 * i + 1] = x; }
            q8[j] = (pg8::i32x8){wds[0], wds[1], wds[2], wds[3], wds[4], wds[5], wds[6], wds[7]}; }
        {
            const float* rt = ROPEt + (size_t)m * 64; float o1[16], o2[16];
#pragma unroll
            for (int i = 0; i < 2; ++i) { const v2u w1 = qraw[8 + i], w2 = qraw[10 + i]; const int i0 = 16 * hi + 8 * i;
                const f32x4 ga = *(LAS const f32x4*)(gq + 128 + i0), gb = *(LAS const f32x4*)(gq + 128 + i0 + 4), gc = *(LAS const f32x4*)(gq + 160 + i0), gd = *(LAS const f32x4*)(gq + 160 + i0 + 4);
                const f32x4 c0 = *(const GAS f32x4*)(rt + i0), c1 = *(const GAS f32x4*)(rt + i0 + 4), s0 = *(const GAS f32x4*)(rt + 32 + i0), s1 = *(const GAS f32x4*)(rt + 32 + i0 + 4);
                const float t1[8] = {Q8F(w1.x, 0) * r * ga.x, Q8F(w1.x, 1) * r * ga.y, Q8F(w1.x, 2) * r * ga.z, Q8F(w1.x, 3) * r * ga.w, Q8F(w1.y, 0) * r * gb.x, Q8F(w1.y, 1) * r * gb.y, Q8F(w1.y, 2) * r * gb.z, Q8F(w1.y, 3) * r * gb.w};
                const float t2[8] = {Q8F(w2.x, 0) * r * gc.x, Q8F(w2.x, 1) * r * gc.y, Q8F(w2.x, 2) * r * gc.z, Q8F(w2.x, 3) * r * gc.w, Q8F(w2.y, 0) * r * gd.x, Q8F(w2.y, 1) * r * gd.y, Q8F(w2.y, 2) * r * gd.z, Q8F(w2.y, 3) * r * gd.w};
                const float cs[8] = {c0.x, c0.y, c0.z, c0.w, c1.x, c1.y, c1.z, c1.w}, sn[8] = {s0.x, s0.y, s0.z, s0.w, s1.x, s1.y, s1.z, s1.w};
#pragma unroll
                for (int e = 0; e < 8; ++e) { o1[8 * i + e] = t1[e] * cs[e] - t2[e] * sn[e]; o2[8 * i + e] = t1[e] * sn[e] + t2[e] * cs[e]; } }
            int wds[8];
#pragma unroll
            for (int k = 0; k < 4; ++k) { int x = __builtin_amdgcn_cvt_pk_fp8_f32(o1[4 * k], o1[4 * k + 1], 0, false); x = __builtin_amdgcn_cvt_pk_fp8_f32(o1[4 * k + 2], o1[4 * k + 3], x, true); wds[k] = x;
                x = __builtin_amdgcn_cvt_pk_fp8_f32(o2[4 * k], o2[4 * k + 1], 0, false); x = __builtin_amdgcn_cvt_pk_fp8_f32(o2[4 * k + 2], o2[4 * k + 3], x, true); wds[4 + k] = x; }
            q8[2] = (pg8::i32x8){wds[0], wds[1], wds[2], wds[3], wds[4], wds[5], wds[6], wds[7]}; }
    }
#undef Q8F
    int ko[6], kmask = 0;
    { int rq = r32; asm volatile("" : "+v"(rq));
#pragma unroll
      for (int j = 0; j < 3; ++j)
#pragma unroll
        for (int w = 0; w < 2; ++w) { const int c = j < 2 ? 4 * j + 2 * hi + w : 8 + hi + 2 * w; const int cp = (c + (rq >> 2)) % 12;
            ko[2 * j + w] = rq * 192 + (cp << 4); kmask |= (cp < 4 ? 1 : 0) << (2 * j + w); } }
    LAS float* wsf = (LAS float*)(lds + AT_WS + wave * 256); LAS float* li_l = wsf; LAS float* al_l = wsf + 32;
    float m_reg = -1e30f, l_reg = 0.f; f32x16 o[4];
#pragma unroll
    for (int d = 0; d < 4; ++d) o[d] = (f32x16){0.f, 0.f, 0.f, 0.f, 0.f, 0.f, 0.f, 0.f, 0.f, 0.f, 0.f, 0.f, 0.f, 0.f, 0.f, 0.f};
    const int qlo = NMETA + 256 * qb + 32 * wave;
    const int qm = qlo + r32 - 4 * hi;
    int vrow0, vsk;
    { const int q = (lane & 15) >> 1; vrow0 = ((q & 3) + 8 * (q >> 2) + 4 * hi) * 128 + 16 * ((lane >> 4) & 1) + 8 * (lane & 1); vsk = ((q >> 1) & 1) | (((q >> 2) & 1) << 1); }
    VM_WAIT(); __syncthreads();
    for (int t = 0; t < NT; ++t) {
        const int buf = t & 1;
        if (t + 1 < NT) at_dma_tile(lds, Kimg + (size_t)(t + 1) * AT_KSZ, Vimg + (size_t)(t + 1) * AT_VSZ, buf ^ 1, wave, lane);
        const int kb = 64 * t;
        if (kb <= qlo + 31) {
            f32x16 p0, p1; float mn, alpha;
            at_qkt8(p0, p1, lds + AT_K0 + buf * AT_KSZ, ko, kmask, q8);
            if (kb + 63 > qlo) at_mask(p0, p1, qm - kb);
            at_partialSM(p0, p1, m_reg, mn, alpha);
            if (__any(alpha < 1.f)) { if (hi == 0) al_l[r32] = alpha; LDS_WAIT();
#pragma unroll
                for (int d = 0; d < 4; ++d)
#pragma unroll
                    for (int r = 0; r < 16; ++r) o[d][r] *= al_l[crow(r, hi)]; }
            const pg8::i32x8 P8 = at_finishSM8(p0, p1, alpha, l_reg);
            LAS const unsigned char* vt = lds + AT_V0 + buf * AT_VSZ + vrow0;
            LAS const unsigned char* const va[4] = {vt + ((0 ^ vsk) << 5), vt + ((1 ^ vsk) << 5), vt + ((2 ^ vsk) << 5), vt + ((3 ^ vsk) << 5)};
            at_pv8(o, va, P8);
        }
        VM_WAIT(); LDS_WAIT(); __syncthreads();
    }
    asm volatile("s_nop 15\n\ts_nop 15" ::: "memory");
    if (hi == 0) li_l[r32] = l_reg;
    LDS_WAIT();
    {   LAS unsigned char* ost = lds + AT_OST + wave * 4096 + 4 * hi * 128 + r32;
#pragma unroll
        for (int r = 0; r < 16; ++r) { const float rl = (ATT_O_SCALE / F8_A_SCALE) * __builtin_amdgcn_rcpf(li_l[crow(r, hi)]);
#pragma unroll
            for (int d0 = 0; d0 < 4; d0 += 2) { const int w = __builtin_amdgcn_cvt_pk_fp8_f32(o[d0][r] * rl, o[d0 + 1][r] * rl, 0, false);
                ost[((r & 3) + 8 * (r >> 2)) * 128 + d0 * 32] = (unsigned char)w; ost[((r & 3) + 8 * (r >> 2)) * 128 + d0 * 32 + 32] = (unsigned char)(w >> 8); } }
        LDS_WAIT();
        unsigned ob = (unsigned)((b * SEQ + 256 * qb + 32 * wave + (lane >> 3)) * (AH * VHD) + h * VHD + 16 * (lane & 7));
        asm volatile("" : "+v"(ob));
#pragma unroll
        for (int j = 0; j < 4; ++j) { const v4u x = *(LAS const v4u*)(lds + AT_OST + wave * 4096 + ((lane >> 3) + 8 * j) * 128 + 16 * (lane & 7));
            *(GAS v4u*)((GAS unsigned char*)ATO + (ob + (unsigned)(8 * j * (AH * VHD)))) = x; } }
    LDS_WAIT(); __syncthreads();
}
__device__ __forceinline__ void attn_phase(Frame& F, const Args& a) {
    if (F.tid < QKD) ((LAS float*)(F.lds + AT_GQ))[F.tid] = ((const float*)a.in[21])[F.tid];
    LDS_WAIT(); __syncthreads();
    for (int n = F.vcu; n < 2048; n += F.G) { const int st = n >> 8, cu = n & 255, xcd = cu >> 5, j = cu & 31; const int bh = 32 * xcd + 4 * st + (j >> 3), p = j & 7;
        attn_block(F, a, bh, 15 - p); attn_block(F, a, bh, p); }
}

__device__ __forceinline__ void meta_in_phase(Frame& F, const Args& a) {
    const bf16* XN = (const bf16*)(a.ws + WS_XN); const bf16* WT = (const bf16*)(a.ws + WS_W_IN); bf16* PROJ = (bf16*)(a.ws + WS_BIG); float* GATES = (float*)(a.ws + WS_GATES);
    const int lane = F.lane, r = lane & 15, q4 = lane >> 4;
    for (int t = F.vcu; t < 769 + 1024; t += F.G) { f32x4 acc[1];
        if (t < 769) { skinny_wg<1>(F, XN + (size_t)MR * DM, WT + (size_t)(16 * t) * DM, WT, DM, acc);
            if (F.wave == 0) {
                if (t < 768) { v2u w; w.x = pk2(acc[0][0], acc[0][1]); w.y = pk2(acc[0][2], acc[0][3]); *(GAS v2u*)(PROJ + (size_t)(MR + r) * NPROJ + 16 * t + 4 * q4) = w; }
                else {
#pragma unroll
                    for (int j = 0; j < 4; ++j) GATES[(size_t)(4 * q4 + j) * MT + MR + r] = acc[0][j]; } } }
        else { const int tt = t - 769;
            skinny_wg<1>(F, WT + (size_t)NPROJ * DM, XN + (size_t)(16 * tt) * DM, XN, DM, acc);
            if (F.wave == 0) *(GAS f32x4*)(GATES + (size_t)r * MT + 16 * tt + 4 * q4) = acc[0]; }
    }
}
__device__ __forceinline__ void meta_out_phase(Frame& F, const Args& a) {
    const bf16* A2 = (const bf16*)(a.ws + WS_XN); const bf16* WT = (const bf16*)(a.ws + WS_W_OUT); float* HM = (float*)(a.ws + WS_HMETA); const float* mt = (const float*)a.in[2];
    const int lane = F.lane, r = lane & 15, q4 = lane >> 4;
    for (int t = F.vcu; t < 256; t += F.G) { f32x4 acc[1]; skinny_wg<1>(F, A2 + (size_t)MR * DM, WT + (size_t)(16 * t) * DM, WT, DM, acc);
        if (F.wave == 0) { const size_t o = (size_t)r * DM + 16 * t + 4 * q4; *(GAS f32x4*)(HM + o) = *(const GAS f32x4*)(mt + o) + acc[0]; } }
}
__device__ __forceinline__ void meta_gu_phase(Frame& F, const Args& a) {
    const bf16* XN = (const bf16*)(a.ws + WS_XN); const bf16* WT = (const bf16*)(a.ws + WS_W_GU0); bf16* ACT = (bf16*)(a.ws + WS_BIG);
    const int lane = F.lane, r = lane & 15, q4 = lane >> 4;
    for (int t = F.vcu; t < DFF / 16; t += F.G) { const int c0 = 16 * t, j = c0 >> 7, i = c0 & 127; f32x4 gu[2];
        skinny_wg<2>(F, XN + (size_t)MR * DM, WT + (size_t)(256 * j + i) * DM, WT + (size_t)(256 * j + 128 + i) * DM, DM, gu);
        if (F.wave == 0) { v2u w; w.x = pk2(pg8::silu_mul(gu[0][0], gu[1][0]), pg8::silu_mul(gu[0][1], gu[1][1])); w.y = pk2(pg8::silu_mul(gu[0][2], gu[1][2]), pg8::silu_mul(gu[0][3], gu[1][3]));
            *(GAS v2u*)(ACT + (size_t)(MR + r) * DFF + c0 + 4 * q4) = w; } }
}
__device__ __forceinline__ void meta_down_phase(Frame& F, const Args& a) {
    const bf16* ACT = (const bf16*)(a.ws + WS_BIG); const bf16* WT = (const bf16*)(a.ws + WS_W_DN0); float* HM = (float*)(a.ws + WS_HMETA);
    const int lane = F.lane, r = lane & 15, q4 = lane >> 4;
    for (int t = F.vcu; t < 256; t += F.G) { f32x4 acc[1]; skinny_wg<1>(F, ACT + (size_t)MR * DFF, WT + (size_t)(16 * t) * DFF, WT, DFF, acc);
        if (F.wave == 0) { const size_t o = (size_t)r * DM + 16 * t + 4 * q4; *(GAS f32x4*)(HM + o) = *(const GAS f32x4*)(HM + o) + acc[0]; } }
}
__device__ __forceinline__ void meta_kvq_phase(Frame& F, const Args& a) {
    const bf16* XN = (const bf16*)(a.ws + WS_XN); const bf16* WT = (const bf16*)(a.ws + WS_W_KVQ); float* LAT = (float*)(a.ws + WS_LAT);
    const int lane = F.lane, r = lane & 15, q4 = lane >> 4;
    for (int t = F.vcu; t < 36; t += F.G) { f32x4 acc[1]; skinny_wg<1>(F, XN + (size_t)MR * DM, WT + (size_t)(16 * t) * DM, WT, DM, acc);
        if (F.wave == 0) *(GAS f32x4*)(LAT + (size_t)(MR + r) * NKVQ + 16 * t + 4 * q4) = acc[0]; }
}
__device__ __forceinline__ void meta_kvup_phase(Frame& F, const Args& a) {
    const bf16* CK = (const bf16*)(a.ws + WS_CKVN); const bf16* WT = (const bf16*)(a.ws + WS_W_KVUP); bf16* KN = (bf16*)(a.ws + WS_KNOPE); unsigned char* Vimg = a.ws + WS_V;
    const int lane = F.lane, r = lane & 15, q4 = lane >> 4;
    for (int t = F.vcu; t < 1024; t += F.G) { f32x4 acc[1]; skinny_wg<1>(F, CK + (size_t)MR * KVLORA, WT + (size_t)(16 * t) * KVLORA, WT, KVLORA, acc);
        if (F.wave == 0) { const int n = 16 * t + 4 * q4, hd = n >> 8, wi = n & 255; v2u w; w.x = pk2(acc[0][0], acc[0][1]); w.y = pk2(acc[0][2], acc[0][3]);
            if (wi < 128) *(GAS v2u*)(KN + (size_t)(MR + r) * 8192 + hd * 128 + wi) = w;
            else { const int c0 = wi - 128; int x = __builtin_amdgcn_cvt_pk_fp8_f32(acc[0][0] * 16.f, acc[0][1] * 16.f, 0, false); x = __builtin_amdgcn_cvt_pk_fp8_f32(acc[0][2] * 16.f, acc[0][3] * 16.f, x, true);
                for (int bb = 0; bb < BATCH; ++bb) *(GAS unsigned*)(Vimg + ((size_t)((bb * AH + hd) * NKT)) * 8192 + pg8::v_img_off8(r, c0)) = (unsigned)x; } } }
}

constexpr int NPH = 18;
__global__ void __launch_bounds__(NTHR, 2) mk_fwd(Args args) {
    extern __shared__ __attribute__((aligned(16))) unsigned char lds_raw[];
    Frame F;
    F.lds = (LAS unsigned char*)lds_raw;
    F.tid = threadIdx.x; F.lane = F.tid & 63; F.wave = __builtin_amdgcn_readfirstlane(F.tid >> 6);
    F.G = gridDim.x; { const int bx = blockIdx.x; F.vcu = (F.G % 8 == 0) ? (bx % 8) * (F.G / 8) + bx / 8 : bx; }
    F.gw = F.vcu * NWAVES + F.wave; F.ngw = F.G * NWAVES;
    volatile LAS unsigned* MISC = (volatile LAS unsigned*)(F.lds + MISC_OFF);
    for (int u = F.tid; u < (LDS_BYTES - LDSCTL_OFF) / 4; u += NTHR) ((LAS unsigned*)(F.lds + LDSCTL_OFF))[u] = 0u;
    __syncthreads();
    unsigned char* ws = args.ws;
    const int lo = args.ph_lo, hi = args.ph_hi;
    const bool one_launch = (hi - lo) > 1;
    XcdBarrier bar; bar.bar = (unsigned*)(ws + WS_CTL); bar.x = 0; bar.st = nullptr;
    if (one_launch) bar = xcd_barrier_post((unsigned*)(ws + WS_CTL), MISC + 8);
    bar.wave = F.wave;
#ifndef MK_PHASES
#define MK_PHASES 0x3ffff
#endif
#define IN(k) ((((MK_PHASES) >> (k)) & 1) && lo <= (k) && (k) < hi)
#define SEAM(k) do { if (IN((k) + 1)) xcd_barrier(bar); } while (0)
    pg8::f16_t* H = (pg8::f16_t*)(ws + WS_H16);
#define REFRESH() do { F.lane = (int)__builtin_amdgcn_mbcnt_hi(~0u, __builtin_amdgcn_mbcnt_lo(~0u, 0u)); F.tid = F.wave * 64 + F.lane; } while (0)
    pg8::f16_t* Hw = args.dry ? (pg8::f16_t*)(ws + WS_END) : H;

    if (IN(0)) { REFRESH(); p0_prologue(F, args); SEAM(0); }
    if (IN(1)) { REFRESH();
        { pg8::Gemm g{(const bf16*)(ws + WS_XN), (const bf16*)(ws + WS_W_IN), MR, 8192, DM}; pg8::StaticOrder S; S.init(MR, 8192, F.G, (int)blockIdx.x);
          pg8::EpiBf16 E{(bf16*)(ws + WS_BIG), NPROJ};
          pg8::gemm_phase<pg8::EpiBf16, pg8::StaticOrder, true, true>(F.lds, g, S, E, F.wave); }
        { pg8::Gemm g{(const bf16*)(ws + WS_HH), (const bf16*)(ws + WS_W_INO8), MR, DM, DM / 2, 0x77777777, 0x7B7B7B7B}; pg8::StaticOrder S; S.init(MR, DM, F.G, (int)blockIdx.x);
          pg8::EpiBf16 E{(bf16*)(ws + WS_BIG) + 8192, NPROJ};
          pg8::gemm_phase<pg8::EpiBf16, pg8::StaticOrder, true, true, true>(F.lds, g, S, E, F.wave); }
        meta_in_phase(F, args); SEAM(1); }
    if (IN(2)) { REFRESH(); for (int u = F.vcu; u < 256; u += F.G) mlstm_unit(F, args, u); SEAM(2); }
    if (IN(3)) { REFRESH(); gate_norm_phase(F, args); SEAM(3); }
    if (IN(4)) { REFRESH();
        pg8::Gemm g{(const bf16*)(ws + WS_XN), (const bf16*)(ws + WS_W_OUT), MR, DM, DM}; pg8::StaticOrder S; S.init(MR, DM, F.G, (int)blockIdx.x);
        pg8::EpiRes<float, pg8::f16_t> E{(const float*)args.in[0], H, DM};
        pg8::gemm_phase<pg8::EpiRes<float, pg8::f16_t>, pg8::StaticOrder, true, true>(F.lds, g, S, E, F.wave);
        meta_out_phase(F, args); SEAM(4); }
    if (IN(5)) { REFRESH(); norm_phase_h(F, H, (const float*)(ws + WS_HMETA), (bf16*)(ws + WS_XN), nullptr, MT, 0); SEAM(5); }
    if (IN(6)) { REFRESH();
        pg8::Gemm g{(const bf16*)(ws + WS_XN), (const bf16*)(ws + WS_W_GU0), MR, NGU, DM}; pg8::StaticOrder S; S.init(MR, NGU, F.G, (int)blockIdx.x);
        pg8::EpiSwiglu E{(bf16*)(ws + WS_BIG), DFF};
        pg8::gemm_phase<pg8::EpiSwiglu, pg8::StaticOrder, true, true>(F.lds, g, S, E, F.wave);
        p0_deferred(F, args, (MR / 256) * (NGU / 256), P0_NITEMS - P0_DEFER_A - P0_DEFER_B, P0_DEFER_A); __syncthreads();
        meta_gu_phase(F, args); SEAM(6); }
    if (IN(7)) { REFRESH();
        pg8::Gemm g{(const bf16*)(ws + WS_BIG), (const bf16*)(ws + WS_W_DN0), MR, DM, DFF}; pg8::StaticOrder S; S.init(MR, DM, F.G, (int)blockIdx.x);
        pg8::EpiRes<pg8::f16_t, pg8::f16_t> E{H, Hw, DM};
        pg8::gemm_phase<pg8::EpiRes<pg8::f16_t, pg8::f16_t>, pg8::StaticOrder, true, true>(F.lds, g, S, E, F.wave);
        meta_down_phase(F, args); SEAM(7); }
    if (IN(8)) { REFRESH(); norm_phase_h(F, H, (const float*)(ws + WS_HMETA), (bf16*)(ws + WS_XN), ws + WS_XN, MT, 2); SEAM(8); }
    if (IN(9)) { REFRESH();
        pg8::Gemm g{(const bf16*)(ws + WS_XN), (const bf16*)(ws + WS_W_KVQ8), MR, NKVQ, DM / 2, 0x77777777, 0x7B7B7B7B}; pg8::StaticOrder S; S.init(MR, NKVQ, F.G, (int)blockIdx.x);
        pg8::EpiF16 E{(pg8::f16_t*)(ws + WS_LAT), NKVQ};
        pg8::gemm_phase<pg8::EpiF16, pg8::StaticOrder, true, true, true>(F.lds, g, S, E, F.wave);
        meta_kvq_phase(F, args); SEAM(9); }
    if (IN(10)) { REFRESH(); latent_norm_phase(F, args); SEAM(10); }
    if (IN(11)) { REFRESH();
        { pg8::Gemm g{(const bf16*)(ws + WS_CKVN), (const bf16*)(ws + WS_W_KVUP8), MR, AH * 256, KVLORA / 2, 0x77777777, 0x7B7B7B7B}; pg8::StaticOrder S; S.init(MR, AH * 256, F.G, (int)blockIdx.x);
          pg8::EpiKvUpK E{ws + WS_K, (bf16*)(ws + WS_V), (const float*)(ws + WS_PRE), (const float*)(ws + WS_SSR), (const float*)args.in[16], (LAS float*)(F.lds + EPI_RED_OFF)};
          pg8::gemm_phase<pg8::EpiKvUpK, pg8::StaticOrder, true, true, true>(F.lds, g, S, E, F.wave); }
        { pg8::Gemm g{(const bf16*)(ws + WS_CQN), (const bf16*)(ws + WS_W_UQ8), MR, AH * QKD, QLORA / 2, 0x77777777, 0x7B7B7B7B}; pg8::StaticOrder S; S.init(MR, AH * QKD, F.G, (int)blockIdx.x);
          pg8::EpiF8 E{ws + WS_BIG, AH * QKD};
          pg8::gemm_phase<pg8::EpiF8, pg8::StaticOrder, true, true, true>(F.lds, g, S, E, F.wave); }
        meta_kvup_phase(F, args); SEAM(11); }
    if (IN(12)) { REFRESH(); k_final_phase(F, args); SEAM(12); }
    if (IN(13)) { REFRESH(); attn_phase(F, args); SEAM(13); }
    if (IN(14)) { REFRESH();
        pg8::Gemm g{(const bf16*)(ws + WS_KNOPE), (const bf16*)(ws + WS_W_O), MR, DM, AH * VHD / 2, 0x77777777, 0x7B7B7B7B}; pg8::StaticOrder S; S.init(MR, DM, F.G, (int)blockIdx.x);
        pg8::EpiRes<pg8::f16_t, pg8::f16_t> E{H, Hw, DM};
        pg8::gemm_phase<pg8::EpiRes<pg8::f16_t, pg8::f16_t>, pg8::StaticOrder, true, true, true>(F.lds, g, S, E, F.wave); SEAM(14); }
    if (IN(15)) { REFRESH(); norm_phase_h(F, H, (const float*)(ws + WS_HMETA), (bf16*)(ws + WS_XN), nullptr, MR, 0); SEAM(15); }
    if (IN(16)) { REFRESH();
        pg8::Gemm g{(const bf16*)(ws + WS_XN), (const bf16*)(ws + WS_W_GU1), MR, NGU, DM}; pg8::StaticOrder S; S.init(MR, NGU, F.G, (int)blockIdx.x);
        pg8::EpiSwiglu E{(bf16*)(ws + WS_BIG), DFF};
        pg8::gemm_phase<pg8::EpiSwiglu, pg8::StaticOrder, true, true>(F.lds, g, S, E, F.wave);
        p0_deferred(F, args, (MR / 256) * (NGU / 256), P0_NITEMS - P0_DEFER_B, P0_DEFER_B); SEAM(16); }
    if (IN(17)) { REFRESH();
        pg8::Gemm g{(const bf16*)(ws + WS_BIG), (const bf16*)(ws + WS_W_DN1), MR, DM, DFF}; pg8::StaticOrder S; S.init(MR, DM, F.G, (int)blockIdx.x);
        pg8::EpiRes<pg8::f16_t, float> E{H, args.dry ? (float*)(ws + WS_END) : args.out, DM};
        pg8::gemm_phase<pg8::EpiRes<pg8::f16_t, float>, pg8::StaticOrder, true, true>(F.lds, g, S, E, F.wave); }
#undef REFRESH
#undef IN
#undef SEAM
}

__global__ void mk_dump(const unsigned char* src, int is_bf16, size_t n_src, float* out, size_t n_out) {
    for (size_t i = (size_t)blockIdx.x * blockDim.x + threadIdx.x; i < n_out; i += (size_t)gridDim.x * blockDim.x) { const size_t j = i % n_src;
        out[i] = is_bf16 ? bf2f(((const unsigned short*)src)[j]) : ((const float*)src)[j]; }
}
extern "C" void kernel_launch(void* const* d_in, const int* in_sizes, int n_in, void* d_out, int out_size, void* d_ws, size_t ws_size, hipStream_t stream) {
    static int grid = 0;
    if (grid == 0) {
        if (n_in != 23 || out_size != MR * DM || ws_size < WS_END) { fprintf(stderr, "kernel_launch: unexpected shapes (n_in %d, out %d, ws %zu < %zu)\n", n_in, out_size, ws_size, (size_t)WS_END); grid = -1; return; }
        int dev = 0, cus = 0, per_cu = 0;
        if (hipGetDevice(&dev) != hipSuccess || hipDeviceGetAttribute(&cus, hipDeviceAttributeMultiprocessorCount, dev) != hipSuccess) { grid = -1; return; }
        if (hipFuncSetAttribute((const void*)mk_fwd, hipFuncAttributeMaxDynamicSharedMemorySize, LDS_BYTES) != hipSuccess) { fprintf(stderr, "kernel_launch: hipFuncSetAttribute failed\n"); grid = -1; return; }
        if (hipOccupancyMaxActiveBlocksPerMultiprocessor(&per_cu, (const void*)mk_fwd, NTHR, LDS_BYTES) != hipSuccess || per_cu < 1) fprintf(stderr, "kernel_launch: occupancy query reports %d\n", per_cu);
        (void)hipGetLastError();
        grid = cus;
    }
    if (grid < 0) return;
    (void)hipMemsetAsync((char*)d_ws + WS_CTL, 0, CTL_ZERO_BYTES, stream);
    Args a{};
    for (int i = 0; i < 23; ++i) a.in[i] = d_in[i];
    a.out = (float*)d_out; a.ws = (unsigned char*)d_ws;
#if defined(MK_STOP_AFTER)
    for (int p = 0; p <= MK_STOP_AFTER; ++p) { a.ph_lo = p; a.ph_hi = p + 1; hipLaunchKernelGGL(mk_fwd, dim3(grid), dim3(NTHR), LDS_BYTES, stream, a); }
#if defined(MK_DUMP_OFF)
    hipLaunchKernelGGL(mk_dump, dim3(2048), dim3(256), 0, stream, (const unsigned char*)d_ws + (size_t)(MK_DUMP_OFF) * MiB, (int)(MK_DUMP_BF16), (size_t)(MK_DUMP_N), (float*)d_out, (size_t)out_size);
#endif
#elif MK_N_LAUNCHES == 1
    a.ph_lo = 0; a.ph_hi = NPH;
    hipLaunchKernelGGL(mk_fwd, dim3(grid), dim3(NTHR), LDS_BYTES, stream, a);
#else
    for (int p = 0; p < NPH; ++p) { a.ph_lo = p; a.ph_hi = p + 1;
#if defined(MK_REPEAT_PHASE)
        if (((MK_REPEAT_PHASE) >> p) & 1) { a.dry = 1; for (int rr = 0; rr < (MK_REPEAT_N); ++rr) hipLaunchKernelGGL(mk_fwd, dim3(grid), dim3(NTHR), LDS_BYTES, stream, a); a.dry = 0; }
#endif
        hipLaunchKernelGGL(mk_fwd, dim3(grid), dim3(NTHR), LDS_BYTES, stream, a);
#if defined(MK_REPEAT_PHASE)
#endif
    }
#endif
}
```
